# Optimizing an MI355X kernel written in HIP

```python
import jax, jax.numpy as jnp
from jax import lax
import numpy as np

D_MODEL = 1024
BATCH = 8
SEQ = 8192
DEPTH = 2

CHUNK = 64
N_META = 16
A_HEADS = 8
A_HEAD_DIM = 64
A_WIDTH = A_HEADS * A_HEAD_DIM
W_LORA = 64
A_LORA = 64
G_LORA = 128
A_IN = 3 * A_WIDTH + W_LORA + A_LORA + G_LORA
A_SPLITS = [A_WIDTH, 2 * A_WIDTH, 3 * A_WIDTH, 3 * A_WIDTH + W_LORA, 3 * A_WIDTH + W_LORA + A_LORA]
LNX_EPS = 64e-5
B_WIDTH = 512
CONV_WIDTH = 31
C_WIDTH = 512
POOL_WINDOWS = (2, 4, 8, 16)
C_GROUPS = len(POOL_WINDOWS)
C_GROUP_DIM = C_WIDTH // C_GROUPS
N_BRANCH = 3
IN_WIDTH = A_IN + 2 * B_WIDTH + C_WIDTH + N_BRANCH * D_MODEL
IN_SPLITS = [A_IN, A_IN + 2 * B_WIDTH, A_IN + 2 * B_WIDTH + C_WIDTH]
D_FF = 2816
N_EXPERTS = 8
TOP_K = 2
MOE_BLOCK = 256
N_DENSE = (DEPTH + 1) // 2
N_MOE = DEPTH // 2
RMS_EPS = 1e-6
LN_EPS = 1e-5

kernel_name = 'hybrid_stream_encoder_block'


def rmsnorm(x, g):
    xf = x.astype(jnp.float32)
    y = xf * lax.rsqrt(jnp.mean(xf * xf, -1, keepdims=True) + RMS_EPS)
    return (y * g.astype(jnp.float32)).astype(x.dtype)


def shift_one(z):
    return jnp.pad(z, ((0, 0), (1, 0), (0, 0)))[:, :-1]


def _wkv_step(S, inp):
    r, dec, k, v, a_vec, b_vec = inp
    Sa = jnp.einsum('bhvk,bhk->bhv', S, a_vec)
    S = S * dec[:, :, None, :] + Sa[..., None] * b_vec[:, :, None, :] + v[..., None] * k[:, :, None, :]
    return S, jnp.einsum('bhvk,bhk->bhv', S, r)


def _wkv_scan(S, seq):
    return lax.scan(_wkv_step, S, seq)


def wkv7(r, dec, k, v, a_vec, b_vec):
    seq = tuple(jnp.moveaxis(t.astype(jnp.float32), 1, 0) for t in (r, dec, k, v, a_vec, b_vec))
    bn, nh, nd = r.shape[0], r.shape[2], r.shape[3]
    S0 = jnp.zeros((bn, nh, nd, nd), jnp.float32)
    S1, y_meta = _wkv_scan(S0, tuple(t[:N_META] for t in seq))
    frames = tuple(t[N_META:].reshape((-1, CHUNK) + t.shape[1:]) for t in seq)
    _, y_frames = lax.scan(_wkv_scan, S1, frames)
    y = jnp.concatenate([y_meta, y_frames.reshape((-1,) + y_meta.shape[1:])], 0)
    return jnp.moveaxis(y, 0, 1)


def rwkv7_mixer(z, mu, w0, w2, a0, a2, g2, k_k, k_a, r_k, lnx_w, lnx_b):
    bn, L, _ = z.shape
    z = z + (shift_one(z) - z) * mu
    r, k, v, wd, ad, gd = jnp.split(z, A_SPLITS, -1)
    w_log = -jax.nn.softplus(-(w0 + jnp.tanh(wd) @ w2)) - 0.5
    dec = jnp.exp(-jnp.exp(w_log.astype(jnp.float32)))
    a = jax.nn.sigmoid(a0 + ad @ a2)
    g = jax.nn.sigmoid(gd) @ g2
    hs = lambda t: t.reshape(bn, L, A_HEADS, A_HEAD_DIM)
    kk = hs(k * k_k).astype(jnp.float32)
    kk = kk / jnp.maximum(jnp.sqrt(jnp.sum(kk * kk, -1, keepdims=True)), 1e-12)
    k = k * (1.0 + (a - 1.0) * k_a)
    r_h, k_h, v_h, a_h = hs(r), hs(k), hs(v), hs(a)
    y = wkv7(r_h, hs(dec), k_h, v_h, -kk, kk * a_h.astype(jnp.float32))
    mean = jnp.mean(y, -1, keepdims=True)
    var = jnp.mean(jnp.square(y - mean), -1, keepdims=True)
    y = ((y - mean) * lax.rsqrt(var + LNX_EPS)).reshape(bn, L, A_WIDTH)
    y = y * lnx_w.astype(jnp.float32) + lnx_b.astype(jnp.float32)
    bonus = jnp.sum((r_h * k_h * r_k).astype(jnp.float32), -1, keepdims=True) * v_h.astype(jnp.float32)
    y = (y + bonus.reshape(bn, L, A_WIDTH)) * g.astype(jnp.float32)
    return y.astype(z.dtype)


def conformer_conv(z, conv_w, conv_b, ln_g, ln_b):
    c = z[..., :B_WIDTH] * jax.nn.sigmoid(z[..., B_WIDTH:])
    c = lax.conv_general_dilated(c, conv_w.astype(c.dtype), window_strides=(1,),
                                 padding=[(CONV_WIDTH - 1, 0)],
                                 dimension_numbers=('NWC', 'WIO', 'NWC'),
                                 feature_group_count=B_WIDTH) + conv_b
    cf = c.astype(jnp.float32)
    mean = jnp.mean(cf, -1, keepdims=True)
    var = jnp.mean(jnp.square(cf - mean), -1, keepdims=True)
    cf = (cf - mean) * lax.rsqrt(var + LN_EPS) * ln_g.astype(jnp.float32) + ln_b.astype(jnp.float32)
    return jax.nn.silu(cf).astype(z.dtype)


def multiscale_pool(z, pool_w, pool_scale):
    bn, L, _ = z.shape
    zg = z.reshape(bn, L, C_GROUPS, C_GROUP_DIM).astype(jnp.float32)
    cs = jnp.cumsum(zg, axis=1)
    pos = jnp.arange(1, L + 1, dtype=jnp.float32)
    means = []
    for j, w in enumerate(POOL_WINDOWS):
        c = cs[:, :, j]
        prev = jnp.pad(c, ((0, 0), (w, 0), (0, 0)))[:, :L]
        means.append((c - prev) / jnp.minimum(pos, w)[None, :, None])
    pooled = (jnp.stack(means, 2) - zg).astype(z.dtype)
    y = jnp.einsum('blgc,gcd->blgd', pooled, pool_w).reshape(bn, L, C_WIDTH)
    return y * pool_scale


def swiglu(h, w_gate, w_up, w_down):
    return (jax.nn.silu(h @ w_gate) * (h @ w_up)) @ w_down


def moe_swiglu(h, router_w, router_b, e_gate, e_up, e_down):
    bn, L, d = h.shape
    t = h.reshape(-1, d)
    T = t.shape[0]
    logits = (t @ router_w).astype(jnp.float32) + router_b.astype(jnp.float32)
    top_l, top_e = lax.top_k(logits, TOP_K)
    gates = jax.nn.softmax(top_l, -1)
    flat_e = top_e.reshape(-1)
    flat_tok = jnp.repeat(jnp.arange(T, dtype=jnp.int32), TOP_K)
    order = jnp.argsort(flat_e)
    se, stok, sg = flat_e[order], flat_tok[order], gates.reshape(-1)[order]
    counts = jnp.bincount(flat_e, length=N_EXPERTS)
    padded = (counts + MOE_BLOCK - 1) // MOE_BLOCK * MOE_BLOCK
    start_sorted = jnp.cumsum(counts) - counts
    pad_end = jnp.cumsum(padded)
    start_pad = pad_end - padded
    dest = start_pad[se] + jnp.arange(T * TOP_K, dtype=jnp.int32) - start_sorted[se]
    n_blocks = (T * TOP_K + N_EXPERTS * (MOE_BLOCK - 1) + MOE_BLOCK - 1) // MOE_BLOCK
    slot_tok = jnp.full((n_blocks * MOE_BLOCK,), T, jnp.int32).at[dest].set(stok)
    block_e = jnp.minimum(jnp.searchsorted(pad_end, jnp.arange(n_blocks) * MOE_BLOCK, side='right'), N_EXPERTS - 1)
    t_pad = jnp.concatenate([t, jnp.zeros((1, d), t.dtype)], 0)

    def run_block(args):
        tok, e = args
        xb = t_pad[tok]
        return swiglu(xb, e_gate[e], e_up[e], e_down[e])

    y_slots = lax.map(run_block, (slot_tok.reshape(n_blocks, MOE_BLOCK), block_e)).reshape(-1, d)
    y = jax.ops.segment_sum(y_slots[dest] * sg[:, None].astype(y_slots.dtype), stok, num_segments=T)
    return y.reshape(bn, L, d)


def setup_inputs(seed: int = 0) -> dict:
    key = jax.random.key(seed)
    ks = iter(jax.random.split(key, 48))
    f32 = jnp.float32
    nrm = lambda shape, scale: scale * jax.random.normal(next(ks), shape, f32)
    return {
        'x': nrm((BATCH, SEQ, D_MODEL), 1.0),
        'meta_tokens': nrm((N_META, D_MODEL), 1.0),
        'mix_norm_g': 1.0 + nrm((DEPTH, D_MODEL), 0.05),
        'w_in': nrm((DEPTH, D_MODEL, IN_WIDTH), D_MODEL ** -0.5),
        'gate_b': nrm((DEPTH, N_BRANCH * D_MODEL), 0.1),
        'a_mu': jax.random.uniform(next(ks), (DEPTH, A_IN), f32),
        'a_w0': -2.0 + nrm((DEPTH, A_WIDTH), 1.0),
        'a_w2': nrm((DEPTH, W_LORA, A_WIDTH), 0.5 * W_LORA ** -0.5),
        'a_a0': nrm((DEPTH, A_WIDTH), 0.5),
        'a_a2': nrm((DEPTH, A_LORA, A_WIDTH), 0.5 * A_LORA ** -0.5),
        'a_g2': nrm((DEPTH, G_LORA, A_WIDTH), G_LORA ** -0.5),
        'a_kk': 0.85 + nrm((DEPTH, A_WIDTH), 0.05),
        'a_ka': 1.0 + nrm((DEPTH, A_WIDTH), 0.05),
        'a_rk': nrm((DEPTH, A_HEADS, A_HEAD_DIM), 0.1),
        'a_lnx_w': 1.0 + nrm((DEPTH, A_WIDTH), 0.05),
        'a_lnx_b': nrm((DEPTH, A_WIDTH), 0.01),
        'b_conv_w': nrm((DEPTH, CONV_WIDTH, 1, B_WIDTH), CONV_WIDTH ** -0.5),
        'b_conv_b': nrm((DEPTH, B_WIDTH), 0.01),
        'b_ln_g': 1.0 + nrm((DEPTH, B_WIDTH), 0.05),
        'b_ln_b': nrm((DEPTH, B_WIDTH), 0.01),
        'c_pool_w': nrm((DEPTH, C_GROUPS, C_GROUP_DIM, C_GROUP_DIM), C_GROUP_DIM ** -0.5),
        'c_scale': 1.0 + nrm((DEPTH, C_WIDTH), 0.05),
        'proj_a': nrm((DEPTH, A_WIDTH, D_MODEL), A_WIDTH ** -0.5),
        'proj_b': nrm((DEPTH, B_WIDTH, D_MODEL), B_WIDTH ** -0.5),
        'proj_c': nrm((DEPTH, C_WIDTH, D_MODEL), C_WIDTH ** -0.5),
        'w_out': nrm((DEPTH, D_MODEL, D_MODEL), 0.5 * D_MODEL ** -0.5),
        'ffn_norm_g': 1.0 + nrm((DEPTH, D_MODEL), 0.05),
        'ffn_gate': nrm((N_DENSE, D_MODEL, D_FF), D_MODEL ** -0.5),
        'ffn_up': nrm((N_DENSE, D_MODEL, D_FF), D_MODEL ** -0.5),
        'ffn_down': nrm((N_DENSE, D_FF, D_MODEL), 0.5 * D_FF ** -0.5),
        'router_w': nrm((N_MOE, D_MODEL, N_EXPERTS), D_MODEL ** -0.5),
        'router_b': nrm((N_MOE, N_EXPERTS), 0.01),
        'exp_gate': nrm((N_MOE, N_EXPERTS, D_MODEL, D_FF), D_MODEL ** -0.5),
        'exp_up': nrm((N_MOE, N_EXPERTS, D_MODEL, D_FF), D_MODEL ** -0.5),
        'exp_down': nrm((N_MOE, N_EXPERTS, D_FF, D_MODEL), 0.5 * D_FF ** -0.5),
        'final_norm_g': 1.0 + nrm((D_MODEL,), 0.05),
    }


def reference(x, meta_tokens, mix_norm_g, w_in, gate_b, a_mu, a_w0, a_w2, a_a0, a_a2, a_g2,
              a_kk, a_ka, a_rk, a_lnx_w, a_lnx_b, b_conv_w, b_conv_b, b_ln_g, b_ln_b,
              c_pool_w, c_scale, proj_a, proj_b, proj_c, w_out, ffn_norm_g, ffn_gate, ffn_up,
              ffn_down, router_w, router_b, exp_gate, exp_up, exp_down, final_norm_g):
    bn = x.shape[0]
    meta = jnp.broadcast_to(meta_tokens[None].astype(x.dtype), (bn, N_META, D_MODEL))
    h = jnp.concatenate([meta, x], 1)
    for i in range(DEPTH):
        n = rmsnorm(h, mix_norm_g[i])
        u = n @ w_in[i]
        z_a, z_b, z_c, z_g = jnp.split(u, IN_SPLITS, -1)
        y_a = rwkv7_mixer(z_a, a_mu[i], a_w0[i], a_w2[i], a_a0[i], a_a2[i], a_g2[i],
                          a_kk[i], a_ka[i], a_rk[i], a_lnx_w[i], a_lnx_b[i])
        y_b = conformer_conv(z_b, b_conv_w[i], b_conv_b[i], b_ln_g[i], b_ln_b[i])
        y_c = multiscale_pool(z_c, c_pool_w[i], c_scale[i])
        g_a, g_b, g_c = jnp.split(jax.nn.sigmoid(z_g + gate_b[i]), N_BRANCH, -1)
        merged = g_a * (y_a @ proj_a[i]) + g_b * (y_b @ proj_b[i]) + g_c * (y_c @ proj_c[i])
        h = h + merged @ w_out[i]
        n = rmsnorm(h, ffn_norm_g[i])
        if i % 2 == 0:
            f = swiglu(n, ffn_gate[i // 2], ffn_up[i // 2], ffn_down[i // 2])
        else:
            f = moe_swiglu(n, router_w[i // 2], router_b[i // 2], exp_gate[i // 2], exp_up[i // 2], exp_down[i // 2])
        h = h + f
    return rmsnorm(h, final_norm_g)[:, N_META:]
```

```cpp
#include <hip/hip_runtime.h>
#include <cstdio>
#include <cstdint>

#define LAS __attribute__((address_space(3)))
#define GAS __attribute__((address_space(1)))
typedef unsigned short bf16_t;
typedef short bf16x8 __attribute__((ext_vector_type(8)));
typedef float f32x4 __attribute__((ext_vector_type(4)));
typedef float f32x2 __attribute__((ext_vector_type(2)));
typedef unsigned u32x4 __attribute__((ext_vector_type(4)));
typedef unsigned u32x2 __attribute__((ext_vector_type(2)));

constexpr int NB = 8, SEQ = 8192, DM = 1024, NMETA = 16;
constexpr int NREAL = NB * SEQ;
constexpr int MBASE = NREAL;
constexpr int NROWS = NREAL + NMETA;
constexpr int AW = 512, AIN = 1792, NABC = 3328, NGATE = 3072, NY = 1536, DFF = 2816, NGU = 5632, NEXP = 8;
constexpr int MAXBLK = 520, PASS0 = 256;
constexpr float RMS_EPS = 1e-6f, LN_EPS = 1e-5f, LNX_EPS = 64e-5f;

constexpr size_t MiB = 1u << 20;
constexpr size_t WS_CTL = 0, CTL_ZERO_BYTES = 1 * MiB;
constexpr size_t WS_SS = 8 * MiB, SS_STRIDE = (size_t)NREAL * 4;
constexpr size_t WS_RT = 4 * MiB;
constexpr size_t WS_HALO = 1 * MiB;
constexpr size_t WS_GC = 12 * MiB, WS_BS = 17 * MiB;
constexpr size_t RT_SLOTRS = WS_RT + 3 * MiB;
constexpr size_t RT_TOKINFO = WS_RT, RT_SLOTTOK = WS_RT + 1 * MiB, RT_CNT = WS_RT + 2 * MiB, RT_TOKSLOT = WS_RT + 3 * MiB - 512 * 1024;
constexpr size_t WS_W = 24 * MiB, WS_HB = 78 * MiB, WS_R1 = 207 * MiB, WS_R2 = 624 * MiB, WS_R3 = 753 * MiB;
constexpr size_t WS_YS = 570 * MiB, WS_WE = 830 * MiB, WS_END = 962 * MiB;
constexpr size_t WL_ABC = 0, WL_G = WL_ABC + (size_t)NABC * DM, WL_P = WL_G + (size_t)NGATE * DM, WL_OUT = WL_P + (size_t)DM * NY,
                 WL_W2 = WL_OUT + (size_t)DM * DM, WL_A2 = WL_W2 + 512 * 64, WL_G2 = WL_A2 + 512 * 64, WL_PW = WL_G2 + 512 * 128, WL_SIZE = WL_PW + 4 * 128 * 128;
constexpr size_t WF_GU = 2 * WL_SIZE, WF_D = WF_GU + (size_t)NGU * DM, W_TOTAL = WF_D + (size_t)DM * DFF;
static_assert(W_TOTAL * 2 <= 54 * MiB, "weights region");
constexpr size_t WE_GU = 0, WE_D = (size_t)NEXP * NGU * DM;
static_assert((WE_D + (size_t)NEXP * DM * DFF) * 2 <= 132 * MiB, "expert region");
static_assert((size_t)NROWS * NABC * 2 <= 417 * MiB && (size_t)NROWS * NGATE * 2 <= 417 * MiB && (size_t)(MAXBLK - PASS0) * 256 * DFF * 2 <= 363 * MiB, "R1");
static_assert((size_t)NROWS * 1024 * 2 <= 129 * MiB && (size_t)NROWS * NY * 2 <= 193 * MiB && (size_t)MAXBLK * 256 * 1024 * 2 <= 260 * MiB, "R2/R3/YS");
constexpr int CW_BAR = 4096;

constexpr int RING_BYTES = 131072, LDSCTL_OFF = RING_BYTES, LDS_BYTES = 147456;

typedef __bf16 bf16x2_t __attribute__((ext_vector_type(2)));
__device__ __forceinline__ unsigned cvt_pk_bf16(float lo, float hi) { const f32x2 v = {lo, hi}; return __builtin_bit_cast(unsigned, __builtin_convertvector(v, bf16x2_t)); }
__device__ __forceinline__ float bf_lo(unsigned u) { return __uint_as_float(u << 16); }
__device__ __forceinline__ float bf_hi(unsigned u) { return __uint_as_float(u & 0xffff0000u); }
__device__ __forceinline__ float bf2f(bf16_t b) { return __uint_as_float(((unsigned)b) << 16); }
__device__ __forceinline__ bf16_t f2bf(float f) { return (bf16_t)(cvt_pk_bf16(f, 0.f) & 0xffffu); }
__device__ __forceinline__ float fast_sigmoid(float x) { return __builtin_amdgcn_rcpf(1.0f + __expf(-x)); }
template <int CTRL> __device__ __forceinline__ float dpp_mov(float v) { return __builtin_bit_cast(float, __builtin_amdgcn_update_dpp(0, __builtin_bit_cast(int, v), CTRL, 0xf, 0xf, false)); }
__device__ __forceinline__ float allreduce8(float v) { v += dpp_mov<0xB1>(v); v += dpp_mov<0x4E>(v); v += dpp_mov<0x141>(v); return v; }
__device__ __forceinline__ float wave_sum(float v) {
    v = allreduce8(v); v += dpp_mov<0x140>(v);
    const int iv = __builtin_bit_cast(int, v);
    const float a = __builtin_bit_cast(float, __builtin_amdgcn_readlane(iv, 0)), b = __builtin_bit_cast(float, __builtin_amdgcn_readlane(iv, 16)),
                c = __builtin_bit_cast(float, __builtin_amdgcn_readlane(iv, 32)), d = __builtin_bit_cast(float, __builtin_amdgcn_readlane(iv, 48));
    return (a + b) + (c + d);
}
__device__ __forceinline__ void unpack8(const u32x4 w, float (&f)[8]) {
    f[0] = bf_lo(w.x); f[1] = bf_hi(w.x); f[2] = bf_lo(w.y); f[3] = bf_hi(w.y); f[4] = bf_lo(w.z); f[5] = bf_hi(w.z); f[6] = bf_lo(w.w); f[7] = bf_hi(w.w);
}
__device__ __forceinline__ u32x4 pack8(const float (&f)[8]) {
    u32x4 w; w.x = cvt_pk_bf16(f[0], f[1]); w.y = cvt_pk_bf16(f[2], f[3]); w.z = cvt_pk_bf16(f[4], f[5]); w.w = cvt_pk_bf16(f[6], f[7]); return w;
}

namespace pg8 {
constexpr int BM = 256, BK = 64, HALF = 128, HTB = HALF * BK * 2, STAGE_BYTES = 8 * HTB, NXCD = 8, WGM = 8;
__host__ __device__ __forceinline__ int lds_byte(int r, int c) { const int st = (r >> 4) * 2 + (c >> 5), rr = r & 15, cc = c & 31, ob = rr * 64 + cc * 2; return st * 1024 + (ob ^ (((ob >> 9) & 1) << 5)); }
__host__ __device__ __forceinline__ void stage_rc(int b, int& R, int& C) { const int st = b / 1024, sb = b % 1024, swz = sb ^ (((sb >> 9) & 1) << 5); R = (st >> 1) * 16 + swz / 64; C = (st & 1) * 32 + (swz % 64) / 2; }
__host__ __device__ __forceinline__ int perm32(int rho) { const int n = rho >> 4, i = rho & 15; return 8 * (i >> 2) + 4 * n + (i & 3); }

struct Unit { int pm, pn, aux; };
struct GemmD { const bf16_t* A; const bf16_t* Bt; int lda, ldb, K; };

__device__ __forceinline__ void tile_of(int wgid, int nM, int nN, int& pm, int& pn) {
    const int nwg = nM * nN;
    { const int q = nwg / NXCD, r = nwg % NXCD, xcd = wgid % NXCD, off = wgid / NXCD; wgid = (xcd < r ? xcd * (q + 1) : r * (q + 1) + (xcd - r) * q) + off; }
    const int nig = WGM * nN, gid = wgid / nig, fm = gid * WGM, gsz = (nM - fm) < WGM ? (nM - fm) : WGM;
    pm = fm + ((wgid % nig) % gsz); pn = (wgid % nig) / gsz;
}

template <class Epi, class Sched, bool GATHER>
__device__ __forceinline__ void gemm_phase(LAS unsigned char* lds, int wave_id, const GemmD g, const Sched& S, const Epi& E) {
    int lane; asm volatile("v_mbcnt_lo_u32_b32 %0, -1, 0\n\tv_mbcnt_hi_u32_b32 %0, -1, %0" : "=v"(lane), "+s"(wave_id));
    const int wid = wave_id, tid = wid * 64 + lane, wr = wid >> 2, wc = wid & 3, fr = lane & 15, fq = lane >> 4;
    const int K = g.K, nt = K / BK;
    int Rst[2], Cst[2];
    unsigned voffB[2];
#pragma unroll
    for (int i = 0; i < 2; ++i) { int R, C; stage_rc(tid * 16 + i * 8192, R, C); Rst[i] = R; Cst[i] = C; const int Rb = (R & ~31) + perm32(R & 31); voffB[i] = (unsigned)(Rb * g.ldb + C) * 2u; }
    const size_t kstep = (size_t)(BK * 2);
    const size_t hstepB = (size_t)HALF * g.ldb * 2;
    const unsigned ldsw = (unsigned)wid * 1024u;
    const int aoff = lds_byte(wr * 64 + fr, fq * 8), boff = lds_byte(wc * 32 + fr, fq * 8);
#define PG8_SA(b, h) (((b) * 2 + (h)) * HTB)
#define PG8_SB(b, h) ((4 + (b) * 2 + (h)) * HTB)
#define PG8_STAGE(bufoff, gbase, v0, v1) do { \
        __builtin_amdgcn_global_load_lds((const unsigned*)((const char*)(gbase) + (v0)), (LAS unsigned*)(lds + (bufoff) + ldsw), 16, 0, 0); \
        __builtin_amdgcn_global_load_lds((const unsigned*)((const char*)(gbase) + (v1)), (LAS unsigned*)(lds + (bufoff) + ldsw + 8192), 16, 0, 0); } while (0)
#define PG8_STAGE_B(bufoff, gbase) PG8_STAGE(bufoff, gbase, voffB[0], voffB[1])
#define PG8_LDA(dst, b, h) do { _Pragma("unroll") for (int m = 0; m < 4; ++m) _Pragma("unroll") for (int k = 0; k < 2; ++k) dst[m][k] = *(const LAS bf16x8*)(lds + PG8_SA(b, h) + aoff + m * 2048 + k * 1024); } while (0)
#define PG8_LDB(dst, b, h) do { _Pragma("unroll") for (int n = 0; n < 2; ++n) _Pragma("unroll") for (int k = 0; k < 2; ++k) dst[n][k] = *(const LAS bf16x8*)(lds + PG8_SB(b, h) + boff + n * 2048 + k * 1024); } while (0)
#define PG8_MMA(ai, bj, At, Bt) do { __builtin_amdgcn_s_setprio(1); _Pragma("unroll") for (int m = 0; m < 4; ++m) _Pragma("unroll") for (int n = 0; n < 2; ++n) _Pragma("unroll") for (int k = 0; k < 2; ++k) \
        acc[ai][bj][m][n] = __builtin_amdgcn_mfma_f32_16x16x32_bf16(Bt[n][k], At[m][k], acc[ai][bj][m][n], 0, 0, 0); __builtin_amdgcn_s_setprio(0); } while (0)
#define PG8_WAIT_V(n) asm volatile("s_waitcnt vmcnt(" #n ")" ::: "memory")
#define PG8_WAIT_L(n) asm volatile("s_waitcnt lgkmcnt(" #n ")" ::: "memory")
#define PG8_BAR __builtin_amdgcn_s_barrier()
#define PG8_SCHED __builtin_amdgcn_sched_barrier(0)
    Unit cur, nxt; int ui = 0;
    if (!S.next(0, cur)) return;
    bool has_next = S.next(1, nxt);
    unsigned vAc[2][2], vAn[2][2];
#pragma unroll
    for (int h = 0; h < 2; ++h)
#pragma unroll
        for (int i = 0; i < 2; ++i) {
            const int rl = h * HALF + Rst[i];
            if constexpr (GATHER) { vAc[h][i] = (unsigned)(S.a_row(cur, rl) * g.lda + Cst[i]) * 2u; vAn[h][i] = has_next ? (unsigned)(S.a_row(nxt, rl) * g.lda + Cst[i]) * 2u : vAc[h][i]; }
            else { vAc[h][i] = (unsigned)(rl * g.lda + Cst[i]) * 2u; vAn[h][i] = vAc[h][i]; }
        }
    f32x4 acc[2][2][4][2];
#pragma unroll
    for (int a = 0; a < 2; ++a)
#pragma unroll
        for (int b = 0; b < 2; ++b)
#pragma unroll
            for (int m = 0; m < 4; ++m)
#pragma unroll
                for (int n = 0; n < 2; ++n) acc[a][b][m][n] = (f32x4){0.f, 0.f, 0.f, 0.f};
    bf16x8 At[4][2], B0[2][2], B1[2][2];
    const char* cA = (const char*)g.A + S.a_off(cur); const char* cB = (const char*)g.Bt + S.b_off(cur);
    PG8_STAGE_B(PG8_SB(0, 0), cB); PG8_STAGE_B(PG8_SB(0, 1), cB + hstepB); PG8_STAGE(PG8_SA(0, 0), cA, vAc[0][0], vAc[0][1]); PG8_STAGE(PG8_SA(0, 1), cA, vAc[1][0], vAc[1][1]);
    if (wr == 1) PG8_BAR;
    PG8_WAIT_V(2); PG8_BAR;
    PG8_STAGE_B(PG8_SB(1, 0), cB + kstep); PG8_STAGE(PG8_SA(1, 0), cA + kstep, vAc[0][0], vAc[0][1]); PG8_STAGE_B(PG8_SB(1, 1), cB + hstepB + kstep);
    PG8_WAIT_V(6); PG8_BAR;
    for (;;) {
        const char* nA = has_next ? (const char*)g.A + S.a_off(nxt) : cA; const char* nB = has_next ? (const char*)g.Bt + S.b_off(nxt) : cB;
        for (int t = 0; t < nt; t += 2) {
            const bool last = (t == nt - 2);
            if constexpr (Epi::MID_EVERY > 0) { if (t > 0 && t % Epi::MID_EVERY == 0) E.mid(acc, cur, wr, wc, fr, fq, t / Epi::MID_EVERY); }
            const char* a1 = cA + (size_t)(t + 1) * kstep;
            const char* a2 = last ? nA : cA + (size_t)(t + 2) * kstep; const char* b2 = last ? nB : cB + (size_t)(t + 2) * kstep;
            const char* a3 = a2 + kstep; const char* b3 = b2 + kstep;
            unsigned v2[2][2];
#pragma unroll
            for (int h = 0; h < 2; ++h)
#pragma unroll
                for (int i = 0; i < 2; ++i) v2[h][i] = (GATHER && last) ? vAn[h][i] : vAc[h][i];
            PG8_LDB(B0, 0, 0); PG8_LDB(B1, 0, 1); PG8_SCHED; PG8_LDA(At, 0, 0); PG8_STAGE(PG8_SA(1, 1), a1, vAc[1][0], vAc[1][1]);
            PG8_WAIT_V(8); PG8_WAIT_L(0); PG8_BAR; PG8_MMA(0, 0, At, B0); PG8_MMA(0, 1, At, B1); PG8_BAR; PG8_SCHED;
            PG8_LDA(At, 0, 1); PG8_STAGE_B(PG8_SB(0, 0), b2); PG8_STAGE_B(PG8_SB(0, 1), b2 + hstepB); PG8_STAGE(PG8_SA(0, 0), a2, v2[0][0], v2[0][1]);
            PG8_WAIT_V(8); PG8_WAIT_L(0); PG8_BAR; PG8_MMA(1, 0, At, B0); PG8_MMA(1, 1, At, B1); PG8_BAR; PG8_SCHED;
            PG8_LDB(B0, 1, 0); PG8_LDB(B1, 1, 1); PG8_SCHED; PG8_LDA(At, 1, 0); PG8_STAGE(PG8_SA(0, 1), a2, v2[1][0], v2[1][1]);
            PG8_WAIT_V(8); PG8_WAIT_L(0); PG8_BAR; PG8_MMA(0, 0, At, B0); PG8_MMA(0, 1, At, B1); PG8_BAR; PG8_SCHED;
            PG8_LDA(At, 1, 1); PG8_STAGE_B(PG8_SB(1, 0), b3); PG8_STAGE_B(PG8_SB(1, 1), b3 + hstepB); PG8_STAGE(PG8_SA(1, 0), a3, v2[0][0], v2[0][1]);
            PG8_WAIT_V(8); PG8_WAIT_L(0); PG8_BAR; PG8_MMA(1, 0, At, B0); PG8_MMA(1, 1, At, B1); PG8_BAR; PG8_SCHED;
        }
        if (wr == 0) PG8_BAR;
        E(acc, cur, wr, wc, fr, fq);
        if (!has_next) break;
#pragma unroll
        for (int a = 0; a < 2; ++a)
#pragma unroll
            for (int b = 0; b < 2; ++b)
#pragma unroll
                for (int m = 0; m < 4; ++m)
#pragma unroll
                    for (int n = 0; n < 2; ++n) acc[a][b][m][n] = (f32x4){0.f, 0.f, 0.f, 0.f};
        cur = nxt; cA = nA; cB = nB; ++ui;
        has_next = S.next(ui + 1, nxt);
        if constexpr (GATHER) {
#pragma unroll
            for (int h = 0; h < 2; ++h)
#pragma unroll
                for (int i = 0; i < 2; ++i) { vAc[h][i] = vAn[h][i]; if (has_next) vAn[h][i] = (unsigned)(S.a_row(nxt, h * HALF + Rst[i]) * g.lda + Cst[i]) * 2u; }
        }
        if (wr == 1) PG8_BAR;
    }
    PG8_WAIT_V(0);
    PG8_BAR;
#undef PG8_SA
#undef PG8_SB
#undef PG8_STAGE
#undef PG8_STAGE_B
#undef PG8_LDA
#undef PG8_LDB
#undef PG8_MMA
#undef PG8_WAIT_V
#undef PG8_WAIT_L
#undef PG8_BAR
#undef PG8_SCHED
}
}

using pg8::Unit; using pg8::GemmD;
struct SchedGrid {
    int nM, nN, G, c; size_t a_tile, b_tile;
    __device__ __forceinline__ bool next(int i, Unit& u) const { const long L = (long)i * G + c; if (L >= (long)nM * nN) return false; pg8::tile_of((int)L, nM, nN, u.pm, u.pn); u.aux = 0; return true; }
    __device__ __forceinline__ size_t a_off(const Unit& u) const { return (size_t)u.pm * a_tile; }
    __device__ __forceinline__ size_t b_off(const Unit& u) const { return (size_t)u.pn * b_tile; }
    __device__ __forceinline__ int a_row(const Unit&, int) const { return 0; }
};
struct SchedMerge {
    int nM, nN, G, c; size_t a_tile, b_tile;
    __device__ __forceinline__ bool next(int i, Unit& u) const { const long L = (long)(i / 3) * G + c; if (L >= (long)nM * nN) return false; pg8::tile_of((int)L, nM, nN, u.pm, u.pn); u.aux = i % 3; return true; }
    __device__ __forceinline__ size_t a_off(const Unit& u) const { return (size_t)u.pm * a_tile + (size_t)u.aux * (AW * 2); }
    __device__ __forceinline__ size_t b_off(const Unit& u) const { return (size_t)u.pn * b_tile + (size_t)u.aux * (AW * 2); }
    __device__ __forceinline__ int a_row(const Unit&, int) const { return 0; }
};
struct SchedMoe {
    int blk0, nblk, nN, G, c; const int* block_e; const int* slot_tok; size_t a_tile, b_tile, b_exp;
    __device__ __forceinline__ bool next(int i, Unit& u) const { const long L = (long)i * G + c; if (L >= (long)nblk * nN) return false; int pm, pn; pg8::tile_of((int)L, nblk, nN, pm, pn); u.pm = blk0 + pm; u.pn = pn; u.aux = block_e[u.pm]; return true; }
    __device__ __forceinline__ size_t a_off(const Unit& u) const { return (size_t)(u.pm - blk0) * a_tile; }
    __device__ __forceinline__ size_t b_off(const Unit& u) const { return (size_t)u.aux * b_exp + (size_t)u.pn * b_tile; }
    __device__ __forceinline__ int a_row(const Unit& u, int r) const { const int t = slot_tok[u.pm * 256 + r]; return t < 0 ? 0 : t; }
};

#define EPI_ROWS_BEGIN _Pragma("unroll") for (int ai = 0; ai < 2; ++ai) _Pragma("unroll") for (int m = 0; m < 4; ++m) { const int r = u.pm * 256 + ai * 128 + wr * 64 + m * 16 + fr;
#define EPI_ROWS_END }
__device__ __forceinline__ float rstd_of(const float* ss, int r) {
    const f32x4 a = *(const f32x4*)(ss + (size_t)r * 4);
    return __builtin_amdgcn_rsqf(((a[0] + a[1]) + (a[2] + a[3])) * (1.0f / DM) + RMS_EPS);
}

#define EPI_RSTD8(rsv, ss)  float rsv[2][4]; { f32x4 raw_[2][4]; \
    _Pragma("unroll") for (int ai = 0; ai < 2; ++ai) _Pragma("unroll") for (int m = 0; m < 4; ++m) raw_[ai][m] = *(const f32x4*)((ss) + (size_t)(u.pm * 256 + ai * 128 + wr * 64 + m * 16 + fr) * 4); \
    asm volatile("" : "+v"(raw_[0][0]), "+v"(raw_[0][1]), "+v"(raw_[0][2]), "+v"(raw_[0][3]), "+v"(raw_[1][0]), "+v"(raw_[1][1]), "+v"(raw_[1][2]), "+v"(raw_[1][3])); \
    _Pragma("unroll") for (int ai = 0; ai < 2; ++ai) _Pragma("unroll") for (int m = 0; m < 4; ++m) rsv[ai][m] = __builtin_amdgcn_rsqf(((raw_[ai][m][0] + raw_[ai][m][1]) + (raw_[ai][m][2] + raw_[ai][m][3])) * (1.0f / DM) + RMS_EPS); }
struct EpiScale { static constexpr int MID_EVERY = 0;
    bf16_t* O; int ldo; const float* ss;
    __device__ __forceinline__ void operator()(const f32x4 (&acc)[2][2][4][2], const Unit& u, int wr, int wc, int fr, int fq) const {
        const int c0 = u.pn * 256 + wc * 32 + 8 * fq;
        EPI_RSTD8(rsv, ss)
        EPI_ROWS_BEGIN
            const float rs = rsv[ai][m]; bf16_t* rowp = O + (size_t)r * ldo + c0;
#pragma unroll
            for (int bj = 0; bj < 2; ++bj) { const f32x4 v0 = acc[ai][bj][m][0] * rs, v1 = acc[ai][bj][m][1] * rs;
                u32x4 w; w.x = cvt_pk_bf16(v0[0], v0[1]); w.y = cvt_pk_bf16(v0[2], v0[3]); w.z = cvt_pk_bf16(v1[0], v1[1]); w.w = cvt_pk_bf16(v1[2], v1[3]); *(u32x4*)(rowp + bj * 128) = w; }
        EPI_ROWS_END
    }
};
struct EpiGate { static constexpr int MID_EVERY = 0;
    bf16_t* O; int ldo; const float* ss; const float* bias;
    __device__ __forceinline__ void operator()(const f32x4 (&acc)[2][2][4][2], const Unit& u, int wr, int wc, int fr, int fq) const {
        const int c0 = u.pn * 256 + wc * 32 + 8 * fq;
        f32x4 bv[2][2];
#pragma unroll
        for (int bj = 0; bj < 2; ++bj) { bv[bj][0] = *(const f32x4*)(bias + c0 + bj * 128); bv[bj][1] = *(const f32x4*)(bias + c0 + bj * 128 + 4); }
        EPI_RSTD8(rsv, ss)
        EPI_ROWS_BEGIN
            const float rs = rsv[ai][m]; bf16_t* rowp = O + (size_t)r * ldo + c0;
#pragma unroll
            for (int bj = 0; bj < 2; ++bj) { f32x4 v0 = acc[ai][bj][m][0] * rs + bv[bj][0], v1 = acc[ai][bj][m][1] * rs + bv[bj][1];
#pragma unroll
                for (int j = 0; j < 4; ++j) { v0[j] = fast_sigmoid(v0[j]); v1[j] = fast_sigmoid(v1[j]); }
                u32x4 w; w.x = cvt_pk_bf16(v0[0], v0[1]); w.y = cvt_pk_bf16(v0[2], v0[3]); w.z = cvt_pk_bf16(v1[0], v1[1]); w.w = cvt_pk_bf16(v1[2], v1[3]); *(u32x4*)(rowp + bj * 128) = w; }
        EPI_ROWS_END
    }
};
struct EpiMerge { static constexpr int MID_EVERY = 0;
    bf16_t* MB; const bf16_t* ZG;
    __device__ __forceinline__ void operator()(const f32x4 (&acc)[2][2][4][2], const Unit& u, int wr, int wc, int fr, int fq) const {
        const int c0 = u.pn * 256 + wc * 32 + 8 * fq; const int br = u.aux;
#pragma unroll
        for (int ai = 0; ai < 2; ++ai) {
            u32x4 graw[4][2], praw[4][2];
#pragma unroll
            for (int m = 0; m < 4; ++m) { const int r = u.pm * 256 + ai * 128 + wr * 64 + m * 16 + fr; const bf16_t* gp = ZG + (size_t)r * NGATE + br * DM + c0; const bf16_t* pp = MB + (size_t)r * DM + c0;
                graw[m][0] = *(const u32x4*)gp; graw[m][1] = *(const u32x4*)(gp + 128);
                if (br > 0) { praw[m][0] = *(const u32x4*)pp; praw[m][1] = *(const u32x4*)(pp + 128); } else { praw[m][0] = (u32x4){0u, 0u, 0u, 0u}; praw[m][1] = praw[m][0]; } }
            asm volatile("" : "+v"(graw[0][0]), "+v"(graw[0][1]), "+v"(graw[1][0]), "+v"(graw[1][1]), "+v"(graw[2][0]), "+v"(graw[2][1]), "+v"(graw[3][0]), "+v"(graw[3][1]),
                              "+v"(praw[0][0]), "+v"(praw[0][1]), "+v"(praw[1][0]), "+v"(praw[1][1]), "+v"(praw[2][0]), "+v"(praw[2][1]), "+v"(praw[3][0]), "+v"(praw[3][1]));
#pragma unroll
            for (int m = 0; m < 4; ++m) { const int r = u.pm * 256 + ai * 128 + wr * 64 + m * 16 + fr; bf16_t* rowp = MB + (size_t)r * DM + c0;
#pragma unroll
                for (int bj = 0; bj < 2; ++bj) {
                    float gt[8], pv[8]; unpack8(graw[m][bj], gt); unpack8(praw[m][bj], pv);
                    float o[8];
#pragma unroll
                    for (int j = 0; j < 4; ++j) { o[j] = pv[j] + gt[j] * acc[ai][bj][m][0][j]; o[4 + j] = pv[4 + j] + gt[4 + j] * acc[ai][bj][m][1][j]; }
                    *(u32x4*)(rowp + bj * 128) = pack8(o); } }
        }
    }
};
struct EpiMerge3 { static constexpr int MID_EVERY = 8;
    bf16_t* MB; const bf16_t* ZG;
    __device__ __forceinline__ void mid(f32x4 (&acc)[2][2][4][2], const Unit& u, int wr, int wc, int fr, int fq, int seg) const {
        const int c0 = u.pn * 256 + wc * 32 + 8 * fq;
#pragma unroll
        for (int ai = 0; ai < 2; ++ai) {
            u32x4 ga[4][2], gb[4][2];
#pragma unroll
            for (int m = 0; m < 4; ++m) { const bf16_t* gp = ZG + (size_t)(u.pm * 256 + ai * 128 + wr * 64 + m * 16 + fr) * NGATE + (seg - 1) * DM + c0;
                ga[m][0] = *(const u32x4*)gp; ga[m][1] = *(const u32x4*)(gp + 128); gb[m][0] = *(const u32x4*)(gp + DM); gb[m][1] = *(const u32x4*)(gp + DM + 128); }
            asm volatile("" : "+v"(ga[0][0]), "+v"(ga[0][1]), "+v"(ga[1][0]), "+v"(ga[1][1]), "+v"(ga[2][0]), "+v"(ga[2][1]), "+v"(ga[3][0]), "+v"(ga[3][1]),
                              "+v"(gb[0][0]), "+v"(gb[0][1]), "+v"(gb[1][0]), "+v"(gb[1][1]), "+v"(gb[2][0]), "+v"(gb[2][1]), "+v"(gb[3][0]), "+v"(gb[3][1]));
#pragma unroll
            for (int m = 0; m < 4; ++m)
#pragma unroll
                for (int bj = 0; bj < 2; ++bj) { float x[8], y[8]; unpack8(ga[m][bj], x); unpack8(gb[m][bj], y);
#pragma unroll
                    for (int j = 0; j < 4; ++j) { acc[ai][bj][m][0][j] *= x[j] * __builtin_amdgcn_rcpf(fmaxf(y[j], 1e-30f)); acc[ai][bj][m][1][j] *= x[4 + j] * __builtin_amdgcn_rcpf(fmaxf(y[4 + j], 1e-30f)); } }
        }
    }
    __device__ __forceinline__ void operator()(const f32x4 (&acc)[2][2][4][2], const Unit& u, int wr, int wc, int fr, int fq) const {
        const int c0 = u.pn * 256 + wc * 32 + 8 * fq;
        u32x4 g2[2][4][2];
#pragma unroll
        for (int ai = 0; ai < 2; ++ai)
#pragma unroll
            for (int m = 0; m < 4; ++m) { const bf16_t* gp = ZG + (size_t)(u.pm * 256 + ai * 128 + wr * 64 + m * 16 + fr) * NGATE + 2 * DM + c0; g2[ai][m][0] = *(const u32x4*)gp; g2[ai][m][1] = *(const u32x4*)(gp + 128); }
        asm volatile("" : "+v"(g2[0][0][0]), "+v"(g2[0][0][1]), "+v"(g2[0][1][0]), "+v"(g2[0][1][1]), "+v"(g2[0][2][0]), "+v"(g2[0][2][1]), "+v"(g2[0][3][0]), "+v"(g2[0][3][1]),
                          "+v"(g2[1][0][0]), "+v"(g2[1][0][1]), "+v"(g2[1][1][0]), "+v"(g2[1][1][1]), "+v"(g2[1][2][0]), "+v"(g2[1][2][1]), "+v"(g2[1][3][0]), "+v"(g2[1][3][1]));
        EPI_ROWS_BEGIN
            bf16_t* rowp = MB + (size_t)r * DM + c0;
#pragma unroll
            for (int bj = 0; bj < 2; ++bj) { float gt[8], o[8]; unpack8(g2[ai][m][bj], gt);
#pragma unroll
                for (int j = 0; j < 4; ++j) { o[j] = gt[j] * acc[ai][bj][m][0][j]; o[4 + j] = gt[4 + j] * acc[ai][bj][m][1][j]; }
                *(u32x4*)(rowp + bj * 128) = pack8(o); }
        EPI_ROWS_END
    }
};
struct EpiResid { static constexpr int MID_EVERY = 0;
    bf16_t* HB; float* ssn; LAS float* red;
    __device__ __forceinline__ void operator()(const f32x4 (&acc)[2][2][4][2], const Unit& u, int wr, int wc, int fr, int fq) const {
        const int c0 = u.pn * 256 + wc * 32 + 8 * fq;
        u32x4 hraw[2][4][2];
#pragma unroll
        for (int ai = 0; ai < 2; ++ai)
#pragma unroll
            for (int m = 0; m < 4; ++m) { const bf16_t* rp = HB + (size_t)(u.pm * 256 + ai * 128 + wr * 64 + m * 16 + fr) * DM + c0; hraw[ai][m][0] = *(const u32x4*)rp; hraw[ai][m][1] = *(const u32x4*)(rp + 128); }
        asm volatile("" : "+v"(hraw[0][0][0]), "+v"(hraw[0][0][1]), "+v"(hraw[0][1][0]), "+v"(hraw[0][1][1]), "+v"(hraw[0][2][0]), "+v"(hraw[0][2][1]), "+v"(hraw[0][3][0]), "+v"(hraw[0][3][1]),
                          "+v"(hraw[1][0][0]), "+v"(hraw[1][0][1]), "+v"(hraw[1][1][0]), "+v"(hraw[1][1][1]), "+v"(hraw[1][2][0]), "+v"(hraw[1][2][1]), "+v"(hraw[1][3][0]), "+v"(hraw[1][3][1]));
        EPI_ROWS_BEGIN
            bf16_t* rowp = HB + (size_t)r * DM + c0; float sq = 0.f;
#pragma unroll
            for (int bj = 0; bj < 2; ++bj) {
                float hv[8]; unpack8(hraw[ai][m][bj], hv);
#pragma unroll
                for (int j = 0; j < 4; ++j) { hv[j] += acc[ai][bj][m][0][j]; hv[4 + j] += acc[ai][bj][m][1][j]; }
                const u32x4 w = pack8(hv); *(u32x4*)(rowp + bj * 128) = w;
                float rv[8]; unpack8(w, rv);
#pragma unroll
                for (int j = 0; j < 8; ++j) sq += rv[j] * rv[j]; }
            { const int ln = fq * 16 + fr; sq += __builtin_bit_cast(float, __builtin_amdgcn_ds_bpermute((ln ^ 16) << 2, __builtin_bit_cast(int, sq))); sq += __builtin_bit_cast(float, __builtin_amdgcn_ds_bpermute((ln ^ 32) << 2, __builtin_bit_cast(int, sq))); }
            if (fq == 0) red[(ai * 128 + wr * 64 + m * 16 + fr) * 4 + wc] = sq;
        EPI_ROWS_END
        asm volatile("s_waitcnt lgkmcnt(0)" ::: "memory"); __builtin_amdgcn_s_barrier(); asm volatile("" ::: "memory");
        { const int t = (wr * 4 + wc) * 64 + fq * 16 + fr;
          if (t < 256) { const f32x4 p = *(const LAS f32x4*)(red + t * 4); ssn[(size_t)(u.pm * 256 + t) * 4 + u.pn] = (p[0] + p[1]) + (p[2] + p[3]); } }
    }
};
struct EpiSwiglu { static constexpr int MID_EVERY = 0;
    bf16_t* HID; const float* ss; const int* slot_tok; int row0;
    __device__ __forceinline__ void operator()(const f32x4 (&acc)[2][2][4][2], const Unit& u, int wr, int wc, int fr, int fq) const {
        const int c0 = u.pn * 128 + wc * 32 + 8 * fq;
        float rsv[2][4];
        if (slot_tok) {
#pragma unroll
            for (int ai = 0; ai < 2; ++ai)
#pragma unroll
                for (int m = 0; m < 4; ++m) rsv[ai][m] = ss[u.pm * 256 + ai * 128 + wr * 64 + m * 16 + fr];
            asm volatile("" : "+v"(rsv[0][0]), "+v"(rsv[0][1]), "+v"(rsv[0][2]), "+v"(rsv[0][3]), "+v"(rsv[1][0]), "+v"(rsv[1][1]), "+v"(rsv[1][2]), "+v"(rsv[1][3]));
        } else { EPI_RSTD8(rs2, ss)
#pragma unroll
            for (int ai = 0; ai < 2; ++ai)
#pragma unroll
                for (int m = 0; m < 4; ++m) rsv[ai][m] = rs2[ai][m]; }
        EPI_ROWS_BEGIN
            const float rs = rsv[ai][m]; const int orow = slot_tok ? r - row0 : r;
            const f32x4 g0 = acc[ai][0][m][0] * rs, g1 = acc[ai][0][m][1] * rs, u0 = acc[ai][1][m][0] * rs, u1 = acc[ai][1][m][1] * rs;
            float o[8];
#pragma unroll
            for (int j = 0; j < 4; ++j) { o[j] = g0[j] * fast_sigmoid(g0[j]) * u0[j]; o[4 + j] = g1[j] * fast_sigmoid(g1[j]) * u1[j]; }
            *(u32x4*)(HID + (size_t)orow * DFF + c0) = pack8(o);
        EPI_ROWS_END
    }
};
struct EpiStore { static constexpr int MID_EVERY = 0;
    bf16_t* O; int ldo;
    __device__ __forceinline__ void operator()(const f32x4 (&acc)[2][2][4][2], const Unit& u, int wr, int wc, int fr, int fq) const {
        const int c0 = u.pn * 256 + wc * 32 + 8 * fq;
        EPI_ROWS_BEGIN
            bf16_t* rowp = O + (size_t)r * ldo + c0;
#pragma unroll
            for (int bj = 0; bj < 2; ++bj) { const f32x4 v0 = acc[ai][bj][m][0], v1 = acc[ai][bj][m][1];
                u32x4 w; w.x = cvt_pk_bf16(v0[0], v0[1]); w.y = cvt_pk_bf16(v0[2], v0[3]); w.z = cvt_pk_bf16(v1[0], v1[1]); w.w = cvt_pk_bf16(v1[2], v1[3]); *(u32x4*)(rowp + bj * 128) = w; }
        EPI_ROWS_END
    }
};

#define XB_TMO      128
#define XB_XCNT(j)  (256  + 64 * (j))
#define XB_XSUB(j)  (1280 + 64 * (j))
#define XB_XGEN(j)  (2304 + 64 * (j))
#define XB_TOP      3328
#define XB_TOPGEN   3392
#define XCD_BAR_WORDS 3456
#define XB_SPIN_CAP (1u << 18)
__device__ __forceinline__ unsigned xb_ld(unsigned* p)              { return __hip_atomic_load(p, __ATOMIC_RELAXED, __HIP_MEMORY_SCOPE_AGENT); }
__device__ __forceinline__ unsigned xb_add(unsigned* p, unsigned v) { return __hip_atomic_fetch_add(p, v, __ATOMIC_RELAXED, __HIP_MEMORY_SCOPE_AGENT); }
__device__ __forceinline__ unsigned xb_xcc_id() { return (unsigned)__builtin_amdgcn_s_getreg((3 << 11) | 20) & 0xFu; }
#define XB_SPIN(cond, bar) do { unsigned _sp = 0; while (cond) { __builtin_amdgcn_s_sleep(1); \
    if ((++_sp & 255u) == 0u) { if (xb_ld(&(bar)[XB_TMO])) break; if (_sp > XB_SPIN_CAP) { atomicAdd(&(bar)[XB_TMO], 1u); break; } } } } while (0)
struct XcdBarrier { unsigned* bar; unsigned x; volatile LAS unsigned* st; };
__device__ __forceinline__ XcdBarrier xcd_barrier_post(unsigned* bar, volatile LAS unsigned* st) {
    XcdBarrier b; b.bar = bar; b.x = xb_xcc_id(); b.st = st;
    if (threadIdx.x == 0) (void)xb_add(&bar[XB_XCNT(b.x)], 1u);
    return b;
}
__device__ __forceinline__ void xcd_barrier_complete(unsigned* bar, unsigned x, unsigned& nloc, unsigned& nx) {
    const unsigned G = gridDim.x * gridDim.y * gridDim.z;
    unsigned sum, cnt, mine, sp = 0u;
    for (;;) {
        sum = 0u; cnt = 0u; mine = 0u;
#pragma unroll
        for (unsigned j = 0; j < 16; ++j) { const unsigned c = xb_ld(&bar[XB_XCNT(j)]); sum += c; cnt += (c > 0u) ? 1u : 0u; mine = (j == x) ? c : mine; }
        if (sum == G) break;
        __builtin_amdgcn_s_sleep(1);
        if ((++sp & 255u) == 0u) { if (xb_ld(&bar[XB_TMO])) break; if (sp > XB_SPIN_CAP) { atomicAdd(&bar[XB_TMO], 1u); break; } }
    }
    nloc = mine > 0u ? mine : 1u; nx = cnt > 0u ? cnt : 1u;
}
__device__ __forceinline__ void xcd_barrier(const XcdBarrier& b, int wave_id) {
    asm volatile("s_waitcnt vmcnt(0)" ::: "memory");
    __syncthreads();
    int lane_; asm volatile("v_mbcnt_lo_u32_b32 %0, -1, 0\n\tv_mbcnt_hi_u32_b32 %0, -1, %0" : "=v"(lane_));
    if (wave_id == 0 && lane_ == 0) {
        unsigned* bar = b.bar;
        __builtin_amdgcn_s_waitcnt(0);
        unsigned nloc = b.st[0], nx = b.st[1];
        if (nloc == 0u) { xcd_barrier_complete(bar, b.x, nloc, nx); b.st[0] = nloc; b.st[1] = nx; }
        const unsigned old = xb_add(&bar[XB_XSUB(b.x)], 1u);
        const unsigned gen = old / nloc;
        if (old + 1u == (gen + 1u) * nloc) {
            __builtin_amdgcn_fence(__ATOMIC_RELEASE, "agent");
            asm volatile("s_waitcnt vmcnt(0)" ::: "memory");
            const unsigned og = xb_add(&bar[XB_TOP], 1u);
            const unsigned tg = og / nx;
            if (og + 1u == (tg + 1u) * nx) xb_add(&bar[XB_TOPGEN], 1u);
            else XB_SPIN(xb_ld(&bar[XB_TOPGEN]) == tg, bar);
            __builtin_amdgcn_fence(__ATOMIC_ACQUIRE, "agent");
            xb_add(&bar[XB_XGEN(b.x)], 1u);
            asm volatile("s_waitcnt vmcnt(0)" ::: "memory");
        } else {
            XB_SPIN(xb_ld(&bar[XB_XGEN(b.x)]) == gen, bar);
            __builtin_amdgcn_fence(__ATOMIC_ACQUIRE, "agent");
            asm volatile("s_waitcnt vmcnt(0)" ::: "memory");
        }
    }
    __syncthreads();
}

struct Args { const float* in[36]; float* out; unsigned char* ws; int ph_lo, ph_hi, li, pad; };
enum { I_X = 0, I_META, I_MIXG, I_WIN, I_GATEB, I_MU, I_W0, I_W2, I_A0, I_A2, I_G2, I_KK, I_KA, I_RK, I_LNXW, I_LNXB, I_CONVW, I_CONVB, I_BLNG, I_BLNB, I_POOLW, I_CSCALE,
       I_PROJA, I_PROJB, I_PROJC, I_WOUT, I_FFNG, I_FGATE, I_FUP, I_FDOWN, I_RW, I_RB, I_EGATE, I_EUP, I_EDOWN, I_FINALG };
constexpr int PTR_OFF = LDSCTL_OFF + 64;
__device__ __forceinline__ GAS unsigned char* lds_ptr(LAS unsigned char* lds, int i) {
    const LAS unsigned* p = (const LAS unsigned*)(lds + PTR_OFF + 8 * i);
    const unsigned lo = __builtin_amdgcn_readfirstlane(p[0]), hi = __builtin_amdgcn_readfirstlane(p[1]);
    return (GAS unsigned char*)(((unsigned long long)hi << 32) | lo);
}
struct Frame {
    LAS unsigned char* lds; int tid, lane, wave, G, bid;
    unsigned char* ws;
    bf16_t* W; bf16_t* WE; bf16_t* HB; bf16_t* R1; bf16_t* R2; bf16_t* R3; bf16_t* YS; float* SS;
};
__device__ __forceinline__ void frame_ptrs(Frame& F) {
    GAS unsigned char* ws = lds_ptr(F.lds, 37); F.ws = (unsigned char*)ws;
    F.W = (bf16_t*)(ws + WS_W); F.WE = (bf16_t*)(ws + WS_WE); F.HB = (bf16_t*)(ws + WS_HB); F.R1 = (bf16_t*)(ws + WS_R1); F.R2 = (bf16_t*)(ws + WS_R2); F.R3 = (bf16_t*)(ws + WS_R3);
    F.YS = (bf16_t*)(ws + WS_YS); F.SS = (float*)(ws + WS_SS);
}
__device__ __forceinline__ const float* in_ptr(const Frame& F, int i) { return (const float*)lds_ptr(F.lds, i); }
#define LDS_WAIT() asm volatile("s_waitcnt lgkmcnt(0)" ::: "memory")
#define PHASE_ENTER(F) do { int l_; int w_ = (F).wave, g_ = (F).G, b_ = (F).bid; asm volatile("v_mbcnt_lo_u32_b32 %0, -1, 0\n\tv_mbcnt_hi_u32_b32 %0, -1, %0" : "=v"(l_), "+s"(w_), "+s"(g_), "+s"(b_) :: "memory"); (F).lane = l_; (F).wave = w_; (F).G = g_; (F).bid = b_; (F).tid = w_ * 64 + l_; frame_ptrs(F); } while (0)


__device__ __forceinline__ int row_of(int b, int l) { return l < NMETA ? MBASE + l : b * SEQ + (l - NMETA); }
__device__ __forceinline__ int prev_row(int r) { if (r >= MBASE) return r > MBASE ? r - 1 : -1; return (r & (SEQ - 1)) ? r - 1 : MBASE + NMETA - 1; }

struct ConvJob { const float* src; int K, srcN, col0, ncols; bf16_t* dst; int dld, dcol0, mode; const float* sc; };
__device__ __forceinline__ int conv_items(const ConvJob& j) { return (j.K / 64) * (j.ncols / 32); }
__device__ __forceinline__ void conv_item(const ConvJob& j, LAS float* scr, int item, int lane) {
    const int nblk = j.ncols / 32, kb = item / nblk, nb = item % nblk, k0 = 64 * kb, n0 = 32 * nb;
    float vv[32];
#pragma unroll
    for (int i = 0; i < 32; ++i) { const int kk = 2 * i + (lane >> 5); vv[i] = j.src[(size_t)(k0 + kk) * j.srcN + j.col0 + n0 + (lane & 31)]; }
    if (j.sc) {
#pragma unroll
        for (int i = 0; i < 32; ++i) vv[i] *= j.sc[k0 + 2 * i + (lane >> 5)]; }
#pragma unroll
    for (int i = 0; i < 32; ++i) { const int kk = 2 * i + (lane >> 5); scr[kk * 33 + (lane & 31)] = vv[i]; }
    LDS_WAIT(); asm volatile("" ::: "memory");
    const int c = lane & 7;
    int drow0 = n0; if (j.mode == 1) drow0 = 256 * (n0 / 128) + (n0 % 128); else if (j.mode == 2) drow0 = 256 * (n0 / 128) + 128 + (n0 % 128);
#pragma unroll
    for (int jj = 0; jj < 4; ++jj) { const int n = (lane >> 3) + 8 * jj; const LAS float* s = scr + (8 * c) * 33 + n;
        u32x4 o; o.x = cvt_pk_bf16(s[0 * 33], s[1 * 33]); o.y = cvt_pk_bf16(s[2 * 33], s[3 * 33]); o.z = cvt_pk_bf16(s[4 * 33], s[5 * 33]); o.w = cvt_pk_bf16(s[6 * 33], s[7 * 33]);
        *(u32x4*)(j.dst + (size_t)(drow0 + n) * j.dld + j.dcol0 + k0 + 8 * c) = o; }
    LDS_WAIT(); asm volatile("" ::: "memory");
}
__device__ __forceinline__ void conv_run(Frame& F, const ConvJob& j) {
    LAS float* scr = (LAS float*)(F.lds + F.wave * 16384);
    const int gw = F.bid * 8 + F.wave, NGW = F.G * 8, n = conv_items(j);
    for (int it = gw; it < n; it += NGW) conv_item(j, scr, it, F.lane);
}
__device__ __forceinline__ void convert_common(Frame& F) {
    PHASE_ENTER(F);
    for (int l = 0; l < 2; ++l) {
        bf16_t* WL = F.W + (size_t)l * WL_SIZE; const float* mg = in_ptr(F, I_MIXG) + l * DM;
        const float* win = in_ptr(F, I_WIN) + (size_t)l * DM * 6400;
        conv_run(F, ConvJob{win, DM, 6400, 0, NABC, WL + WL_ABC, DM, 0, 0, mg});
        conv_run(F, ConvJob{win, DM, 6400, NABC, NGATE, WL + WL_G, DM, 0, 0, mg});
        conv_run(F, ConvJob{in_ptr(F, I_PROJA) + (size_t)l * AW * DM, AW, DM, 0, DM, WL + WL_P, NY, 0, 0, nullptr});
        conv_run(F, ConvJob{in_ptr(F, I_PROJB) + (size_t)l * AW * DM, AW, DM, 0, DM, WL + WL_P, NY, AW, 0, nullptr});
        conv_run(F, ConvJob{in_ptr(F, I_PROJC) + (size_t)l * AW * DM, AW, DM, 0, DM, WL + WL_P, NY, 2 * AW, 0, nullptr});
        conv_run(F, ConvJob{in_ptr(F, I_WOUT) + (size_t)l * DM * DM, DM, DM, 0, DM, WL + WL_OUT, DM, 0, 0, nullptr});
        conv_run(F, ConvJob{in_ptr(F, I_W2) + (size_t)l * 64 * AW, 64, AW, 0, AW, WL + WL_W2, 64, 0, 0, nullptr});
        conv_run(F, ConvJob{in_ptr(F, I_A2) + (size_t)l * 64 * AW, 64, AW, 0, AW, WL + WL_A2, 64, 0, 0, nullptr});
        conv_run(F, ConvJob{in_ptr(F, I_G2) + (size_t)l * 128 * AW, 128, AW, 0, AW, WL + WL_G2, 128, 0, 0, nullptr});
        for (int g = 0; g < 4; ++g) conv_run(F, ConvJob{in_ptr(F, I_POOLW) + ((size_t)l * 4 + g) * 128 * 128, 128, 128, 0, 128, WL + WL_PW + (size_t)g * 128 * 128, 128, 0, 0, nullptr});
    }
    const float* fg = in_ptr(F, I_FFNG);
    conv_run(F, ConvJob{in_ptr(F, I_FGATE), DM, DFF, 0, DFF, F.W + WF_GU, DM, 0, 1, fg});
    conv_run(F, ConvJob{in_ptr(F, I_FUP), DM, DFF, 0, DFF, F.W + WF_GU, DM, 0, 2, fg});
    conv_run(F, ConvJob{in_ptr(F, I_FDOWN), DFF, DM, 0, DM, F.W + WF_D, DFF, 0, 0, nullptr});
}
__device__ __forceinline__ void convert_experts(Frame& F) {
    PHASE_ENTER(F);
    const float* fg = in_ptr(F, I_FFNG) + DM;
    for (int e = 0; e < NEXP; ++e) {
        conv_run(F, ConvJob{in_ptr(F, I_EGATE) + (size_t)e * DM * DFF, DM, DFF, 0, DFF, F.WE + WE_GU + (size_t)e * NGU * DM, DM, 0, 1, fg});
        conv_run(F, ConvJob{in_ptr(F, I_EUP) + (size_t)e * DM * DFF, DM, DFF, 0, DFF, F.WE + WE_GU + (size_t)e * NGU * DM, DM, 0, 2, fg});
        conv_run(F, ConvJob{in_ptr(F, I_EDOWN) + (size_t)e * DFF * DM, DFF, DM, 0, DM, F.WE + WE_D + (size_t)e * DM * DFF, DFF, 0, 0, nullptr});
    }
}
__device__ __forceinline__ void x_to_hb(Frame& F) {
    PHASE_ENTER(F);
    const int gw = F.bid * 8 + F.wave, NGW = F.G * 8;
    for (int r = gw; r < NROWS; r += NGW) {
        const float* src = r < NREAL ? in_ptr(F, I_X) + (size_t)r * DM : in_ptr(F, I_META) + (size_t)(r - MBASE) * DM;
        const f32x4* xr = (const f32x4*)src + F.lane; u32x2* o = (u32x2*)(F.HB + (size_t)r * DM) + F.lane; float sq = 0.f;
#pragma unroll
        for (int j = 0; j < 4; ++j) { const f32x4 v = xr[64 * j]; u32x2 w; w.x = cvt_pk_bf16(v[0], v[1]); w.y = cvt_pk_bf16(v[2], v[3]); o[64 * j] = w;
            const float a = bf_lo(w.x), b = bf_hi(w.x), c = bf_lo(w.y), d = bf_hi(w.y); sq += (a * a + b * b) + (c * c + d * d); }
        sq = wave_sum(sq);
        if (r < NREAL && F.lane < 4) F.SS[(size_t)r * 4 + F.lane] = F.lane == 0 ? sq : 0.f;
    }
}

__device__ __forceinline__ float meta_tile(Frame& F, const bf16_t* A16, int lda, const bf16_t* Bt, int ldb, int K, int brow0) {
    LAS float* red = (LAS float*)F.lds;
    const int kw = K / 8, k0 = F.wave * kw, fr = F.lane & 15, fq = F.lane >> 4;
    f32x4 acc = (f32x4){0.f, 0.f, 0.f, 0.f};
    const bf16_t* ap = A16 + (size_t)fr * lda + k0 + 8 * fq; const bf16_t* bp = Bt + (size_t)(brow0 + fr) * ldb + k0 + 8 * fq;
    for (int k = 0; k < kw; k += 32) { const bf16x8 a = *(const bf16x8*)(ap + k), b = *(const bf16x8*)(bp + k); acc = __builtin_amdgcn_mfma_f32_16x16x32_bf16(b, a, acc, 0, 0, 0); }
#pragma unroll
    for (int j = 0; j < 4; ++j) red[F.wave * 256 + fr * 16 + 4 * fq + j] = acc[j];
    __syncthreads();
    float v = 0.f;
    if (F.tid < 256) {
#pragma unroll
        for (int w = 0; w < 8; ++w) v += red[w * 256 + F.tid];
    }
    __syncthreads();
    return v;
}


__device__ __forceinline__ void meta_rstd_setup(Frame& F) {
    LAS float* mrs = (LAS float*)(F.lds + 8192);
#pragma unroll
    for (int i = 0; i < 2; ++i) { const int row = 2 * F.wave + i; float hv[16]; const bf16_t* hp = F.HB + (size_t)(MBASE + row) * DM + 16 * F.lane;
        unpack8(*(const u32x4*)hp, *(float(*)[8])&hv[0]); unpack8(*(const u32x4*)(hp + 8), *(float(*)[8])&hv[8]); float sq = 0.f;
#pragma unroll
        for (int j = 0; j < 16; ++j) sq += hv[j] * hv[j];
        sq = wave_sum(sq); if (F.lane == 0) mrs[row] = __builtin_amdgcn_rsqf(sq * (1.0f / DM) + RMS_EPS); }
    __syncthreads();
}
#define META_RS(F, row16) (((const LAS float*)((F).lds + 8192))[row16])

__device__ __forceinline__ void prep_afrags(bf16x8 (&af)[8], const bf16_t* U, const float* mu, int row, int fq) {
    const int prow = prev_row(row), pr = prow >= 0 ? prow : row; const float pm = prow >= 0 ? 1.0f : 0.0f;
    u32x4 rc[8], rp[8];
#pragma unroll
    for (int s = 0; s < 8; ++s) { const int col = 1536 + 32 * s + 8 * fq; rc[s] = *(const u32x4*)(U + (size_t)row * NABC + col); rp[s] = *(const u32x4*)(U + (size_t)pr * NABC + col); }
#pragma unroll
    for (int s = 0; s < 8; ++s) {
        const int col = 1536 + 32 * s + 8 * fq;
        float cur[8], prv[8]; unpack8(rc[s], cur); unpack8(rp[s], prv);
        const f32x4 m0 = *(const f32x4*)(mu + col), m1 = *(const f32x4*)(mu + col + 4);
        float x[8];
#pragma unroll
        for (int j = 0; j < 8; ++j) { const float mm = j < 4 ? m0[j] : m1[j - 4]; float v = cur[j] + (pm * prv[j] - cur[j]) * mm;
            if (s < 2) v = 1.0f - 2.0f * __builtin_amdgcn_rcpf(1.0f + __expf(2.0f * v));
            else if (s >= 4) v = fast_sigmoid(v);
            x[j] = v; }
        const u32x4 p = pack8(x); af[s] = __builtin_bit_cast(bf16x8, p);
    }
}
template <int NG> __device__ __forceinline__ void prep_tile(const bf16x8 (&af)[NG][8], const int (&rows)[NG], int ct, int fr, int fq, const bf16_t* w2t, const bf16_t* a2t, const bf16_t* g2t,
                                                            const float* w0, const float* a0, bf16_t* WAw, bf16_t* WAa, bf16_t* Y) {
    const bf16_t* bw = w2t + (size_t)(16 * ct + fr) * 64 + 8 * fq; const bf16_t* ba = a2t + (size_t)(16 * ct + fr) * 64 + 8 * fq; const bf16_t* bg = g2t + (size_t)(16 * ct + fr) * 128 + 8 * fq;
    bf16x8 fw[2], fa[2], fg[4];
#pragma unroll
    for (int s = 0; s < 2; ++s) { fw[s] = *(const bf16x8*)(bw + 32 * s); fa[s] = *(const bf16x8*)(ba + 32 * s); }
#pragma unroll
    for (int s = 0; s < 4; ++s) fg[s] = *(const bf16x8*)(bg + 32 * s);
    const int c = 16 * ct + 4 * fq;
    const f32x4 w0v = *(const f32x4*)(w0 + c), a0v = *(const f32x4*)(a0 + c);
#pragma unroll
    for (int gi = 0; gi < NG; ++gi) {
        f32x4 aw = (f32x4){0.f, 0.f, 0.f, 0.f}, aa = aw, ag = aw;
#pragma unroll
        for (int s = 0; s < 2; ++s) { aw = __builtin_amdgcn_mfma_f32_16x16x32_bf16(fw[s], af[gi][s], aw, 0, 0, 0); aa = __builtin_amdgcn_mfma_f32_16x16x32_bf16(fa[s], af[gi][2 + s], aa, 0, 0, 0); }
#pragma unroll
        for (int s = 0; s < 4; ++s) ag = __builtin_amdgcn_mfma_f32_16x16x32_bf16(fg[s], af[gi][4 + s], ag, 0, 0, 0);
        u32x2 ow, oa, og;
        ow.x = cvt_pk_bf16(0.60653066f * fast_sigmoid(aw[0] + w0v[0]), 0.60653066f * fast_sigmoid(aw[1] + w0v[1])); ow.y = cvt_pk_bf16(0.60653066f * fast_sigmoid(aw[2] + w0v[2]), 0.60653066f * fast_sigmoid(aw[3] + w0v[3]));
        oa.x = cvt_pk_bf16(fast_sigmoid(aa[0] + a0v[0]), fast_sigmoid(aa[1] + a0v[1])); oa.y = cvt_pk_bf16(fast_sigmoid(aa[2] + a0v[2]), fast_sigmoid(aa[3] + a0v[3]));
        og.x = cvt_pk_bf16(ag[0], ag[1]); og.y = cvt_pk_bf16(ag[2], ag[3]);
        const size_t row = rows[gi];
        *(u32x2*)(WAw + row * AW + c) = ow; *(u32x2*)(WAa + row * AW + c) = oa; *(u32x2*)(Y + row * NY + AW + c) = og;
    }
}
__device__ __forceinline__ void phase_prep(Frame& F, int l) {
    PHASE_ENTER(F);
    const bf16_t* U = F.R1; bf16_t* WAw = F.R2; bf16_t* WAa = F.R2 + (size_t)NROWS * AW; bf16_t* Y = F.R3;
    const bf16_t* WL = F.W + (size_t)l * WL_SIZE; const bf16_t* w2t = WL + WL_W2; const bf16_t* a2t = WL + WL_A2; const bf16_t* g2t = WL + WL_G2;
    const float* mu = in_ptr(F, I_MU) + l * AIN; const float* w0 = in_ptr(F, I_W0) + l * AW; const float* a0 = in_ptr(F, I_A0) + l * AW;
    const int fr = F.lane & 15, fq = F.lane >> 4;
    const int gw = F.bid * 8 + F.wave, NGW = F.G * 8;
    for (int grp = gw; grp < NREAL / 16; grp += 2 * NGW) {
        const int grp2 = grp + NGW;
        if (grp2 < NREAL / 16) {
            bf16x8 af[2][8]; const int rows[2] = {grp * 16 + fr, grp2 * 16 + fr};
            prep_afrags(af[0], U, mu, rows[0], fq); prep_afrags(af[1], U, mu, rows[1], fq);
#pragma unroll 2
            for (int ct = 0; ct < 32; ++ct) prep_tile<2>(af, rows, ct, fr, fq, w2t, a2t, g2t, w0, a0, WAw, WAa, Y);
        } else {
            bf16x8 af[1][8]; const int rows[1] = {grp * 16 + fr};
            prep_afrags(af[0], U, mu, rows[0], fq);
#pragma unroll 2
            for (int ct = 0; ct < 32; ++ct) prep_tile<1>(af, rows, ct, fr, fq, w2t, a2t, g2t, w0, a0, WAw, WAa, Y);
        }
    }
    for (int hi = gw; hi < NB * 256; hi += NGW) { const int hb = hi >> 8, hc = (hi & 255) + 1; const int src = hc == 1 ? MBASE + NMETA - 1 : hb * SEQ + 32 * (hc - 1) - 1;
        bf16_t* hd = (bf16_t*)(F.ws + WS_HALO) + (size_t)hi * 1536;
#pragma unroll
        for (int j = 0; j < 3; ++j) *(u32x4*)(hd + 512 * j + 8 * F.lane) = *(const u32x4*)(U + (size_t)src * NABC + 512 * j + 8 * F.lane); }
    if (gw < 32) { bf16x8 af[1][8]; const int rows[1] = {MBASE + fr}; prep_afrags(af[0], U, mu, rows[0], fq); prep_tile<1>(af, rows, gw, fr, fq, w2t, a2t, g2t, w0, a0, WAw, WAa, Y); }
}

constexpr int SC_TOK = 32, SC_VEC = SC_TOK * 64, SC_BUF_F = 5 * SC_VEC + SC_TOK * 16 * 4, SC_BUF = SC_BUF_F * 4, SC_YB = 2 * SC_BUF, SC_NCH = 1 + SEQ / SC_TOK;
template <int N> __device__ __forceinline__ float ror16(float v) { return __builtin_bit_cast(float, __builtin_amdgcn_update_dpp(0, __builtin_bit_cast(int, v), 0x120 + N, 0xf, 0xf, false)); }
__device__ __forceinline__ float allreduce16(float v) { v += ror16<8>(v); v += ror16<4>(v); v += ror16<2>(v); v += ror16<1>(v); return v; }
struct ScanRegs { u32x4 zr, zrp, zk, zkp, ww, aa, zv, zvp; };
__device__ __forceinline__ void scan_load(ScanRegs& R, const bf16_t* U, const bf16_t* WAw, const bf16_t* WAa, int b, int h, int q, int c, int sw, int lane) {
    c = c < SC_NCH ? c : SC_NCH - 1;
    const int ntok = c == 0 ? NMETA : SC_TOK, p0 = c == 0 ? 0 : NMETA + SC_TOK * (c - 1), per = ntok / 4, i0 = lane >> 3, i = i0 < per ? i0 : per - 1, o = lane & 7;
    const int p = p0 + sw * per + i, row = row_of(b, p), prow = row_of(b, p > 0 ? p - 1 : 0), ch = h * 64 + 8 * o, cv = 1024 + h * 64 + 16 * q + 8 * (o & 1);
    R.zr = *(const u32x4*)(U + (size_t)row * NABC + ch); R.zk = *(const u32x4*)(U + (size_t)row * NABC + 512 + ch);
    R.ww = *(const u32x4*)(WAw + (size_t)row * AW + ch); R.aa = *(const u32x4*)(WAa + (size_t)row * AW + ch);
    R.zv = *(const u32x4*)(U + (size_t)row * NABC + cv);
    R.zrp = *(const u32x4*)(U + (size_t)prow * NABC + ch); R.zkp = *(const u32x4*)(U + (size_t)prow * NABC + 512 + ch); R.zvp = *(const u32x4*)(U + (size_t)prow * NABC + cv);
}
__device__ __forceinline__ void scan_stage(const ScanRegs& R, LAS float* buf, int c, int sw, int lane, const float (&mur)[8], const float (&muk)[8], const float (&muv)[8], const float (&kkc)[8], const float (&kac)[8]) {
    const int ntok = c == 0 ? NMETA : SC_TOK, per = ntok / 4, i = lane >> 3, o = lane & 7;
    if (i < per) {
        const int tt = sw * per + i;
        float zr[8], zrp[8], zk[8], zkp[8], ww[8], aa[8];
        unpack8(R.zr, zr); unpack8(R.zrp, zrp); unpack8(R.zk, zk); unpack8(R.zkp, zkp); unpack8(R.ww, ww); unpack8(R.aa, aa);
        const bool first = (c == 0 && tt == 0);
        if (first) {
#pragma unroll
            for (int j = 0; j < 8; ++j) { zrp[j] = 0.f; zkp[j] = 0.f; } }
        float r[8], kx[8], kk[8], ss = 0.f;
#pragma unroll
        for (int j = 0; j < 8; ++j) { r[j] = zr[j] + (zrp[j] - zr[j]) * mur[j]; kx[j] = zk[j] + (zkp[j] - zk[j]) * muk[j]; kk[j] = kx[j] * kkc[j]; ss += kk[j] * kk[j]; }
        ss = allreduce8(ss);
        const float inv = 1.0f / fmaxf(sqrtf(ss), 1e-12f);
        float av[8], bv[8], dv[8], k2[8], rd[8], br = 0.f, kr = 0.f;
#pragma unroll
        for (int j = 0; j < 8; ++j) { const float kn = kk[j] * inv; av[j] = -kn; bv[j] = kn * aa[j]; dv[j] = __expf(-ww[j]); k2[j] = kx[j] * (1.0f + (aa[j] - 1.0f) * kac[j]); rd[j] = dv[j] * r[j];
            br += bv[j] * r[j]; kr += k2[j] * r[j]; }
        br = allreduce8(br); kr = allreduce8(kr);
        LAS float* dst = buf + tt * 64 + 8 * o;
        *(LAS f32x4*)(dst + 0 * SC_VEC) = (f32x4){av[0], av[1], av[2], av[3]}; *(LAS f32x4*)(dst + 0 * SC_VEC + 4) = (f32x4){av[4], av[5], av[6], av[7]};
        *(LAS f32x4*)(dst + 1 * SC_VEC) = (f32x4){bv[0], bv[1], bv[2], bv[3]}; *(LAS f32x4*)(dst + 1 * SC_VEC + 4) = (f32x4){bv[4], bv[5], bv[6], bv[7]};
        *(LAS f32x4*)(dst + 2 * SC_VEC) = (f32x4){dv[0], dv[1], dv[2], dv[3]}; *(LAS f32x4*)(dst + 2 * SC_VEC + 4) = (f32x4){dv[4], dv[5], dv[6], dv[7]};
        *(LAS f32x4*)(dst + 3 * SC_VEC) = (f32x4){k2[0], k2[1], k2[2], k2[3]}; *(LAS f32x4*)(dst + 3 * SC_VEC + 4) = (f32x4){k2[4], k2[5], k2[6], k2[7]};
        *(LAS f32x4*)(dst + 4 * SC_VEC) = (f32x4){rd[0], rd[1], rd[2], rd[3]}; *(LAS f32x4*)(dst + 4 * SC_VEC + 4) = (f32x4){rd[4], rd[5], rd[6], rd[7]};
        if (o < 2) { float zv[8], zvp[8]; unpack8(R.zv, zv); unpack8(R.zvp, zvp); float v[8];
            if (first) {
#pragma unroll
                for (int j = 0; j < 8; ++j) zvp[j] = 0.f; }
#pragma unroll
            for (int j = 0; j < 8; ++j) { v[j] = zv[j] + (zvp[j] - zv[j]) * muv[j]; }
            LAS float* vd = buf + 5 * SC_VEC + (tt * 16 + 8 * o) * 4;
#pragma unroll
            for (int j = 0; j < 8; ++j) *(LAS f32x4*)(vd + 4 * j) = (f32x4){v[j], br, kr, 0.f}; }
    }
}
struct StepIn { f32x4 a, b, d, k, rd, vs; };
template <int J> __device__ __forceinline__ void step_load(StepIn& I, unsigned avec, unsigned avs) {
    asm volatile("ds_read_b128 %0, %1 offset:%2" : "=v"(I.a) : "v"(avec), "n"(J * 256));
    asm volatile("ds_read_b128 %0, %1 offset:%2" : "=v"(I.b) : "v"(avec), "n"(J * 256 + 8192));
    asm volatile("ds_read_b128 %0, %1 offset:%2" : "=v"(I.d) : "v"(avec), "n"(J * 256 + 16384));
    asm volatile("ds_read_b128 %0, %1 offset:%2" : "=v"(I.k) : "v"(avec), "n"(J * 256 + 24576));
    asm volatile("ds_read_b128 %0, %1 offset:%2" : "=v"(I.rd) : "v"(avec), "n"(J * 256 + 32768));
    asm volatile("ds_read_b128 %0, %1 offset:%2" : "=v"(I.vs) : "v"(avs), "n"(J * 256));
}
#define STEP_WAIT(I, n) asm volatile("s_waitcnt lgkmcnt(" #n ")" : "+v"(I.a), "+v"(I.b), "+v"(I.d), "+v"(I.k), "+v"(I.rd), "+v"(I.vs))
static_assert(SC_VEC * 4 == 8192, "asm offsets");
__device__ __forceinline__ float step_compute(const StepIn& I, f32x2& S01, f32x2& S23) {
    const f32x2 a01 = {I.a[0], I.a[1]}, a23 = {I.a[2], I.a[3]}, r01 = {I.rd[0], I.rd[1]}, r23 = {I.rd[2], I.rd[3]};
    f32x2 q = S01 * a01; q = S23 * a23 + q; f32x2 w = S01 * r01; w = S23 * r23 + w;
    float p1 = q.x + q.y, p2 = w.x + w.y;
    p1 = allreduce16(p1); p2 = allreduce16(p2);
    const float y = p2 + (p1 * I.vs[1] + I.vs[0] * I.vs[2]);
    const f32x2 pv = {p1, p1}, vv = {I.vs[0], I.vs[0]}, b01 = {I.b[0], I.b[1]}, b23 = {I.b[2], I.b[3]}, k01 = {I.k[0], I.k[1]}, k23 = {I.k[2], I.k[3]}, d01 = {I.d[0], I.d[1]}, d23 = {I.d[2], I.d[3]};
    S01 = S01 * d01 + (pv * b01 + vv * k01); S23 = S23 * d23 + (pv * b23 + vv * k23);
    return y;
}
__device__ __forceinline__ void phase_scan(Frame& F, int l) {
    PHASE_ENTER(F);
    const bf16_t* U = F.R1; const bf16_t* WAw = F.R2; const bf16_t* WAa = F.R2 + (size_t)NROWS * AW; bf16_t* Y = F.R3;
    const float* mu = in_ptr(F, I_MU) + l * AIN; const float* kkp = in_ptr(F, I_KK) + l * AW; const float* kap = in_ptr(F, I_KA) + l * AW;
    const int lane = F.lane, wave = F.wave;
    constexpr int NIT = SC_NCH + 4;
    static_assert(NIT % 3 == 0, "NIT");
    for (int unit = F.bid; unit < NB * 8 * 4; unit += F.G) {
        const int b = unit >> 5, h = (unit >> 2) & 7, q = unit & 3;
        __syncthreads();
        if (wave >= 4) {
            const int sw = wave - 4, o = lane & 7, ch = h * 64 + 8 * o, cv = 1024 + h * 64 + 16 * q + 8 * (o & 1);
            float mur[8], muk[8], muv[8], kkc[8], kac[8];
#pragma unroll
            for (int j = 0; j < 8; ++j) { mur[j] = mu[ch + j]; muk[j] = mu[512 + ch + j]; muv[j] = mu[cv + j]; kkc[j] = kkp[ch + j]; kac[j] = kap[ch + j]; }
            ScanRegs R0, R1, R2; scan_load(R0, U, WAw, WAa, b, h, q, 0, sw, lane); scan_load(R1, U, WAw, WAa, b, h, q, 1, sw, lane);
#define SC_FLUSH(kk_) do { const int c_ = (kk_) - 2; if (c_ >= 0 && c_ < SC_NCH) { const int ntok_ = c_ == 0 ? NMETA : SC_TOK, p0_ = c_ == 0 ? 0 : NMETA + SC_TOK * (c_ - 1); \
                const LAS float* yb_ = (const LAS float*)(F.lds + SC_YB + (c_ & 1) * (SC_TOK * 16 * 4)); const int t2_ = sw * 64 + lane, tt_ = t2_ >> 3, pr_ = t2_ & 7; \
                if (tt_ < ntok_ && (b == 0 || c_ > 0)) { const int row_ = row_of(b, p0_ + tt_); \
                    *(unsigned*)(Y + (size_t)row_ * NY + h * 64 + 16 * q + 2 * pr_) = cvt_pk_bf16(yb_[tt_ * 16 + 2 * pr_], yb_[tt_ * 16 + 2 * pr_ + 1]); } } } while (0)
#define SC_SUBIT(kk_, RC_, RL_) do { scan_load(RL_, U, WAw, WAa, b, h, q, (kk_) + 2, sw, lane); \
                if ((kk_) < SC_NCH) scan_stage(RC_, (LAS float*)(F.lds + ((kk_) & 1) * SC_BUF), (kk_), sw, lane, mur, muk, muv, kkc, kac); \
                SC_FLUSH(kk_); LDS_WAIT(); __builtin_amdgcn_s_barrier(); asm volatile("" ::: "memory"); } while (0)
            for (int k = 0; k < NIT; k += 3) { SC_SUBIT(k, R0, R2); SC_SUBIT(k + 1, R1, R0); SC_SUBIT(k + 2, R2, R1); }
#undef SC_SUBIT
#undef SC_FLUSH
        } else {
            const int rr = lane >> 4, kq = lane & 15, row16 = 4 * wave + rr;
            f32x2 S01 = {0.f, 0.f}, S23 = {0.f, 0.f};
            for (int k = 0; k < NIT; ++k) {
                if (k >= 1 && k <= SC_NCH) {
                    const int c = k - 1, ntok = c == 0 ? NMETA : SC_TOK;
                    const LAS float* buf = (const LAS float*)(F.lds + (c & 1) * SC_BUF);
                    LAS float* yb = (LAS float*)(F.lds + SC_YB + (c & 1) * (SC_TOK * 16 * 4));
                    const unsigned bvec = (unsigned)(size_t)buf + 16u * kq, bvs = (unsigned)(size_t)buf + (5 * SC_VEC + row16 * 4) * 4u;
                    for (int t0 = 0; t0 < ntok; t0 += 16) {
                        float yk = 0.f; StepIn I0, I1, I2;
                        const unsigned v0 = bvec + t0 * 256u, w0 = bvs + t0 * 256u;
#define SC_LD(I, j) step_load<j>(I, v0, w0)
#define SC_ST(I, j, n) do { STEP_WAIT(I, n); const float y_ = step_compute(I, S01, S23); yk = (kq == (j)) ? y_ : yk; } while (0)
                        SC_LD(I0, 0); SC_LD(I1, 1);
                        SC_LD(I2, 2); SC_ST(I0, 0, 12); SC_LD(I0, 3); SC_ST(I1, 1, 12); SC_LD(I1, 4); SC_ST(I2, 2, 12);
                        SC_LD(I2, 5); SC_ST(I0, 3, 12); SC_LD(I0, 6); SC_ST(I1, 4, 12); SC_LD(I1, 7); SC_ST(I2, 5, 12);
                        SC_LD(I2, 8); SC_ST(I0, 6, 12); SC_LD(I0, 9); SC_ST(I1, 7, 12); SC_LD(I1, 10); SC_ST(I2, 8, 12);
                        SC_LD(I2, 11); SC_ST(I0, 9, 12); SC_LD(I0, 12); SC_ST(I1, 10, 12); SC_LD(I1, 13); SC_ST(I2, 11, 12);
                        SC_LD(I2, 14); SC_ST(I0, 12, 12); SC_LD(I0, 15); SC_ST(I1, 13, 12); SC_ST(I2, 14, 6); SC_ST(I0, 15, 0);
#undef SC_LD
#undef SC_ST
                        yb[(t0 + kq) * 16 + row16] = yk;
                    }
                }
                LDS_WAIT(); __builtin_amdgcn_s_barrier(); asm volatile("" ::: "memory");
            }
        }
    }
}

#define LD8(dst, p) float dst[8]; { const f32x4 x0_ = *(const f32x4*)(p), x1_ = *(const f32x4*)((p) + 4); dst[0] = x0_[0]; dst[1] = x0_[1]; dst[2] = x0_[2]; dst[3] = x0_[3]; dst[4] = x1_[0]; dst[5] = x1_[1]; dst[6] = x1_[2]; dst[7] = x1_[3]; }
namespace p2 {
constexpr int X_AT = 0, X_RT = 4096, X_BT = 8192, X_KT = 12288, X_VT = 16384, X_AAB = 20480, X_AAK = 24576, X_MRK = 26624, X_TT = 28672, X_A21 = 30720, X_TC11 = 31232, X_Z1T = 31744, SZ = 32256, NW = 4;
constexpr int G_TT = 0, G_MRB = 2048, G_XA = 4096, G_FA = 8192, G_SZ = 12288;
static_assert(NW * SZ <= LDSCTL_OFF && X_AAK == X_AAB + 4096 && X_MRK == X_AAK + 2048 && X_TT == X_MRK + 2048, "prep2 LDS");
}
constexpr int P2_UNITS = 8 * (1 + NB * 256);
static_assert((size_t)P2_UNITS * p2::G_SZ <= (size_t)NREAL * DM * 4, "scan side blocks");
__device__ __forceinline__ int p2_unit(int b, int h, int c) { return (c == 0 ? 0 : 1 + b * 256 + (c - 1)) * 8 + h; }
namespace ck {
constexpr int PSZ = 26880, NSLOT = 4, O_AT = 0, O_RT = 4096, O_TT = 8192, O_MRB = 10240, O_XA = 12288, O_FA = 14336, O_BT = 16384, O_KT = 20992, BK_LD = 72  , O_VV = 25600  , O_GV = 26624;
constexpr int C_BASE = 132096, O_ST = 0, O_U0T = 2048, O_WT = 3072, O_FLAG = 4096, NCH = 1 + SEQ / 32;
static_assert(NSLOT * PSZ <= LDSCTL_OFF && C_BASE + O_FLAG + 64 <= LDS_BYTES && C_BASE >= PTR_OFF + 8 * 40, "chunked-scan LDS map");
typedef float f32x4v __attribute__((ext_vector_type(4)));
__device__ __forceinline__ f32x4 mma(bf16x8 a, bf16x8 b, f32x4 c) { return __builtin_amdgcn_mfma_f32_16x16x32_bf16(a, b, c, 0, 0, 0); }
__device__ __forceinline__ bf16x8 frag(const LAS unsigned char* base, int ld, int row0, int k0, int lane) { return *(const LAS bf16x8*)(base + ((row0 + (lane & 15)) * ld + k0 + 8 * (lane >> 4)) * 2); }
__device__ __forceinline__ bf16x8 frag16(const LAS unsigned char* base, int ld, int row0, int lane) { const bf16x8 z = {0, 0, 0, 0, 0, 0, 0, 0}; const int q = lane >> 4; bf16x8 v = *(const LAS bf16x8*)(base + ((row0 + (lane & 15)) * ld + 8 * (q & 1)) * 2); return q < 2 ? v : z; }
__device__ __forceinline__ void lds_spin(volatile LAS unsigned* p, unsigned want) { while (*p < want) __builtin_amdgcn_s_sleep(1); }
__device__ __forceinline__ bf16x8 frag_tr(const LAS unsigned char* base, int pitch, int k0, int n0, int lane) {
    const unsigned a0 = (unsigned)(size_t)base + (unsigned)((k0 + 8 * (lane >> 4) + ((lane >> 2) & 3)) * pitch + n0 * 2 + 8 * (lane & 3)), a1 = a0 + 4u * (unsigned)pitch;
    u32x2 lo, hi; asm volatile("ds_read_b64_tr_b16 %0, %2\n\tds_read_b64_tr_b16 %1, %3\n\ts_waitcnt lgkmcnt(0)" : "=&v"(lo), "=&v"(hi) : "v"(a0), "v"(a1) : "memory");
    const u32x4 v = {lo.x, lo.y, hi.x, hi.y}; return __builtin_bit_cast(bf16x8, v);
}
}
#define LD8G(dst, p) float dst[8]; { const f32x4 x0_ = *(const GAS f32x4*)(p), x1_ = *(const GAS f32x4*)((p) + 4); dst[0] = x0_[0]; dst[1] = x0_[1]; dst[2] = x0_[2]; dst[3] = x0_[3]; dst[4] = x1_[0]; dst[5] = x1_[1]; dst[6] = x1_[2]; dst[7] = x1_[3]; }
__device__ __forceinline__ bf16x8 pack_acc(f32x4 a, f32x4 b) { const u32x4 v = {cvt_pk_bf16(a[0], a[1]), cvt_pk_bf16(a[2], a[3]), cvt_pk_bf16(b[0], b[1]), cvt_pk_bf16(b[2], b[3])}; return __builtin_bit_cast(bf16x8, v); }
struct TrF { u32x2 lo, hi; };
__device__ __forceinline__ void tr_issue(TrF& f, const LAS unsigned char* base, int pitch, int k0, int n0, int step, int lane) {
    const unsigned a0 = (unsigned)(size_t)base + (unsigned)((k0 + step * (lane >> 4) + ((lane >> 2) & 3)) * pitch + n0 * 2 + 8 * (lane & 3)), a1 = a0 + (unsigned)((step == 8 ? 4 : 16) * pitch);
    asm volatile("ds_read_b64_tr_b16 %0, %2\n\tds_read_b64_tr_b16 %1, %3" : "=&v"(f.lo), "=&v"(f.hi) : "v"(a0), "v"(a1) : "memory");
}
__device__ __forceinline__ bf16x8 tr_get(const TrF& f) { const u32x4 v = {f.lo.x, f.lo.y, f.hi.x, f.hi.y}; return __builtin_bit_cast(bf16x8, v); }
#define TR_WAIT4(a, b, c, d) asm volatile("s_waitcnt lgkmcnt(0)" : "+v"(a.lo), "+v"(a.hi), "+v"(b.lo), "+v"(b.hi), "+v"(c.lo), "+v"(c.hi), "+v"(d.lo), "+v"(d.hi) :: "memory")
#define TR_WAIT5(a, b, c, d, e) asm volatile("s_waitcnt lgkmcnt(0)" : "+v"(a.lo), "+v"(a.hi), "+v"(b.lo), "+v"(b.hi), "+v"(c.lo), "+v"(c.hi), "+v"(d.lo), "+v"(d.hi), "+v"(e.lo), "+v"(e.hi) :: "memory")
__device__ __forceinline__ void ck_fetch(u32x4 (&PR)[24], const bf16_t* U, const bf16_t* WAw, const bf16_t* WAa, const float* GC, const unsigned char* CKX, int b, int h, int q, int c, int lane) {
    c = c < ck::NCH ? c : ck::NCH - 1;
    const int o = lane & 7, ti = lane >> 3, ch = h * 64 + 8 * o; const int p0 = c == 0 ? 0 : NMETA + 32 * (c - 1), nreal = c == 0 ? NMETA : 32;
#pragma unroll
    for (int p = 0; p < 4; ++p) { const int t = 8 * p + ti; const size_t row = (size_t)row_of(b, p0 + (t < nreal ? t : 0));
        PR[p] = *(const GAS u32x4*)(WAw + row * AW + ch); PR[4 + p] = *(const GAS u32x4*)(WAa + row * AW + ch);
        PR[8 + p] = *(const GAS u32x4*)(U + row * NABC + ch); PR[12 + p] = *(const GAS u32x4*)(U + row * NABC + 512 + ch); }
    { const int t = lane >> 1; PR[16] = *(const GAS u32x4*)(U + (size_t)row_of(b, p0 + (t < nreal ? t : 0)) * NABC + 1024 + h * 64 + 16 * q + 8 * (lane & 1)); }
    const unsigned char* gx = CKX + (size_t)p2_unit(b, h, c) * p2::G_SZ;
    PR[17] = *(const GAS u32x4*)(gx + p2::G_TT + lane * 32); PR[18] = *(const GAS u32x4*)(gx + p2::G_TT + lane * 32 + 16);
    PR[19] = *(const GAS u32x4*)(gx + p2::G_MRB + lane * 32); PR[20] = *(const GAS u32x4*)(gx + p2::G_MRB + lane * 32 + 16);
    { const u32x2 x0 = *(const GAS u32x2*)(gx + p2::G_XA + ((q * 2 + 0) * 64 + lane) * 8), x1 = *(const GAS u32x2*)(gx + p2::G_XA + ((q * 2 + 1) * 64 + lane) * 8);
      const u32x2 f0 = *(const GAS u32x2*)(gx + p2::G_FA + ((q * 2 + 0) * 64 + lane) * 8), f1 = *(const GAS u32x2*)(gx + p2::G_FA + ((q * 2 + 1) * 64 + lane) * 8);
      PR[21] = (u32x4){x0.x, x0.y, x1.x, x1.y}; PR[22] = (u32x4){f0.x, f0.y, f1.x, f1.y}; }
    PR[23] = *(const GAS u32x4*)(GC + ((size_t)((c == 0 ? 0 : b) * 8 + h) * 257 + c) * 64 + 4 * (lane & 15));
}
__device__ __forceinline__ void ck_put(LAS unsigned char* pb, const u32x4 (&PR)[24], int c, int lane) {
    using namespace ck;
    const int o = lane & 7, ti = lane >> 3; const int nreal = c == 0 ? NMETA : 32; const u32x4 z4 = {0u, 0u, 0u, 0u};
    const int o4 = o & 3, gl = (4 * (o4 & 1) + (o4 >> 1)) * 8 + (o >> 2) * 64;
#pragma unroll
    for (int p = 0; p < 4; ++p) { const int t = 8 * p + ti; const bool real = t < nreal; const u32x4 xa = real ? PR[p] : z4, xr = real ? PR[8 + p] : z4;
        *(LAS u32x2*)(pb + O_AT + t * 128 + gl) = (u32x2){xa.x, xa.y}; *(LAS u32x2*)(pb + O_AT + t * 128 + gl + 16) = (u32x2){xa.z, xa.w};
        *(LAS u32x2*)(pb + O_RT + t * 128 + gl) = (u32x2){xr.x, xr.y}; *(LAS u32x2*)(pb + O_RT + t * 128 + gl + 16) = (u32x2){xr.z, xr.w};
        *(LAS u32x4*)(pb + O_BT + (t * BK_LD + 8 * o) * 2) = real ? PR[4 + p] : z4; *(LAS u32x4*)(pb + O_KT + (t * BK_LD + 8 * o) * 2) = real ? PR[12 + p] : z4; }
    *(LAS u32x4*)(pb + O_VV + lane * 16) = (lane >> 1) < nreal ? PR[16] : z4;
    { const int trow = lane >> 1, hf = lane & 1;
#pragma unroll
      for (int e = 0; e < 2; ++e) { const int o5 = 2 * hf + e, g5 = (4 * (o5 & 1) + (o5 >> 1)) * 8; const u32x4 xt = PR[17 + e], xm = PR[19 + e];
          *(LAS u32x2*)(pb + O_TT + trow * 64 + g5) = (u32x2){xt.x, xt.y}; *(LAS u32x2*)(pb + O_TT + trow * 64 + g5 + 16) = (u32x2){xt.z, xt.w};
          *(LAS u32x2*)(pb + O_MRB + trow * 64 + g5) = (u32x2){xm.x, xm.y}; *(LAS u32x2*)(pb + O_MRB + trow * 64 + g5 + 16) = (u32x2){xm.z, xm.w}; } }
    { const u32x4 x = PR[21], f = PR[22];
      *(LAS u32x4*)(pb + O_XA + lane * 16) = (u32x4){x.x << 16, x.x & 0xffff0000u, x.y << 16, x.y & 0xffff0000u}; *(LAS u32x4*)(pb + O_XA + (64 + lane) * 16) = (u32x4){x.z << 16, x.z & 0xffff0000u, x.w << 16, x.w & 0xffff0000u};
      *(LAS u32x4*)(pb + O_FA + lane * 16) = (u32x4){f.x << 16, f.x & 0xffff0000u, f.y << 16, f.y & 0xffff0000u}; *(LAS u32x4*)(pb + O_FA + (64 + lane) * 16) = (u32x4){f.z << 16, f.z & 0xffff0000u, f.w << 16, f.w & 0xffff0000u}; }
    if (lane < 16) *(LAS u32x4*)(pb + O_GV + lane * 16) = PR[23];
}
__device__ __forceinline__ void phase_scan_chunked(Frame& F, int l) {
    PHASE_ENTER(F);
    using namespace ck;
    const bf16_t* U = F.R1; const bf16_t* WAw = F.R2; const bf16_t* WAa = F.R2 + (size_t)NROWS * AW; bf16_t* Y = F.R3;
    const float* GC = (const float*)(F.ws + WS_GC); const unsigned char* CKX = (const unsigned char*)lds_ptr(F.lds, 36);
    const int lane = F.lane, wave = F.wave, fr = lane & 15, fq = lane >> 4;
    LAS unsigned char* cb = F.lds + C_BASE; volatile LAS unsigned* flags = (volatile LAS unsigned*)(cb + O_FLAG);
    for (int u0 = F.bid; u0 < NB * 8 * 4; u0 += F.G) {
        const int unit = F.G == 256 ? (u0 & 7) * 32 + (u0 >> 3) : u0;
        const int b = unit >> 5, h = (unit >> 2) & 7, q = unit & 3;
        __syncthreads();
        if (F.tid < 16) flags[F.tid] = 0u;
        for (int i = F.tid; i < 1024; i += 512) ((LAS unsigned*)(cb + O_ST))[i] = 0u;
        __syncthreads();
        if (wave >= 1 && wave <= NSLOT) {
            const int sl = wave - 1; LAS unsigned char* pb = F.lds + sl * PSZ;
            unsigned n = 0; u32x4 PR[24]; ck_fetch(PR, U, WAw, WAa, GC, CKX, b, h, q, sl, lane);
            for (int c = sl; c < NCH; c += NSLOT, ++n) {
                lds_spin(flags + 4 + sl, n);
                asm volatile("" ::: "memory");
                ck_put(pb, PR, c, lane);
                ck_fetch(PR, U, WAw, WAa, GC, CKX, b, h, q, c + NSLOT, lane);
                asm volatile("s_waitcnt lgkmcnt(0)" ::: "memory");
                if (lane == 0) flags[sl] = n + 1;
            }
        } else if (wave == 0) {
            f32x4 accS[4];
#pragma unroll
            for (int kt = 0; kt < 4; ++kt) accS[kt] = (f32x4){0.f, 0.f, 0.f, 0.f};
            for (int c = 0; c < NCH; ++c) {
                const int s = c & (NSLOT - 1); const unsigned n = (unsigned)(c >> 2);
                const LAS unsigned char* sb = F.lds + s * PSZ;
                lds_spin(flags + s, n + 1);
                asm volatile("" ::: "memory");
                f32x4 u0 = *(const LAS f32x4*)(sb + O_XA + lane * 16), u1 = *(const LAS f32x4*)(sb + O_XA + (64 + lane) * 16);
                const bf16x8 a00 = frag(sb + O_AT, 64, 0, 0, lane), a01 = frag(sb + O_AT, 64, 0, 32, lane), a10 = frag(sb + O_AT, 64, 16, 0, lane), a11 = frag(sb + O_AT, 64, 16, 32, lane);
                const bf16x8 t0 = frag(sb + O_TT, 32, 0, 0, lane), t1 = frag(sb + O_TT, 32, 16, 0, lane);
                const bf16x8 pA = pack_acc(accS[0], accS[1]), pB = pack_acc(accS[2], accS[3]);
                asm volatile("" ::: "memory");
                f32x4 y0 = *(const LAS f32x4*)(sb + O_FA + lane * 16), y1 = *(const LAS f32x4*)(sb + O_FA + (64 + lane) * 16);
                const bf16x8 r00 = frag(sb + O_RT, 64, 0, 0, lane), r01 = frag(sb + O_RT, 64, 0, 32, lane), r10 = frag(sb + O_RT, 64, 16, 0, lane), r11 = frag(sb + O_RT, 64, 16, 32, lane);
                const bf16x8 m0 = frag(sb + O_MRB, 32, 0, 0, lane), m1 = frag(sb + O_MRB, 32, 16, 0, lane);
                f32x4 g[4];
#pragma unroll
                for (int kt = 0; kt < 4; ++kt) g[kt] = *(const LAS f32x4*)(sb + O_GV + (16 * kt + 4 * fq) * 4);
                u0 = mma(a00, pA, u0); u1 = mma(a10, pA, u1); u0 = mma(a01, pB, u0); u1 = mma(a11, pB, u1);
                y0 = mma(pA, r00, y0); y1 = mma(pA, r10, y1); y0 = mma(pB, r01, y0); y1 = mma(pB, r11, y1);
                TrF fv, fk[4], fb[4];
                tr_issue(fv, sb + O_VV, 32, 0, 0, 8, lane);
#pragma unroll
                for (int kt = 0; kt < 4; ++kt) tr_issue(fk[kt], sb + O_KT, 2 * BK_LD, 0, 16 * kt, 8, lane);
                const bf16x8 pU = pack_acc(u0, u1);
                f32x4 w0 = {0.f, 0.f, 0.f, 0.f}, w1 = w0; w0 = mma(t0, pU, w0); w1 = mma(t1, pU, w1);
                TR_WAIT5(fv, fk[0], fk[1], fk[2], fk[3]);
#pragma unroll
                for (int kt = 0; kt < 4; ++kt) tr_issue(fb[kt], sb + O_BT, 2 * BK_LD, 0, 16 * kt, 4, lane);
                { const bf16x8 fvv = tr_get(fv);
#pragma unroll
                  for (int kt = 0; kt < 4; ++kt) accS[kt] = mma(tr_get(fk[kt]), fvv, accS[kt]); }
                const bf16x8 pW = pack_acc(w0, w1);
                y0 = mma(pW, m0, y0); y1 = mma(pW, m1, y1);
                TR_WAIT4(fb[0], fb[1], fb[2], fb[3]);
                if (lane == 0) flags[4 + s] = n + 1;
#pragma unroll
                for (int kt = 0; kt < 4; ++kt) { accS[kt] = mma(tr_get(fb[kt]), pW, accS[kt]); accS[kt] = accS[kt] * g[kt]; }
                { const int nreal = c == 0 ? NMETA : 32, p0 = c == 0 ? 0 : NMETA + 32 * (c - 1);
                  if (fr < nreal && (b == 0 || c > 0)) *(u32x2*)(Y + (size_t)row_of(b, p0 + fr) * NY + h * 64 + 16 * q + 4 * fq) = (u32x2){cvt_pk_bf16(y0[0], y0[1]), cvt_pk_bf16(y0[2], y0[3])};
                  if (16 + fr < nreal && (b == 0 || c > 0)) *(u32x2*)(Y + (size_t)row_of(b, p0 + 16 + fr) * NY + h * 64 + 16 * q + 4 * fq) = (u32x2){cvt_pk_bf16(y1[0], y1[1]), cvt_pk_bf16(y1[2], y1[3])}; }
            }
        }
    }
    __syncthreads();
}

template <int WIN> __device__ __forceinline__ void pool_group(const bf16_t* U, bf16_t* Y, const bf16_t* pwt, const float* csc, int b, int pbase, int g, int lane) {
    const int fr = lane & 15, fq = lane >> 4, p = pbase + fr, row = row_of(b, p), cnt = (p + 1) < WIN ? (p + 1) : WIN;
    const float inv = 1.0f / (float)cnt;
    int rows[WIN];
#pragma unroll
    for (int i = 0; i < WIN; ++i) rows[i] = row_of(b, p - i > 0 ? p - i : 0);
    bf16x8 af[4];
#pragma unroll
    for (int ks = 0; ks < 4; ++ks) {
        const int col = AIN + 1024 + g * 128 + 32 * ks + 8 * fq;
        float sum[8], z0[8];
        constexpr int NB8 = WIN < 8 ? WIN : 8;
#pragma unroll
        for (int i0 = 0; i0 < WIN; i0 += NB8) {
            u32x4 raw[NB8];
#pragma unroll
            for (int i = 0; i < NB8; ++i) raw[i] = *(const u32x4*)(U + (size_t)rows[i0 + i] * NABC + col);
#pragma unroll
            for (int i = 0; i < NB8; ++i) { float zz[8]; unpack8(raw[i], zz);
                if (i0 + i == 0) {
#pragma unroll
                    for (int j = 0; j < 8; ++j) { z0[j] = zz[j]; sum[j] = zz[j]; } }
                else { const float m = (i0 + i) < cnt ? 1.0f : 0.0f;
#pragma unroll
                    for (int j = 0; j < 8; ++j) sum[j] += m * zz[j]; } }
        }
#pragma unroll
        for (int j = 0; j < 8; ++j) sum[j] = sum[j] * inv - z0[j];
        const u32x4 pk = pack8(sum); af[ks] = __builtin_bit_cast(bf16x8, pk);
    }
    const bf16_t* bw = pwt + (size_t)g * 128 * 128;
#pragma unroll 2
    for (int ctile = 0; ctile < 8; ++ctile) {
        f32x4 acc = (f32x4){0.f, 0.f, 0.f, 0.f};
#pragma unroll
        for (int ks = 0; ks < 4; ++ks) acc = __builtin_amdgcn_mfma_f32_16x16x32_bf16(*(const bf16x8*)(bw + (size_t)(16 * ctile + fr) * 128 + 32 * ks + 8 * fq), af[ks], acc, 0, 0, 0);
        const int c = g * 128 + 16 * ctile + 4 * fq; const f32x4 sc = *(const f32x4*)(csc + c);
        u32x2 o; o.x = cvt_pk_bf16(acc[0] * sc[0], acc[1] * sc[1]); o.y = cvt_pk_bf16(acc[2] * sc[2], acc[3] * sc[3]);
        *(u32x2*)(Y + (size_t)row * NY + 2 * AW + c) = o;
    }
}
constexpr int PB_CW = 0, PB_CT = 31 * 512 * 4, PB_NUNIT = NREAL / 32 + 1;
#ifndef PB_REP
#define PB_REP 0
#endif
__device__ __forceinline__ void pb_unit(int u, int& b, int& p0, int& ntok) { const bool meta = (u == PB_NUNIT - 1); b = meta ? 0 : (u >> 8); p0 = meta ? 0 : NMETA + 32 * (u & 255); ntok = meta ? NMETA : 32; }
template <bool DRY> __device__ __forceinline__ void postbc_a(Frame& F, int l) {
    PHASE_ENTER(F);
    const bf16_t* U = F.R1; const float* BS = (const float*)(F.ws + WS_BS); bf16_t* Y = F.R3;
    const int lane = F.lane, wave = F.wave, c8 = 8 * lane;
    float lxw[8], lxb[8];
#pragma unroll
    for (int j = 0; j < 8; ++j) { lxw[j] = in_ptr(F, I_LNXW)[l * AW + c8 + j]; lxb[j] = in_ptr(F, I_LNXB)[l * AW + c8 + j]; }
    for (int u = F.bid; u < PB_NUNIT; u += F.G) {
        int b, p0, ntok; pb_unit(u, b, p0, ntok);
        for (int tt = wave; tt < ntok; tt += 8) {
            const int p = p0 + tt, row = row_of(b, p);
            float y[8], zv[8], gv[8];
            unpack8(*(const u32x4*)(Y + (size_t)row * NY + c8), y); unpack8(*(const u32x4*)(Y + (size_t)row * NY + AW + c8), gv);
            unpack8(*(const u32x4*)(U + (size_t)row * NABC + 1024 + c8), zv);
            const float bs = BS[(size_t)row * 8 + (lane >> 3)];
            float s = 0.f;
#pragma unroll
            for (int j = 0; j < 8; ++j) s += y[j];
            s = allreduce8(s);
            const float mean = s * (1.0f / 64.0f); float qv = 0.f;
#pragma unroll
            for (int j = 0; j < 8; ++j) { y[j] -= mean; qv += y[j] * y[j]; }
            qv = allreduce8(qv);
            const float rstd = __builtin_amdgcn_rsqf(qv * (1.0f / 64.0f) + LNX_EPS);
            float o[8];
#pragma unroll
            for (int j = 0; j < 8; ++j) o[j] = (y[j] * rstd * lxw[j] + lxb[j] + bs * zv[j]) * gv[j];
            if (DRY) *(u32x4*)((bf16_t*)(F.ws + 962 * MiB) + (size_t)(row & 32767) * AW + c8) = pack8(o); else *(u32x4*)(Y + (size_t)row * NY + c8) = pack8(o);
        }
    }
}
__device__ __forceinline__ void postbc_b(Frame& F, int l) {
    PHASE_ENTER(F);
    const bf16_t* U = F.R1; bf16_t* Y = F.R3;
    LAS float* cw = (LAS float*)(F.lds + PB_CW); LAS bf16_t* ct = (LAS bf16_t*)(F.lds + PB_CT);
    const int lane = F.lane, wave = F.wave, c8 = 8 * lane;
    __syncthreads();
    for (int i = F.tid; i < 31 * 512; i += 512) cw[i] = in_ptr(F, I_CONVW)[(size_t)l * 31 * 512 + i];
    float cvb[8], lng[8], lnb[8];
#pragma unroll
    for (int j = 0; j < 8; ++j) { cvb[j] = in_ptr(F, I_CONVB)[l * AW + c8 + j]; lng[j] = in_ptr(F, I_BLNG)[l * AW + c8 + j]; lnb[j] = in_ptr(F, I_BLNB)[l * AW + c8 + j]; }
    for (int u = F.bid; u < PB_NUNIT; u += F.G) {
        int b, p0, ntok; pb_unit(u, b, p0, ntok);
        __syncthreads();
        {
            u32x4 r1[8], r2[8];
#pragma unroll
            for (int it = 0; it < 8; ++it) { const int idx = F.tid + it * 512, i = idx >> 6, oc = idx & 63, p = p0 - 30 + i; const int row = row_of(b, p > 0 ? p : 0);
                r1[it] = *(const u32x4*)(U + (size_t)row * NABC + AIN + 8 * oc); r2[it] = *(const u32x4*)(U + (size_t)row * NABC + AIN + 512 + 8 * oc); }
#pragma unroll
            for (int it = 0; it < 8; ++it) { const int idx = F.tid + it * 512, i = idx >> 6, oc = idx & 63, p = p0 - 30 + i;
                if (i < 30 + ntok) { float z1[8], z2[8]; unpack8(r1[it], z1); unpack8(r2[it], z2); const float m = p >= 0 ? 1.0f : 0.0f;
#pragma unroll
                    for (int j = 0; j < 8; ++j) z1[j] *= m * fast_sigmoid(z2[j]);
                    *(LAS u32x4*)(ct + i * 512 + 8 * oc) = pack8(z1); } }
        }
        __syncthreads();
        const int TPW = ntok / 8, t0w = wave * TPW;
        {
            float acc[4][8];
#pragma unroll
            for (int i = 0; i < 4; ++i)
#pragma unroll
                for (int j = 0; j < 8; ++j) acc[i][j] = cvb[j];
            float win[4][8];
#pragma unroll
            for (int i = 0; i < 3; ++i) unpack8(*(const LAS u32x4*)(ct + (t0w + i) * 512 + c8), win[i + 1]);
#pragma unroll 2
            for (int jt = 0; jt < 31; ++jt) {
#pragma unroll
                for (int i = 0; i < 3; ++i)
#pragma unroll
                    for (int j = 0; j < 8; ++j) win[i][j] = win[i + 1][j];
                unpack8(*(const LAS u32x4*)(ct + (t0w + jt + 3) * 512 + c8), win[3]);
                const f32x4 w0 = *(const LAS f32x4*)(cw + jt * 512 + c8), w1 = *(const LAS f32x4*)(cw + jt * 512 + c8 + 4);
#pragma unroll
                for (int i = 0; i < 4; ++i)
#pragma unroll
                    for (int j = 0; j < 4; ++j) { acc[i][j] += win[i][j] * w0[j]; acc[i][4 + j] += win[i][4 + j] * w1[j]; }
            }
#pragma unroll
            for (int i = 0; i < 4; ++i) {
                if (i < TPW) {
                    const int row = row_of(b, p0 + t0w + i);
                    float s = 0.f;
#pragma unroll
                    for (int j = 0; j < 8; ++j) s += acc[i][j];
                    const float mean = wave_sum(s) * (1.0f / 512.0f); float qv = 0.f;
#pragma unroll
                    for (int j = 0; j < 8; ++j) { acc[i][j] -= mean; qv += acc[i][j] * acc[i][j]; }
                    const float rstd = __builtin_amdgcn_rsqf(wave_sum(qv) * (1.0f / 512.0f) + LN_EPS);
                    float o[8];
#pragma unroll
                    for (int j = 0; j < 8; ++j) { const float x = acc[i][j] * rstd * lng[j] + lnb[j]; o[j] = x * fast_sigmoid(x); }
                    *(u32x4*)(Y + (size_t)row * NY + AW + c8) = pack8(o);
                }
            }
        }
    }
    __syncthreads();
}
__device__ __forceinline__ void postbc_c(Frame& F, int l) {
    PHASE_ENTER(F);
    const bf16_t* U = F.R1; bf16_t* Y = F.R3; const bf16_t* pwt = F.W + (size_t)l * WL_SIZE + WL_PW; const float* csc = in_ptr(F, I_CSCALE) + l * AW;
    const int lane = F.lane, rg = F.wave & 1, g = F.wave >> 1, fr = lane & 15, fq = lane >> 4;
    LAS unsigned char* tile = F.lds;
    for (int u = F.bid; u < PB_NUNIT; u += F.G) {
        int b, p0, ntok; pb_unit(u, b, p0, ntok);
        __syncthreads();
        {
            u32x4 rr[6];
#pragma unroll
            for (int it = 0; it < 6; ++it) { const int idx = F.tid + it * 512, i = idx >> 6, oc = idx & 63, p = p0 - 15 + i; const int row = row_of(b, p > 0 ? (p < NMETA + SEQ ? p : 0) : 0);
                rr[it] = *(const GAS u32x4*)(U + (size_t)row * NABC + AIN + 1024 + 8 * oc); }
#pragma unroll
            for (int it = 0; it < 6; ++it) { const int idx = F.tid + it * 512, i = idx >> 6, oc = idx & 63, p = p0 - 15 + i;
                if (i < 15 + ntok) *(LAS u32x4*)(tile + (i * 512 + 8 * oc) * 2) = p >= 0 ? rr[it] : (u32x4){0u, 0u, 0u, 0u}; }
        }
        __syncthreads();
        if (rg * 16 < ntok) {
            const int win = 2 << g, t = rg * 16 + fr, p = p0 + t, cnt = (p + 1) < win ? (p + 1) : win; const float inv = 1.0f / (float)cnt;
            const bf16_t* bwp = pwt + (size_t)g * 128 * 128 + (size_t)fr * 128 + 8 * fq;
            bf16x8 bfr[4][4];
#pragma unroll
            for (int ctile = 0; ctile < 4; ++ctile)
#pragma unroll
                for (int ks = 0; ks < 4; ++ks) bfr[ctile][ks] = *(const GAS bf16x8*)(bwp + (size_t)(16 * ctile) * 128 + 32 * ks);
            bf16x8 af[4];
#pragma unroll
            for (int ks = 0; ks < 4; ++ks) {
                const LAS unsigned char* cp = tile + ((15 + t) * 512 + g * 128 + 32 * ks + 8 * fq) * 2;
                float z0[8], sum[8]; unpack8(*(const LAS u32x4*)cp, z0);
#pragma unroll
                for (int j = 0; j < 8; ++j) sum[j] = z0[j];
#pragma unroll 1
                for (int i = 1; i < win; ++i) { float zz[8]; unpack8(*(const LAS u32x4*)(cp - i * 1024), zz);
#pragma unroll
                    for (int j = 0; j < 8; ++j) sum[j] += zz[j]; }
#pragma unroll
                for (int j = 0; j < 8; ++j) sum[j] = sum[j] * inv - z0[j];
                const u32x4 pk = pack8(sum); af[ks] = __builtin_bit_cast(bf16x8, pk);
            }
            const int row = row_of(b, p);
#pragma unroll
            for (int half = 0; half < 2; ++half) {
                if (half == 1) {
#pragma unroll
                    for (int ctile = 0; ctile < 4; ++ctile)
#pragma unroll
                        for (int ks = 0; ks < 4; ++ks) bfr[ctile][ks] = *(const GAS bf16x8*)(bwp + (size_t)(16 * (4 + ctile)) * 128 + 32 * ks);
                }
#pragma unroll
                for (int ct4 = 0; ct4 < 4; ++ct4) {
                    const int ctile = 4 * half + ct4;
                    f32x4 acc = (f32x4){0.f, 0.f, 0.f, 0.f};
#pragma unroll
                    for (int ks = 0; ks < 4; ++ks) acc = __builtin_amdgcn_mfma_f32_16x16x32_bf16(bfr[ct4][ks], af[ks], acc, 0, 0, 0);
                    const int c = g * 128 + 16 * ctile + 4 * fq; const f32x4 sc = *(const GAS f32x4*)(csc + c);
                    u32x2 o; o.x = cvt_pk_bf16(acc[0] * sc[0], acc[1] * sc[1]); o.y = cvt_pk_bf16(acc[2] * sc[2], acc[3] * sc[3]);
                    *(u32x2*)(Y + (size_t)row * NY + 2 * AW + c) = o;
                }
            }
        }
    }
    __syncthreads();
}
__device__ __forceinline__ void phase_postbc(Frame& F, int l) {
    if (PB_REP & 4) postbc_a<true>(F, l); postbc_a<false>(F, l); postbc_b(F, l); if (PB_REP & 1) postbc_b(F, l); postbc_c(F, l); if (PB_REP & 2) postbc_c(F, l);
}

__device__ __forceinline__ void phase_prep2(Frame& F, int l) {
    PHASE_ENTER(F);
    using namespace p2; using ck::frag; using ck::frag16; using ck::frag_tr; using ck::mma;
    bf16_t* U = F.R1; bf16_t* WAw = F.R2; bf16_t* WAa = F.R2 + (size_t)NROWS * AW;
    const bf16_t* HALO = (const bf16_t*)(F.ws + WS_HALO); float* GC = (float*)(F.ws + WS_GC); float* BS = (float*)(F.ws + WS_BS);
    const float* mu = in_ptr(F, I_MU) + l * AIN; const float* kkp = in_ptr(F, I_KK) + l * AW; const float* kap = in_ptr(F, I_KA) + l * AW; const float* rkp = in_ptr(F, I_RK) + l * AW;
    const int lane = F.lane, o = lane & 7, ti = lane >> 3;
    if (F.wave < NW) {
    LAS unsigned char* pb = F.lds + F.wave * SZ; LAS float* cwb = (LAS float*)(pb + X_AAB);
    for (int un = F.bid * NW + F.wave; un < P2_UNITS; un += F.G * NW) {
        const int h = un & 7, rest = un >> 3; const int b = rest == 0 ? 0 : (rest - 1) >> 8, c = rest == 0 ? 0 : ((rest - 1) & 255) + 1;
        const int ch = h * 64 + 8 * o, p0 = c == 0 ? 0 : NMETA + 32 * (c - 1), nreal = c == 0 ? NMETA : 32;
        const bool real = 4 * ti < nreal; const int row0 = row_of(b, p0 + (real ? 4 * ti : 0));
        u32x4 zr[5], zk[5], zv[5], ww[4], aa[4];
        { const bf16_t* prow = (real ? ti : 0) == 0 ? HALO + (size_t)(b * 256 + (c > 0 ? c - 1 : 0)) * 1536 : U + (size_t)(row0 - 1) * NABC;
          zr[0] = *(const GAS u32x4*)(prow + ch); zk[0] = *(const GAS u32x4*)(prow + 512 + ch); zv[0] = *(const GAS u32x4*)(prow + 1024 + ch); }
        { const bf16_t* ur = U + (size_t)row0 * NABC + ch; const bf16_t* wr = WAw + (size_t)row0 * AW + ch; const bf16_t* ar = WAa + (size_t)row0 * AW + ch;
#pragma unroll
          for (int p = 0; p < 4; ++p) { zr[p + 1] = *(const GAS u32x4*)(ur + p * NABC); zk[p + 1] = *(const GAS u32x4*)(ur + p * NABC + 512); zv[p + 1] = *(const GAS u32x4*)(ur + p * NABC + 1024);
              ww[p] = *(const GAS u32x4*)(wr + p * AW); aa[p] = *(const GAS u32x4*)(ar + p * AW); } }
        { const float msk = real ? 1.0f : 0.0f;
#pragma unroll
          for (int p = 0; p < 4; ++p) { float w8[8]; unpack8(ww[p], w8); LAS float* cw = cwb + (4 * ti + p) * 64 + 8 * o;
            *(LAS f32x4*)cw = (f32x4){msk * w8[0], msk * w8[1], msk * w8[2], msk * w8[3]}; *(LAS f32x4*)(cw + 4) = (f32x4){msk * w8[4], msk * w8[5], msk * w8[6], msk * w8[7]}; } }
        LDS_WAIT();
        { LAS float* cw = cwb + lane; float cv_[32];
#pragma unroll
          for (int i = 0; i < 32; ++i) cv_[i] = cw[i * 64];
          asm volatile("" ::: "memory");
#pragma unroll
          for (int i = 1; i < 32; ++i) cv_[i] += cv_[i - 1];
#pragma unroll
          for (int i = 0; i < 32; ++i) cw[i * 64] = cv_[i]; }
        LDS_WAIT();
        float cx[8];
        { const LAS float* cwp = cwb + (ti > 0 ? 4 * ti - 1 : 0) * 64 + 8 * o; const f32x4 x0 = *(const LAS f32x4*)cwp, x1 = *(const LAS f32x4*)(cwp + 4);
#pragma unroll
          for (int j = 0; j < 8; ++j) cx[j] = ti > 0 ? (j < 4 ? x0[j] : x1[j - 4]) : 0.f; }
        {
        LD8G(mur, mu + ch) LD8G(muk, mu + 512 + ch) LD8G(muv, mu + 1024 + ch) LD8G(kkc, kkp + ch) LD8G(kac, kap + ch) LD8G(rkc, rkp + ch)
        int row0s = row0; asm volatile("" : "+v"(row0s));
        bf16_t* ud = U + (size_t)row0s * NABC + ch; bf16_t* wd = WAw + (size_t)row0s * AW + ch; bf16_t* ad = WAa + (size_t)row0s * AW + ch;
        const float msk = real ? 1.0f : 0.0f;
#pragma unroll
        for (int p = 0; p < 4; ++p) {
            const float pm = (c == 0 && ti == 0 && p == 0) ? 0.0f : 1.0f; const int t = 4 * ti + p;
            float r8[8], rp8[8], k8[8], kp8[8], a8[8], v8[8], vp8[8];
            unpack8(zr[p + 1], r8); unpack8(zr[p], rp8); unpack8(zk[p + 1], k8); unpack8(zk[p], kp8); unpack8(aa[p], a8); unpack8(zv[p + 1], v8); unpack8(zv[p], vp8);
            float A[8], B[8], K[8], R[8], V[8], kx[8], kk[8], ss = 0.f, bsum = 0.f;
#pragma unroll
            for (int j = 0; j < 8; ++j) { R[j] = msk * (r8[j] + (pm * rp8[j] - r8[j]) * mur[j]); kx[j] = k8[j] + (pm * kp8[j] - k8[j]) * muk[j]; kk[j] = kx[j] * kkc[j]; ss += kk[j] * kk[j]; V[j] = msk * (v8[j] + (pm * vp8[j] - v8[j]) * muv[j]); }
            ss = allreduce8(ss);
            const float inv = msk / fmaxf(sqrtf(ss), 1e-12f);
#pragma unroll
            for (int j = 0; j < 8; ++j) { const float kn = kk[j] * inv; A[j] = -kn; B[j] = kn * a8[j]; K[j] = msk * kx[j] * (1.0f + (a8[j] - 1.0f) * kac[j]); bsum += R[j] * K[j] * rkc[j]; }
            bsum = allreduce8(bsum);
            const LAS float* cw = cwb + t * 64 + 8 * o; const f32x4 c0 = *(const LAS f32x4*)cw, c1 = *(const LAS f32x4*)(cw + 4);
            float at[8], rt[8], bt[8], kt[8], en[8];
#pragma unroll
            for (int j = 0; j < 8; ++j) { const float ci = j < 4 ? c0[j] : c1[j - 4]; const float ep = __expf(ci); en[j] = __builtin_amdgcn_rcpf(ep);
                at[j] = A[j] * __expf(-cx[j]); rt[j] = R[j] * en[j]; bt[j] = B[j] * ep; kt[j] = K[j] * ep; cx[j] = ci; }
            const u32x4 pa = pack8(at), pr = pack8(rt), pbv = pack8(bt), pk = pack8(kt), pv = pack8(V);
            *(LAS u32x4*)(pb + X_AT + (t * 64 + 8 * o) * 2) = pa; *(LAS u32x4*)(pb + X_RT + (t * 64 + 8 * o) * 2) = pr; *(LAS u32x4*)(pb + X_BT + (t * 64 + 8 * o) * 2) = pbv;
            *(LAS u32x4*)(pb + X_KT + (t * 64 + 8 * o) * 2) = pk; *(LAS u32x4*)(pb + X_VT + (t * 64 + 8 * o) * 2) = pv;
            if (real) {
                *(u32x4*)(wd + p * AW) = pa; *(u32x4*)(ad + p * AW) = pbv; *(u32x4*)(ud + p * NABC) = pr; *(u32x4*)(ud + p * NABC + 512) = pk; *(u32x4*)(ud + p * NABC + 1024) = pv;
                if (o == 0) BS[(size_t)(row0s + p) * 8 + h] = bsum;
            }
            if (p == 3 && ti == 7) { float* gv = GC + ((size_t)(b * 8 + h) * 257 + c) * 64 + 8 * o; *(f32x4*)gv = (f32x4){en[0], en[1], en[2], en[3]}; *(f32x4*)(gv + 4) = (f32x4){en[4], en[5], en[6], en[7]}; }
        }
        }
        LDS_WAIT();
        int ln; asm volatile("v_mbcnt_lo_u32_b32 %0, -1, 0\n\tv_mbcnt_hi_u32_b32 %0, -1, %0" : "=v"(ln)); const int fr = ln & 15, fq = ln >> 4;
        unsigned char* gx0 = (unsigned char*)lds_ptr(F.lds, 36) + (size_t)un * G_SZ; asm volatile("" : "+s"(gx0)); GAS unsigned char* gx = (GAS unsigned char*)gx0;
#pragma unroll
        for (int it = 0; it < 2; ++it)
#pragma unroll
            for (int jt = 0; jt < 2; ++jt) {
                f32x4 ab = {0.f, 0.f, 0.f, 0.f}, ak = ab, rb = ab, rk = ab;
                if (jt <= it) {
#pragma unroll
                    for (int s = 0; s < 2; ++s) { const bf16x8 fb = frag(pb + X_BT, 64, 16 * jt, 32 * s, ln), fk = frag(pb + X_KT, 64, 16 * jt, 32 * s, ln), fa = frag(pb + X_AT, 64, 16 * it, 32 * s, ln), frr = frag(pb + X_RT, 64, 16 * it, 32 * s, ln);
                        ab = mma(fb, fa, ab); ak = mma(fk, fa, ak); rb = mma(fb, frr, rb); rk = mma(fk, frr, rk); }
                }
                const int i = 16 * it + fr, j0 = 16 * jt + 4 * fq;
#pragma unroll
                for (int jj = 0; jj < 4; ++jj) { const bool st = (j0 + jj) < i, inc = (j0 + jj) <= i; ab[jj] = st ? ab[jj] : 0.f; ak[jj] = st ? ak[jj] : 0.f; rb[jj] = inc ? rb[jj] : 0.f; rk[jj] = inc ? rk[jj] : 0.f; }
                asm volatile("" : "+v"(ab), "+v"(ak), "+v"(rb), "+v"(rk));
                *(LAS f32x4*)(pb + X_AAB + (i * 32 + j0) * 4) = ab;
                *(LAS u32x2*)(pb + X_AAK + (i * 32 + j0) * 2) = (u32x2){cvt_pk_bf16(ak[0], ak[1]), cvt_pk_bf16(ak[2], ak[3])};
                *(LAS u32x2*)(pb + X_MRK + (i * 32 + j0) * 2) = (u32x2){cvt_pk_bf16(rk[0], rk[1]), cvt_pk_bf16(rk[2], rk[3])};
                *(u32x2*)(gx + G_MRB + (i * 32 + j0) * 2) = (u32x2){cvt_pk_bf16(rb[0], rb[1]), cvt_pk_bf16(rb[2], rb[3])};
            }
        LDS_WAIT();
        {
            const int blk = (ln >> 4) & 1, jc = ln & 15; float t[16];
            const LAS float* arow = (const LAS float*)(pb + X_AAB) + (16 * blk) * 32 + 16 * blk;
#pragma unroll
            for (int i = 0; i < 16; ++i) { float acc = (i == jc) ? 1.0f : 0.f;
#pragma unroll
                for (int m4 = 0; m4 < 4; ++m4) { if (4 * m4 < i) { const f32x4 a4 = *(const LAS f32x4*)(arow + i * 32 + 4 * m4);
#pragma unroll
                    for (int mm = 0; mm < 4; ++mm) if (4 * m4 + mm < i) acc += a4[mm] * t[4 * m4 + mm]; } }
                t[i] = acc; if ((i & 3) == 3) asm volatile("" ::: "memory"); }
            { const int ar = ln >> 2, ac = 4 * (ln & 3); const f32x4 a4 = *(const LAS f32x4*)(pb + X_AAB + ((16 + ar) * 32 + ac) * 4);
              asm volatile("" ::: "memory");
              *(LAS u32x2*)(pb + X_A21 + (ar * 16 + ac) * 2) = (u32x2){cvt_pk_bf16(a4[0], a4[1]), cvt_pk_bf16(a4[2], a4[3])}; }
            if (ln < 32) {
#pragma unroll
                for (int i = 0; i < 16; ++i) *(LAS unsigned short*)(pb + X_TT + ((16 * blk + i) * 32 + 16 * blk + jc) * 2) = f2bf(t[i]);
                if (blk == 0) {
#pragma unroll
                    for (int i = 0; i < 16; ++i) *(LAS unsigned short*)(pb + X_TT + (i * 32 + 16 + jc) * 2) = 0;
                    u32x4 lo, hi; lo.x = cvt_pk_bf16(t[0], t[1]); lo.y = cvt_pk_bf16(t[2], t[3]); lo.z = cvt_pk_bf16(t[4], t[5]); lo.w = cvt_pk_bf16(t[6], t[7]);
                    hi.x = cvt_pk_bf16(t[8], t[9]); hi.y = cvt_pk_bf16(t[10], t[11]); hi.z = cvt_pk_bf16(t[12], t[13]); hi.w = cvt_pk_bf16(t[14], t[15]);
                    *(LAS u32x4*)(pb + X_TC11 + jc * 32) = lo; *(LAS u32x4*)(pb + X_TC11 + jc * 32 + 16) = hi;
                }
            }
            LDS_WAIT();
            { f32x4 z = {0.f, 0.f, 0.f, 0.f}; z = mma(frag16(pb + X_A21, 16, 0, ln), frag16(pb + X_TC11, 16, 0, ln), z);
              *(LAS u32x2*)(pb + X_Z1T + (fr * 16 + 4 * fq) * 2) = (u32x2){cvt_pk_bf16(z[0], z[1]), cvt_pk_bf16(z[2], z[3])}; }
            LDS_WAIT();
            { f32x4 d = {0.f, 0.f, 0.f, 0.f}; const bf16x8 zz = {0, 0, 0, 0, 0, 0, 0, 0};
              bf16x8 t22 = *(const LAS bf16x8*)(pb + X_TT + ((16 + fr) * 32 + 16 + 8 * (fq & 1)) * 2); t22 = fq < 2 ? t22 : zz;
              d = mma(frag16(pb + X_Z1T, 16, 0, ln), t22, d);
              *(LAS u32x2*)(pb + X_TT + ((16 + fr) * 32 + 4 * fq) * 2) = (u32x2){cvt_pk_bf16(d[0], d[1]), cvt_pk_bf16(d[2], d[3])}; }
            LDS_WAIT();
            { const u32x4 t0 = *(const LAS u32x4*)(pb + X_TT + ln * 32), t1 = *(const LAS u32x4*)(pb + X_TT + ln * 32 + 16); *(u32x4*)(gx + G_TT + ln * 32) = t0; *(u32x4*)(gx + G_TT + ln * 32 + 16) = t1; }
        }
#pragma unroll 1
        for (int vq = 0; vq < 4; ++vq) {
            const bf16x8 fvt = frag_tr(pb + X_VT, 128, 0, 16 * vq, ln);
#pragma unroll
            for (int tt2 = 0; tt2 < 2; ++tt2) {
                f32x4 x = {0.f, 0.f, 0.f, 0.f}, f = x;
                x = mma(frag(pb + X_AAK, 32, 16 * tt2, 0, ln), fvt, x);
                f = mma(fvt, frag(pb + X_MRK, 32, 16 * tt2, 0, ln), f);
                *(u32x2*)(gx + G_XA + ((vq * 2 + tt2) * 64 + ln) * 8) = (u32x2){cvt_pk_bf16(x[0], x[1]), cvt_pk_bf16(x[2], x[3])};
                *(u32x2*)(gx + G_FA + ((vq * 2 + tt2) * 64 + ln) * 8) = (u32x2){cvt_pk_bf16(f[0], f[1]), cvt_pk_bf16(f[2], f[3])};
            }
        }
        LDS_WAIT();
    }
    }
}

__device__ __forceinline__ void phase_router(Frame& F) {
    PHASE_ENTER(F);
    LAS int* hist = (LAS int*)(F.lds + 32768);
    const float* ss = F.SS + 3 * SS_STRIDE;
    u32x4* tokinfo = (u32x4*)(F.ws + RT_TOKINFO); int* slot_tok = (int*)(F.ws + RT_SLOTTOK); int* cnt = (int*)(F.ws + RT_CNT);
    const int lane = F.lane;
    f32x4 wr[16][2];
    { const float* RW = in_ptr(F, I_RW) + (size_t)(16 * lane) * NEXP; const float* fgp = in_ptr(F, I_FFNG) + DM + 16 * lane;
#pragma unroll
      for (int k = 0; k < 16; ++k) { const float gk = fgp[k]; wr[k][0] = *(const f32x4*)(RW + NEXP * k) * gk; wr[k][1] = *(const f32x4*)(RW + NEXP * k + 4) * gk; } }
    for (int blk = F.bid; blk < NREAL / 256; blk += F.G) {
        __syncthreads();
        if (F.tid < NEXP) hist[F.tid] = 0;
        for (int i = F.tid; i < MAXBLK; i += 512) { slot_tok[blk * MAXBLK + i] = -1; ((float*)(F.ws + RT_SLOTRS))[blk * MAXBLK + i] = 0.f; }
        __syncthreads();
        for (int t = F.wave; t < 256; t += 16) {
            const int tok0 = blk * 256 + t, tok1 = tok0 + 8;
            u32x4 raw[2][2];
            raw[0][0] = *(const u32x4*)(F.HB + (size_t)tok0 * DM + 16 * lane); raw[0][1] = *(const u32x4*)(F.HB + (size_t)tok0 * DM + 16 * lane + 8);
            raw[1][0] = *(const u32x4*)(F.HB + (size_t)tok1 * DM + 16 * lane); raw[1][1] = *(const u32x4*)(F.HB + (size_t)tok1 * DM + 16 * lane + 8);
            const float rs2[2] = {rstd_of(ss, tok0), rstd_of(ss, tok1)};
#pragma unroll
            for (int q = 0; q < 2; ++q) {
                const int tok = q == 0 ? tok0 : tok1;
                float hv[16]; unpack8(raw[q][0], *(float(*)[8])&hv[0]); unpack8(raw[q][1], *(float(*)[8])&hv[8]);
                float lg[8];
#pragma unroll
                for (int e = 0; e < 8; ++e) lg[e] = 0.f;
#pragma unroll
                for (int k = 0; k < 16; ++k) {
#pragma unroll
                    for (int e = 0; e < 4; ++e) { lg[e] += hv[k] * wr[k][0][e]; lg[4 + e] += hv[k] * wr[k][1][e]; } }
                const float rs = rs2[q];
#pragma unroll
                for (int e = 0; e < 8; ++e) lg[e] = wave_sum(lg[e]) * rs + in_ptr(F, I_RB)[e];
                int e1 = 0; float l1 = lg[0];
#pragma unroll
                for (int e = 1; e < 8; ++e) if (lg[e] > l1) { l1 = lg[e]; e1 = e; }
                int e2 = -1; float l2 = -3.0e38f;
#pragma unroll
                for (int e = 0; e < 8; ++e) if (e != e1 && lg[e] > l2) { l2 = lg[e]; e2 = e; }
                const float g2 = 1.0f / (1.0f + __expf(l1 - l2)), g1 = 1.0f - g2;
                if (lane == 0) { tokinfo[tok] = (u32x4){(unsigned)(e1 | (e2 << 8)), __float_as_uint(g1), __float_as_uint(g2), 0u}; __hip_atomic_fetch_add(&hist[e1], 1, __ATOMIC_RELAXED, __HIP_MEMORY_SCOPE_WORKGROUP); __hip_atomic_fetch_add(&hist[e2], 1, __ATOMIC_RELAXED, __HIP_MEMORY_SCOPE_WORKGROUP); }
            }
        }
        __syncthreads();
        if (F.tid < NEXP) cnt[blk * NEXP + F.tid] = hist[F.tid];
    }
    __syncthreads();
}
__device__ __forceinline__ void phase_assign(Frame& F) {
    PHASE_ENTER(F);
    LAS int* L = (LAS int*)F.lds;
    const u32x4* tokinfo = (const u32x4*)(F.ws + RT_TOKINFO); int* slot_tok = (int*)(F.ws + RT_SLOTTOK); const int* cnt = (const int*)(F.ws + RT_CNT);
    int* block_e = (int*)(F.ws + RT_CNT + 16384); int* nblkp = (int*)(F.ws + RT_CNT + 32768); int* tokslot = (int*)(F.ws + RT_TOKSLOT);
    for (int blk = F.bid; blk < NREAL / 256; blk += F.G) {
        __syncthreads();
        if (F.tid < 256) {
            const u32x4 c0 = *(const u32x4*)(cnt + F.tid * NEXP), c1 = *(const u32x4*)(cnt + F.tid * NEXP + 4); const unsigned cc[8] = {c0.x, c0.y, c0.z, c0.w, c1.x, c1.y, c1.z, c1.w};
            const float inf = F.tid < blk ? 1.0f : 0.0f;
#pragma unroll
            for (int e = 0; e < NEXP; ++e) { const float tt = wave_sum((float)cc[e]), pp = wave_sum(inf * (float)cc[e]); if (F.lane == 0) { L[64 + F.wave * 16 + e] = (int)tt; L[64 + F.wave * 16 + 8 + e] = (int)pp; } }
        }
        __syncthreads();
        if (F.tid < NEXP) { int tot = 0, pre = 0;
#pragma unroll
            for (int w = 0; w < 4; ++w) { tot += L[64 + w * 16 + F.tid]; pre += L[64 + w * 16 + 8 + F.tid]; } L[F.tid] = tot; L[8 + F.tid] = pre; }
        __syncthreads();
        if (F.tid == 0) { int start = 0; for (int e = 0; e < NEXP; ++e) { L[16 + e] = start; start += (L[e] + 255) & ~255; L[24 + e] = start; }
            if (blk == 0) *nblkp = start >> 8; }
        __syncthreads();
        if (blk == 0) { const int nb_ = L[24 + NEXP - 1] >> 8;
            for (int j = F.tid; j < nb_; j += 512) { int e = 0; while (e < NEXP - 1 && L[24 + e] <= j * 256) ++e; block_e[j] = e; } }
        int e1 = 0, e2 = 0, r1 = 0, r2 = 0; const int w = F.wave, lane = F.lane;
        if (F.tid < 256) {
            const unsigned ee = tokinfo[blk * 256 + F.tid].x; e1 = ee & 0xff; e2 = (ee >> 8) & 0xff;
            const unsigned long long lt = (1ull << lane) - 1ull;
#pragma unroll
            for (int e = 0; e < NEXP; ++e) { const unsigned long long m1 = __ballot(e1 == e), m2 = __ballot(e2 == e);
                if (e1 == e) r1 = __popcll(m1 & lt); if (e2 == e) r2 = __popcll(m1) + __popcll(m2 & lt);
                if (lane == 0) L[32 + w * 8 + e] = __popcll(m1) + __popcll(m2); }
        }
        __syncthreads();
        if (F.tid < 256) {
            int o1 = L[16 + e1] + L[8 + e1], o2 = L[16 + e2] + L[8 + e2];
            for (int ww = 0; ww < w; ++ww) { o1 += L[32 + ww * 8 + e1]; o2 += L[32 + ww * 8 + e2]; }
            const int s1 = o1 + r1, s2 = o2 + r2, tok = blk * 256 + F.tid;
            slot_tok[s1] = tok; slot_tok[s2] = tok; tokslot[2 * tok] = s1; tokslot[2 * tok + 1] = s2;
            { const float rs = rstd_of(F.SS + 3 * SS_STRIDE, tok); float* srs = (float*)(F.ws + RT_SLOTRS); srs[s1] = rs; srs[s2] = rs; }
        }
    }
    __syncthreads();
}
__device__ __forceinline__ void phase_combine(Frame& F) {
    PHASE_ENTER(F);
    const u32x4* tokinfo = (const u32x4*)(F.ws + RT_TOKINFO); const int* tokslot = (const int*)(F.ws + RT_TOKSLOT);
    const int gw = F.bid * 8 + F.wave, NGW = F.G * 8, lane = F.lane;
    f32x4 gf[4];
#pragma unroll
    for (int j = 0; j < 4; ++j) gf[j] = *(const f32x4*)(in_ptr(F, I_FINALG) + 4 * lane + 256 * j);
    float* outp = (float*)lds_ptr(F.lds, 36);
    int tokA = gw, tokB = gw + NGW;
    u32x4 tiA = tokinfo[tokA < NREAL ? tokA : 0], tiB = tokinfo[tokB < NREAL ? tokB : 0];
    u32x2 slA = *(const u32x2*)(tokslot + 2 * (tokA < NREAL ? tokA : 0)), slB = *(const u32x2*)(tokslot + 2 * (tokB < NREAL ? tokB : 0));
    for (; tokA < NREAL; tokA += 2 * NGW, tokB += 2 * NGW) {
        const int nA = tokA + 2 * NGW, nB = tokB + 2 * NGW;
        const u32x4 tinA = tokinfo[nA < NREAL ? nA : 0], tinB = tokinfo[nB < NREAL ? nB : 0];
        const u32x2 slnA = *(const u32x2*)(tokslot + 2 * (nA < NREAL ? nA : 0)), slnB = *(const u32x2*)(tokslot + 2 * (nB < NREAL ? nB : 0));
        const bool hasB = tokB < NREAL; const int tB = hasB ? tokB : tokA;
        const u32x2* hpA = (const u32x2*)(F.HB + (size_t)tokA * DM) + lane; const u32x2* y1A = (const u32x2*)(F.YS + (size_t)slA.x * DM) + lane; const u32x2* y2A = (const u32x2*)(F.YS + (size_t)slA.y * DM) + lane;
        const u32x2* hpB = (const u32x2*)(F.HB + (size_t)tB * DM) + lane; const u32x2* y1B = (const u32x2*)(F.YS + (size_t)(hasB ? slB.x : slA.x) * DM) + lane; const u32x2* y2B = (const u32x2*)(F.YS + (size_t)(hasB ? slB.y : slA.y) * DM) + lane;
        u32x2 hA[4], aA[4], bA[4], hB[4], aB[4], bB[4];
#pragma unroll
        for (int j = 0; j < 4; ++j) { hA[j] = hpA[64 * j]; aA[j] = y1A[64 * j]; bA[j] = y2A[64 * j]; hB[j] = hpB[64 * j]; aB[j] = y1B[64 * j]; bB[j] = y2B[64 * j]; }
#define CMB_ONE(TOK, TI, H, A, B) do { const float g1 = __uint_as_float((TI).y), g2 = __uint_as_float((TI).z); f32x4 v[4]; float sq = 0.f; \
        _Pragma("unroll") for (int j = 0; j < 4; ++j) { \
            v[j][0] = bf_lo(H[j].x) + g1 * bf_lo(A[j].x) + g2 * bf_lo(B[j].x); v[j][1] = bf_hi(H[j].x) + g1 * bf_hi(A[j].x) + g2 * bf_hi(B[j].x); \
            v[j][2] = bf_lo(H[j].y) + g1 * bf_lo(A[j].y) + g2 * bf_lo(B[j].y); v[j][3] = bf_hi(H[j].y) + g1 * bf_hi(A[j].y) + g2 * bf_hi(B[j].y); \
            sq += (v[j][0] * v[j][0] + v[j][1] * v[j][1]) + (v[j][2] * v[j][2] + v[j][3] * v[j][3]); } \
        const float rs = __builtin_amdgcn_rsqf(wave_sum(sq) * (1.0f / DM) + RMS_EPS); \
        f32x4* op = (f32x4*)(outp + (size_t)(TOK) * DM) + lane; \
        _Pragma("unroll") for (int j = 0; j < 4; ++j) op[64 * j] = v[j] * rs * gf[j]; } while (0)
        CMB_ONE(tokA, tiA, hA, aA, bA);
        if (hasB) CMB_ONE(tokB, tiB, hB, aB, bB);
#undef CMB_ONE
        tiA = tinA; tiB = tinB; slA = slnA; slB = slnB;
    }
}

__device__ __forceinline__ SchedGrid grid_sched(Frame& F, int nN, int lda, int ldb) { return SchedGrid{NREAL / 256, nN, F.G, F.bid, (size_t)256 * lda * 2, (size_t)256 * ldb * 2}; }
__device__ __forceinline__ void phase_g1(Frame& F, int l) {
    PHASE_ENTER(F);
    const bf16_t* Wt = F.W + (size_t)l * WL_SIZE + WL_ABC; const float* ss = F.SS + (size_t)(2 * l) * SS_STRIDE; bf16_t* U = F.R1;
    meta_rstd_setup(F);
    for (int j = F.bid; j < NABC / 16; j += F.G) { const float v = meta_tile(F, F.HB + (size_t)MBASE * DM, DM, Wt, DM, DM, 16 * j);
        if (F.tid < 256) { const int row = MBASE + (F.tid >> 4); U[(size_t)row * NABC + 16 * j + (F.tid & 15)] = f2bf(v * META_RS(F, F.tid >> 4)); } }
    __syncthreads();
    pg8::gemm_phase<EpiScale, SchedGrid, false>(F.lds, F.wave, GemmD{F.HB, Wt, DM, DM, DM}, grid_sched(F, NABC / 256, DM, DM), EpiScale{U, NABC, ss});
}
__device__ __forceinline__ void phase_g2(Frame& F, int l) {
    PHASE_ENTER(F);
    const bf16_t* Wt = F.W + (size_t)l * WL_SIZE + WL_G; const float* ss = F.SS + (size_t)(2 * l) * SS_STRIDE; bf16_t* ZG = F.R1; const float* gb = in_ptr(F, I_GATEB) + l * NGATE;
    if (l == 0) { meta_rstd_setup(F); for (int j = F.bid; j < NGATE / 16; j += F.G) { const float v = meta_tile(F, F.HB + (size_t)MBASE * DM, DM, Wt, DM, DM, 16 * j);
        if (F.tid < 256) { const int row = MBASE + (F.tid >> 4), col = 16 * j + (F.tid & 15); ZG[(size_t)row * NGATE + col] = f2bf(fast_sigmoid(v * META_RS(F, F.tid >> 4) + gb[col])); } }
        __syncthreads(); }
    pg8::gemm_phase<EpiGate, SchedGrid, false>(F.lds, F.wave, GemmD{F.HB, Wt, DM, DM, DM}, grid_sched(F, NGATE / 256, DM, DM), EpiGate{ZG, NGATE, ss, gb});
}
__device__ __forceinline__ void phase_g3(Frame& F, int l) {
    PHASE_ENTER(F);
    const bf16_t* Pt = F.W + (size_t)l * WL_SIZE + WL_P; const bf16_t* ZG = F.R1; const bf16_t* Y = F.R3; bf16_t* MB = F.R2;
    if (l == 0) for (int j = F.bid; j < DM / 16; j += F.G) { float tot = 0.f;
        for (int br = 0; br < 3; ++br) { const float v = meta_tile(F, Y + (size_t)MBASE * NY + br * AW, NY, Pt + br * AW, NY, AW, 16 * j);
            if (F.tid < 256) tot += v * bf2f(ZG[(size_t)(MBASE + (F.tid >> 4)) * NGATE + br * DM + 16 * j + (F.tid & 15)]); }
        if (F.tid < 256) MB[(size_t)(MBASE + (F.tid >> 4)) * DM + 16 * j + (F.tid & 15)] = f2bf(tot); }
    pg8::gemm_phase<EpiMerge3, SchedGrid, false>(F.lds, F.wave, GemmD{Y, Pt, NY, NY, NY}, grid_sched(F, DM / 256, NY, NY), EpiMerge3{MB, ZG});
}
__device__ __forceinline__ void phase_resid(Frame& F, const bf16_t* Amat, int K, const bf16_t* Wt, float* ssn, bool do_meta) {
    PHASE_ENTER(F);
    if (do_meta) for (int j = F.bid; j < DM / 16; j += F.G) { const float v = meta_tile(F, Amat + (size_t)MBASE * K, K, Wt, K, K, 16 * j);
        if (F.tid < 256) { const int row = MBASE + (F.tid >> 4); bf16_t* hp = F.HB + (size_t)row * DM + 16 * j + (F.tid & 15); *hp = f2bf(bf2f(*hp) + v); } }
    pg8::gemm_phase<EpiResid, SchedGrid, false>(F.lds, F.wave, GemmD{Amat, Wt, K, K, K}, grid_sched(F, DM / 256, K, K), EpiResid{F.HB, ssn, (LAS float*)(F.lds + 139264)});
}
__device__ __forceinline__ void phase_g5(Frame& F) {
    PHASE_ENTER(F);
    const bf16_t* Wt = F.W + WF_GU; const float* ss = F.SS + SS_STRIDE; bf16_t* HID = F.R1;
    meta_rstd_setup(F);
    for (int j = F.bid; j < DFF / 16; j += F.G) { const int c0 = 16 * j, br = 256 * (c0 / 128) + (c0 % 128);
        const float vg = meta_tile(F, F.HB + (size_t)MBASE * DM, DM, Wt, DM, DM, br), vu = meta_tile(F, F.HB + (size_t)MBASE * DM, DM, Wt, DM, DM, br + 128);
        if (F.tid < 256) { const int row = MBASE + (F.tid >> 4); const float rs = META_RS(F, F.tid >> 4), g = vg * rs, u = vu * rs; HID[(size_t)row * DFF + c0 + (F.tid & 15)] = f2bf(g * fast_sigmoid(g) * u); } }
    __syncthreads();
    pg8::gemm_phase<EpiSwiglu, SchedGrid, false>(F.lds, F.wave, GemmD{F.HB, Wt, DM, DM, DM}, grid_sched(F, NGU / 256, DM, DM), EpiSwiglu{HID, ss, nullptr, 0});
}
__device__ __forceinline__ void moe_range(Frame& F, int pass, int& blk0, int& nb) {
    const int nblk = *(const int*)(F.ws + RT_CNT + 32768); blk0 = pass * PASS0; nb = nblk - blk0; if (nb > (pass == 0 ? PASS0 : MAXBLK - PASS0)) nb = (pass == 0 ? PASS0 : MAXBLK - PASS0); if (nb < 0) nb = 0;
}
__device__ __forceinline__ void phase_g5m(Frame& F, int pass) {
    int blk0, nb; moe_range(F, pass, blk0, nb);
    const int* block_e = (const int*)(F.ws + RT_CNT + 16384); const int* slot_tok = (const int*)(F.ws + RT_SLOTTOK);
    pg8::gemm_phase<EpiSwiglu, SchedMoe, true>(F.lds, F.wave, GemmD{F.HB, F.WE + WE_GU, DM, DM, DM},
        SchedMoe{blk0, nb, NGU / 256, F.G, F.bid, block_e, slot_tok, 0, (size_t)256 * DM * 2, (size_t)NGU * DM * 2}, EpiSwiglu{F.R1, (const float*)(F.ws + RT_SLOTRS), slot_tok, blk0 * 256});
}
__device__ __forceinline__ void phase_g6m(Frame& F, int pass) {
    int blk0, nb; moe_range(F, pass, blk0, nb);
    const int* block_e = (const int*)(F.ws + RT_CNT + 16384); const int* slot_tok = (const int*)(F.ws + RT_SLOTTOK);
    pg8::gemm_phase<EpiStore, SchedMoe, false>(F.lds, F.wave, GemmD{F.R1, F.WE + WE_D, DFF, DFF, DFF},
        SchedMoe{blk0, nb, DM / 256, F.G, F.bid, block_e, slot_tok, (size_t)256 * DFF * 2, (size_t)256 * DFF * 2, (size_t)DM * DFF * 2}, EpiStore{F.YS, DM});
}

#ifndef CK_MODE
#define CK_MODE 1
#endif
constexpr int N_PHASES = 24;
__global__ void __launch_bounds__(512, 2) fwd_kernel(Args args) {
    extern __shared__ __attribute__((aligned(16))) unsigned char lds[];
    Frame F;
    F.lds = (LAS unsigned char*)lds; F.tid = threadIdx.x; F.lane = F.tid & 63; F.wave = __builtin_amdgcn_readfirstlane(F.tid >> 6); F.G = gridDim.x; F.bid = blockIdx.x;
    volatile LAS unsigned* MISC = (volatile LAS unsigned*)(F.lds + LDSCTL_OFF);
    for (int u = F.tid; u < (LDS_BYTES - LDSCTL_OFF) / 4; u += 512) MISC[u] = 0u;
    __syncthreads();
    if (F.tid < 38) { const unsigned long long pv = F.tid < 36 ? (unsigned long long)args.in[F.tid] : (F.tid == 36 ? (unsigned long long)args.out : (unsigned long long)args.ws);
        *(LAS unsigned long long*)(F.lds + PTR_OFF + 8 * F.tid) = pv; }
    __syncthreads();
    frame_ptrs(F);
    const int lo = args.ph_lo, hi = args.ph_hi;
    XcdBarrier bar; bar.bar = (unsigned*)F.ws + CW_BAR + args.li * XCD_BAR_WORDS; bar.x = 0; bar.st = MISC + 8;
    if (hi - lo > 1) bar = xcd_barrier_post((unsigned*)F.ws + CW_BAR + args.li * XCD_BAR_WORDS, MISC + 8);
#ifdef ONLY_PH
#define PH(p) ((p) == ONLY_PH || ((p) - 9) == ONLY_PH)
#else
#define PH(p) (lo <= (p) && (p) < hi)
#endif
#ifndef REP_MASK
#define REP_MASK 0ull
#endif
#define REPS(p) ((REP_MASK >> (p)) & 1ull)
#define SEAM(p) do { if (PH(p) && PH((p) + 1)) { XcdBarrier b2_ = bar; asm volatile("" : "+s"(b2_.bar)); xcd_barrier(b2_, F.wave); } } while (0)
    if (PH(0)) { convert_common(F); x_to_hb(F); if (REPS(0)) { convert_common(F); x_to_hb(F); } } SEAM(0);
    for (int l = 0; l < 2; ++l) {
        const int pb = 1 + 9 * l;
        if (PH(pb + 0)) { phase_g1(F, l); if (REPS(pb + 0)) phase_g1(F, l); } SEAM(pb + 0);
        if (PH(pb + 1)) { phase_prep(F, l); { XcdBarrier b2_ = bar; asm volatile("" : "+s"(b2_.bar)); xcd_barrier(b2_, F.wave); } phase_prep2(F, l); } SEAM(pb + 1);
        if (PH(pb + 2)) { if (CK_MODE != 1) phase_scan(F, l); if (CK_MODE != 0) phase_scan_chunked(F, l); } SEAM(pb + 2);
        if (PH(pb + 3)) phase_postbc(F, l); SEAM(pb + 3);
        if (PH(pb + 4)) { phase_g2(F, l); if (REPS(pb + 4)) phase_g2(F, l); } SEAM(pb + 4);
        if (PH(pb + 5)) { phase_g3(F, l); if (REPS(pb + 5)) phase_g3(F, l); } SEAM(pb + 5);
        if (PH(pb + 6)) phase_resid(F, F.R2, DM, F.W + (size_t)l * WL_SIZE + WL_OUT, F.SS + (size_t)(2 * l + 1) * SS_STRIDE, l == 0); SEAM(pb + 6);
        if (l == 0) {
            if (PH(8)) { phase_g5(F); if (REPS(8)) phase_g5(F); } SEAM(8);
            if (PH(9)) phase_resid(F, F.R1, DFF, F.W + WF_D, F.SS + 2 * SS_STRIDE, true); SEAM(9);
        }
    }
    if (PH(17)) { convert_experts(F); phase_router(F); if (REPS(17)) { convert_experts(F); phase_router(F); } } SEAM(17);
    if (PH(18)) { phase_assign(F); if (REPS(18)) phase_assign(F); } SEAM(18);
    for (int pass = 0; pass < 2; ++pass) {
        if (PH(19 + 2 * pass)) { phase_g5m(F, pass); if (REPS(19 + 2 * pass)) phase_g5m(F, pass); } SEAM(19 + 2 * pass);
        if (PH(20 + 2 * pass)) { phase_g6m(F, pass); if (REPS(20 + 2 * pass)) phase_g6m(F, pass); } SEAM(20 + 2 * pass);
    }
    if (PH(23)) { phase_combine(F); if (REPS(23)) phase_combine(F); }
#undef PH
#undef SEAM
}

#ifndef MK_N_LAUNCHES
#define MK_N_LAUNCHES 1
#endif
extern "C" void kernel_launch(void* const* d_in, const int* in_sizes, int n_in, void* d_out, int out_size, void* d_ws, size_t ws_size, hipStream_t stream) {
    static int grid = 0;
    if (grid == 0) {
        if (n_in != 36 || in_sizes[0] != NREAL * DM || out_size != NREAL * DM || ws_size < WS_END) {
            fprintf(stderr, "kernel_launch: unexpected problem (n_in %d, in0 %d, out %d, ws %zu; need ws >= %zu); nothing launched\n", n_in, n_in > 0 ? in_sizes[0] : -1, out_size, ws_size, (size_t)WS_END); grid = -1; return; }
        int dev = 0, cus = 0, per_cu = 0;
        if (hipGetDevice(&dev) != hipSuccess || hipDeviceGetAttribute(&cus, hipDeviceAttributeMultiprocessorCount, dev) != hipSuccess) { grid = -1; return; }
        if (hipFuncSetAttribute((const void*)fwd_kernel, hipFuncAttributeMaxDynamicSharedMemorySize, LDS_BYTES) != hipSuccess) { fprintf(stderr, "kernel_launch: hipFuncSetAttribute failed\n"); grid = -1; return; }
        if (hipOccupancyMaxActiveBlocksPerMultiprocessor(&per_cu, (const void*)fwd_kernel, 512, LDS_BYTES) != hipSuccess || per_cu < 1) { fprintf(stderr, "kernel_launch: occupancy query says %d blocks per CU\n", per_cu); (void)hipGetLastError(); grid = -1; return; }
        grid = cus;
    }
    if (grid < 0) return;
    if (hipMemsetAsync((char*)d_ws + WS_CTL, 0, CTL_ZERO_BYTES, stream) != hipSuccess) return;
    Args a{};
    for (int i = 0; i < 36; ++i) a.in[i] = (const float*)d_in[i];
    a.out = (float*)d_out; a.ws = (unsigned char*)d_ws;
    if (MK_N_LAUNCHES == 1) { a.ph_lo = 0; a.ph_hi = N_PHASES; a.li = 0; hipLaunchKernelGGL(fwd_kernel, dim3(grid), dim3(512), LDS_BYTES, stream, a); }
    else for (int p = 0; p < N_PHASES; ++p) { a.ph_lo = p; a.ph_hi = p + 1; a.li = 0; hipLaunchKernelGGL(fwd_kernel, dim3(grid), dim3(512), LDS_BYTES, stream, a); }
}
```

```cpp
#include <hip/hip_runtime.h>
#include <cstdio>
#include <cstdint>

#define LAS __attribute__((address_space(3)))
#define GAS __attribute__((address_space(1)))
typedef unsigned short bf16_t;
typedef short bf16x8 __attribute__((ext_vector_type(8)));
typedef float f32x4 __attribute__((ext_vector_type(4)));
typedef float f32x2 __attribute__((ext_vector_type(2)));
typedef unsigned u32x4 __attribute__((ext_vector_type(4)));
typedef unsigned u32x2 __attribute__((ext_vector_type(2)));

constexpr int NB = 8, SEQ = 8192, DM = 1024, NMETA = 16;
constexpr int NREAL = NB * SEQ;
constexpr int MBASE = NREAL;
constexpr int NROWS = NREAL + NMETA;
constexpr int AW = 512, AIN = 1792, NABC = 3328, NGATE = 3072, NY = 1536, DFF = 2816, NGU = 5632, NEXP = 8;
constexpr int MAXBLK = 520, PASS0 = 256;
constexpr float RMS_EPS = 1e-6f, LN_EPS = 1e-5f, LNX_EPS = 64e-5f;

constexpr size_t MiB = 1u << 20;
constexpr size_t WS_CTL = 0, CTL_ZERO_BYTES = 1 * MiB;
constexpr size_t WS_SS = 8 * MiB, SS_STRIDE = (size_t)NREAL * 4;
constexpr size_t WS_RT = 4 * MiB;
constexpr size_t WS_HALO = 1 * MiB;
constexpr size_t WS_GC = 12 * MiB, WS_BS = 17 * MiB;
constexpr size_t RT_SLOTRS = WS_RT + 3 * MiB;
constexpr size_t RT_TOKINFO = WS_RT, RT_SLOTTOK = WS_RT + 1 * MiB, RT_CNT = WS_RT + 2 * MiB, RT_TOKSLOT = WS_RT + 3 * MiB - 512 * 1024;
constexpr size_t WS_W = 24 * MiB, WS_HB = 78 * MiB, WS_R1 = 207 * MiB, WS_R2 = 624 * MiB, WS_R3 = 753 * MiB;
constexpr size_t WS_YS = 570 * MiB, WS_WE = 830 * MiB, WS_END = 962 * MiB;
constexpr size_t WL_ABC = 0, WL_G = WL_ABC + (size_t)NABC * DM, WL_P = WL_G + (size_t)NGATE * DM, WL_OUT = WL_P + (size_t)DM * NY,
                 WL_W2 = WL_OUT + (size_t)DM * DM, WL_A2 = WL_W2 + 512 * 64, WL_G2 = WL_A2 + 512 * 64, WL_PW = WL_G2 + 512 * 128, WL_SIZE = WL_PW + 4 * 128 * 128;
constexpr size_t WF_GU = 2 * WL_SIZE, WF_D = WF_GU + (size_t)NGU * DM, W_TOTAL = WF_D + (size_t)DM * DFF;
static_assert(W_TOTAL * 2 <= 54 * MiB, "weights region");
constexpr size_t WE_GU = 0, WE_D = (size_t)NEXP * NGU * DM;
static_assert((WE_D + (size_t)NEXP * DM * DFF) * 2 <= 132 * MiB, "expert region");
static_assert((size_t)NROWS * NABC * 2 <= 417 * MiB && (size_t)NROWS * NGATE * 2 <= 417 * MiB && (size_t)(MAXBLK - PASS0) * 256 * DFF * 2 <= 363 * MiB, "R1");
static_assert((size_t)NROWS * 1024 * 2 <= 129 * MiB && (size_t)NROWS * NY * 2 <= 193 * MiB && (size_t)MAXBLK * 256 * 1024 * 2 <= 260 * MiB, "R2/R3/YS");
constexpr int CW_BAR = 4096;

constexpr int RING_BYTES = 131072, LDSCTL_OFF = RING_BYTES, LDS_BYTES = 147456;

typedef __bf16 bf16x2_t __attribute__((ext_vector_type(2)));
__device__ __forceinline__ unsigned cvt_pk_bf16(float lo, float hi) { const f32x2 v = {lo, hi}; return __builtin_bit_cast(unsigned, __builtin_convertvector(v, bf16x2_t)); }
__device__ __forceinline__ float bf_lo(unsigned u) { return __uint_as_float(u << 16); }
__device__ __forceinline__ float bf_hi(unsigned u) { return __uint_as_float(u & 0xffff0000u); }
__device__ __forceinline__ float bf2f(bf16_t b) { return __uint_as_float(((unsigned)b) << 16); }
__device__ __forceinline__ bf16_t f2bf(float f) { return (bf16_t)(cvt_pk_bf16(f, 0.f) & 0xffffu); }
__device__ __forceinline__ float fast_sigmoid(float x) { return __builtin_amdgcn_rcpf(1.0f + __expf(-x)); }
template <int CTRL> __device__ __forceinline__ float dpp_mov(float v) { return __builtin_bit_cast(float, __builtin_amdgcn_update_dpp(0, __builtin_bit_cast(int, v), CTRL, 0xf, 0xf, false)); }
__device__ __forceinline__ float allreduce8(float v) { v += dpp_mov<0xB1>(v); v += dpp_mov<0x4E>(v); v += dpp_mov<0x141>(v); return v; }
__device__ __forceinline__ float wave_sum(float v) {
    v = allreduce8(v); v += dpp_mov<0x140>(v);
    const int iv = __builtin_bit_cast(int, v);
    const float a = __builtin_bit_cast(float, __builtin_amdgcn_readlane(iv, 0)), b = __builtin_bit_cast(float, __builtin_amdgcn_readlane(iv, 16)),
                c = __builtin_bit_cast(float, __builtin_amdgcn_readlane(iv, 32)), d = __builtin_bit_cast(float, __builtin_amdgcn_readlane(iv, 48));
    return (a + b) + (c + d);
}
__device__ __forceinline__ void unpack8(const u32x4 w, float (&f)[8]) {
    f[0] = bf_lo(w.x); f[1] = bf_hi(w.x); f[2] = bf_lo(w.y); f[3] = bf_hi(w.y); f[4] = bf_lo(w.z); f[5] = bf_hi(w.z); f[6] = bf_lo(w.w); f[7] = bf_hi(w.w);
}
__device__ __forceinline__ u32x4 pack8(const float (&f)[8]) {
    u32x4 w; w.x = cvt_pk_bf16(f[0], f[1]); w.y = cvt_pk_bf16(f[2], f[3]); w.z = cvt_pk_bf16(f[4], f[5]); w.w = cvt_pk_bf16(f[6], f[7]); return w;
}

namespace pg8 {
constexpr int BM = 256, BK = 64, HALF = 128, HTB = HALF * BK * 2, STAGE_BYTES = 8 * HTB, NXCD = 8, WGM = 8;
__host__ __device__ __forceinline__ int lds_byte(int r, int c) { const int st = (r >> 4) * 2 + (c >> 5), rr = r & 15, cc = c & 31, ob = rr * 64 + cc * 2; return st * 1024 + (ob ^ (((ob >> 9) & 1) << 5)); }
__host__ __device__ __forceinline__ void stage_rc(int b, int& R, int& C) { const int st = b / 1024, sb = b % 1024, swz = sb ^ (((sb >> 9) & 1) << 5); R = (st >> 1) * 16 + swz / 64; C = (st & 1) * 32 + (swz % 64) / 2; }
__host__ __device__ __forceinline__ int perm32(int rho) { const int n = rho >> 4, i = rho & 15; return 8 * (i >> 2) + 4 * n + (i & 3); }

struct Unit { int pm, pn, aux; };
struct GemmD { const bf16_t* A; const bf16_t* Bt; int lda, ldb, K; };

__device__ __forceinline__ void tile_of(int wgid, int nM, int nN, int& pm, int& pn) {
    const int nwg = nM * nN;
    { const int q = nwg / NXCD, r = nwg % NXCD, xcd = wgid % NXCD, off = wgid / NXCD; wgid = (xcd < r ? xcd * (q + 1) : r * (q + 1) + (xcd - r) * q) + off; }
    const int nig = WGM * nN, gid = wgid / nig, fm = gid * WGM, gsz = (nM - fm) < WGM ? (nM - fm) : WGM;
    pm = fm + ((wgid % nig) % gsz); pn = (wgid % nig) / gsz;
}

template <class Epi, class Sched, bool GATHER>
__device__ __forceinline__ void gemm_phase(LAS unsigned char* lds, int wave_id, const GemmD g, const Sched& S, const Epi& E) {
    int lane; asm volatile("v_mbcnt_lo_u32_b32 %0, -1, 0\n\tv_mbcnt_hi_u32_b32 %0, -1, %0" : "=v"(lane), "+s"(wave_id));
    const int wid = wave_id, tid = wid * 64 + lane, wr = wid >> 2, wc = wid & 3, fr = lane & 15, fq = lane >> 4;
    const int K = g.K, nt = K / BK;
    int Rst[2], Cst[2];
    unsigned voffB[2];
#pragma unroll
    for (int i = 0; i < 2; ++i) { int R, C; stage_rc(tid * 16 + i * 8192, R, C); Rst[i] = R; Cst[i] = C; const int Rb = (R & ~31) + perm32(R & 31); voffB[i] = (unsigned)(Rb * g.ldb + C) * 2u; }
    const size_t kstep = (size_t)(BK * 2);
    const size_t hstepB = (size_t)HALF * g.ldb * 2;
    const unsigned ldsw = (unsigned)wid * 1024u;
    const int aoff = lds_byte(wr * 64 + fr, fq * 8), boff = lds_byte(wc * 32 + fr, fq * 8);
#define PG8_SA(b, h) (((b) * 2 + (h)) * HTB)
#define PG8_SB(b, h) ((4 + (b) * 2 + (h)) * HTB)
#define PG8_STAGE(bufoff, gbase, v0, v1) do { \
        __builtin_amdgcn_global_load_lds((const unsigned*)((const char*)(gbase) + (v0)), (LAS unsigned*)(lds + (bufoff) + ldsw), 16, 0, 0); \
        __builtin_amdgcn_global_load_lds((const unsigned*)((const char*)(gbase) + (v1)), (LAS unsigned*)(lds + (bufoff) + ldsw + 8192), 16, 0, 0); } while (0)
#define PG8_STAGE_B(bufoff, gbase) PG8_STAGE(bufoff, gbase, voffB[0], voffB[1])
#define PG8_LDA(dst, b, h) do { _Pragma("unroll") for (int m = 0; m < 4; ++m) _Pragma("unroll") for (int k = 0; k < 2; ++k) dst[m][k] = *(const LAS bf16x8*)(lds + PG8_SA(b, h) + aoff + m * 2048 + k * 1024); } while (0)
#define PG8_LDB(dst, b, h) do { _Pragma("unroll") for (int n = 0; n < 2; ++n) _Pragma("unroll") for (int k = 0; k < 2; ++k) dst[n][k] = *(const LAS bf16x8*)(lds + PG8_SB(b, h) + boff + n * 2048 + k * 1024); } while (0)
#define PG8_MMA(ai, bj, At, Bt) do { __builtin_amdgcn_s_setprio(1); _Pragma("unroll") for (int m = 0; m < 4; ++m) _Pragma("unroll") for (int n = 0; n < 2; ++n) _Pragma("unroll") for (int k = 0; k < 2; ++k) \
        acc[ai][bj][m][n] = __builtin_amdgcn_mfma_f32_16x16x32_bf16(Bt[n][k], At[m][k], acc[ai][bj][m][n], 0, 0, 0); __builtin_amdgcn_s_setprio(0); } while (0)
#define PG8_WAIT_V(n) asm volatile("s_waitcnt vmcnt(" #n ")" ::: "memory")
#define PG8_WAIT_L(n) asm volatile("s_waitcnt lgkmcnt(" #n ")" ::: "memory")
#define PG8_BAR __builtin_amdgcn_s_barrier()
#define PG8_SCHED __builtin_amdgcn_sched_barrier(0)
    Unit cur, nxt; int ui = 0;
    if (!S.next(0, cur)) return;
    bool has_next = S.next(1, nxt);
    unsigned vAc[2][2], vAn[2][2];
#pragma unroll
    for (int h = 0; h < 2; ++h)
#pragma unroll
        for (int i = 0; i < 2; ++i) {
            const int rl = h * HALF + Rst[i];
            if constexpr (GATHER) { vAc[h][i] = (unsigned)(S.a_row(cur, rl) * g.lda + Cst[i]) * 2u; vAn[h][i] = has_next ? (unsigned)(S.a_row(nxt, rl) * g.lda + Cst[i]) * 2u : vAc[h][i]; }
            else { vAc[h][i] = (unsigned)(rl * g.lda + Cst[i]) * 2u; vAn[h][i] = vAc[h][i]; }
        }
    f32x4 acc[2][2][4][2];
#pragma unroll
    for (int a = 0; a < 2; ++a)
#pragma unroll
        for (int b = 0; b < 2; ++b)
#pragma unroll
            for (int m = 0; m < 4; ++m)
#pragma unroll
                for (int n = 0; n < 2; ++n) acc[a][b][m][n] = (f32x4){0.f, 0.f, 0.f, 0.f};
    bf16x8 At[4][2], B0[2][2], B1[2][2];
    const char* cA = (const char*)g.A + S.a_off(cur); const char* cB = (const char*)g.Bt + S.b_off(cur);
    PG8_STAGE_B(PG8_SB(0, 0), cB); PG8_STAGE_B(PG8_SB(0, 1), cB + hstepB); PG8_STAGE(PG8_SA(0, 0), cA, vAc[0][0], vAc[0][1]); PG8_STAGE(PG8_SA(0, 1), cA, vAc[1][0], vAc[1][1]);
    if (wr == 1) PG8_BAR;
    PG8_WAIT_V(2); PG8_BAR;
    PG8_STAGE_B(PG8_SB(1, 0), cB + kstep); PG8_STAGE(PG8_SA(1, 0), cA + kstep, vAc[0][0], vAc[0][1]); PG8_STAGE_B(PG8_SB(1, 1), cB + hstepB + kstep);
    PG8_WAIT_V(6); PG8_BAR;
    for (;;) {
        const char* nA = has_next ? (const char*)g.A + S.a_off(nxt) : cA; const char* nB = has_next ? (const char*)g.Bt + S.b_off(nxt) : cB;
        for (int t = 0; t < nt; t += 2) {
            const bool last = (t == nt - 2);
            if constexpr (Epi::MID_EVERY > 0) { if (t > 0 && t % Epi::MID_EVERY == 0) E.mid(acc, cur, wr, wc, fr, fq, t / Epi::MID_EVERY); }
            const char* a1 = cA + (size_t)(t + 1) * kstep;
            const char* a2 = last ? nA : cA + (size_t)(t + 2) * kstep; const char* b2 = last ? nB : cB + (size_t)(t + 2) * kstep;
            const char* a3 = a2 + kstep; const char* b3 = b2 + kstep;
            unsigned v2[2][2];
#pragma unroll
            for (int h = 0; h < 2; ++h)
#pragma unroll
                for (int i = 0; i < 2; ++i) v2[h][i] = (GATHER && last) ? vAn[h][i] : vAc[h][i];
            PG8_LDB(B0, 0, 0); PG8_LDB(B1, 0, 1); PG8_SCHED; PG8_LDA(At, 0, 0); PG8_STAGE(PG8_SA(1, 1), a1, vAc[1][0], vAc[1][1]);
            PG8_WAIT_V(8); PG8_WAIT_L(0); PG8_BAR; PG8_MMA(0, 0, At, B0); PG8_MMA(0, 1, At, B1); PG8_BAR; PG8_SCHED;
            PG8_LDA(At, 0, 1); PG8_STAGE_B(PG8_SB(0, 0), b2); PG8_STAGE_B(PG8_SB(0, 1), b2 + hstepB); PG8_STAGE(PG8_SA(0, 0), a2, v2[0][0], v2[0][1]);
            PG8_WAIT_V(8); PG8_WAIT_L(0); PG8_BAR; PG8_MMA(1, 0, At, B0); PG8_MMA(1, 1, At, B1); PG8_BAR; PG8_SCHED;
            PG8_LDB(B0, 1, 0); PG8_LDB(B1, 1, 1); PG8_SCHED; PG8_LDA(At, 1, 0); PG8_STAGE(PG8_SA(0, 1), a2, v2[1][0], v2[1][1]);
            PG8_WAIT_V(8); PG8_WAIT_L(0); PG8_BAR; PG8_MMA(0, 0, At, B0); PG8_MMA(0, 1, At, B1); PG8_BAR; PG8_SCHED;
            PG8_LDA(At, 1, 1); PG8_STAGE_B(PG8_SB(1, 0), b3); PG8_STAGE_B(PG8_SB(1, 1), b3 + hstepB); PG8_STAGE(PG8_SA(1, 0), a3, v2[0][0], v2[0][1]);
            PG8_WAIT_V(8); PG8_WAIT_L(0); PG8_BAR; PG8_MMA(1, 0, At, B0); PG8_MMA(1, 1, At, B1); PG8_BAR; PG8_SCHED;
        }
        if (wr == 0) PG8_BAR;
        E(acc, cur, wr, wc, fr, fq);
        if (!has_next) break;
#pragma unroll
        for (int a = 0; a < 2; ++a)
#pragma unroll
            for (int b = 0; b < 2; ++b)
#pragma unroll
                for (int m = 0; m < 4; ++m)
#pragma unroll
                    for (int n = 0; n < 2; ++n) acc[a][b][m][n] = (f32x4){0.f, 0.f, 0.f, 0.f};
        cur = nxt; cA = nA; cB = nB; ++ui;
        has_next = S.next(ui + 1, nxt);
        if constexpr (GATHER) {
#pragma unroll
            for (int h = 0; h < 2; ++h)
#pragma unroll
                for (int i = 0; i < 2; ++i) { vAc[h][i] = vAn[h][i]; if (has_next) vAn[h][i] = (unsigned)(S.a_row(nxt, h * HALF + Rst[i]) * g.lda + Cst[i]) * 2u; }
        }
        if (wr == 1) PG8_BAR;
    }
    PG8_WAIT_V(0);
    PG8_BAR;
#undef PG8_SA
#undef PG8_SB
#undef PG8_STAGE
#undef PG8_STAGE_B
#undef PG8_LDA
#undef PG8_LDB
#undef PG8_MMA
#undef PG8_WAIT_V
#undef PG8_WAIT_L
#undef PG8_BAR
#undef PG8_SCHED
}
}

using pg8::Unit; using pg8::GemmD;
struct SchedGrid {
    int nM, nN, G, c; size_t a_tile, b_tile;
    __device__ __forceinline__ bool next(int i, Unit& u) const { const long L = (long)i * G + c; if (L >= (long)nM * nN) return false; pg8::tile_of((int)L, nM, nN, u.pm, u.pn); u.aux = 0; return true; }
    __device__ __forceinline__ size_t a_off(const Unit& u) const { return (size_t)u.pm * a_tile; }
    __device__ __forceinline__ size_t b_off(const Unit& u) const { return (size_t)u.pn * b_tile; }
    __device__ __forceinline__ int a_row(const Unit&, int) const { return 0; }
};
struct SchedMerge {
    int nM, nN, G, c; size_t a_tile, b_tile;
    __device__ __forceinline__ bool next(int i, Unit& u) const { const long L = (long)(i / 3) * G + c; if (L >= (long)nM * nN) return false; pg8::tile_of((int)L, nM, nN, u.pm, u.pn); u.aux = i % 3; return true; }
    __device__ __forceinline__ size_t a_off(const Unit& u) const { return (size_t)u.pm * a_tile + (size_t)u.aux * (AW * 2); }
    __device__ __forceinline__ size_t b_off(const Unit& u) const { return (size_t)u.pn * b_tile + (size_t)u.aux * (AW * 2); }
    __device__ __forceinline__ int a_row(const Unit&, int) const { return 0; }
};
struct SchedMoe {
    int blk0, nblk, nN, G, c; const int* block_e; const int* slot_tok; size_t a_tile, b_tile, b_exp;
    __device__ __forceinline__ bool next(int i, Unit& u) const { const long L = (long)i * G + c; if (L >= (long)nblk * nN) return false; int pm, pn; pg8::tile_of((int)L, nblk, nN, pm, pn); u.pm = blk0 + pm; u.pn = pn; u.aux = block_e[u.pm]; return true; }
    __device__ __forceinline__ size_t a_off(const Unit& u) const { return (size_t)(u.pm - blk0) * a_tile; }
    __device__ __forceinline__ size_t b_off(const Unit& u) const { return (size_t)u.aux * b_exp + (size_t)u.pn * b_tile; }
    __device__ __forceinline__ int a_row(const Unit& u, int r) const { const int t = slot_tok[u.pm * 256 + r]; return t < 0 ? 0 : t; }
};

#define EPI_ROWS_BEGIN _Pragma("unroll") for (int ai = 0; ai < 2; ++ai) _Pragma("unroll") for (int m = 0; m < 4; ++m) { const int r = u.pm * 256 + ai * 128 + wr * 64 + m * 16 + fr;
#define EPI_ROWS_END }
__device__ __forceinline__ float rstd_of(const float* ss, int r) {
    const f32x4 a = *(const f32x4*)(ss + (size_t)r * 4);
    return __builtin_amdgcn_rsqf(((a[0] + a[1]) + (a[2] + a[3])) * (1.0f / DM) + RMS_EPS);
}

#define EPI_RSTD8(rsv, ss)  float rsv[2][4]; { f32x4 raw_[2][4]; \
    _Pragma("unroll") for (int ai = 0; ai < 2; ++ai) _Pragma("unroll") for (int m = 0; m < 4; ++m) raw_[ai][m] = *(const f32x4*)((ss) + (size_t)(u.pm * 256 + ai * 128 + wr * 64 + m * 16 + fr) * 4); \
    asm volatile("" : "+v"(raw_[0][0]), "+v"(raw_[0][1]), "+v"(raw_[0][2]), "+v"(raw_[0][3]), "+v"(raw_[1][0]), "+v"(raw_[1][1]), "+v"(raw_[1][2]), "+v"(raw_[1][3])); \
    _Pragma("unroll") for (int ai = 0; ai < 2; ++ai) _Pragma("unroll") for (int m = 0; m < 4; ++m) rsv[ai][m] = __builtin_amdgcn_rsqf(((raw_[ai][m][0] + raw_[ai][m][1]) + (raw_[ai][m][2] + raw_[ai][m][3])) * (1.0f / DM) + RMS_EPS); }
struct EpiScale { static constexpr int MID_EVERY = 0;
    bf16_t* O; int ldo; const float* ss;
    __device__ __forceinline__ void operator()(const f32x4 (&acc)[2][2][4][2], const Unit& u, int wr, int wc, int fr, int fq) const {
        const int c0 = u.pn * 256 + wc * 32 + 8 * fq;
        EPI_RSTD8(rsv, ss)
        EPI_ROWS_BEGIN
            const float rs = rsv[ai][m]; bf16_t* rowp = O + (size_t)r * ldo + c0;
#pragma unroll
            for (int bj = 0; bj < 2; ++bj) { const f32x4 v0 = acc[ai][bj][m][0] * rs, v1 = acc[ai][bj][m][1] * rs;
                u32x4 w; w.x = cvt_pk_bf16(v0[0], v0[1]); w.y = cvt_pk_bf16(v0[2], v0[3]); w.z = cvt_pk_bf16(v1[0], v1[1]); w.w = cvt_pk_bf16(v1[2], v1[3]); *(u32x4*)(rowp + bj * 128) = w; }
        EPI_ROWS_END
    }
};
struct EpiGate { static constexpr int MID_EVERY = 0;
    bf16_t* O; int ldo; const float* ss; const float* bias;
    __device__ __forceinline__ void operator()(const f32x4 (&acc)[2][2][4][2], const Unit& u, int wr, int wc, int fr, int fq) const {
        const int c0 = u.pn * 256 + wc * 32 + 8 * fq;
        f32x4 bv[2][2];
#pragma unroll
        for (int bj = 0; bj < 2; ++bj) { bv[bj][0] = *(const f32x4*)(bias + c0 + bj * 128); bv[bj][1] = *(const f32x4*)(bias + c0 + bj * 128 + 4); }
        EPI_RSTD8(rsv, ss)
        EPI_ROWS_BEGIN
            const float rs = rsv[ai][m]; bf16_t* rowp = O + (size_t)r * ldo + c0;
#pragma unroll
            for (int bj = 0; bj < 2; ++bj) { f32x4 v0 = acc[ai][bj][m][0] * rs + bv[bj][0], v1 = acc[ai][bj][m][1] * rs + bv[bj][1];
#pragma unroll
                for (int j = 0; j < 4; ++j) { v0[j] = fast_sigmoid(v0[j]); v1[j] = fast_sigmoid(v1[j]); }
                u32x4 w; w.x = cvt_pk_bf16(v0[0], v0[1]); w.y = cvt_pk_bf16(v0[2], v0[3]); w.z = cvt_pk_bf16(v1[0], v1[1]); w.w = cvt_pk_bf16(v1[2], v1[3]); *(u32x4*)(rowp + bj * 128) = w; }
        EPI_ROWS_END
    }
};
struct EpiMerge { static constexpr int MID_EVERY = 0;
    bf16_t* MB; const bf16_t* ZG;
    __device__ __forceinline__ void operator()(const f32x4 (&acc)[2][2][4][2], const Unit& u, int wr, int wc, int fr, int fq) const {
        const int c0 = u.pn * 256 + wc * 32 + 8 * fq; const int br = u.aux;
#pragma unroll
        for (int ai = 0; ai < 2; ++ai) {
            u32x4 graw[4][2], praw[4][2];
#pragma unroll
            for (int m = 0; m < 4; ++m) { const int r = u.pm * 256 + ai * 128 + wr * 64 + m * 16 + fr; const bf16_t* gp = ZG + (size_t)r * NGATE + br * DM + c0; const bf16_t* pp = MB + (size_t)r * DM + c0;
                graw[m][0] = *(const u32x4*)gp; graw[m][1] = *(const u32x4*)(gp + 128);
                if (br > 0) { praw[m][0] = *(const u32x4*)pp; praw[m][1] = *(const u32x4*)(pp + 128); } else { praw[m][0] = (u32x4){0u, 0u, 0u, 0u}; praw[m][1] = praw[m][0]; } }
            asm volatile("" : "+v"(graw[0][0]), "+v"(graw[0][1]), "+v"(graw[1][0]), "+v"(graw[1][1]), "+v"(graw[2][0]), "+v"(graw[2][1]), "+v"(graw[3][0]), "+v"(graw[3][1]),
                              "+v"(praw[0][0]), "+v"(praw[0][1]), "+v"(praw[1][0]), "+v"(praw[1][1]), "+v"(praw[2][0]), "+v"(praw[2][1]), "+v"(praw[3][0]), "+v"(praw[3][1]));
#pragma unroll
            for (int m = 0; m < 4; ++m) { const int r = u.pm * 256 + ai * 128 + wr * 64 + m * 16 + fr; bf16_t* rowp = MB + (size_t)r * DM + c0;
#pragma unroll
                for (int bj = 0; bj < 2; ++bj) {
                    float gt[8], pv[8]; unpack8(graw[m][bj], gt); unpack8(praw[m][bj], pv);
                    float o[8];
#pragma unroll
                    for (int j = 0; j < 4; ++j) { o[j] = pv[j] + gt[j] * acc[ai][bj][m][0][j]; o[4 + j] = pv[4 + j] + gt[4 + j] * acc[ai][bj][m][1][j]; }
                    *(u32x4*)(rowp + bj * 128) = pack8(o); } }
        }
    }
};
constexpr float GATE_FLOOR = 1e-20f;
struct EpiMerge3 { static constexpr int MID_EVERY = 8;
    bf16_t* MB; const bf16_t* ZG;
    __device__ __forceinline__ void mid(f32x4 (&acc)[2][2][4][2], const Unit& u, int wr, int wc, int fr, int fq, int seg) const {
        const int c0 = u.pn * 256 + wc * 32 + 8 * fq;
#pragma unroll
        for (int ai = 0; ai < 2; ++ai) {
            u32x4 ga[4][2], gb[4][2];
#pragma unroll
            for (int m = 0; m < 4; ++m) { const bf16_t* gp = ZG + (size_t)(u.pm * 256 + ai * 128 + wr * 64 + m * 16 + fr) * NGATE + (seg - 1) * DM + c0;
                ga[m][0] = *(const u32x4*)gp; ga[m][1] = *(const u32x4*)(gp + 128); gb[m][0] = *(const u32x4*)(gp + DM); gb[m][1] = *(const u32x4*)(gp + DM + 128); }
            asm volatile("" : "+v"(ga[0][0]), "+v"(ga[0][1]), "+v"(ga[1][0]), "+v"(ga[1][1]), "+v"(ga[2][0]), "+v"(ga[2][1]), "+v"(ga[3][0]), "+v"(ga[3][1]),
                              "+v"(gb[0][0]), "+v"(gb[0][1]), "+v"(gb[1][0]), "+v"(gb[1][1]), "+v"(gb[2][0]), "+v"(gb[2][1]), "+v"(gb[3][0]), "+v"(gb[3][1]));
#pragma unroll
            for (int m = 0; m < 4; ++m)
#pragma unroll
                for (int bj = 0; bj < 2; ++bj) { float x[8], y[8]; unpack8(ga[m][bj], x); unpack8(gb[m][bj], y);
#pragma unroll
                    for (int j = 0; j < 4; ++j) { acc[ai][bj][m][0][j] *= fmaxf(x[j], GATE_FLOOR) * __builtin_amdgcn_rcpf(fmaxf(y[j], GATE_FLOOR)); acc[ai][bj][m][1][j] *= fmaxf(x[4 + j], GATE_FLOOR) * __builtin_amdgcn_rcpf(fmaxf(y[4 + j], GATE_FLOOR)); } }
        }
    }
    __device__ __forceinline__ void operator()(const f32x4 (&acc)[2][2][4][2], const Unit& u, int wr, int wc, int fr, int fq) const {
        const int c0 = u.pn * 256 + wc * 32 + 8 * fq;
        u32x4 g2[2][4][2];
#pragma unroll
        for (int ai = 0; ai < 2; ++ai)
#pragma unroll
            for (int m = 0; m < 4; ++m) { const bf16_t* gp = ZG + (size_t)(u.pm * 256 + ai * 128 + wr * 64 + m * 16 + fr) * NGATE + 2 * DM + c0; g2[ai][m][0] = *(const u32x4*)gp; g2[ai][m][1] = *(const u32x4*)(gp + 128); }
        asm volatile("" : "+v"(g2[0][0][0]), "+v"(g2[0][0][1]), "+v"(g2[0][1][0]), "+v"(g2[0][1][1]), "+v"(g2[0][2][0]), "+v"(g2[0][2][1]), "+v"(g2[0][3][0]), "+v"(g2[0][3][1]),
                          "+v"(g2[1][0][0]), "+v"(g2[1][0][1]), "+v"(g2[1][1][0]), "+v"(g2[1][1][1]), "+v"(g2[1][2][0]), "+v"(g2[1][2][1]), "+v"(g2[1][3][0]), "+v"(g2[1][3][1]));
        EPI_ROWS_BEGIN
            bf16_t* rowp = MB + (size_t)r * DM + c0;
#pragma unroll
            for (int bj = 0; bj < 2; ++bj) { float gt[8], o[8]; unpack8(g2[ai][m][bj], gt);
#pragma unroll
                for (int j = 0; j < 4; ++j) { o[j] = fmaxf(gt[j], GATE_FLOOR) * acc[ai][bj][m][0][j]; o[4 + j] = fmaxf(gt[4 + j], GATE_FLOOR) * acc[ai][bj][m][1][j]; }
                *(u32x4*)(rowp + bj * 128) = pack8(o); }
        EPI_ROWS_END
    }
};
struct EpiResid { static constexpr int MID_EVERY = 0;
    bf16_t* HB; float* ssn; LAS float* red;
    __device__ __forceinline__ void operator()(const f32x4 (&acc)[2][2][4][2], const Unit& u, int wr, int wc, int fr, int fq) const {
        const int c0 = u.pn * 256 + wc * 32 + 8 * fq;
        u32x4 hraw[2][4][2];
#pragma unroll
        for (int ai = 0; ai < 2; ++ai)
#pragma unroll
            for (int m = 0; m < 4; ++m) { const bf16_t* rp = HB + (size_t)(u.pm * 256 + ai * 128 + wr * 64 + m * 16 + fr) * DM + c0; hraw[ai][m][0] = *(const u32x4*)rp; hraw[ai][m][1] = *(const u32x4*)(rp + 128); }
        asm volatile("" : "+v"(hraw[0][0][0]), "+v"(hraw[0][0][1]), "+v"(hraw[0][1][0]), "+v"(hraw[0][1][1]), "+v"(hraw[0][2][0]), "+v"(hraw[0][2][1]), "+v"(hraw[0][3][0]), "+v"(hraw[0][3][1]),
                          "+v"(hraw[1][0][0]), "+v"(hraw[1][0][1]), "+v"(hraw[1][1][0]), "+v"(hraw[1][1][1]), "+v"(hraw[1][2][0]), "+v"(hraw[1][2][1]), "+v"(hraw[1][3][0]), "+v"(hraw[1][3][1]));
        EPI_ROWS_BEGIN
            bf16_t* rowp = HB + (size_t)r * DM + c0; float sq = 0.f;
#pragma unroll
            for (int bj = 0; bj < 2; ++bj) {
                float hv[8]; unpack8(hraw[ai][m][bj], hv);
#pragma unroll
                for (int j = 0; j < 4; ++j) { hv[j] += acc[ai][bj][m][0][j]; hv[4 + j] += acc[ai][bj][m][1][j]; }
                const u32x4 w = pack8(hv); *(u32x4*)(rowp + bj * 128) = w;
                float rv[8]; unpack8(w, rv);
#pragma unroll
                for (int j = 0; j < 8; ++j) sq += rv[j] * rv[j]; }
            { const int ln = fq * 16 + fr; sq += __builtin_bit_cast(float, __builtin_amdgcn_ds_bpermute((ln ^ 16) << 2, __builtin_bit_cast(int, sq))); sq += __builtin_bit_cast(float, __builtin_amdgcn_ds_bpermute((ln ^ 32) << 2, __builtin_bit_cast(int, sq))); }
            if (fq == 0) red[(ai * 128 + wr * 64 + m * 16 + fr) * 4 + wc] = sq;
        EPI_ROWS_END
        asm volatile("s_waitcnt lgkmcnt(0)" ::: "memory"); __builtin_amdgcn_s_barrier(); asm volatile("" ::: "memory");
        { const int t = (wr * 4 + wc) * 64 + fq * 16 + fr;
          if (t < 256) { const f32x4 p = *(const LAS f32x4*)(red + t * 4); ssn[(size_t)(u.pm * 256 + t) * 4 + u.pn] = (p[0] + p[1]) + (p[2] + p[3]); } }
    }
};
struct EpiSwiglu { static constexpr int MID_EVERY = 0;
    bf16_t* HID; const float* ss; const int* slot_tok; int row0;
    __device__ __forceinline__ void operator()(const f32x4 (&acc)[2][2][4][2], const Unit& u, int wr, int wc, int fr, int fq) const {
        const int c0 = u.pn * 128 + wc * 32 + 8 * fq;
        float rsv[2][4];
        if (slot_tok) {
#pragma unroll
            for (int ai = 0; ai < 2; ++ai)
#pragma unroll
                for (int m = 0; m < 4; ++m) rsv[ai][m] = ss[u.pm * 256 + ai * 128 + wr * 64 + m * 16 + fr];
            asm volatile("" : "+v"(rsv[0][0]), "+v"(rsv[0][1]), "+v"(rsv[0][2]), "+v"(rsv[0][3]), "+v"(rsv[1][0]), "+v"(rsv[1][1]), "+v"(rsv[1][2]), "+v"(rsv[1][3]));
        } else { EPI_RSTD8(rs2, ss)
#pragma unroll
            for (int ai = 0; ai < 2; ++ai)
#pragma unroll
                for (int m = 0; m < 4; ++m) rsv[ai][m] = rs2[ai][m]; }
        EPI_ROWS_BEGIN
            const float rs = rsv[ai][m]; const int orow = slot_tok ? r - row0 : r;
            const f32x4 g0 = acc[ai][0][m][0] * rs, g1 = acc[ai][0][m][1] * rs, u0 = acc[ai][1][m][0] * rs, u1 = acc[ai][1][m][1] * rs;
            float o[8];
#pragma unroll
            for (int j = 0; j < 4; ++j) { o[j] = g0[j] * fast_sigmoid(g0[j]) * u0[j]; o[4 + j] = g1[j] * fast_sigmoid(g1[j]) * u1[j]; }
            *(u32x4*)(HID + (size_t)orow * DFF + c0) = pack8(o);
        EPI_ROWS_END
    }
};
struct EpiStore { static constexpr int MID_EVERY = 0;
    bf16_t* O; int ldo;
    __device__ __forceinline__ void operator()(const f32x4 (&acc)[2][2][4][2], const Unit& u, int wr, int wc, int fr, int fq) const {
        const int c0 = u.pn * 256 + wc * 32 + 8 * fq;
        EPI_ROWS_BEGIN
            bf16_t* rowp = O + (size_t)r * ldo + c0;
#pragma unroll
            for (int bj = 0; bj < 2; ++bj) { const f32x4 v0 = acc[ai][bj][m][0], v1 = acc[ai][bj][m][1];
                u32x4 w; w.x = cvt_pk_bf16(v0[0], v0[1]); w.y = cvt_pk_bf16(v0[2], v0[3]); w.z = cvt_pk_bf16(v1[0], v1[1]); w.w = cvt_pk_bf16(v1[2], v1[3]); *(u32x4*)(rowp + bj * 128) = w; }
        EPI_ROWS_END
    }
};

#define XB_TMO      128
#define XB_XCNT(j)  (256  + 64 * (j))
#define XB_XSUB(j)  (1280 + 64 * (j))
#define XB_XGEN(j)  (2304 + 64 * (j))
#define XB_TOP      3328
#define XB_TOPGEN   3392
#define XCD_BAR_WORDS 3456
#define XB_SPIN_CAP (1u << 18)
__device__ __forceinline__ unsigned xb_ld(unsigned* p)              { return __hip_atomic_load(p, __ATOMIC_RELAXED, __HIP_MEMORY_SCOPE_AGENT); }
__device__ __forceinline__ unsigned xb_add(unsigned* p, unsigned v) { return __hip_atomic_fetch_add(p, v, __ATOMIC_RELAXED, __HIP_MEMORY_SCOPE_AGENT); }
__device__ __forceinline__ unsigned xb_xcc_id() { return (unsigned)__builtin_amdgcn_s_getreg((3 << 11) | 20) & 0xFu; }
#define XB_SPIN(cond, bar) do { unsigned _sp = 0; while (cond) { __builtin_amdgcn_s_sleep(1); \
    if ((++_sp & 255u) == 0u) { if (xb_ld(&(bar)[XB_TMO])) break; if (_sp > XB_SPIN_CAP) { atomicAdd(&(bar)[XB_TMO], 1u); break; } } } } while (0)
struct XcdBarrier { unsigned* bar; unsigned x; volatile LAS unsigned* st; };
__device__ __forceinline__ XcdBarrier xcd_barrier_post(unsigned* bar, volatile LAS unsigned* st) {
    XcdBarrier b; b.bar = bar; b.x = xb_xcc_id(); b.st = st;
    if (threadIdx.x == 0) (void)xb_add(&bar[XB_XCNT(b.x)], 1u);
    return b;
}
__device__ __forceinline__ void xcd_barrier_complete(unsigned* bar, unsigned x, unsigned& nloc, unsigned& nx) {
    const unsigned G = gridDim.x * gridDim.y * gridDim.z;
    unsigned sum, cnt, mine, sp = 0u;
    for (;;) {
        sum = 0u; cnt = 0u; mine = 0u;
#pragma unroll
        for (unsigned j = 0; j < 16; ++j) { const unsigned c = xb_ld(&bar[XB_XCNT(j)]); sum += c; cnt += (c > 0u) ? 1u : 0u; mine = (j == x) ? c : mine; }
        if (sum == G) break;
        __builtin_amdgcn_s_sleep(1);
        if ((++sp & 255u) == 0u) { if (xb_ld(&bar[XB_TMO])) break; if (sp > XB_SPIN_CAP) { atomicAdd(&bar[XB_TMO], 1u); break; } }
    }
    nloc = mine > 0u ? mine : 1u; nx = cnt > 0u ? cnt : 1u;
}
__device__ __forceinline__ void xcd_barrier(const XcdBarrier& b, int wave_id) {
    asm volatile("s_waitcnt vmcnt(0)" ::: "memory");
    __syncthreads();
    int lane_; asm volatile("v_mbcnt_lo_u32_b32 %0, -1, 0\n\tv_mbcnt_hi_u32_b32 %0, -1, %0" : "=v"(lane_));
    if (wave_id == 0 && lane_ == 0) {
        unsigned* bar = b.bar;
        __builtin_amdgcn_s_waitcnt(0);
        unsigned nloc = b.st[0], nx = b.st[1];
        if (nloc == 0u) { xcd_barrier_complete(bar, b.x, nloc, nx); b.st[0] = nloc; b.st[1] = nx; }
        const unsigned old = xb_add(&bar[XB_XSUB(b.x)], 1u);
        const unsigned gen = old / nloc;
        if (old + 1u == (gen + 1u) * nloc) {
            __builtin_amdgcn_fence(__ATOMIC_RELEASE, "agent");
            asm volatile("s_waitcnt vmcnt(0)" ::: "memory");
            const unsigned og = xb_add(&bar[XB_TOP], 1u);
            const unsigned tg = og / nx;
            if (og + 1u == (tg + 1u) * nx) xb_add(&bar[XB_TOPGEN], 1u);
            else XB_SPIN(xb_ld(&bar[XB_TOPGEN]) == tg, bar);
            __builtin_amdgcn_fence(__ATOMIC_ACQUIRE, "agent");
            xb_add(&bar[XB_XGEN(b.x)], 1u);
            asm volatile("s_waitcnt vmcnt(0)" ::: "memory");
        } else {
            XB_SPIN(xb_ld(&bar[XB_XGEN(b.x)]) == gen, bar);
            __builtin_amdgcn_fence(__ATOMIC_ACQUIRE, "agent");
            asm volatile("s_waitcnt vmcnt(0)" ::: "memory");
        }
    }
    __syncthreads();
}

struct Args { const float* in[36]; float* out; unsigned char* ws; int ph_lo, ph_hi, li, pad; };
enum { I_X = 0, I_META, I_MIXG, I_WIN, I_GATEB, I_MU, I_W0, I_W2, I_A0, I_A2, I_G2, I_KK, I_KA, I_RK, I_LNXW, I_LNXB, I_CONVW, I_CONVB, I_BLNG, I_BLNB, I_POOLW, I_CSCALE,
       I_PROJA, I_PROJB, I_PROJC, I_WOUT, I_FFNG, I_FGATE, I_FUP, I_FDOWN, I_RW, I_RB, I_EGATE, I_EUP, I_EDOWN, I_FINALG };
constexpr int PTR_OFF = LDSCTL_OFF + 64;
__device__ __forceinline__ GAS unsigned char* lds_ptr(LAS unsigned char* lds, int i) {
    const LAS unsigned* p = (const LAS unsigned*)(lds + PTR_OFF + 8 * i);
    const unsigned lo = __builtin_amdgcn_readfirstlane(p[0]), hi = __builtin_amdgcn_readfirstlane(p[1]);
    return (GAS unsigned char*)(((unsigned long long)hi << 32) | lo);
}
struct Frame {
    LAS unsigned char* lds; int tid, lane, wave, G, bid;
    unsigned char* ws;
    bf16_t* W; bf16_t* WE; bf16_t* HB; bf16_t* R1; bf16_t* R2; bf16_t* R3; bf16_t* YS; float* SS;
};
__device__ __forceinline__ void frame_ptrs(Frame& F) {
    GAS unsigned char* ws = lds_ptr(F.lds, 37); F.ws = (unsigned char*)ws;
    F.W = (bf16_t*)(ws + WS_W); F.WE = (bf16_t*)(ws + WS_WE); F.HB = (bf16_t*)(ws + WS_HB); F.R1 = (bf16_t*)(ws + WS_R1); F.R2 = (bf16_t*)(ws + WS_R2); F.R3 = (bf16_t*)(ws + WS_R3);
    F.YS = (bf16_t*)(ws + WS_YS); F.SS = (float*)(ws + WS_SS);
}
__device__ __forceinline__ const float* in_ptr(const Frame& F, int i) { return (const float*)lds_ptr(F.lds, i); }
#define LDS_WAIT() asm volatile("s_waitcnt lgkmcnt(0)" ::: "memory")
#define PHASE_ENTER(F) do { int l_; int w_ = (F).wave, g_ = (F).G, b_ = (F).bid; asm volatile("v_mbcnt_lo_u32_b32 %0, -1, 0\n\tv_mbcnt_hi_u32_b32 %0, -1, %0" : "=v"(l_), "+s"(w_), "+s"(g_), "+s"(b_) :: "memory"); (F).lane = l_; (F).wave = w_; (F).G = g_; (F).bid = b_; (F).tid = w_ * 64 + l_; frame_ptrs(F); } while (0)


__device__ __forceinline__ int row_of(int b, int l) { return l < NMETA ? MBASE + l : b * SEQ + (l - NMETA); }
__device__ __forceinline__ int prev_row(int r) { if (r >= MBASE) return r > MBASE ? r - 1 : -1; return (r & (SEQ - 1)) ? r - 1 : MBASE + NMETA - 1; }

struct ConvJob { const float* src; int K, srcN, col0, ncols; bf16_t* dst; int dld, dcol0, mode; const float* sc; };
__device__ __forceinline__ int conv_items(const ConvJob& j) { return (j.K / 64) * (j.ncols / 32); }
__device__ __forceinline__ void conv_item(const ConvJob& j, LAS float* scr, int item, int lane) {
    const int nblk = j.ncols / 32, kb = item / nblk, nb = item % nblk, k0 = 64 * kb, n0 = 32 * nb;
    float vv[32];
#pragma unroll
    for (int i = 0; i < 32; ++i) { const int kk = 2 * i + (lane >> 5); vv[i] = j.src[(size_t)(k0 + kk) * j.srcN + j.col0 + n0 + (lane & 31)]; }
    if (j.sc) {
#pragma unroll
        for (int i = 0; i < 32; ++i) vv[i] *= j.sc[k0 + 2 * i + (lane >> 5)]; }
#pragma unroll
    for (int i = 0; i < 32; ++i) { const int kk = 2 * i + (lane >> 5); scr[kk * 33 + (lane & 31)] = vv[i]; }
    LDS_WAIT(); asm volatile("" ::: "memory");
    const int c = lane & 7;
    int drow0 = n0; if (j.mode == 1) drow0 = 256 * (n0 / 128) + (n0 % 128); else if (j.mode == 2) drow0 = 256 * (n0 / 128) + 128 + (n0 % 128);
#pragma unroll
    for (int jj = 0; jj < 4; ++jj) { const int n = (lane >> 3) + 8 * jj; const LAS float* s = scr + (8 * c) * 33 + n;
        u32x4 o; o.x = cvt_pk_bf16(s[0 * 33], s[1 * 33]); o.y = cvt_pk_bf16(s[2 * 33], s[3 * 33]); o.z = cvt_pk_bf16(s[4 * 33], s[5 * 33]); o.w = cvt_pk_bf16(s[6 * 33], s[7 * 33]);
        *(u32x4*)(j.dst + (size_t)(drow0 + n) * j.dld + j.dcol0 + k0 + 8 * c) = o; }
    LDS_WAIT(); asm volatile("" ::: "memory");
}
__device__ __forceinline__ void conv_run(Frame& F, const ConvJob& j) {
    LAS float* scr = (LAS float*)(F.lds + F.wave * 16384);
    const int gw = F.bid * 8 + F.wave, NGW = F.G * 8, n = conv_items(j);
    for (int it = gw; it < n; it += NGW) conv_item(j, scr, it, F.lane);
}
__device__ __forceinline__ void convert_common(Frame& F) {
    PHASE_ENTER(F);
    for (int l = 0; l < 2; ++l) {
        bf16_t* WL = F.W + (size_t)l * WL_SIZE; const float* mg = in_ptr(F, I_MIXG) + l * DM;
        const float* win = in_ptr(F, I_WIN) + (size_t)l * DM * 6400;
        conv_run(F, ConvJob{win, DM, 6400, 0, NABC, WL + WL_ABC, DM, 0, 0, mg});
        conv_run(F, ConvJob{win, DM, 6400, NABC, NGATE, WL + WL_G, DM, 0, 0, mg});
        conv_run(F, ConvJob{in_ptr(F, I_PROJA) + (size_t)l * AW * DM, AW, DM, 0, DM, WL + WL_P, NY, 0, 0, nullptr});
        conv_run(F, ConvJob{in_ptr(F, I_PROJB) + (size_t)l * AW * DM, AW, DM, 0, DM, WL + WL_P, NY, AW, 0, nullptr});
        conv_run(F, ConvJob{in_ptr(F, I_PROJC) + (size_t)l * AW * DM, AW, DM, 0, DM, WL + WL_P, NY, 2 * AW, 0, nullptr});
        conv_run(F, ConvJob{in_ptr(F, I_WOUT) + (size_t)l * DM * DM, DM, DM, 0, DM, WL + WL_OUT, DM, 0, 0, nullptr});
        conv_run(F, ConvJob{in_ptr(F, I_W2) + (size_t)l * 64 * AW, 64, AW, 0, AW, WL + WL_W2, 64, 0, 0, nullptr});
        conv_run(F, ConvJob{in_ptr(F, I_A2) + (size_t)l * 64 * AW, 64, AW, 0, AW, WL + WL_A2, 64, 0, 0, nullptr});
        conv_run(F, ConvJob{in_ptr(F, I_G2) + (size_t)l * 128 * AW, 128, AW, 0, AW, WL + WL_G2, 128, 0, 0, nullptr});
        for (int g = 0; g < 4; ++g) conv_run(F, ConvJob{in_ptr(F, I_POOLW) + ((size_t)l * 4 + g) * 128 * 128, 128, 128, 0, 128, WL + WL_PW + (size_t)g * 128 * 128, 128, 0, 0, nullptr});
    }
    const float* fg = in_ptr(F, I_FFNG);
    conv_run(F, ConvJob{in_ptr(F, I_FGATE), DM, DFF, 0, DFF, F.W + WF_GU, DM, 0, 1, fg});
    conv_run(F, ConvJob{in_ptr(F, I_FUP), DM, DFF, 0, DFF, F.W + WF_GU, DM, 0, 2, fg});
    conv_run(F, ConvJob{in_ptr(F, I_FDOWN), DFF, DM, 0, DM, F.W + WF_D, DFF, 0, 0, nullptr});
}
__device__ __forceinline__ void convert_experts(Frame& F) {
    PHASE_ENTER(F);
    const float* fg = in_ptr(F, I_FFNG) + DM;
    for (int e = 0; e < NEXP; ++e) {
        conv_run(F, ConvJob{in_ptr(F, I_EGATE) + (size_t)e * DM * DFF, DM, DFF, 0, DFF, F.WE + WE_GU + (size_t)e * NGU * DM, DM, 0, 1, fg});
        conv_run(F, ConvJob{in_ptr(F, I_EUP) + (size_t)e * DM * DFF, DM, DFF, 0, DFF, F.WE + WE_GU + (size_t)e * NGU * DM, DM, 0, 2, fg});
        conv_run(F, ConvJob{in_ptr(F, I_EDOWN) + (size_t)e * DFF * DM, DFF, DM, 0, DM, F.WE + WE_D + (size_t)e * DM * DFF, DFF, 0, 0, nullptr});
    }
}
__device__ __forceinline__ void x_to_hb(Frame& F) {
    PHASE_ENTER(F);
    const int gw = F.bid * 8 + F.wave, NGW = F.G * 8;
    for (int r = gw; r < NROWS; r += NGW) {
        const float* src = r < NREAL ? in_ptr(F, I_X) + (size_t)r * DM : in_ptr(F, I_META) + (size_t)(r - MBASE) * DM;
        const f32x4* xr = (const f32x4*)src + F.lane; u32x2* o = (u32x2*)(F.HB + (size_t)r * DM) + F.lane; float sq = 0.f;
#pragma unroll
        for (int j = 0; j < 4; ++j) { const f32x4 v = xr[64 * j]; u32x2 w; w.x = cvt_pk_bf16(v[0], v[1]); w.y = cvt_pk_bf16(v[2], v[3]); o[64 * j] = w;
            const float a = bf_lo(w.x), b = bf_hi(w.x), c = bf_lo(w.y), d = bf_hi(w.y); sq += (a * a + b * b) + (c * c + d * d); }
        sq = wave_sum(sq);
        if (r < NREAL && F.lane < 4) F.SS[(size_t)r * 4 + F.lane] = F.lane == 0 ? sq : 0.f;
    }
}

__device__ __forceinline__ float meta_tile(Frame& F, const bf16_t* A16, int lda, const bf16_t* Bt, int ldb, int K, int brow0) {
    LAS float* red = (LAS float*)F.lds;
    const int kw = K / 8, k0 = F.wave * kw, fr = F.lane & 15, fq = F.lane >> 4;
    f32x4 acc = (f32x4){0.f, 0.f, 0.f, 0.f};
    const bf16_t* ap = A16 + (size_t)fr * lda + k0 + 8 * fq; const bf16_t* bp = Bt + (size_t)(brow0 + fr) * ldb + k0 + 8 * fq;
    for (int k = 0; k < kw; k += 32) { const bf16x8 a = *(const bf16x8*)(ap + k), b = *(const bf16x8*)(bp + k); acc = __builtin_amdgcn_mfma_f32_16x16x32_bf16(b, a, acc, 0, 0, 0); }
#pragma unroll
    for (int j = 0; j < 4; ++j) red[F.wave * 256 + fr * 16 + 4 * fq + j] = acc[j];
    __syncthreads();
    float v = 0.f;
    if (F.tid < 256) {
#pragma unroll
        for (int w = 0; w < 8; ++w) v += red[w * 256 + F.tid];
    }
    __syncthreads();
    return v;
}


__device__ __forceinline__ void meta_rstd_setup(Frame& F) {
    LAS float* mrs = (LAS float*)(F.lds + 8192);
#pragma unroll
    for (int i = 0; i < 2; ++i) { const int row = 2 * F.wave + i; float hv[16]; const bf16_t* hp = F.HB + (size_t)(MBASE + row) * DM + 16 * F.lane;
        unpack8(*(const u32x4*)hp, *(float(*)[8])&hv[0]); unpack8(*(const u32x4*)(hp + 8), *(float(*)[8])&hv[8]); float sq = 0.f;
#pragma unroll
        for (int j = 0; j < 16; ++j) sq += hv[j] * hv[j];
        sq = wave_sum(sq); if (F.lane == 0) mrs[row] = __builtin_amdgcn_rsqf(sq * (1.0f / DM) + RMS_EPS); }
    __syncthreads();
}
#define META_RS(F, row16) (((const LAS float*)((F).lds + 8192))[row16])

__device__ __forceinline__ void prep_afrags(bf16x8 (&af)[8], const bf16_t* U, const float* mu, int row, int fq) {
    const int prow = prev_row(row), pr = prow >= 0 ? prow : row; const float pm = prow >= 0 ? 1.0f : 0.0f;
    u32x4 rc[8], rp[8];
#pragma unroll
    for (int s = 0; s < 8; ++s) { const int col = 1536 + 32 * s + 8 * fq; rc[s] = *(const u32x4*)(U + (size_t)row * NABC + col); rp[s] = *(const u32x4*)(U + (size_t)pr * NABC + col); }
#pragma unroll
    for (int s = 0; s < 8; ++s) {
        const int col = 1536 + 32 * s + 8 * fq;
        float cur[8], prv[8]; unpack8(rc[s], cur); unpack8(rp[s], prv);
        const f32x4 m0 = *(const f32x4*)(mu + col), m1 = *(const f32x4*)(mu + col + 4);
        float x[8];
#pragma unroll
        for (int j = 0; j < 8; ++j) { const float mm = j < 4 ? m0[j] : m1[j - 4]; float v = cur[j] + (pm * prv[j] - cur[j]) * mm;
            if (s < 2) v = 1.0f - 2.0f * __builtin_amdgcn_rcpf(1.0f + __expf(2.0f * v));
            else if (s >= 4) v = fast_sigmoid(v);
            x[j] = v; }
        const u32x4 p = pack8(x); af[s] = __builtin_bit_cast(bf16x8, p);
    }
}
template <int NG> __device__ __forceinline__ void prep_tile(const bf16x8 (&af)[NG][8], const int (&rows)[NG], int ct, int fr, int fq, const bf16_t* w2t, const bf16_t* a2t, const bf16_t* g2t,
                                                            const float* w0, const float* a0, bf16_t* WAw, bf16_t* WAa, bf16_t* Y) {
    const bf16_t* bw = w2t + (size_t)(16 * ct + fr) * 64 + 8 * fq; const bf16_t* ba = a2t + (size_t)(16 * ct + fr) * 64 + 8 * fq; const bf16_t* bg = g2t + (size_t)(16 * ct + fr) * 128 + 8 * fq;
    bf16x8 fw[2], fa[2], fg[4];
#pragma unroll
    for (int s = 0; s < 2; ++s) { fw[s] = *(const bf16x8*)(bw + 32 * s); fa[s] = *(const bf16x8*)(ba + 32 * s); }
#pragma unroll
    for (int s = 0; s < 4; ++s) fg[s] = *(const bf16x8*)(bg + 32 * s);
    const int c = 16 * ct + 4 * fq;
    const f32x4 w0v = *(const f32x4*)(w0 + c), a0v = *(const f32x4*)(a0 + c);
#pragma unroll
    for (int gi = 0; gi < NG; ++gi) {
        f32x4 aw = (f32x4){0.f, 0.f, 0.f, 0.f}, aa = aw, ag = aw;
#pragma unroll
        for (int s = 0; s < 2; ++s) { aw = __builtin_amdgcn_mfma_f32_16x16x32_bf16(fw[s], af[gi][s], aw, 0, 0, 0); aa = __builtin_amdgcn_mfma_f32_16x16x32_bf16(fa[s], af[gi][2 + s], aa, 0, 0, 0); }
#pragma unroll
        for (int s = 0; s < 4; ++s) ag = __builtin_amdgcn_mfma_f32_16x16x32_bf16(fg[s], af[gi][4 + s], ag, 0, 0, 0);
        u32x2 ow, oa, og;
        ow.x = cvt_pk_bf16(0.60653066f * fast_sigmoid(aw[0] + w0v[0]), 0.60653066f * fast_sigmoid(aw[1] + w0v[1])); ow.y = cvt_pk_bf16(0.60653066f * fast_sigmoid(aw[2] + w0v[2]), 0.60653066f * fast_sigmoid(aw[3] + w0v[3]));
        oa.x = cvt_pk_bf16(fast_sigmoid(aa[0] + a0v[0]), fast_sigmoid(aa[1] + a0v[1])); oa.y = cvt_pk_bf16(fast_sigmoid(aa[2] + a0v[2]), fast_sigmoid(aa[3] + a0v[3]));
        og.x = cvt_pk_bf16(ag[0], ag[1]); og.y = cvt_pk_bf16(ag[2], ag[3]);
        const size_t row = rows[gi];
        *(u32x2*)(WAw + row * AW + c) = ow; *(u32x2*)(WAa + row * AW + c) = oa; *(u32x2*)(Y + row * NY + AW + c) = og;
    }
}
__device__ __forceinline__ void phase_prep(Frame& F, int l) {
    PHASE_ENTER(F);
    const bf16_t* U = F.R1; bf16_t* WAw = F.R2; bf16_t* WAa = F.R2 + (size_t)NROWS * AW; bf16_t* Y = F.R3;
    const bf16_t* WL = F.W + (size_t)l * WL_SIZE; const bf16_t* w2t = WL + WL_W2; const bf16_t* a2t = WL + WL_A2; const bf16_t* g2t = WL + WL_G2;
    const float* mu = in_ptr(F, I_MU) + l * AIN; const float* w0 = in_ptr(F, I_W0) + l * AW; const float* a0 = in_ptr(F, I_A0) + l * AW;
    const int fr = F.lane & 15, fq = F.lane >> 4;
    const int gw = F.bid * 8 + F.wave, NGW = F.G * 8;
    for (int grp = gw; grp < NREAL / 16; grp += 2 * NGW) {
        const int grp2 = grp + NGW;
        if (grp2 < NREAL / 16) {
            bf16x8 af[2][8]; const int rows[2] = {grp * 16 + fr, grp2 * 16 + fr};
            prep_afrags(af[0], U, mu, rows[0], fq); prep_afrags(af[1], U, mu, rows[1], fq);
#pragma unroll 2
            for (int ct = 0; ct < 32; ++ct) prep_tile<2>(af, rows, ct, fr, fq, w2t, a2t, g2t, w0, a0, WAw, WAa, Y);
        } else {
            bf16x8 af[1][8]; const int rows[1] = {grp * 16 + fr};
            prep_afrags(af[0], U, mu, rows[0], fq);
#pragma unroll 2
            for (int ct = 0; ct < 32; ++ct) prep_tile<1>(af, rows, ct, fr, fq, w2t, a2t, g2t, w0, a0, WAw, WAa, Y);
        }
    }
    for (int hi = gw; hi < NB * 256; hi += NGW) { const int hb = hi >> 8, hc = (hi & 255) + 1; const int src = hc == 1 ? MBASE + NMETA - 1 : hb * SEQ + 32 * (hc - 1) - 1;
        bf16_t* hd = (bf16_t*)(F.ws + WS_HALO) + (size_t)hi * 1536;
#pragma unroll
        for (int j = 0; j < 3; ++j) *(u32x4*)(hd + 512 * j + 8 * F.lane) = *(const u32x4*)(U + (size_t)src * NABC + 512 * j + 8 * F.lane); }
    if (gw < 32) { bf16x8 af[1][8]; const int rows[1] = {MBASE + fr}; prep_afrags(af[0], U, mu, rows[0], fq); prep_tile<1>(af, rows, gw, fr, fq, w2t, a2t, g2t, w0, a0, WAw, WAa, Y); }
}

constexpr int SC_TOK = 32, SC_VEC = SC_TOK * 64, SC_BUF_F = 5 * SC_VEC + SC_TOK * 16 * 4, SC_BUF = SC_BUF_F * 4, SC_YB = 2 * SC_BUF, SC_NCH = 1 + SEQ / SC_TOK;
template <int N> __device__ __forceinline__ float ror16(float v) { return __builtin_bit_cast(float, __builtin_amdgcn_update_dpp(0, __builtin_bit_cast(int, v), 0x120 + N, 0xf, 0xf, false)); }
__device__ __forceinline__ float allreduce16(float v) { v += ror16<8>(v); v += ror16<4>(v); v += ror16<2>(v); v += ror16<1>(v); return v; }
struct ScanRegs { u32x4 zr, zrp, zk, zkp, ww, aa, zv, zvp; };
__device__ __forceinline__ void scan_load(ScanRegs& R, const bf16_t* U, const bf16_t* WAw, const bf16_t* WAa, int b, int h, int q, int c, int sw, int lane) {
    c = c < SC_NCH ? c : SC_NCH - 1;
    const int ntok = c == 0 ? NMETA : SC_TOK, p0 = c == 0 ? 0 : NMETA + SC_TOK * (c - 1), per = ntok / 4, i0 = lane >> 3, i = i0 < per ? i0 : per - 1, o = lane & 7;
    const int p = p0 + sw * per + i, row = row_of(b, p), prow = row_of(b, p > 0 ? p - 1 : 0), ch = h * 64 + 8 * o, cv = 1024 + h * 64 + 16 * q + 8 * (o & 1);
    R.zr = *(const u32x4*)(U + (size_t)row * NABC + ch); R.zk = *(const u32x4*)(U + (size_t)row * NABC + 512 + ch);
    R.ww = *(const u32x4*)(WAw + (size_t)row * AW + ch); R.aa = *(const u32x4*)(WAa + (size_t)row * AW + ch);
    R.zv = *(const u32x4*)(U + (size_t)row * NABC + cv);
    R.zrp = *(const u32x4*)(U + (size_t)prow * NABC + ch); R.zkp = *(const u32x4*)(U + (size_t)prow * NABC + 512 + ch); R.zvp = *(const u32x4*)(U + (size_t)prow * NABC + cv);
}
__device__ __forceinline__ void scan_stage(const ScanRegs& R, LAS float* buf, int c, int sw, int lane, const float (&mur)[8], const float (&muk)[8], const float (&muv)[8], const float (&kkc)[8], const float (&kac)[8]) {
    const int ntok = c == 0 ? NMETA : SC_TOK, per = ntok / 4, i = lane >> 3, o = lane & 7;
    if (i < per) {
        const int tt = sw * per + i;
        float zr[8], zrp[8], zk[8], zkp[8], ww[8], aa[8];
        unpack8(R.zr, zr); unpack8(R.zrp, zrp); unpack8(R.zk, zk); unpack8(R.zkp, zkp); unpack8(R.ww, ww); unpack8(R.aa, aa);
        const bool first = (c == 0 && tt == 0);
        if (first) {
#pragma unroll
            for (int j = 0; j < 8; ++j) { zrp[j] = 0.f; zkp[j] = 0.f; } }
        float r[8], kx[8], kk[8], ss = 0.f;
#pragma unroll
        for (int j = 0; j < 8; ++j) { r[j] = zr[j] + (zrp[j] - zr[j]) * mur[j]; kx[j] = zk[j] + (zkp[j] - zk[j]) * muk[j]; kk[j] = kx[j] * kkc[j]; ss += kk[j] * kk[j]; }
        ss = allreduce8(ss);
        const float inv = 1.0f / fmaxf(sqrtf(ss), 1e-12f);
        float av[8], bv[8], dv[8], k2[8], rd[8], br = 0.f, kr = 0.f;
#pragma unroll
        for (int j = 0; j < 8; ++j) { const float kn = kk[j] * inv; av[j] = -kn; bv[j] = kn * aa[j]; dv[j] = __expf(-ww[j]); k2[j] = kx[j] * (1.0f + (aa[j] - 1.0f) * kac[j]); rd[j] = dv[j] * r[j];
            br += bv[j] * r[j]; kr += k2[j] * r[j]; }
        br = allreduce8(br); kr = allreduce8(kr);
        LAS float* dst = buf + tt * 64 + 8 * o;
        *(LAS f32x4*)(dst + 0 * SC_VEC) = (f32x4){av[0], av[1], av[2], av[3]}; *(LAS f32x4*)(dst + 0 * SC_VEC + 4) = (f32x4){av[4], av[5], av[6], av[7]};
        *(LAS f32x4*)(dst + 1 * SC_VEC) = (f32x4){bv[0], bv[1], bv[2], bv[3]}; *(LAS f32x4*)(dst + 1 * SC_VEC + 4) = (f32x4){bv[4], bv[5], bv[6], bv[7]};
        *(LAS f32x4*)(dst + 2 * SC_VEC) = (f32x4){dv[0], dv[1], dv[2], dv[3]}; *(LAS f32x4*)(dst + 2 * SC_VEC + 4) = (f32x4){dv[4], dv[5], dv[6], dv[7]};
        *(LAS f32x4*)(dst + 3 * SC_VEC) = (f32x4){k2[0], k2[1], k2[2], k2[3]}; *(LAS f32x4*)(dst + 3 * SC_VEC + 4) = (f32x4){k2[4], k2[5], k2[6], k2[7]};
        *(LAS f32x4*)(dst + 4 * SC_VEC) = (f32x4){rd[0], rd[1], rd[2], rd[3]}; *(LAS f32x4*)(dst + 4 * SC_VEC + 4) = (f32x4){rd[4], rd[5], rd[6], rd[7]};
        if (o < 2) { float zv[8], zvp[8]; unpack8(R.zv, zv); unpack8(R.zvp, zvp); float v[8];
            if (first) {
#pragma unroll
                for (int j = 0; j < 8; ++j) zvp[j] = 0.f; }
#pragma unroll
            for (int j = 0; j < 8; ++j) { v[j] = zv[j] + (zvp[j] - zv[j]) * muv[j]; }
            LAS float* vd = buf + 5 * SC_VEC + (tt * 16 + 8 * o) * 4;
#pragma unroll
            for (int j = 0; j < 8; ++j) *(LAS f32x4*)(vd + 4 * j) = (f32x4){v[j], br, kr, 0.f}; }
    }
}
struct StepIn { f32x4 a, b, d, k, rd, vs; };
template <int J> __device__ __forceinline__ void step_load(StepIn& I, unsigned avec, unsigned avs) {
    asm volatile("ds_read_b128 %0, %1 offset:%2" : "=v"(I.a) : "v"(avec), "n"(J * 256));
    asm volatile("ds_read_b128 %0, %1 offset:%2" : "=v"(I.b) : "v"(avec), "n"(J * 256 + 8192));
    asm volatile("ds_read_b128 %0, %1 offset:%2" : "=v"(I.d) : "v"(avec), "n"(J * 256 + 16384));
    asm volatile("ds_read_b128 %0, %1 offset:%2" : "=v"(I.k) : "v"(avec), "n"(J * 256 + 24576));
    asm volatile("ds_read_b128 %0, %1 offset:%2" : "=v"(I.rd) : "v"(avec), "n"(J * 256 + 32768));
    asm volatile("ds_read_b128 %0, %1 offset:%2" : "=v"(I.vs) : "v"(avs), "n"(J * 256));
}
#define STEP_WAIT(I, n) asm volatile("s_waitcnt lgkmcnt(" #n ")" : "+v"(I.a), "+v"(I.b), "+v"(I.d), "+v"(I.k), "+v"(I.rd), "+v"(I.vs))
static_assert(SC_VEC * 4 == 8192, "asm offsets");
__device__ __forceinline__ float step_compute(const StepIn& I, f32x2& S01, f32x2& S23) {
    const f32x2 a01 = {I.a[0], I.a[1]}, a23 = {I.a[2], I.a[3]}, r01 = {I.rd[0], I.rd[1]}, r23 = {I.rd[2], I.rd[3]};
    f32x2 q = S01 * a01; q = S23 * a23 + q; f32x2 w = S01 * r01; w = S23 * r23 + w;
    float p1 = q.x + q.y, p2 = w.x + w.y;
    p1 = allreduce16(p1); p2 = allreduce16(p2);
    const float y = p2 + (p1 * I.vs[1] + I.vs[0] * I.vs[2]);
    const f32x2 pv = {p1, p1}, vv = {I.vs[0], I.vs[0]}, b01 = {I.b[0], I.b[1]}, b23 = {I.b[2], I.b[3]}, k01 = {I.k[0], I.k[1]}, k23 = {I.k[2], I.k[3]}, d01 = {I.d[0], I.d[1]}, d23 = {I.d[2], I.d[3]};
    S01 = S01 * d01 + (pv * b01 + vv * k01); S23 = S23 * d23 + (pv * b23 + vv * k23);
    return y;
}
__device__ __forceinline__ void phase_scan(Frame& F, int l) {
    PHASE_ENTER(F);
    const bf16_t* U = F.R1; const bf16_t* WAw = F.R2; const bf16_t* WAa = F.R2 + (size_t)NROWS * AW; bf16_t* Y = F.R3;
    const float* mu = in_ptr(F, I_MU) + l * AIN; const float* kkp = in_ptr(F, I_KK) + l * AW; const float* kap = in_ptr(F, I_KA) + l * AW;
    const int lane = F.lane, wave = F.wave;
    constexpr int NIT = SC_NCH + 4;
    static_assert(NIT % 3 == 0, "NIT");
    for (int unit = F.bid; unit < NB * 8 * 4; unit += F.G) {
        const int b = unit >> 5, h = (unit >> 2) & 7, q = unit & 3;
        __syncthreads();
        if (wave >= 4) {
            const int sw = wave - 4, o = lane & 7, ch = h * 64 + 8 * o, cv = 1024 + h * 64 + 16 * q + 8 * (o & 1);
            float mur[8], muk[8], muv[8], kkc[8], kac[8];
#pragma unroll
            for (int j = 0; j < 8; ++j) { mur[j] = mu[ch + j]; muk[j] = mu[512 + ch + j]; muv[j] = mu[cv + j]; kkc[j] = kkp[ch + j]; kac[j] = kap[ch + j]; }
            ScanRegs R0, R1, R2; scan_load(R0, U, WAw, WAa, b, h, q, 0, sw, lane); scan_load(R1, U, WAw, WAa, b, h, q, 1, sw, lane);
#define SC_FLUSH(kk_) do { const int c_ = (kk_) - 2; if (c_ >= 0 && c_ < SC_NCH) { const int ntok_ = c_ == 0 ? NMETA : SC_TOK, p0_ = c_ == 0 ? 0 : NMETA + SC_TOK * (c_ - 1); \
                const LAS float* yb_ = (const LAS float*)(F.lds + SC_YB + (c_ & 1) * (SC_TOK * 16 * 4)); const int t2_ = sw * 64 + lane, tt_ = t2_ >> 3, pr_ = t2_ & 7; \
                if (tt_ < ntok_ && (b == 0 || c_ > 0)) { const int row_ = row_of(b, p0_ + tt_); \
                    *(unsigned*)(Y + (size_t)row_ * NY + h * 64 + 16 * q + 2 * pr_) = cvt_pk_bf16(yb_[tt_ * 16 + 2 * pr_], yb_[tt_ * 16 + 2 * pr_ + 1]); } } } while (0)
#define SC_SUBIT(kk_, RC_, RL_) do { scan_load(RL_, U, WAw, WAa, b, h, q, (kk_) + 2, sw, lane); \
                if ((kk_) < SC_NCH) scan_stage(RC_, (LAS float*)(F.lds + ((kk_) & 1) * SC_BUF), (kk_), sw, lane, mur, muk, muv, kkc, kac); \
                SC_FLUSH(kk_); LDS_WAIT(); __builtin_amdgcn_s_barrier(); asm volatile("" ::: "memory"); } while (0)
            for (int k = 0; k < NIT; k += 3) { SC_SUBIT(k, R0, R2); SC_SUBIT(k + 1, R1, R0); SC_SUBIT(k + 2, R2, R1); }
#undef SC_SUBIT
#undef SC_FLUSH
        } else {
            const int rr = lane >> 4, kq = lane & 15, row16 = 4 * wave + rr;
            f32x2 S01 = {0.f, 0.f}, S23 = {0.f, 0.f};
            for (int k = 0; k < NIT; ++k) {
                if (k >= 1 && k <= SC_NCH) {
                    const int c = k - 1, ntok = c == 0 ? NMETA : SC_TOK;
                    const LAS float* buf = (const LAS float*)(F.lds + (c & 1) * SC_BUF);
                    LAS float* yb = (LAS float*)(F.lds + SC_YB + (c & 1) * (SC_TOK * 16 * 4));
                    const unsigned bvec = (unsigned)(size_t)buf + 16u * kq, bvs = (unsigned)(size_t)buf + (5 * SC_VEC + row16 * 4) * 4u;
                    for (int t0 = 0; t0 < ntok; t0 += 16) {
                        float yk = 0.f; StepIn I0, I1, I2;
                        const unsigned v0 = bvec + t0 * 256u, w0 = bvs + t0 * 256u;
#define SC_LD(I, j) step_load<j>(I, v0, w0)
#define SC_ST(I, j, n) do { STEP_WAIT(I, n); const float y_ = step_compute(I, S01, S23); yk = (kq == (j)) ? y_ : yk; } while (0)
                        SC_LD(I0, 0); SC_LD(I1, 1);
                        SC_LD(I2, 2); SC_ST(I0, 0, 12); SC_LD(I0, 3); SC_ST(I1, 1, 12); SC_LD(I1, 4); SC_ST(I2, 2, 12);
                        SC_LD(I2, 5); SC_ST(I0, 3, 12); SC_LD(I0, 6); SC_ST(I1, 4, 12); SC_LD(I1, 7); SC_ST(I2, 5, 12);
                        SC_LD(I2, 8); SC_ST(I0, 6, 12); SC_LD(I0, 9); SC_ST(I1, 7, 12); SC_LD(I1, 10); SC_ST(I2, 8, 12);
                        SC_LD(I2, 11); SC_ST(I0, 9, 12); SC_LD(I0, 12); SC_ST(I1, 10, 12); SC_LD(I1, 13); SC_ST(I2, 11, 12);
                        SC_LD(I2, 14); SC_ST(I0, 12, 12); SC_LD(I0, 15); SC_ST(I1, 13, 12); SC_ST(I2, 14, 6); SC_ST(I0, 15, 0);
#undef SC_LD
#undef SC_ST
                        yb[(t0 + kq) * 16 + row16] = yk;
                    }
                }
                LDS_WAIT(); __builtin_amdgcn_s_barrier(); asm volatile("" ::: "memory");
            }
        }
    }
}

#define LD8(dst, p) float dst[8]; { const f32x4 x0_ = *(const f32x4*)(p), x1_ = *(const f32x4*)((p) + 4); dst[0] = x0_[0]; dst[1] = x0_[1]; dst[2] = x0_[2]; dst[3] = x0_[3]; dst[4] = x1_[0]; dst[5] = x1_[1]; dst[6] = x1_[2]; dst[7] = x1_[3]; }
namespace p2 {
constexpr int X_AT = 0, X_RT = 4096, X_BT = 8192, X_KT = 12288, X_VT = 16384, X_AAB = 20480, X_AAK = 24576, X_MRK = 26624, X_TT = 28672, X_A21 = 30720, X_TC11 = 31232, X_Z1T = 31744, SZ = 32256, NW = 4;
constexpr int G_TT = 0, G_MRB = 2048, G_XA = 4096, G_FA = 8192, G_SZ = 12288;
static_assert(NW * SZ <= LDSCTL_OFF && X_AAK == X_AAB + 4096 && X_MRK == X_AAK + 2048 && X_TT == X_MRK + 2048, "prep2 LDS");
}
constexpr int P2_UNITS = 8 * (1 + NB * 256);
static_assert((size_t)P2_UNITS * p2::G_SZ <= (size_t)NREAL * DM * 4, "scan side blocks");
__device__ __forceinline__ int p2_unit(int b, int h, int c) { return (c == 0 ? 0 : 1 + b * 256 + (c - 1)) * 8 + h; }
namespace ck {
constexpr int PSZ = 26880, NSLOT = 4, O_AT = 0, O_RT = 4096, O_TT = 8192, O_MRB = 10240, O_XA = 12288, O_FA = 14336, O_BT = 16384, O_KT = 20992, BK_LD = 72  , O_VV = 25600  , O_GV = 26624;
constexpr int C_BASE = 132096, O_ST = 0, O_U0T = 2048, O_WT = 3072, O_FLAG = 4096, NCH = 1 + SEQ / 32;
static_assert(NSLOT * PSZ <= LDSCTL_OFF && C_BASE + O_FLAG + 64 <= LDS_BYTES && C_BASE >= PTR_OFF + 8 * 40, "chunked-scan LDS map");
typedef float f32x4v __attribute__((ext_vector_type(4)));
__device__ __forceinline__ f32x4 mma(bf16x8 a, bf16x8 b, f32x4 c) { return __builtin_amdgcn_mfma_f32_16x16x32_bf16(a, b, c, 0, 0, 0); }
__device__ __forceinline__ bf16x8 frag(const LAS unsigned char* base, int ld, int row0, int k0, int lane) { return *(const LAS bf16x8*)(base + ((row0 + (lane & 15)) * ld + k0 + 8 * (lane >> 4)) * 2); }
__device__ __forceinline__ bf16x8 frag16(const LAS unsigned char* base, int ld, int row0, int lane) { const bf16x8 z = {0, 0, 0, 0, 0, 0, 0, 0}; const int q = lane >> 4; bf16x8 v = *(const LAS bf16x8*)(base + ((row0 + (lane & 15)) * ld + 8 * (q & 1)) * 2); return q < 2 ? v : z; }
__device__ __forceinline__ void lds_spin(volatile LAS unsigned* p, unsigned want) { while (*p < want) __builtin_amdgcn_s_sleep(1); }
__device__ __forceinline__ bf16x8 frag_tr(const LAS unsigned char* base, int pitch, int k0, int n0, int lane) {
    const unsigned a0 = (unsigned)(size_t)base + (unsigned)((k0 + 8 * (lane >> 4) + ((lane >> 2) & 3)) * pitch + n0 * 2 + 8 * (lane & 3)), a1 = a0 + 4u * (unsigned)pitch;
    u32x2 lo, hi; asm volatile("ds_read_b64_tr_b16 %0, %2\n\tds_read_b64_tr_b16 %1, %3\n\ts_waitcnt lgkmcnt(0)" : "=&v"(lo), "=&v"(hi) : "v"(a0), "v"(a1) : "memory");
    const u32x4 v = {lo.x, lo.y, hi.x, hi.y}; return __builtin_bit_cast(bf16x8, v);
}
}
#define LD8G(dst, p) float dst[8]; { const f32x4 x0_ = *(const GAS f32x4*)(p), x1_ = *(const GAS f32x4*)((p) + 4); dst[0] = x0_[0]; dst[1] = x0_[1]; dst[2] = x0_[2]; dst[3] = x0_[3]; dst[4] = x1_[0]; dst[5] = x1_[1]; dst[6] = x1_[2]; dst[7] = x1_[3]; }
__device__ __forceinline__ bf16x8 pack_acc(f32x4 a, f32x4 b) { const u32x4 v = {cvt_pk_bf16(a[0], a[1]), cvt_pk_bf16(a[2], a[3]), cvt_pk_bf16(b[0], b[1]), cvt_pk_bf16(b[2], b[3])}; return __builtin_bit_cast(bf16x8, v); }
struct TrF { u32x2 lo, hi; };
__device__ __forceinline__ void tr_issue(TrF& f, const LAS unsigned char* base, int pitch, int k0, int n0, int step, int lane) {
    const unsigned a0 = (unsigned)(size_t)base + (unsigned)((k0 + step * (lane >> 4) + ((lane >> 2) & 3)) * pitch + n0 * 2 + 8 * (lane & 3)), a1 = a0 + (unsigned)((step == 8 ? 4 : 16) * pitch);
    asm volatile("ds_read_b64_tr_b16 %0, %2\n\tds_read_b64_tr_b16 %1, %3" : "=&v"(f.lo), "=&v"(f.hi) : "v"(a0), "v"(a1) : "memory");
}
__device__ __forceinline__ bf16x8 tr_get(const TrF& f) { const u32x4 v = {f.lo.x, f.lo.y, f.hi.x, f.hi.y}; return __builtin_bit_cast(bf16x8, v); }
#define TR_WAIT4(a, b, c, d) asm volatile("s_waitcnt lgkmcnt(0)" : "+v"(a.lo), "+v"(a.hi), "+v"(b.lo), "+v"(b.hi), "+v"(c.lo), "+v"(c.hi), "+v"(d.lo), "+v"(d.hi) :: "memory")
#define TR_WAIT5(a, b, c, d, e) asm volatile("s_waitcnt lgkmcnt(0)" : "+v"(a.lo), "+v"(a.hi), "+v"(b.lo), "+v"(b.hi), "+v"(c.lo), "+v"(c.hi), "+v"(d.lo), "+v"(d.hi), "+v"(e.lo), "+v"(e.hi) :: "memory")
__device__ __forceinline__ void ck_fetch(u32x4 (&PR)[24], const bf16_t* U, const bf16_t* WAw, const bf16_t* WAa, const float* GC, const unsigned char* CKX, int b, int h, int q, int c, int lane) {
    c = c < ck::NCH ? c : ck::NCH - 1;
    const int o = lane & 7, ti = lane >> 3, ch = h * 64 + 8 * o; const int p0 = c == 0 ? 0 : NMETA + 32 * (c - 1), nreal = c == 0 ? NMETA : 32;
#pragma unroll
    for (int p = 0; p < 4; ++p) { const int t = 8 * p + ti; const size_t row = (size_t)row_of(b, p0 + (t < nreal ? t : 0));
        PR[p] = *(const GAS u32x4*)(WAw + row * AW + ch); PR[4 + p] = *(const GAS u32x4*)(WAa + row * AW + ch);
        PR[8 + p] = *(const GAS u32x4*)(U + row * NABC + ch); PR[12 + p] = *(const GAS u32x4*)(U + row * NABC + 512 + ch); }
    { const int t = lane >> 1; PR[16] = *(const GAS u32x4*)(U + (size_t)row_of(b, p0 + (t < nreal ? t : 0)) * NABC + 1024 + h * 64 + 16 * q + 8 * (lane & 1)); }
    const unsigned char* gx = CKX + (size_t)p2_unit(b, h, c) * p2::G_SZ;
    PR[17] = *(const GAS u32x4*)(gx + p2::G_TT + lane * 32); PR[18] = *(const GAS u32x4*)(gx + p2::G_TT + lane * 32 + 16);
    PR[19] = *(const GAS u32x4*)(gx + p2::G_MRB + lane * 32); PR[20] = *(const GAS u32x4*)(gx + p2::G_MRB + lane * 32 + 16);
    { const u32x2 x0 = *(const GAS u32x2*)(gx + p2::G_XA + ((q * 2 + 0) * 64 + lane) * 8), x1 = *(const GAS u32x2*)(gx + p2::G_XA + ((q * 2 + 1) * 64 + lane) * 8);
      const u32x2 f0 = *(const GAS u32x2*)(gx + p2::G_FA + ((q * 2 + 0) * 64 + lane) * 8), f1 = *(const GAS u32x2*)(gx + p2::G_FA + ((q * 2 + 1) * 64 + lane) * 8);
      PR[21] = (u32x4){x0.x, x0.y, x1.x, x1.y}; PR[22] = (u32x4){f0.x, f0.y, f1.x, f1.y}; }
    PR[23] = *(const GAS u32x4*)(GC + ((size_t)((c == 0 ? 0 : b) * 8 + h) * 257 + c) * 64 + 4 * (lane & 15));
}
__device__ __forceinline__ void ck_put(LAS unsigned char* pb, const u32x4 (&PR)[24], int c, int lane) {
    using namespace ck;
    const int o = lane & 7, ti = lane >> 3; const int nreal = c == 0 ? NMETA : 32; const u32x4 z4 = {0u, 0u, 0u, 0u};
    const int o4 = o & 3, gl = (4 * (o4 & 1) + (o4 >> 1)) * 8 + (o >> 2) * 64;
#pragma unroll
    for (int p = 0; p < 4; ++p) { const int t = 8 * p + ti; const bool real = t < nreal; const u32x4 xa = real ? PR[p] : z4, xr = real ? PR[8 + p] : z4;
        *(LAS u32x2*)(pb + O_AT + t * 128 + gl) = (u32x2){xa.x, xa.y}; *(LAS u32x2*)(pb + O_AT + t * 128 + gl + 16) = (u32x2){xa.z, xa.w};
        *(LAS u32x2*)(pb + O_RT + t * 128 + gl) = (u32x2){xr.x, xr.y}; *(LAS u32x2*)(pb + O_RT + t * 128 + gl + 16) = (u32x2){xr.z, xr.w};
        *(LAS u32x4*)(pb + O_BT + (t * BK_LD + 8 * o) * 2) = real ? PR[4 + p] : z4; *(LAS u32x4*)(pb + O_KT + (t * BK_LD + 8 * o) * 2) = real ? PR[12 + p] : z4; }
    *(LAS u32x4*)(pb + O_VV + lane * 16) = (lane >> 1) < nreal ? PR[16] : z4;
    { const int trow = lane >> 1, hf = lane & 1;
#pragma unroll
      for (int e = 0; e < 2; ++e) { const int o5 = 2 * hf + e, g5 = (4 * (o5 & 1) + (o5 >> 1)) * 8; const u32x4 xt = PR[17 + e], xm = PR[19 + e];
          *(LAS u32x2*)(pb + O_TT + trow * 64 + g5) = (u32x2){xt.x, xt.y}; *(LAS u32x2*)(pb + O_TT + trow * 64 + g5 + 16) = (u32x2){xt.z, xt.w};
          *(LAS u32x2*)(pb + O_MRB + trow * 64 + g5) = (u32x2){xm.x, xm.y}; *(LAS u32x2*)(pb + O_MRB + trow * 64 + g5 + 16) = (u32x2){xm.z, xm.w}; } }
    { const u32x4 x = PR[21], f = PR[22];
      *(LAS u32x4*)(pb + O_XA + lane * 16) = (u32x4){x.x << 16, x.x & 0xffff0000u, x.y << 16, x.y & 0xffff0000u}; *(LAS u32x4*)(pb + O_XA + (64 + lane) * 16) = (u32x4){x.z << 16, x.z & 0xffff0000u, x.w << 16, x.w & 0xffff0000u};
      *(LAS u32x4*)(pb + O_FA + lane * 16) = (u32x4){f.x << 16, f.x & 0xffff0000u, f.y << 16, f.y & 0xffff0000u}; *(LAS u32x4*)(pb + O_FA + (64 + lane) * 16) = (u32x4){f.z << 16, f.z & 0xffff0000u, f.w << 16, f.w & 0xffff0000u}; }
    if (lane < 16) *(LAS u32x4*)(pb + O_GV + lane * 16) = PR[23];
}
__device__ __forceinline__ void phase_scan_chunked(Frame& F, int l) {
    PHASE_ENTER(F);
    using namespace ck;
    const bf16_t* U = F.R1; const bf16_t* WAw = F.R2; const bf16_t* WAa = F.R2 + (size_t)NROWS * AW; bf16_t* Y = F.R3;
    const float* GC = (const float*)(F.ws + WS_GC); const unsigned char* CKX = (const unsigned char*)lds_ptr(F.lds, 36);
    const int lane = F.lane, wave = F.wave, fr = lane & 15, fq = lane >> 4;
    LAS unsigned char* cb = F.lds + C_BASE; volatile LAS unsigned* flags = (volatile LAS unsigned*)(cb + O_FLAG);
    for (int u0 = F.bid; u0 < NB * 8 * 4; u0 += F.G) {
        const int unit = F.G == 256 ? (u0 & 7) * 32 + (u0 >> 3) : u0;
        const int b = unit >> 5, h = (unit >> 2) & 7, q = unit & 3;
        __syncthreads();
        if (F.tid < 16) flags[F.tid] = 0u;
        for (int i = F.tid; i < 1024; i += 512) ((LAS unsigned*)(cb + O_ST))[i] = 0u;
        __syncthreads();
        if (wave >= 1 && wave <= NSLOT) {
            const int sl = wave - 1; LAS unsigned char* pb = F.lds + sl * PSZ;
            unsigned n = 0; u32x4 PR[24]; ck_fetch(PR, U, WAw, WAa, GC, CKX, b, h, q, sl, lane);
            for (int c = sl; c < NCH; c += NSLOT, ++n) {
                lds_spin(flags + 4 + sl, n);
                asm volatile("" ::: "memory");
                ck_put(pb, PR, c, lane);
                ck_fetch(PR, U, WAw, WAa, GC, CKX, b, h, q, c + NSLOT, lane);
                asm volatile("s_waitcnt lgkmcnt(0)" ::: "memory");
                if (lane == 0) flags[sl] = n + 1;
            }
        } else if (wave == 0) {
            f32x4 accS[4];
#pragma unroll
            for (int kt = 0; kt < 4; ++kt) accS[kt] = (f32x4){0.f, 0.f, 0.f, 0.f};
            for (int c = 0; c < NCH; ++c) {
                const int s = c & (NSLOT - 1); const unsigned n = (unsigned)(c >> 2);
                const LAS unsigned char* sb = F.lds + s * PSZ;
                lds_spin(flags + s, n + 1);
                asm volatile("" ::: "memory");
                f32x4 u0 = *(const LAS f32x4*)(sb + O_XA + lane * 16), u1 = *(const LAS f32x4*)(sb + O_XA + (64 + lane) * 16);
                const bf16x8 a00 = frag(sb + O_AT, 64, 0, 0, lane), a01 = frag(sb + O_AT, 64, 0, 32, lane), a10 = frag(sb + O_AT, 64, 16, 0, lane), a11 = frag(sb + O_AT, 64, 16, 32, lane);
                const bf16x8 t0 = frag(sb + O_TT, 32, 0, 0, lane), t1 = frag(sb + O_TT, 32, 16, 0, lane);
                const bf16x8 pA = pack_acc(accS[0], accS[1]), pB = pack_acc(accS[2], accS[3]);
                asm volatile("" ::: "memory");
                f32x4 y0 = *(const LAS f32x4*)(sb + O_FA + lane * 16), y1 = *(const LAS f32x4*)(sb + O_FA + (64 + lane) * 16);
                const bf16x8 r00 = frag(sb + O_RT, 64, 0, 0, lane), r01 = frag(sb + O_RT, 64, 0, 32, lane), r10 = frag(sb + O_RT, 64, 16, 0, lane), r11 = frag(sb + O_RT, 64, 16, 32, lane);
                const bf16x8 m0 = frag(sb + O_MRB, 32, 0, 0, lane), m1 = frag(sb + O_MRB, 32, 16, 0, lane);
                f32x4 g[4];
#pragma unroll
                for (int kt = 0; kt < 4; ++kt) g[kt] = *(const LAS f32x4*)(sb + O_GV + (16 * kt + 4 * fq) * 4);
                u0 = mma(a00, pA, u0); u1 = mma(a10, pA, u1); u0 = mma(a01, pB, u0); u1 = mma(a11, pB, u1);
                y0 = mma(pA, r00, y0); y1 = mma(pA, r10, y1); y0 = mma(pB, r01, y0); y1 = mma(pB, r11, y1);
                TrF fv, fk[4], fb[4];
                tr_issue(fv, sb + O_VV, 32, 0, 0, 8, lane);
#pragma unroll
                for (int kt = 0; kt < 4; ++kt) tr_issue(fk[kt], sb + O_KT, 2 * BK_LD, 0, 16 * kt, 8, lane);
                const bf16x8 pU = pack_acc(u0, u1);
                f32x4 w0 = {0.f, 0.f, 0.f, 0.f}, w1 = w0; w0 = mma(t0, pU, w0); w1 = mma(t1, pU, w1);
                TR_WAIT5(fv, fk[0], fk[1], fk[2], fk[3]);
#pragma unroll
                for (int kt = 0; kt < 4; ++kt) tr_issue(fb[kt], sb + O_BT, 2 * BK_LD, 0, 16 * kt, 4, lane);
                { const bf16x8 fvv = tr_get(fv);
#pragma unroll
                  for (int kt = 0; kt < 4; ++kt) accS[kt] = mma(tr_get(fk[kt]), fvv, accS[kt]); }
                const bf16x8 pW = pack_acc(w0, w1);
                y0 = mma(pW, m0, y0); y1 = mma(pW, m1, y1);
                TR_WAIT4(fb[0], fb[1], fb[2], fb[3]);
                if (lane == 0) flags[4 + s] = n + 1;
#pragma unroll
                for (int kt = 0; kt < 4; ++kt) { accS[kt] = mma(tr_get(fb[kt]), pW, accS[kt]); accS[kt] = accS[kt] * g[kt]; }
                { const int nreal = c == 0 ? NMETA : 32, p0 = c == 0 ? 0 : NMETA + 32 * (c - 1);
                  if (fr < nreal && (b == 0 || c > 0)) *(u32x2*)(Y + (size_t)row_of(b, p0 + fr) * NY + h * 64 + 16 * q + 4 * fq) = (u32x2){cvt_pk_bf16(y0[0], y0[1]), cvt_pk_bf16(y0[2], y0[3])};
                  if (16 + fr < nreal && (b == 0 || c > 0)) *(u32x2*)(Y + (size_t)row_of(b, p0 + 16 + fr) * NY + h * 64 + 16 * q + 4 * fq) = (u32x2){cvt_pk_bf16(y1[0], y1[1]), cvt_pk_bf16(y1[2], y1[3])}; }
            }
        }
    }
    __syncthreads();
}

template <int WIN> __device__ __forceinline__ void pool_group(const bf16_t* U, bf16_t* Y, const bf16_t* pwt, const float* csc, int b, int pbase, int g, int lane) {
    const int fr = lane & 15, fq = lane >> 4, p = pbase + fr, row = row_of(b, p), cnt = (p + 1) < WIN ? (p + 1) : WIN;
    const float inv = 1.0f / (float)cnt;
    int rows[WIN];
#pragma unroll
    for (int i = 0; i < WIN; ++i) rows[i] = row_of(b, p - i > 0 ? p - i : 0);
    bf16x8 af[4];
#pragma unroll
    for (int ks = 0; ks < 4; ++ks) {
        const int col = AIN + 1024 + g * 128 + 32 * ks + 8 * fq;
        float sum[8], z0[8];
        constexpr int NB8 = WIN < 8 ? WIN : 8;
#pragma unroll
        for (int i0 = 0; i0 < WIN; i0 += NB8) {
            u32x4 raw[NB8];
#pragma unroll
            for (int i = 0; i < NB8; ++i) raw[i] = *(const u32x4*)(U + (size_t)rows[i0 + i] * NABC + col);
#pragma unroll
            for (int i = 0; i < NB8; ++i) { float zz[8]; unpack8(raw[i], zz);
                if (i0 + i == 0) {
#pragma unroll
                    for (int j = 0; j < 8; ++j) { z0[j] = zz[j]; sum[j] = zz[j]; } }
                else { const float m = (i0 + i) < cnt ? 1.0f : 0.0f;
#pragma unroll
                    for (int j = 0; j < 8; ++j) sum[j] += m * zz[j]; } }
        }
#pragma unroll
        for (int j = 0; j < 8; ++j) sum[j] = sum[j] * inv - z0[j];
        const u32x4 pk = pack8(sum); af[ks] = __builtin_bit_cast(bf16x8, pk);
    }
    const bf16_t* bw = pwt + (size_t)g * 128 * 128;
#pragma unroll 2
    for (int ctile = 0; ctile < 8; ++ctile) {
        f32x4 acc = (f32x4){0.f, 0.f, 0.f, 0.f};
#pragma unroll
        for (int ks = 0; ks < 4; ++ks) acc = __builtin_amdgcn_mfma_f32_16x16x32_bf16(*(const bf16x8*)(bw + (size_t)(16 * ctile + fr) * 128 + 32 * ks + 8 * fq), af[ks], acc, 0, 0, 0);
        const int c = g * 128 + 16 * ctile + 4 * fq; const f32x4 sc = *(const f32x4*)(csc + c);
        u32x2 o; o.x = cvt_pk_bf16(acc[0] * sc[0], acc[1] * sc[1]); o.y = cvt_pk_bf16(acc[2] * sc[2], acc[3] * sc[3]);
        *(u32x2*)(Y + (size_t)row * NY + 2 * AW + c) = o;
    }
}
constexpr int PB_CW = 0, PB_CT = 31 * 512 * 4, PB_NUNIT = NREAL / 32 + 1;
#ifndef PB_REP
#define PB_REP 0
#endif
__device__ __forceinline__ void pb_unit(int u, int& b, int& p0, int& ntok) { const bool meta = (u == PB_NUNIT - 1); b = meta ? 0 : (u >> 8); p0 = meta ? 0 : NMETA + 32 * (u & 255); ntok = meta ? NMETA : 32; }
template <bool DRY> __device__ __forceinline__ void postbc_a(Frame& F, int l) {
    PHASE_ENTER(F);
    const bf16_t* U = F.R1; const float* BS = (const float*)(F.ws + WS_BS); bf16_t* Y = F.R3;
    const int lane = F.lane, wave = F.wave, c8 = 8 * lane;
    float lxw[8], lxb[8];
#pragma unroll
    for (int j = 0; j < 8; ++j) { lxw[j] = in_ptr(F, I_LNXW)[l * AW + c8 + j]; lxb[j] = in_ptr(F, I_LNXB)[l * AW + c8 + j]; }
    for (int u = F.bid; u < PB_NUNIT; u += F.G) {
        int b, p0, ntok; pb_unit(u, b, p0, ntok);
        for (int tt = wave; tt < ntok; tt += 8) {
            const int p = p0 + tt, row = row_of(b, p);
            float y[8], zv[8], gv[8];
            unpack8(*(const u32x4*)(Y + (size_t)row * NY + c8), y); unpack8(*(const u32x4*)(Y + (size_t)row * NY + AW + c8), gv);
            unpack8(*(const u32x4*)(U + (size_t)row * NABC + 1024 + c8), zv);
            const float bs = BS[(size_t)row * 8 + (lane >> 3)];
            float s = 0.f;
#pragma unroll
            for (int j = 0; j < 8; ++j) s += y[j];
            s = allreduce8(s);
            const float mean = s * (1.0f / 64.0f); float qv = 0.f;
#pragma unroll
            for (int j = 0; j < 8; ++j) { y[j] -= mean; qv += y[j] * y[j]; }
            qv = allreduce8(qv);
            const float rstd = __builtin_amdgcn_rsqf(qv * (1.0f / 64.0f) + LNX_EPS);
            float o[8];
#pragma unroll
            for (int j = 0; j < 8; ++j) o[j] = (y[j] * rstd * lxw[j] + lxb[j] + bs * zv[j]) * gv[j];
            if (DRY) *(u32x4*)((bf16_t*)(F.ws + 962 * MiB) + (size_t)(row & 32767) * AW + c8) = pack8(o); else *(u32x4*)(Y + (size_t)row * NY + c8) = pack8(o);
        }
    }
}
__device__ __forceinline__ void postbc_b(Frame& F, int l) {
    PHASE_ENTER(F);
    const bf16_t* U = F.R1; bf16_t* Y = F.R3;
    LAS float* cw = (LAS float*)(F.lds + PB_CW); LAS bf16_t* ct = (LAS bf16_t*)(F.lds + PB_CT);
    const int lane = F.lane, wave = F.wave, c8 = 8 * lane;
    __syncthreads();
    for (int i = F.tid; i < 31 * 512; i += 512) cw[i] = in_ptr(F, I_CONVW)[(size_t)l * 31 * 512 + i];
    float cvb[8], lng[8], lnb[8];
#pragma unroll
    for (int j = 0; j < 8; ++j) { cvb[j] = in_ptr(F, I_CONVB)[l * AW + c8 + j]; lng[j] = in_ptr(F, I_BLNG)[l * AW + c8 + j]; lnb[j] = in_ptr(F, I_BLNB)[l * AW + c8 + j]; }
    for (int u = F.bid; u < PB_NUNIT; u += F.G) {
        int b, p0, ntok; pb_unit(u, b, p0, ntok);
        __syncthreads();
        {
            u32x4 r1[8], r2[8];
#pragma unroll
            for (int it = 0; it < 8; ++it) { const int idx = F.tid + it * 512, i = idx >> 6, oc = idx & 63, p = p0 - 30 + i; const int row = row_of(b, p > 0 ? p : 0);
                r1[it] = *(const u32x4*)(U + (size_t)row * NABC + AIN + 8 * oc); r2[it] = *(const u32x4*)(U + (size_t)row * NABC + AIN + 512 + 8 * oc); }
#pragma unroll
            for (int it = 0; it < 8; ++it) { const int idx = F.tid + it * 512, i = idx >> 6, oc = idx & 63, p = p0 - 30 + i;
                if (i < 30 + ntok) { float z1[8], z2[8]; unpack8(r1[it], z1); unpack8(r2[it], z2); const float m = p >= 0 ? 1.0f : 0.0f;
#pragma unroll
                    for (int j = 0; j < 8; ++j) z1[j] *= m * fast_sigmoid(z2[j]);
                    *(LAS u32x4*)(ct + i * 512 + 8 * oc) = pack8(z1); } }
        }
        __syncthreads();
        const int TPW = ntok / 8, t0w = wave * TPW;
        {
            float acc[4][8];
#pragma unroll
            for (int i = 0; i < 4; ++i)
#pragma unroll
                for (int j = 0; j < 8; ++j) acc[i][j] = cvb[j];
            float win[4][8];
#pragma unroll
            for (int i = 0; i < 3; ++i) unpack8(*(const LAS u32x4*)(ct + (t0w + i) * 512 + c8), win[i + 1]);
#pragma unroll 2
            for (int jt = 0; jt < 31; ++jt) {
#pragma unroll
                for (int i = 0; i < 3; ++i)
#pragma unroll
                    for (int j = 0; j < 8; ++j) win[i][j] = win[i + 1][j];
                unpack8(*(const LAS u32x4*)(ct + (t0w + jt + 3) * 512 + c8), win[3]);
                const f32x4 w0 = *(const LAS f32x4*)(cw + jt * 512 + c8), w1 = *(const LAS f32x4*)(cw + jt * 512 + c8 + 4);
#pragma unroll
                for (int i = 0; i < 4; ++i)
#pragma unroll
                    for (int j = 0; j < 4; ++j) { acc[i][j] += win[i][j] * w0[j]; acc[i][4 + j] += win[i][4 + j] * w1[j]; }
            }
#pragma unroll
            for (int i = 0; i < 4; ++i) {
                if (i < TPW) {
                    const int row = row_of(b, p0 + t0w + i);
                    float s = 0.f;
#pragma unroll
                    for (int j = 0; j < 8; ++j) s += acc[i][j];
                    const float mean = wave_sum(s) * (1.0f / 512.0f); float qv = 0.f;
#pragma unroll
                    for (int j = 0; j < 8; ++j) { acc[i][j] -= mean; qv += acc[i][j] * acc[i][j]; }
                    const float rstd = __builtin_amdgcn_rsqf(wave_sum(qv) * (1.0f / 512.0f) + LN_EPS);
                    float o[8];
#pragma unroll
                    for (int j = 0; j < 8; ++j) { const float x = acc[i][j] * rstd * lng[j] + lnb[j]; o[j] = x * fast_sigmoid(x); }
                    *(u32x4*)(Y + (size_t)row * NY + AW + c8) = pack8(o);
                }
            }
        }
    }
    __syncthreads();
}
__device__ __forceinline__ void postbc_c(Frame& F, int l) {
    PHASE_ENTER(F);
    const bf16_t* U = F.R1; bf16_t* Y = F.R3; const bf16_t* pwt = F.W + (size_t)l * WL_SIZE + WL_PW; const float* csc = in_ptr(F, I_CSCALE) + l * AW;
    const int lane = F.lane, rg = F.wave & 1, g = F.wave >> 1, fr = lane & 15, fq = lane >> 4;
    LAS unsigned char* tile = F.lds;
    for (int u = F.bid; u < PB_NUNIT; u += F.G) {
        int b, p0, ntok; pb_unit(u, b, p0, ntok);
        __syncthreads();
        {
            u32x4 rr[6];
#pragma unroll
            for (int it = 0; it < 6; ++it) { const int idx = F.tid + it * 512, i = idx >> 6, oc = idx & 63, p = p0 - 15 + i; const int row = row_of(b, p > 0 ? (p < NMETA + SEQ ? p : 0) : 0);
                rr[it] = *(const GAS u32x4*)(U + (size_t)row * NABC + AIN + 1024 + 8 * oc); }
#pragma unroll
            for (int it = 0; it < 6; ++it) { const int idx = F.tid + it * 512, i = idx >> 6, oc = idx & 63, p = p0 - 15 + i;
                if (i < 15 + ntok) *(LAS u32x4*)(tile + (i * 512 + 8 * oc) * 2) = p >= 0 ? rr[it] : (u32x4){0u, 0u, 0u, 0u}; }
        }
        __syncthreads();
        if (rg * 16 < ntok) {
            const int win = 2 << g, t = rg * 16 + fr, p = p0 + t, cnt = (p + 1) < win ? (p + 1) : win; const float inv = 1.0f / (float)cnt;
            const bf16_t* bwp = pwt + (size_t)g * 128 * 128 + (size_t)fr * 128 + 8 * fq;
            bf16x8 bfr[4][4];
#pragma unroll
            for (int ctile = 0; ctile < 4; ++ctile)
#pragma unroll
                for (int ks = 0; ks < 4; ++ks) bfr[ctile][ks] = *(const GAS bf16x8*)(bwp + (size_t)(16 * ctile) * 128 + 32 * ks);
            bf16x8 af[4];
#pragma unroll
            for (int ks = 0; ks < 4; ++ks) {
                const LAS unsigned char* cp = tile + ((15 + t) * 512 + g * 128 + 32 * ks + 8 * fq) * 2;
                float z0[8], sum[8]; unpack8(*(const LAS u32x4*)cp, z0);
#pragma unroll
                for (int j = 0; j < 8; ++j) sum[j] = z0[j];
#pragma unroll 1
                for (int i = 1; i < win; ++i) { float zz[8]; unpack8(*(const LAS u32x4*)(cp - i * 1024), zz);
#pragma unroll
                    for (int j = 0; j < 8; ++j) sum[j] += zz[j]; }
#pragma unroll
                for (int j = 0; j < 8; ++j) sum[j] = sum[j] * inv - z0[j];
                const u32x4 pk = pack8(sum); af[ks] = __builtin_bit_cast(bf16x8, pk);
            }
            const int row = row_of(b, p);
#pragma unroll
            for (int half = 0; half < 2; ++half) {
                if (half == 1) {
#pragma unroll
                    for (int ctile = 0; ctile < 4; ++ctile)
#pragma unroll
                        for (int ks = 0; ks < 4; ++ks) bfr[ctile][ks] = *(const GAS bf16x8*)(bwp + (size_t)(16 * (4 + ctile)) * 128 + 32 * ks);
                }
#pragma unroll
                for (int ct4 = 0; ct4 < 4; ++ct4) {
                    const int ctile = 4 * half + ct4;
                    f32x4 acc = (f32x4){0.f, 0.f, 0.f, 0.f};
#pragma unroll
                    for (int ks = 0; ks < 4; ++ks) acc = __builtin_amdgcn_mfma_f32_16x16x32_bf16(bfr[ct4][ks], af[ks], acc, 0, 0, 0);
                    const int c = g * 128 + 16 * ctile + 4 * fq; const f32x4 sc = *(const GAS f32x4*)(csc + c);
                    u32x2 o; o.x = cvt_pk_bf16(acc[0] * sc[0], acc[1] * sc[1]); o.y = cvt_pk_bf16(acc[2] * sc[2], acc[3] * sc[3]);
                    *(u32x2*)(Y + (size_t)row * NY + 2 * AW + c) = o;
                }
            }
        }
    }
    __syncthreads();
}
__device__ __forceinline__ void phase_postbc(Frame& F, int l) {
    if (PB_REP & 4) postbc_a<true>(F, l); postbc_a<false>(F, l); postbc_b(F, l); if (PB_REP & 1) postbc_b(F, l); postbc_c(F, l); if (PB_REP & 2) postbc_c(F, l);
}

__device__ __forceinline__ void phase_prep2(Frame& F, int l) {
    PHASE_ENTER(F);
    using namespace p2; using ck::frag; using ck::frag16; using ck::frag_tr; using ck::mma;
    bf16_t* U = F.R1; bf16_t* WAw = F.R2; bf16_t* WAa = F.R2 + (size_t)NROWS * AW;
    const bf16_t* HALO = (const bf16_t*)(F.ws + WS_HALO); float* GC = (float*)(F.ws + WS_GC); float* BS = (float*)(F.ws + WS_BS);
    const float* mu = in_ptr(F, I_MU) + l * AIN; const float* kkp = in_ptr(F, I_KK) + l * AW; const float* kap = in_ptr(F, I_KA) + l * AW; const float* rkp = in_ptr(F, I_RK) + l * AW;
    const int lane = F.lane, o = lane & 7, ti = lane >> 3;
    if (F.wave < NW) {
    LAS unsigned char* pb = F.lds + F.wave * SZ; LAS float* cwb = (LAS float*)(pb + X_AAB);
    for (int un = F.bid * NW + F.wave; un < P2_UNITS; un += F.G * NW) {
        const int h = un & 7, rest = un >> 3; const int b = rest == 0 ? 0 : (rest - 1) >> 8, c = rest == 0 ? 0 : ((rest - 1) & 255) + 1;
        const int ch = h * 64 + 8 * o, p0 = c == 0 ? 0 : NMETA + 32 * (c - 1), nreal = c == 0 ? NMETA : 32;
        const bool real = 4 * ti < nreal; const int row0 = row_of(b, p0 + (real ? 4 * ti : 0));
        u32x4 zr[5], zk[5], zv[5], ww[4], aa[4];
        { const bf16_t* prow = (real ? ti : 0) == 0 ? HALO + (size_t)(b * 256 + (c > 0 ? c - 1 : 0)) * 1536 : U + (size_t)(row0 - 1) * NABC;
          zr[0] = *(const GAS u32x4*)(prow + ch); zk[0] = *(const GAS u32x4*)(prow + 512 + ch); zv[0] = *(const GAS u32x4*)(prow + 1024 + ch); }
        { const bf16_t* ur = U + (size_t)row0 * NABC + ch; const bf16_t* wr = WAw + (size_t)row0 * AW + ch; const bf16_t* ar = WAa + (size_t)row0 * AW + ch;
#pragma unroll
          for (int p = 0; p < 4; ++p) { zr[p + 1] = *(const GAS u32x4*)(ur + p * NABC); zk[p + 1] = *(const GAS u32x4*)(ur + p * NABC + 512); zv[p + 1] = *(const GAS u32x4*)(ur + p * NABC + 1024);
              ww[p] = *(const GAS u32x4*)(wr + p * AW); aa[p] = *(const GAS u32x4*)(ar + p * AW); } }
        { const float msk = real ? 1.0f : 0.0f;
#pragma unroll
          for (int p = 0; p < 4; ++p) { float w8[8]; unpack8(ww[p], w8); LAS float* cw = cwb + (4 * ti + p) * 64 + 8 * o;
            *(LAS f32x4*)cw = (f32x4){msk * w8[0], msk * w8[1], msk * w8[2], msk * w8[3]}; *(LAS f32x4*)(cw + 4) = (f32x4){msk * w8[4], msk * w8[5], msk * w8[6], msk * w8[7]}; } }
        LDS_WAIT();
        { LAS float* cw = cwb + lane; float cv_[32];
#pragma unroll
          for (int i = 0; i < 32; ++i) cv_[i] = cw[i * 64];
          asm volatile("" ::: "memory");
#pragma unroll
          for (int i = 1; i < 32; ++i) cv_[i] += cv_[i - 1];
#pragma unroll
          for (int i = 0; i < 32; ++i) cw[i * 64] = cv_[i]; }
        LDS_WAIT();
        float cx[8];
        { const LAS float* cwp = cwb + (ti > 0 ? 4 * ti - 1 : 0) * 64 + 8 * o; const f32x4 x0 = *(const LAS f32x4*)cwp, x1 = *(const LAS f32x4*)(cwp + 4);
#pragma unroll
          for (int j = 0; j < 8; ++j) cx[j] = ti > 0 ? (j < 4 ? x0[j] : x1[j - 4]) : 0.f; }
        {
        LD8G(mur, mu + ch) LD8G(muk, mu + 512 + ch) LD8G(muv, mu + 1024 + ch) LD8G(kkc, kkp + ch) LD8G(kac, kap + ch) LD8G(rkc, rkp + ch)
        int row0s = row0; asm volatile("" : "+v"(row0s));
        bf16_t* ud = U + (size_t)row0s * NABC + ch; bf16_t* wd = WAw + (size_t)row0s * AW + ch; bf16_t* ad = WAa + (size_t)row0s * AW + ch;
        const float msk = real ? 1.0f : 0.0f;
#pragma unroll
        for (int p = 0; p < 4; ++p) {
            const float pm = (c == 0 && ti == 0 && p == 0) ? 0.0f : 1.0f; const int t = 4 * ti + p;
            float r8[8], rp8[8], k8[8], kp8[8], a8[8], v8[8], vp8[8];
            unpack8(zr[p + 1], r8); unpack8(zr[p], rp8); unpack8(zk[p + 1], k8); unpack8(zk[p], kp8); unpack8(aa[p], a8); unpack8(zv[p + 1], v8); unpack8(zv[p], vp8);
            float A[8], B[8], K[8], R[8], V[8], kx[8], kk[8], ss = 0.f, bsum = 0.f;
#pragma unroll
            for (int j = 0; j < 8; ++j) { R[j] = msk * (r8[j] + (pm * rp8[j] - r8[j]) * mur[j]); kx[j] = k8[j] + (pm * kp8[j] - k8[j]) * muk[j]; kk[j] = kx[j] * kkc[j]; ss += kk[j] * kk[j]; V[j] = msk * (v8[j] + (pm * vp8[j] - v8[j]) * muv[j]); }
            ss = allreduce8(ss);
            const float inv = msk / fmaxf(sqrtf(ss), 1e-12f);
#pragma unroll
            for (int j = 0; j < 8; ++j) { const float kn = kk[j] * inv; A[j] = -kn; B[j] = kn * a8[j]; K[j] = msk * kx[j] * (1.0f + (a8[j] - 1.0f) * kac[j]); bsum += R[j] * K[j] * rkc[j]; }
            bsum = allreduce8(bsum);
            const LAS float* cw = cwb + t * 64 + 8 * o; const f32x4 c0 = *(const LAS f32x4*)cw, c1 = *(const LAS f32x4*)(cw + 4);
            float at[8], rt[8], bt[8], kt[8], en[8];
#pragma unroll
            for (int j = 0; j < 8; ++j) { const float ci = j < 4 ? c0[j] : c1[j - 4]; const float ep = __expf(ci); en[j] = __builtin_amdgcn_rcpf(ep);
                at[j] = A[j] * __expf(-cx[j]); rt[j] = R[j] * en[j]; bt[j] = B[j] * ep; kt[j] = K[j] * ep; cx[j] = ci; }
            const u32x4 pa = pack8(at), pr = pack8(rt), pbv = pack8(bt), pk = pack8(kt), pv = pack8(V);
            *(LAS u32x4*)(pb + X_AT + (t * 64 + 8 * o) * 2) = pa; *(LAS u32x4*)(pb + X_RT + (t * 64 + 8 * o) * 2) = pr; *(LAS u32x4*)(pb + X_BT + (t * 64 + 8 * o) * 2) = pbv;
            *(LAS u32x4*)(pb + X_KT + (t * 64 + 8 * o) * 2) = pk; *(LAS u32x4*)(pb + X_VT + (t * 64 + 8 * o) * 2) = pv;
            if (real) {
                *(u32x4*)(wd + p * AW) = pa; *(u32x4*)(ad + p * AW) = pbv; *(u32x4*)(ud + p * NABC) = pr; *(u32x4*)(ud + p * NABC + 512) = pk; *(u32x4*)(ud + p * NABC + 1024) = pv;
                if (o == 0) BS[(size_t)(row0s + p) * 8 + h] = bsum;
            }
            if (p == 3 && ti == 7) { float* gv = GC + ((size_t)(b * 8 + h) * 257 + c) * 64 + 8 * o; *(f32x4*)gv = (f32x4){en[0], en[1], en[2], en[3]}; *(f32x4*)(gv + 4) = (f32x4){en[4], en[5], en[6], en[7]}; }
        }
        }
        LDS_WAIT();
        int ln; asm volatile("v_mbcnt_lo_u32_b32 %0, -1, 0\n\tv_mbcnt_hi_u32_b32 %0, -1, %0" : "=v"(ln)); const int fr = ln & 15, fq = ln >> 4;
        unsigned char* gx0 = (unsigned char*)lds_ptr(F.lds, 36) + (size_t)un * G_SZ; asm volatile("" : "+s"(gx0)); GAS unsigned char* gx = (GAS unsigned char*)gx0;
#pragma unroll
        for (int it = 0; it < 2; ++it)
#pragma unroll
            for (int jt = 0; jt < 2; ++jt) {
                f32x4 ab = {0.f, 0.f, 0.f, 0.f}, ak = ab, rb = ab, rk = ab;
                if (jt <= it) {
#pragma unroll
                    for (int s = 0; s < 2; ++s) { const bf16x8 fb = frag(pb + X_BT, 64, 16 * jt, 32 * s, ln), fk = frag(pb + X_KT, 64, 16 * jt, 32 * s, ln), fa = frag(pb + X_AT, 64, 16 * it, 32 * s, ln), frr = frag(pb + X_RT, 64, 16 * it, 32 * s, ln);
                        ab = mma(fb, fa, ab); ak = mma(fk, fa, ak); rb = mma(fb, frr, rb); rk = mma(fk, frr, rk); }
                }
                const int i = 16 * it + fr, j0 = 16 * jt + 4 * fq;
#pragma unroll
                for (int jj = 0; jj < 4; ++jj) { const bool st = (j0 + jj) < i, inc = (j0 + jj) <= i; ab[jj] = st ? ab[jj] : 0.f; ak[jj] = st ? ak[jj] : 0.f; rb[jj] = inc ? rb[jj] : 0.f; rk[jj] = inc ? rk[jj] : 0.f; }
                asm volatile("" : "+v"(ab), "+v"(ak), "+v"(rb), "+v"(rk));
                *(LAS f32x4*)(pb + X_AAB + (i * 32 + j0) * 4) = ab;
                *(LAS u32x2*)(pb + X_AAK + (i * 32 + j0) * 2) = (u32x2){cvt_pk_bf16(ak[0], ak[1]), cvt_pk_bf16(ak[2], ak[3])};
                *(LAS u32x2*)(pb + X_MRK + (i * 32 + j0) * 2) = (u32x2){cvt_pk_bf16(rk[0], rk[1]), cvt_pk_bf16(rk[2], rk[3])};
                *(u32x2*)(gx + G_MRB + (i * 32 + j0) * 2) = (u32x2){cvt_pk_bf16(rb[0], rb[1]), cvt_pk_bf16(rb[2], rb[3])};
            }
        LDS_WAIT();
        {
            const int blk = (ln >> 4) & 1, jc = ln & 15; float t[16];
            const LAS float* arow = (const LAS float*)(pb + X_AAB) + (16 * blk) * 32 + 16 * blk;
#pragma unroll
            for (int i = 0; i < 16; ++i) { float acc = (i == jc) ? 1.0f : 0.f;
#pragma unroll
                for (int m4 = 0; m4 < 4; ++m4) { if (4 * m4 < i) { const f32x4 a4 = *(const LAS f32x4*)(arow + i * 32 + 4 * m4);
#pragma unroll
                    for (int mm = 0; mm < 4; ++mm) if (4 * m4 + mm < i) acc += a4[mm] * t[4 * m4 + mm]; } }
                t[i] = acc; if ((i & 3) == 3) asm volatile("" ::: "memory"); }
            { const int ar = ln >> 2, ac = 4 * (ln & 3); const f32x4 a4 = *(const LAS f32x4*)(pb + X_AAB + ((16 + ar) * 32 + ac) * 4);
              asm volatile("" ::: "memory");
              *(LAS u32x2*)(pb + X_A21 + (ar * 16 + ac) * 2) = (u32x2){cvt_pk_bf16(a4[0], a4[1]), cvt_pk_bf16(a4[2], a4[3])}; }
            if (ln < 32) {
#pragma unroll
                for (int i = 0; i < 16; ++i) *(LAS unsigned short*)(pb + X_TT + ((16 * blk + i) * 32 + 16 * blk + jc) * 2) = f2bf(t[i]);
                if (blk == 0) {
#pragma unroll
                    for (int i = 0; i < 16; ++i) *(LAS unsigned short*)(pb + X_TT + (i * 32 + 16 + jc) * 2) = 0;
                    u32x4 lo, hi; lo.x = cvt_pk_bf16(t[0], t[1]); lo.y = cvt_pk_bf16(t[2], t[3]); lo.z = cvt_pk_bf16(t[4], t[5]); lo.w = cvt_pk_bf16(t[6], t[7]);
                    hi.x = cvt_pk_bf16(t[8], t[9]); hi.y = cvt_pk_bf16(t[10], t[11]); hi.z = cvt_pk_bf16(t[12], t[13]); hi.w = cvt_pk_bf16(t[14], t[15]);
                    *(LAS u32x4*)(pb + X_TC11 + jc * 32) = lo; *(LAS u32x4*)(pb + X_TC11 + jc * 32 + 16) = hi;
                }
            }
            LDS_WAIT();
            { f32x4 z = {0.f, 0.f, 0.f, 0.f}; z = mma(frag16(pb + X_A21, 16, 0, ln), frag16(pb + X_TC11, 16, 0, ln), z);
              *(LAS u32x2*)(pb + X_Z1T + (fr * 16 + 4 * fq) * 2) = (u32x2){cvt_pk_bf16(z[0], z[1]), cvt_pk_bf16(z[2], z[3])}; }
            LDS_WAIT();
            { f32x4 d = {0.f, 0.f, 0.f, 0.f}; const bf16x8 zz = {0, 0, 0, 0, 0, 0, 0, 0};
              bf16x8 t22 = *(const LAS bf16x8*)(pb + X_TT + ((16 + fr) * 32 + 16 + 8 * (fq & 1)) * 2); t22 = fq < 2 ? t22 : zz;
              d = mma(frag16(pb + X_Z1T, 16, 0, ln), t22, d);
              *(LAS u32x2*)(pb + X_TT + ((16 + fr) * 32 + 4 * fq) * 2) = (u32x2){cvt_pk_bf16(d[0], d[1]), cvt_pk_bf16(d[2], d[3])}; }
            LDS_WAIT();
            { const u32x4 t0 = *(const LAS u32x4*)(pb + X_TT + ln * 32), t1 = *(const LAS u32x4*)(pb + X_TT + ln * 32 + 16); *(u32x4*)(gx + G_TT + ln * 32) = t0; *(u32x4*)(gx + G_TT + ln * 32 + 16) = t1; }
        }
#pragma unroll 1
        for (int vq = 0; vq < 4; ++vq) {
            const bf16x8 fvt = frag_tr(pb + X_VT, 128, 0, 16 * vq, ln);
#pragma unroll
            for (int tt2 = 0; tt2 < 2; ++tt2) {
                f32x4 x = {0.f, 0.f, 0.f, 0.f}, f = x;
                x = mma(frag(pb + X_AAK, 32, 16 * tt2, 0, ln), fvt, x);
                f = mma(fvt, frag(pb + X_MRK, 32, 16 * tt2, 0, ln), f);
                *(u32x2*)(gx + G_XA + ((vq * 2 + tt2) * 64 + ln) * 8) = (u32x2){cvt_pk_bf16(x[0], x[1]), cvt_pk_bf16(x[2], x[3])};
                *(u32x2*)(gx + G_FA + ((vq * 2 + tt2) * 64 + ln) * 8) = (u32x2){cvt_pk_bf16(f[0], f[1]), cvt_pk_bf16(f[2], f[3])};
            }
        }
        LDS_WAIT();
    }
    }
}

__device__ __forceinline__ void phase_router(Frame& F) {
    PHASE_ENTER(F);
    LAS int* hist = (LAS int*)(F.lds + 32768);
    const float* ss = F.SS + 3 * SS_STRIDE;
    u32x4* tokinfo = (u32x4*)(F.ws + RT_TOKINFO); int* slot_tok = (int*)(F.ws + RT_SLOTTOK); int* cnt = (int*)(F.ws + RT_CNT);
    const int lane = F.lane;
    f32x4 wr[16][2];
    { const float* RW = in_ptr(F, I_RW) + (size_t)(16 * lane) * NEXP; const float* fgp = in_ptr(F, I_FFNG) + DM + 16 * lane;
#pragma unroll
      for (int k = 0; k < 16; ++k) { const float gk = fgp[k]; wr[k][0] = *(const f32x4*)(RW + NEXP * k) * gk; wr[k][1] = *(const f32x4*)(RW + NEXP * k + 4) * gk; } }
    for (int blk = F.bid; blk < NREAL / 256; blk += F.G) {
        __syncthreads();
        if (F.tid < NEXP) hist[F.tid] = 0;
        for (int i = F.tid; i < MAXBLK; i += 512) { slot_tok[blk * MAXBLK + i] = -1; ((float*)(F.ws + RT_SLOTRS))[blk * MAXBLK + i] = 0.f; }
        __syncthreads();
        for (int t = F.wave; t < 256; t += 16) {
            const int tok0 = blk * 256 + t, tok1 = tok0 + 8;
            u32x4 raw[2][2];
            raw[0][0] = *(const u32x4*)(F.HB + (size_t)tok0 * DM + 16 * lane); raw[0][1] = *(const u32x4*)(F.HB + (size_t)tok0 * DM + 16 * lane + 8);
            raw[1][0] = *(const u32x4*)(F.HB + (size_t)tok1 * DM + 16 * lane); raw[1][1] = *(const u32x4*)(F.HB + (size_t)tok1 * DM + 16 * lane + 8);
            const float rs2[2] = {rstd_of(ss, tok0), rstd_of(ss, tok1)};
#pragma unroll
            for (int q = 0; q < 2; ++q) {
                const int tok = q == 0 ? tok0 : tok1;
                float hv[16]; unpack8(raw[q][0], *(float(*)[8])&hv[0]); unpack8(raw[q][1], *(float(*)[8])&hv[8]);
                float lg[8];
#pragma unroll
                for (int e = 0; e < 8; ++e) lg[e] = 0.f;
#pragma unroll
                for (int k = 0; k < 16; ++k) {
#pragma unroll
                    for (int e = 0; e < 4; ++e) { lg[e] += hv[k] * wr[k][0][e]; lg[4 + e] += hv[k] * wr[k][1][e]; } }
                const float rs = rs2[q];
#pragma unroll
                for (int e = 0; e < 8; ++e) lg[e] = wave_sum(lg[e]) * rs + in_ptr(F, I_RB)[e];
                int e1 = 0; float l1 = lg[0];
#pragma unroll
                for (int e = 1; e < 8; ++e) if (lg[e] > l1) { l1 = lg[e]; e1 = e; }
                int e2 = -1; float l2 = -3.0e38f;
#pragma unroll
                for (int e = 0; e < 8; ++e) if (e != e1 && lg[e] > l2) { l2 = lg[e]; e2 = e; }
                const float g2 = 1.0f / (1.0f + __expf(l1 - l2)), g1 = 1.0f - g2;
                if (lane == 0) { tokinfo[tok] = (u32x4){(unsigned)(e1 | (e2 << 8)), __float_as_uint(g1), __float_as_uint(g2), 0u}; __hip_atomic_fetch_add(&hist[e1], 1, __ATOMIC_RELAXED, __HIP_MEMORY_SCOPE_WORKGROUP); __hip_atomic_fetch_add(&hist[e2], 1, __ATOMIC_RELAXED, __HIP_MEMORY_SCOPE_WORKGROUP); }
            }
        }
        __syncthreads();
        if (F.tid < NEXP) cnt[blk * NEXP + F.tid] = hist[F.tid];
    }
    __syncthreads();
}
__device__ __forceinline__ void phase_assign(Frame& F) {
    PHASE_ENTER(F);
    LAS int* L = (LAS int*)F.lds;
    const u32x4* tokinfo = (const u32x4*)(F.ws + RT_TOKINFO); int* slot_tok = (int*)(F.ws + RT_SLOTTOK); const int* cnt = (const int*)(F.ws + RT_CNT);
    int* block_e = (int*)(F.ws + RT_CNT + 16384); int* nblkp = (int*)(F.ws + RT_CNT + 32768); int* tokslot = (int*)(F.ws + RT_TOKSLOT);
    for (int blk = F.bid; blk < NREAL / 256; blk += F.G) {
        __syncthreads();
        if (F.tid < 256) {
            const u32x4 c0 = *(const u32x4*)(cnt + F.tid * NEXP), c1 = *(const u32x4*)(cnt + F.tid * NEXP + 4); const unsigned cc[8] = {c0.x, c0.y, c0.z, c0.w, c1.x, c1.y, c1.z, c1.w};
            const float inf = F.tid < blk ? 1.0f : 0.0f;
#pragma unroll
            for (int e = 0; e < NEXP; ++e) { const float tt = wave_sum((float)cc[e]), pp = wave_sum(inf * (float)cc[e]); if (F.lane == 0) { L[64 + F.wave * 16 + e] = (int)tt; L[64 + F.wave * 16 + 8 + e] = (int)pp; } }
        }
        __syncthreads();
        if (F.tid < NEXP) { int tot = 0, pre = 0;
#pragma unroll
            for (int w = 0; w < 4; ++w) { tot += L[64 + w * 16 + F.tid]; pre += L[64 + w * 16 + 8 + F.tid]; } L[F.tid] = tot; L[8 + F.tid] = pre; }
        __syncthreads();
        if (F.tid == 0) { int start = 0; for (int e = 0; e < NEXP; ++e) { L[16 + e] = start; start += (L[e] + 255) & ~255; L[24 + e] = start; }
            if (blk == 0) *nblkp = start >> 8; }
        __syncthreads();
        if (blk == 0) { const int nb_ = L[24 + NEXP - 1] >> 8;
            for (int j = F.tid; j < nb_; j += 512) { int e = 0; while (e < NEXP - 1 && L[24 + e] <= j * 256) ++e; block_e[j] = e; } }
        int e1 = 0, e2 = 0, r1 = 0, r2 = 0; const int w = F.wave, lane = F.lane;
        if (F.tid < 256) {
            const unsigned ee = tokinfo[blk * 256 + F.tid].x; e1 = ee & 0xff; e2 = (ee >> 8) & 0xff;
            const unsigned long long lt = (1ull << lane) - 1ull;
#pragma unroll
            for (int e = 0; e < NEXP; ++e) { const unsigned long long m1 = __ballot(e1 == e), m2 = __ballot(e2 == e);
                if (e1 == e) r1 = __popcll(m1 & lt); if (e2 == e) r2 = __popcll(m1) + __popcll(m2 & lt);
                if (lane == 0) L[32 + w * 8 + e] = __popcll(m1) + __popcll(m2); }
        }
        __syncthreads();
        if (F.tid < 256) {
            int o1 = L[16 + e1] + L[8 + e1], o2 = L[16 + e2] + L[8 + e2];
            for (int ww = 0; ww < w; ++ww) { o1 += L[32 + ww * 8 + e1]; o2 += L[32 + ww * 8 + e2]; }
            const int s1 = o1 + r1, s2 = o2 + r2, tok = blk * 256 + F.tid;
            slot_tok[s1] = tok; slot_tok[s2] = tok; tokslot[2 * tok] = s1; tokslot[2 * tok + 1] = s2;
            { const float rs = rstd_of(F.SS + 3 * SS_STRIDE, tok); float* srs = (float*)(F.ws + RT_SLOTRS); srs[s1] = rs; srs[s2] = rs; }
        }
    }
    __syncthreads();
}
__device__ __forceinline__ void phase_combine(Frame& F) {
    PHASE_ENTER(F);
    const u32x4* tokinfo = (const u32x4*)(F.ws + RT_TOKINFO); const int* tokslot = (const int*)(F.ws + RT_TOKSLOT);
    const int gw = F.bid * 8 + F.wave, NGW = F.G * 8, lane = F.lane;
    f32x4 gf[4];
#pragma unroll
    for (int j = 0; j < 4; ++j) gf[j] = *(const f32x4*)(in_ptr(F, I_FINALG) + 4 * lane + 256 * j);
    float* outp = (float*)lds_ptr(F.lds, 36);
    int tokA = gw, tokB = gw + NGW;
    u32x4 tiA = tokinfo[tokA < NREAL ? tokA : 0], tiB = tokinfo[tokB < NREAL ? tokB : 0];
    u32x2 slA = *(const u32x2*)(tokslot + 2 * (tokA < NREAL ? tokA : 0)), slB = *(const u32x2*)(tokslot + 2 * (tokB < NREAL ? tokB : 0));
    for (; tokA < NREAL; tokA += 2 * NGW, tokB += 2 * NGW) {
        const int nA = tokA + 2 * NGW, nB = tokB + 2 * NGW;
        const u32x4 tinA = tokinfo[nA < NREAL ? nA : 0], tinB = tokinfo[nB < NREAL ? nB : 0];
        const u32x2 slnA = *(const u32x2*)(tokslot + 2 * (nA < NREAL ? nA : 0)), slnB = *(const u32x2*)(tokslot + 2 * (nB < NREAL ? nB : 0));
        const bool hasB = tokB < NREAL; const int tB = hasB ? tokB : tokA;
        const u32x2* hpA = (const u32x2*)(F.HB + (size_t)tokA * DM) + lane; const u32x2* y1A = (const u32x2*)(F.YS + (size_t)slA.x * DM) + lane; const u32x2* y2A = (const u32x2*)(F.YS + (size_t)slA.y * DM) + lane;
        const u32x2* hpB = (const u32x2*)(F.HB + (size_t)tB * DM) + lane; const u32x2* y1B = (const u32x2*)(F.YS + (size_t)(hasB ? slB.x : slA.x) * DM) + lane; const u32x2* y2B = (const u32x2*)(F.YS + (size_t)(hasB ? slB.y : slA.y) * DM) + lane;
        u32x2 hA[4], aA[4], bA[4], hB[4], aB[4], bB[4];
#pragma unroll
        for (int j = 0; j < 4; ++j) { hA[j] = hpA[64 * j]; aA[j] = y1A[64 * j]; bA[j] = y2A[64 * j]; hB[j] = hpB[64 * j]; aB[j] = y1B[64 * j]; bB[j] = y2B[64 * j]; }
#define CMB_ONE(TOK, TI, H, A, B) do { const float g1 = __uint_as_float((TI).y), g2 = __uint_as_float((TI).z); f32x4 v[4]; float sq = 0.f; \
        _Pragma("unroll") for (int j = 0; j < 4; ++j) { \
            v[j][0] = bf_lo(H[j].x) + g1 * bf_lo(A[j].x) + g2 * bf_lo(B[j].x); v[j][1] = bf_hi(H[j].x) + g1 * bf_hi(A[j].x) + g2 * bf_hi(B[j].x); \
            v[j][2] = bf_lo(H[j].y) + g1 * bf_lo(A[j].y) + g2 * bf_lo(B[j].y); v[j][3] = bf_hi(H[j].y) + g1 * bf_hi(A[j].y) + g2 * bf_hi(B[j].y); \
            sq += (v[j][0] * v[j][0] + v[j][1] * v[j][1]) + (v[j][2] * v[j][2] + v[j][3] * v[j][3]); } \
        const float rs = __builtin_amdgcn_rsqf(wave_sum(sq) * (1.0f / DM) + RMS_EPS); \
        f32x4* op = (f32x4*)(outp + (size_t)(TOK) * DM) + lane; \
        _Pragma("unroll") for (int j = 0; j < 4; ++j) op[64 * j] = v[j] * rs * gf[j]; } while (0)
        CMB_ONE(tokA, tiA, hA, aA, bA);
        if (hasB) CMB_ONE(tokB, tiB, hB, aB, bB);
#undef CMB_ONE
        tiA = tinA; tiB = tinB; slA = slnA; slB = slnB;
    }
}

__device__ __forceinline__ SchedGrid grid_sched(Frame& F, int nN, int lda, int ldb) { return SchedGrid{NREAL / 256, nN, F.G, F.bid, (size_t)256 * lda * 2, (size_t)256 * ldb * 2}; }
__device__ __forceinline__ void phase_g1(Frame& F, int l) {
    PHASE_ENTER(F);
    const bf16_t* Wt = F.W + (size_t)l * WL_SIZE + WL_ABC; const float* ss = F.SS + (size_t)(2 * l) * SS_STRIDE; bf16_t* U = F.R1;
    meta_rstd_setup(F);
    for (int j = F.bid; j < NABC / 16; j += F.G) { const float v = meta_tile(F, F.HB + (size_t)MBASE * DM, DM, Wt, DM, DM, 16 * j);
        if (F.tid < 256) { const int row = MBASE + (F.tid >> 4); U[(size_t)row * NABC + 16 * j + (F.tid & 15)] = f2bf(v * META_RS(F, F.tid >> 4)); } }
    __syncthreads();
    pg8::gemm_phase<EpiScale, SchedGrid, false>(F.lds, F.wave, GemmD{F.HB, Wt, DM, DM, DM}, grid_sched(F, NABC / 256, DM, DM), EpiScale{U, NABC, ss});
}
__device__ __forceinline__ void phase_g2(Frame& F, int l) {
    PHASE_ENTER(F);
    const bf16_t* Wt = F.W + (size_t)l * WL_SIZE + WL_G; const float* ss = F.SS + (size_t)(2 * l) * SS_STRIDE; bf16_t* ZG = F.R1; const float* gb = in_ptr(F, I_GATEB) + l * NGATE;
    if (l == 0) { meta_rstd_setup(F); for (int j = F.bid; j < NGATE / 16; j += F.G) { const float v = meta_tile(F, F.HB + (size_t)MBASE * DM, DM, Wt, DM, DM, 16 * j);
        if (F.tid < 256) { const int row = MBASE + (F.tid >> 4), col = 16 * j + (F.tid & 15); ZG[(size_t)row * NGATE + col] = f2bf(fast_sigmoid(v * META_RS(F, F.tid >> 4) + gb[col])); } }
        __syncthreads(); }
    pg8::gemm_phase<EpiGate, SchedGrid, false>(F.lds, F.wave, GemmD{F.HB, Wt, DM, DM, DM}, grid_sched(F, NGATE / 256, DM, DM), EpiGate{ZG, NGATE, ss, gb});
}
__device__ __forceinline__ void phase_g3(Frame& F, int l) {
    PHASE_ENTER(F);
    const bf16_t* Pt = F.W + (size_t)l * WL_SIZE + WL_P; const bf16_t* ZG = F.R1; const bf16_t* Y = F.R3; bf16_t* MB = F.R2;
    if (l == 0) for (int j = F.bid; j < DM / 16; j += F.G) { float tot = 0.f;
        for (int br = 0; br < 3; ++br) { const float v = meta_tile(F, Y + (size_t)MBASE * NY + br * AW, NY, Pt + br * AW, NY, AW, 16 * j);
            if (F.tid < 256) tot += v * bf2f(ZG[(size_t)(MBASE + (F.tid >> 4)) * NGATE + br * DM + 16 * j + (F.tid & 15)]); }
        if (F.tid < 256) MB[(size_t)(MBASE + (F.tid >> 4)) * DM + 16 * j + (F.tid & 15)] = f2bf(tot); }
    pg8::gemm_phase<EpiMerge3, SchedGrid, false>(F.lds, F.wave, GemmD{Y, Pt, NY, NY, NY}, grid_sched(F, DM / 256, NY, NY), EpiMerge3{MB, ZG});
}
__device__ __forceinline__ void phase_resid(Frame& F, const bf16_t* Amat, int K, const bf16_t* Wt, float* ssn, bool do_meta) {
    PHASE_ENTER(F);
    if (do_meta) for (int j = F.bid; j < DM / 16; j += F.G) { const float v = meta_tile(F, Amat + (size_t)MBASE * K, K, Wt, K, K, 16 * j);
        if (F.tid < 256) { const int row = MBASE + (F.tid >> 4); bf16_t* hp = F.HB + (size_t)row * DM + 16 * j + (F.tid & 15); *hp = f2bf(bf2f(*hp) + v); } }
    pg8::gemm_phase<EpiResid, SchedGrid, false>(F.lds, F.wave, GemmD{Amat, Wt, K, K, K}, grid_sched(F, DM / 256, K, K), EpiResid{F.HB, ssn, (LAS float*)(F.lds + 139264)});
}
__device__ __forceinline__ void phase_g5(Frame& F) {
    PHASE_ENTER(F);
    const bf16_t* Wt = F.W + WF_GU; const float* ss = F.SS + SS_STRIDE; bf16_t* HID = F.R1;
    meta_rstd_setup(F);
    for (int j = F.bid; j < DFF / 16; j += F.G) { const int c0 = 16 * j, br = 256 * (c0 / 128) + (c0 % 128);
        const float vg = meta_tile(F, F.HB + (size_t)MBASE * DM, DM, Wt, DM, DM, br), vu = meta_tile(F, F.HB + (size_t)MBASE * DM, DM, Wt, DM, DM, br + 128);
        if (F.tid < 256) { const int row = MBASE + (F.tid >> 4); const float rs = META_RS(F, F.tid >> 4), g = vg * rs, u = vu * rs; HID[(size_t)row * DFF + c0 + (F.tid & 15)] = f2bf(g * fast_sigmoid(g) * u); } }
    __syncthreads();
    pg8::gemm_phase<EpiSwiglu, SchedGrid, false>(F.lds, F.wave, GemmD{F.HB, Wt, DM, DM, DM}, grid_sched(F, NGU / 256, DM, DM), EpiSwiglu{HID, ss, nullptr, 0});
}
__device__ __forceinline__ void moe_range(Frame& F, int pass, int& blk0, int& nb) {
    const int nblk = *(const int*)(F.ws + RT_CNT + 32768); blk0 = pass * PASS0; nb = nblk - blk0; if (nb > (pass == 0 ? PASS0 : MAXBLK - PASS0)) nb = (pass == 0 ? PASS0 : MAXBLK - PASS0); if (nb < 0) nb = 0;
}
__device__ __forceinline__ void phase_g5m(Frame& F, int pass) {
    int blk0, nb; moe_range(F, pass, blk0, nb);
    const int* block_e = (const int*)(F.ws + RT_CNT + 16384); const int* slot_tok = (const int*)(F.ws + RT_SLOTTOK);
    pg8::gemm_phase<EpiSwiglu, SchedMoe, true>(F.lds, F.wave, GemmD{F.HB, F.WE + WE_GU, DM, DM, DM},
        SchedMoe{blk0, nb, NGU / 256, F.G, F.bid, block_e, slot_tok, 0, (size_t)256 * DM * 2, (size_t)NGU * DM * 2}, EpiSwiglu{F.R1, (const float*)(F.ws + RT_SLOTRS), slot_tok, blk0 * 256});
}
__device__ __forceinline__ void phase_g6m(Frame& F, int pass) {
    int blk0, nb; moe_range(F, pass, blk0, nb);
    const int* block_e = (const int*)(F.ws + RT_CNT + 16384); const int* slot_tok = (const int*)(F.ws + RT_SLOTTOK);
    pg8::gemm_phase<EpiStore, SchedMoe, false>(F.lds, F.wave, GemmD{F.R1, F.WE + WE_D, DFF, DFF, DFF},
        SchedMoe{blk0, nb, DM / 256, F.G, F.bid, block_e, slot_tok, (size_t)256 * DFF * 2, (size_t)256 * DFF * 2, (size_t)DM * DFF * 2}, EpiStore{F.YS, DM});
}

#ifndef CK_MODE
#define CK_MODE 1
#endif
constexpr int N_PHASES = 24;
__global__ void __launch_bounds__(512, 2) fwd_kernel(Args args) {
    extern __shared__ __attribute__((aligned(16))) unsigned char lds[];
    Frame F;
    F.lds = (LAS unsigned char*)lds; F.tid = threadIdx.x; F.lane = F.tid & 63; F.wave = __builtin_amdgcn_readfirstlane(F.tid >> 6); F.G = gridDim.x; F.bid = blockIdx.x;
    volatile LAS unsigned* MISC = (volatile LAS unsigned*)(F.lds + LDSCTL_OFF);
    for (int u = F.tid; u < (LDS_BYTES - LDSCTL_OFF) / 4; u += 512) MISC[u] = 0u;
    __syncthreads();
    if (F.tid < 38) { const unsigned long long pv = F.tid < 36 ? (unsigned long long)args.in[F.tid] : (F.tid == 36 ? (unsigned long long)args.out : (unsigned long long)args.ws);
        *(LAS unsigned long long*)(F.lds + PTR_OFF + 8 * F.tid) = pv; }
    __syncthreads();
    frame_ptrs(F);
    const int lo = args.ph_lo, hi = args.ph_hi;
    XcdBarrier bar; bar.bar = (unsigned*)F.ws + CW_BAR + args.li * XCD_BAR_WORDS; bar.x = 0; bar.st = MISC + 8;
    if (hi - lo > 1) bar = xcd_barrier_post((unsigned*)F.ws + CW_BAR + args.li * XCD_BAR_WORDS, MISC + 8);
#ifdef ONLY_PH
#define PH(p) ((p) == ONLY_PH || ((p) - 9) == ONLY_PH)
#else
#define PH(p) (lo <= (p) && (p) < hi)
#endif
#ifndef REP_MASK
#define REP_MASK 0ull
#endif
#define REPS(p) ((REP_MASK >> (p)) & 1ull)
#define SEAM(p) do { if (PH(p) && PH((p) + 1)) { XcdBarrier b2_ = bar; asm volatile("" : "+s"(b2_.bar)); xcd_barrier(b2_, F.wave); } } while (0)
    if (PH(0)) { convert_common(F); x_to_hb(F); if (REPS(0)) { convert_common(F); x_to_hb(F); } } SEAM(0);
    for (int l = 0; l < 2; ++l) {
        const int pb = 1 + 9 * l;
        if (PH(pb + 0)) { phase_g1(F, l); if (REPS(pb + 0)) phase_g1(F, l); } SEAM(pb + 0);
        if (PH(pb + 1)) { phase_prep(F, l); { XcdBarrier b2_ = bar; asm volatile("" : "+s"(b2_.bar)); xcd_barrier(b2_, F.wave); } phase_prep2(F, l); } SEAM(pb + 1);
        if (PH(pb + 2)) { if (CK_MODE != 1) phase_scan(F, l); if (CK_MODE != 0) phase_scan_chunked(F, l); } SEAM(pb + 2);
        if (PH(pb + 3)) phase_postbc(F, l); SEAM(pb + 3);
        if (PH(pb + 4)) { phase_g2(F, l); if (REPS(pb + 4)) phase_g2(F, l); } SEAM(pb + 4);
        if (PH(pb + 5)) { phase_g3(F, l); if (REPS(pb + 5)) phase_g3(F, l); } SEAM(pb + 5);
        if (PH(pb + 6)) phase_resid(F, F.R2, DM, F.W + (size_t)l * WL_SIZE + WL_OUT, F.SS + (size_t)(2 * l + 1) * SS_STRIDE, l == 0); SEAM(pb + 6);
        if (l == 0) {
            if (PH(8)) { phase_g5(F); if (REPS(8)) phase_g5(F); } SEAM(8);
            if (PH(9)) phase_resid(F, F.R1, DFF, F.W + WF_D, F.SS + 2 * SS_STRIDE, true); SEAM(9);
        }
    }
    if (PH(17)) { convert_experts(F); phase_router(F); if (REPS(17)) { convert_experts(F); phase_router(F); } } SEAM(17);
    if (PH(18)) { phase_assign(F); if (REPS(18)) phase_assign(F); } SEAM(18);
    for (int pass = 0; pass < 2; ++pass) {
        if (PH(19 + 2 * pass)) { phase_g5m(F, pass); if (REPS(19 + 2 * pass)) phase_g5m(F, pass); } SEAM(19 + 2 * pass);
        if (PH(20 + 2 * pass)) { phase_g6m(F, pass); if (REPS(20 + 2 * pass)) phase_g6m(F, pass); } SEAM(20 + 2 * pass);
    }
    if (PH(23)) { phase_combine(F); if (REPS(23)) phase_combine(F); }
#undef PH
#undef SEAM
}

#ifndef MK_N_LAUNCHES
#define MK_N_LAUNCHES 1
#endif
extern "C" void kernel_launch(void* const* d_in, const int* in_sizes, int n_in, void* d_out, int out_size, void* d_ws, size_t ws_size, hipStream_t stream) {
    static int grid = 0;
    if (grid == 0) {
        if (n_in != 36 || in_sizes[0] != NREAL * DM || out_size != NREAL * DM || ws_size < WS_END) {
            fprintf(stderr, "kernel_launch: unexpected problem (n_in %d, in0 %d, out %d, ws %zu; need ws >= %zu); nothing launched\n", n_in, n_in > 0 ? in_sizes[0] : -1, out_size, ws_size, (size_t)WS_END); grid = -1; return; }
        int dev = 0, cus = 0, per_cu = 0;
        if (hipGetDevice(&dev) != hipSuccess || hipDeviceGetAttribute(&cus, hipDeviceAttributeMultiprocessorCount, dev) != hipSuccess) { grid = -1; return; }
        if (hipFuncSetAttribute((const void*)fwd_kernel, hipFuncAttributeMaxDynamicSharedMemorySize, LDS_BYTES) != hipSuccess) { fprintf(stderr, "kernel_launch: hipFuncSetAttribute failed\n"); grid = -1; return; }
        if (hipOccupancyMaxActiveBlocksPerMultiprocessor(&per_cu, (const void*)fwd_kernel, 512, LDS_BYTES) != hipSuccess || per_cu < 1) { fprintf(stderr, "kernel_launch: occupancy query says %d blocks per CU\n", per_cu); (void)hipGetLastError(); grid = -1; return; }
        grid = cus;
    }
    if (grid < 0) return;
    if (hipMemsetAsync((char*)d_ws + WS_CTL, 0, CTL_ZERO_BYTES, stream) != hipSuccess) return;
    Args a{};
    for (int i = 0; i < 36; ++i) a.in[i] = (const float*)d_in[i];
    a.out = (float*)d_out; a.ws = (unsigned char*)d_ws;
    if (MK_N_LAUNCHES == 1) { a.ph_lo = 0; a.ph_hi = N_PHASES; a.li = 0; hipLaunchKernelGGL(fwd_kernel, dim3(grid), dim3(512), LDS_BYTES, stream, a); }
    else for (int p = 0; p < N_PHASES; ++p) { a.ph_lo = p; a.ph_hi = p + 1; a.li = 0; hipLaunchKernelGGL(fwd_kernel, dim3(grid), dim3(512), LDS_BYTES, stream, a); }
}
```

```cpp
#include <hip/hip_runtime.h>
#include <cstdio>
#include <cstdint>

#define LAS __attribute__((address_space(3)))
#define GAS __attribute__((address_space(1)))
typedef unsigned short bf16_t;
typedef short bf16x8 __attribute__((ext_vector_type(8)));
typedef float f32x4 __attribute__((ext_vector_type(4)));
typedef float f32x2 __attribute__((ext_vector_type(2)));
typedef unsigned u32x4 __attribute__((ext_vector_type(4)));
typedef unsigned u32x2 __attribute__((ext_vector_type(2)));

constexpr int NB = 8, SEQ = 8192, DM = 1024, NMETA = 16;
constexpr int NREAL = NB * SEQ;
constexpr int MBASE = NREAL;
constexpr int NROWS = NREAL + NMETA;
constexpr int AW = 512, AIN = 1792, NABC = 3328, NGATE = 3072, NY = 1536, DFF = 2816, NGU = 5632, NEXP = 8;
constexpr int MAXBLK = 520, PASS0 = 256;
constexpr float RMS_EPS = 1e-6f, LN_EPS = 1e-5f, LNX_EPS = 64e-5f;

constexpr size_t MiB = 1u << 20;
constexpr size_t WS_CTL = 0, CTL_ZERO_BYTES = 1 * MiB;
constexpr size_t WS_SS = 8 * MiB, SS_STRIDE = (size_t)NREAL * 4;
constexpr size_t WS_RT = 4 * MiB;
constexpr size_t WS_HALO = 1 * MiB;
constexpr size_t WS_GC = 12 * MiB, WS_BS = 17 * MiB;
constexpr size_t RT_SLOTRS = WS_RT + 3 * MiB;
constexpr size_t RT_TOKINFO = WS_RT, RT_SLOTTOK = WS_RT + 1 * MiB, RT_CNT = WS_RT + 2 * MiB, RT_TOKSLOT = WS_RT + 3 * MiB - 512 * 1024;
constexpr size_t WS_W = 24 * MiB, WS_HB = 78 * MiB, WS_R1 = 207 * MiB, WS_R2 = 624 * MiB, WS_R3 = 753 * MiB;
constexpr size_t WS_YS = 570 * MiB, WS_WE = 830 * MiB, WS_END = 962 * MiB;
constexpr size_t WL_ABC = 0, WL_G = WL_ABC + (size_t)NABC * DM, WL_P = WL_G + (size_t)NGATE * DM, WL_OUT = WL_P + (size_t)DM * NY,
                 WL_W2 = WL_OUT + (size_t)DM * DM, WL_A2 = WL_W2 + 512 * 64, WL_G2 = WL_A2 + 512 * 64, WL_PW = WL_G2 + 512 * 128, WL_SIZE = WL_PW + 4 * 128 * 128;
constexpr size_t WF_GU = 2 * WL_SIZE, WF_D = WF_GU + (size_t)NGU * DM, W_TOTAL = WF_D + (size_t)DM * DFF;
static_assert(W_TOTAL * 2 <= 54 * MiB, "weights region");
constexpr size_t WE_GU = 0, WE_D = (size_t)NEXP * NGU * DM;
static_assert((WE_D + (size_t)NEXP * DM * DFF) * 2 <= 132 * MiB, "expert region");
static_assert((size_t)NROWS * NABC * 2 <= 417 * MiB && (size_t)NROWS * NGATE * 2 <= 417 * MiB && (size_t)(MAXBLK - PASS0) * 256 * DFF * 2 <= 363 * MiB, "R1");
static_assert((size_t)NROWS * 1024 * 2 <= 129 * MiB && (size_t)NROWS * NY * 2 <= 193 * MiB && (size_t)MAXBLK * 256 * 1024 * 2 <= 260 * MiB, "R2/R3/YS");
constexpr int CW_BAR = 4096;

constexpr int RING_BYTES = 131072, LDSCTL_OFF = RING_BYTES, LDS_BYTES = 147456;

typedef __bf16 bf16x2_t __attribute__((ext_vector_type(2)));
__device__ __forceinline__ unsigned cvt_pk_bf16(float lo, float hi) { const f32x2 v = {lo, hi}; return __builtin_bit_cast(unsigned, __builtin_convertvector(v, bf16x2_t)); }
__device__ __forceinline__ float bf_lo(unsigned u) { return __uint_as_float(u << 16); }
__device__ __forceinline__ float bf_hi(unsigned u) { return __uint_as_float(u & 0xffff0000u); }
__device__ __forceinline__ float bf2f(bf16_t b) { return __uint_as_float(((unsigned)b) << 16); }
__device__ __forceinline__ bf16_t f2bf(float f) { return (bf16_t)(cvt_pk_bf16(f, 0.f) & 0xffffu); }
__device__ __forceinline__ float fast_sigmoid(float x) { return __builtin_amdgcn_rcpf(1.0f + __expf(-x)); }
template <int CTRL> __device__ __forceinline__ float dpp_mov(float v) { return __builtin_bit_cast(float, __builtin_amdgcn_update_dpp(0, __builtin_bit_cast(int, v), CTRL, 0xf, 0xf, false)); }
__device__ __forceinline__ float allreduce8(float v) { v += dpp_mov<0xB1>(v); v += dpp_mov<0x4E>(v); v += dpp_mov<0x141>(v); return v; }
__device__ __forceinline__ float wave_sum(float v) {
    v = allreduce8(v); v += dpp_mov<0x140>(v);
    const int iv = __builtin_bit_cast(int, v);
    const float a = __builtin_bit_cast(float, __builtin_amdgcn_readlane(iv, 0)), b = __builtin_bit_cast(float, __builtin_amdgcn_readlane(iv, 16)),
                c = __builtin_bit_cast(float, __builtin_amdgcn_readlane(iv, 32)), d = __builtin_bit_cast(float, __builtin_amdgcn_readlane(iv, 48));
    return (a + b) + (c + d);
}
__device__ __forceinline__ void unpack8(const u32x4 w, float (&f)[8]) {
    f[0] = bf_lo(w.x); f[1] = bf_hi(w.x); f[2] = bf_lo(w.y); f[3] = bf_hi(w.y); f[4] = bf_lo(w.z); f[5] = bf_hi(w.z); f[6] = bf_lo(w.w); f[7] = bf_hi(w.w);
}
__device__ __forceinline__ u32x4 pack8(const float (&f)[8]) {
    u32x4 w; w.x = cvt_pk_bf16(f[0], f[1]); w.y = cvt_pk_bf16(f[2], f[3]); w.z = cvt_pk_bf16(f[4], f[5]); w.w = cvt_pk_bf16(f[6], f[7]); return w;
}

namespace pg8 {
constexpr int BM = 256, BK = 64, HALF = 128, HTB = HALF * BK * 2, STAGE_BYTES = 8 * HTB, NXCD = 8, WGM = 8;
__host__ __device__ __forceinline__ int lds_byte(int r, int c) { const int st = (r >> 4) * 2 + (c >> 5), rr = r & 15, cc = c & 31, ob = rr * 64 + cc * 2; return st * 1024 + (ob ^ (((ob >> 9) & 1) << 5)); }
__host__ __device__ __forceinline__ void stage_rc(int b, int& R, int& C) { const int st = b / 1024, sb = b % 1024, swz = sb ^ (((sb >> 9) & 1) << 5); R = (st >> 1) * 16 + swz / 64; C = (st & 1) * 32 + (swz % 64) / 2; }
__host__ __device__ __forceinline__ int perm32(int rho) { const int n = rho >> 4, i = rho & 15; return 8 * (i >> 2) + 4 * n + (i & 3); }

struct Unit { int pm, pn, aux; };
struct GemmD { const bf16_t* A; const bf16_t* Bt; int lda, ldb, K; };

__device__ __forceinline__ void tile_of(int wgid, int nM, int nN, int& pm, int& pn) {
    const int nwg = nM * nN;
    { const int q = nwg / NXCD, r = nwg % NXCD, xcd = wgid % NXCD, off = wgid / NXCD; wgid = (xcd < r ? xcd * (q + 1) : r * (q + 1) + (xcd - r) * q) + off; }
    const int nig = WGM * nN, gid = wgid / nig, fm = gid * WGM, gsz = (nM - fm) < WGM ? (nM - fm) : WGM;
    pm = fm + ((wgid % nig) % gsz); pn = (wgid % nig) / gsz;
}

template <class Epi, class Sched, bool GATHER>
__device__ __forceinline__ void gemm_phase(LAS unsigned char* lds, int wave_id, const GemmD g, const Sched& S, const Epi& E) {
    int lane; asm volatile("v_mbcnt_lo_u32_b32 %0, -1, 0\n\tv_mbcnt_hi_u32_b32 %0, -1, %0" : "=v"(lane), "+s"(wave_id));
    const int wid = wave_id, tid = wid * 64 + lane, wr = wid >> 2, wc = wid & 3, fr = lane & 15, fq = lane >> 4;
    const int K = g.K, nt = K / BK;
    int Rst[2], Cst[2];
    unsigned voffB[2];
#pragma unroll
    for (int i = 0; i < 2; ++i) { int R, C; stage_rc(tid * 16 + i * 8192, R, C); Rst[i] = R; Cst[i] = C; const int Rb = (R & ~31) + perm32(R & 31); voffB[i] = (unsigned)(Rb * g.ldb + C) * 2u; }
    const size_t kstep = (size_t)(BK * 2);
    const size_t hstepB = (size_t)HALF * g.ldb * 2;
    const unsigned ldsw = (unsigned)wid * 1024u;
    const int aoff = lds_byte(wr * 64 + fr, fq * 8), boff = lds_byte(wc * 32 + fr, fq * 8);
#define PG8_SA(b, h) (((b) * 2 + (h)) * HTB)
#define PG8_SB(b, h) ((4 + (b) * 2 + (h)) * HTB)
#define PG8_STAGE(bufoff, gbase, v0, v1) do { \
        __builtin_amdgcn_global_load_lds((const unsigned*)((const char*)(gbase) + (v0)), (LAS unsigned*)(lds + (bufoff) + ldsw), 16, 0, 0); \
        __builtin_amdgcn_global_load_lds((const unsigned*)((const char*)(gbase) + (v1)), (LAS unsigned*)(lds + (bufoff) + ldsw + 8192), 16, 0, 0); } while (0)
#define PG8_STAGE_B(bufoff, gbase) PG8_STAGE(bufoff, gbase, voffB[0], voffB[1])
#define PG8_LDA(dst, b, h) do { _Pragma("unroll") for (int m = 0; m < 4; ++m) _Pragma("unroll") for (int k = 0; k < 2; ++k) dst[m][k] = *(const LAS bf16x8*)(lds + PG8_SA(b, h) + aoff + m * 2048 + k * 1024); } while (0)
#define PG8_LDB(dst, b, h) do { _Pragma("unroll") for (int n = 0; n < 2; ++n) _Pragma("unroll") for (int k = 0; k < 2; ++k) dst[n][k] = *(const LAS bf16x8*)(lds + PG8_SB(b, h) + boff + n * 2048 + k * 1024); } while (0)
#define PG8_MMA(ai, bj, At, Bt) do { __builtin_amdgcn_s_setprio(1); _Pragma("unroll") for (int m = 0; m < 4; ++m) _Pragma("unroll") for (int n = 0; n < 2; ++n) _Pragma("unroll") for (int k = 0; k < 2; ++k) \
        acc[ai][bj][m][n] = __builtin_amdgcn_mfma_f32_16x16x32_bf16(Bt[n][k], At[m][k], acc[ai][bj][m][n], 0, 0, 0); __builtin_amdgcn_s_setprio(0); } while (0)
#define PG8_WAIT_V(n) asm volatile("s_waitcnt vmcnt(" #n ")" ::: "memory")
#define PG8_WAIT_L(n) asm volatile("s_waitcnt lgkmcnt(" #n ")" ::: "memory")
#define PG8_BAR __builtin_amdgcn_s_barrier()
#define PG8_SCHED __builtin_amdgcn_sched_barrier(0)
    Unit cur, nxt; int ui = 0;
    if (!S.next(0, cur)) return;
    bool has_next = S.next(1, nxt);
    unsigned vAc[2][2], vAn[2][2];
#pragma unroll
    for (int h = 0; h < 2; ++h)
#pragma unroll
        for (int i = 0; i < 2; ++i) {
            const int rl = h * HALF + Rst[i];
            if constexpr (GATHER) { vAc[h][i] = (unsigned)(S.a_row(cur, rl) * g.lda + Cst[i]) * 2u; vAn[h][i] = has_next ? (unsigned)(S.a_row(nxt, rl) * g.lda + Cst[i]) * 2u : vAc[h][i]; }
            else { vAc[h][i] = (unsigned)(rl * g.lda + Cst[i]) * 2u; vAn[h][i] = vAc[h][i]; }
        }
    f32x4 acc[2][2][4][2];
#pragma unroll
    for (int a = 0; a < 2; ++a)
#pragma unroll
        for (int b = 0; b < 2; ++b)
#pragma unroll
            for (int m = 0; m < 4; ++m)
#pragma unroll
                for (int n = 0; n < 2; ++n) acc[a][b][m][n] = (f32x4){0.f, 0.f, 0.f, 0.f};
    bf16x8 At[4][2], B0[2][2], B1[2][2];
    const char* cA = (const char*)g.A + S.a_off(cur); const char* cB = (const char*)g.Bt + S.b_off(cur);
    PG8_STAGE_B(PG8_SB(0, 0), cB); PG8_STAGE_B(PG8_SB(0, 1), cB + hstepB); PG8_STAGE(PG8_SA(0, 0), cA, vAc[0][0], vAc[0][1]); PG8_STAGE(PG8_SA(0, 1), cA, vAc[1][0], vAc[1][1]);
    if (wr == 1) PG8_BAR;
    PG8_WAIT_V(2); PG8_BAR;
    PG8_STAGE_B(PG8_SB(1, 0), cB + kstep); PG8_STAGE(PG8_SA(1, 0), cA + kstep, vAc[0][0], vAc[0][1]); PG8_STAGE_B(PG8_SB(1, 1), cB + hstepB + kstep);
    PG8_WAIT_V(6); PG8_BAR;
    for (;;) {
        const char* nA = has_next ? (const char*)g.A + S.a_off(nxt) : cA; const char* nB = has_next ? (const char*)g.Bt + S.b_off(nxt) : cB;
        for (int t = 0; t < nt; t += 2) {
            const bool last = (t == nt - 2);
            if constexpr (Epi::MID_EVERY > 0) { if (t > 0 && t % Epi::MID_EVERY == 0) E.mid(acc, cur, wr, wc, fr, fq, t / Epi::MID_EVERY); }
            const char* a1 = cA + (size_t)(t + 1) * kstep;
            const char* a2 = last ? nA : cA + (size_t)(t + 2) * kstep; const char* b2 = last ? nB : cB + (size_t)(t + 2) * kstep;
            const char* a3 = a2 + kstep; const char* b3 = b2 + kstep;
            unsigned v2[2][2];
#pragma unroll
            for (int h = 0; h < 2; ++h)
#pragma unroll
                for (int i = 0; i < 2; ++i) v2[h][i] = (GATHER && last) ? vAn[h][i] : vAc[h][i];
            PG8_LDB(B0, 0, 0); PG8_LDB(B1, 0, 1); PG8_SCHED; PG8_LDA(At, 0, 0); PG8_STAGE(PG8_SA(1, 1), a1, vAc[1][0], vAc[1][1]);
            PG8_WAIT_V(8); PG8_WAIT_L(0); PG8_BAR; PG8_MMA(0, 0, At, B0); PG8_MMA(0, 1, At, B1); PG8_BAR; PG8_SCHED;
            PG8_LDA(At, 0, 1); PG8_STAGE_B(PG8_SB(0, 0), b2); PG8_STAGE_B(PG8_SB(0, 1), b2 + hstepB); PG8_STAGE(PG8_SA(0, 0), a2, v2[0][0], v2[0][1]);
            PG8_WAIT_V(8); PG8_WAIT_L(0); PG8_BAR; PG8_MMA(1, 0, At, B0); PG8_MMA(1, 1, At, B1); PG8_BAR; PG8_SCHED;
            PG8_LDB(B0, 1, 0); PG8_LDB(B1, 1, 1); PG8_SCHED; PG8_LDA(At, 1, 0); PG8_STAGE(PG8_SA(0, 1), a2, v2[1][0], v2[1][1]);
            PG8_WAIT_V(8); PG8_WAIT_L(0); PG8_BAR; PG8_MMA(0, 0, At, B0); PG8_MMA(0, 1, At, B1); PG8_BAR; PG8_SCHED;
            PG8_LDA(At, 1, 1); PG8_STAGE_B(PG8_SB(1, 0), b3); PG8_STAGE_B(PG8_SB(1, 1), b3 + hstepB); PG8_STAGE(PG8_SA(1, 0), a3, v2[0][0], v2[0][1]);
            PG8_WAIT_V(8); PG8_WAIT_L(0); PG8_BAR; PG8_MMA(1, 0, At, B0); PG8_MMA(1, 1, At, B1); PG8_BAR; PG8_SCHED;
        }
        if (wr == 0) PG8_BAR;
        E(acc, cur, wr, wc, fr, fq);
        if (!has_next) break;
#pragma unroll
        for (int a = 0; a < 2; ++a)
#pragma unroll
            for (int b = 0; b < 2; ++b)
#pragma unroll
                for (int m = 0; m < 4; ++m)
#pragma unroll
                    for (int n = 0; n < 2; ++n) acc[a][b][m][n] = (f32x4){0.f, 0.f, 0.f, 0.f};
        cur = nxt; cA = nA; cB = nB; ++ui;
        has_next = S.next(ui + 1, nxt);
        if constexpr (GATHER) {
#pragma unroll
            for (int h = 0; h < 2; ++h)
#pragma unroll
                for (int i = 0; i < 2; ++i) { vAc[h][i] = vAn[h][i]; if (has_next) vAn[h][i] = (unsigned)(S.a_row(nxt, h * HALF + Rst[i]) * g.lda + Cst[i]) * 2u; }
        }
        if (wr == 1) PG8_BAR;
    }
    PG8_WAIT_V(0);
    PG8_BAR;
#undef PG8_SA
#undef PG8_SB
#undef PG8_STAGE
#undef PG8_STAGE_B
#undef PG8_LDA
#undef PG8_LDB
#undef PG8_MMA
#undef PG8_WAIT_V
#undef PG8_WAIT_L
#undef PG8_BAR
#undef PG8_SCHED
}
}

using pg8::Unit; using pg8::GemmD;
struct SchedGrid {
    int nM, nN, G, c; size_t a_tile, b_tile; int rev;
    __device__ __forceinline__ bool next(int i, Unit& u) const { const long L = (long)i * G + c; if (L >= (long)nM * nN) return false; pg8::tile_of((int)L, nM, nN, u.pm, u.pn); if (rev) u.pm = nM - 1 - u.pm; u.aux = 0; return true; }
    __device__ __forceinline__ size_t a_off(const Unit& u) const { return (size_t)u.pm * a_tile; }
    __device__ __forceinline__ size_t b_off(const Unit& u) const { return (size_t)u.pn * b_tile; }
    __device__ __forceinline__ int a_row(const Unit&, int) const { return 0; }
};
struct SchedMerge {
    int nM, nN, G, c; size_t a_tile, b_tile;
    __device__ __forceinline__ bool next(int i, Unit& u) const { const long L = (long)(i / 3) * G + c; if (L >= (long)nM * nN) return false; pg8::tile_of((int)L, nM, nN, u.pm, u.pn); u.aux = i % 3; return true; }
    __device__ __forceinline__ size_t a_off(const Unit& u) const { return (size_t)u.pm * a_tile + (size_t)u.aux * (AW * 2); }
    __device__ __forceinline__ size_t b_off(const Unit& u) const { return (size_t)u.pn * b_tile + (size_t)u.aux * (AW * 2); }
    __device__ __forceinline__ int a_row(const Unit&, int) const { return 0; }
};
struct SchedMoe {
    int blk0, nblk, nN, G, c; const int* block_e; const int* slot_tok; size_t a_tile, b_tile, b_exp; int rev;
    __device__ __forceinline__ bool next(int i, Unit& u) const { const long L = (long)i * G + c; if (L >= (long)nblk * nN) return false; int pm, pn; pg8::tile_of((int)L, nblk, nN, pm, pn); u.pm = blk0 + (rev ? nblk - 1 - pm : pm); u.pn = pn; u.aux = block_e[u.pm]; return true; }
    __device__ __forceinline__ size_t a_off(const Unit& u) const { return (size_t)(u.pm - blk0) * a_tile; }
    __device__ __forceinline__ size_t b_off(const Unit& u) const { return (size_t)u.aux * b_exp + (size_t)u.pn * b_tile; }
    __device__ __forceinline__ int a_row(const Unit& u, int r) const { const int t = slot_tok[u.pm * 256 + r]; return t < 0 ? 0 : t; }
};

#define EPI_ROWS_BEGIN _Pragma("unroll") for (int ai = 0; ai < 2; ++ai) _Pragma("unroll") for (int m = 0; m < 4; ++m) { const int r = u.pm * 256 + ai * 128 + wr * 64 + m * 16 + fr;
#define EPI_ROWS_END }
__device__ __forceinline__ float rstd_of(const float* ss, int r) {
    const f32x4 a = *(const f32x4*)(ss + (size_t)r * 4);
    return __builtin_amdgcn_rsqf(((a[0] + a[1]) + (a[2] + a[3])) * (1.0f / DM) + RMS_EPS);
}

#define EPI_RSTD8(rsv, ss)  float rsv[2][4]; { f32x4 raw_[2][4]; \
    _Pragma("unroll") for (int ai = 0; ai < 2; ++ai) _Pragma("unroll") for (int m = 0; m < 4; ++m) raw_[ai][m] = *(const f32x4*)((ss) + (size_t)(u.pm * 256 + ai * 128 + wr * 64 + m * 16 + fr) * 4); \
    asm volatile("" : "+v"(raw_[0][0]), "+v"(raw_[0][1]), "+v"(raw_[0][2]), "+v"(raw_[0][3]), "+v"(raw_[1][0]), "+v"(raw_[1][1]), "+v"(raw_[1][2]), "+v"(raw_[1][3])); \
    _Pragma("unroll") for (int ai = 0; ai < 2; ++ai) _Pragma("unroll") for (int m = 0; m < 4; ++m) rsv[ai][m] = __builtin_amdgcn_rsqf(((raw_[ai][m][0] + raw_[ai][m][1]) + (raw_[ai][m][2] + raw_[ai][m][3])) * (1.0f / DM) + RMS_EPS); }
struct EpiScale { static constexpr int MID_EVERY = 0;
    bf16_t* O; int ldo; const float* ss;
    __device__ __forceinline__ void operator()(const f32x4 (&acc)[2][2][4][2], const Unit& u, int wr, int wc, int fr, int fq) const {
        const int c0 = u.pn * 256 + wc * 32 + 8 * fq;
        EPI_RSTD8(rsv, ss)
        EPI_ROWS_BEGIN
            const float rs = rsv[ai][m]; bf16_t* rowp = O + (size_t)r * ldo + c0;
#pragma unroll
            for (int bj = 0; bj < 2; ++bj) { const f32x4 v0 = acc[ai][bj][m][0] * rs, v1 = acc[ai][bj][m][1] * rs;
                u32x4 w; w.x = cvt_pk_bf16(v0[0], v0[1]); w.y = cvt_pk_bf16(v0[2], v0[3]); w.z = cvt_pk_bf16(v1[0], v1[1]); w.w = cvt_pk_bf16(v1[2], v1[3]); *(u32x4*)(rowp + bj * 128) = w; }
        EPI_ROWS_END
    }
};
struct EpiGate { static constexpr int MID_EVERY = 0;
    bf16_t* O; int ldo; const float* ss; const float* bias;
    __device__ __forceinline__ void operator()(const f32x4 (&acc)[2][2][4][2], const Unit& u, int wr, int wc, int fr, int fq) const {
        const int c0 = u.pn * 256 + wc * 32 + 8 * fq;
        f32x4 bv[2][2];
#pragma unroll
        for (int bj = 0; bj < 2; ++bj) { bv[bj][0] = *(const f32x4*)(bias + c0 + bj * 128); bv[bj][1] = *(const f32x4*)(bias + c0 + bj * 128 + 4); }
        EPI_RSTD8(rsv, ss)
        EPI_ROWS_BEGIN
            const float rs = rsv[ai][m]; bf16_t* rowp = O + (size_t)r * ldo + c0;
#pragma unroll
            for (int bj = 0; bj < 2; ++bj) { f32x4 v0 = acc[ai][bj][m][0] * rs + bv[bj][0], v1 = acc[ai][bj][m][1] * rs + bv[bj][1];
#pragma unroll
                for (int j = 0; j < 4; ++j) { v0[j] = fast_sigmoid(v0[j]); v1[j] = fast_sigmoid(v1[j]); }
                u32x4 w; w.x = cvt_pk_bf16(v0[0], v0[1]); w.y = cvt_pk_bf16(v0[2], v0[3]); w.z = cvt_pk_bf16(v1[0], v1[1]); w.w = cvt_pk_bf16(v1[2], v1[3]); *(u32x4*)(rowp + bj * 128) = w; }
        EPI_ROWS_END
    }
};
struct EpiMerge { static constexpr int MID_EVERY = 0;
    bf16_t* MB; const bf16_t* ZG;
    __device__ __forceinline__ void operator()(const f32x4 (&acc)[2][2][4][2], const Unit& u, int wr, int wc, int fr, int fq) const {
        const int c0 = u.pn * 256 + wc * 32 + 8 * fq; const int br = u.aux;
#pragma unroll
        for (int ai = 0; ai < 2; ++ai) {
            u32x4 graw[4][2], praw[4][2];
#pragma unroll
            for (int m = 0; m < 4; ++m) { const int r = u.pm * 256 + ai * 128 + wr * 64 + m * 16 + fr; const bf16_t* gp = ZG + (size_t)r * NGATE + br * DM + c0; const bf16_t* pp = MB + (size_t)r * DM + c0;
                graw[m][0] = *(const u32x4*)gp; graw[m][1] = *(const u32x4*)(gp + 128);
                if (br > 0) { praw[m][0] = *(const u32x4*)pp; praw[m][1] = *(const u32x4*)(pp + 128); } else { praw[m][0] = (u32x4){0u, 0u, 0u, 0u}; praw[m][1] = praw[m][0]; } }
            asm volatile("" : "+v"(graw[0][0]), "+v"(graw[0][1]), "+v"(graw[1][0]), "+v"(graw[1][1]), "+v"(graw[2][0]), "+v"(graw[2][1]), "+v"(graw[3][0]), "+v"(graw[3][1]),
                              "+v"(praw[0][0]), "+v"(praw[0][1]), "+v"(praw[1][0]), "+v"(praw[1][1]), "+v"(praw[2][0]), "+v"(praw[2][1]), "+v"(praw[3][0]), "+v"(praw[3][1]));
#pragma unroll
            for (int m = 0; m < 4; ++m) { const int r = u.pm * 256 + ai * 128 + wr * 64 + m * 16 + fr; bf16_t* rowp = MB + (size_t)r * DM + c0;
#pragma unroll
                for (int bj = 0; bj < 2; ++bj) {
                    float gt[8], pv[8]; unpack8(graw[m][bj], gt); unpack8(praw[m][bj], pv);
                    float o[8];
#pragma unroll
                    for (int j = 0; j < 4; ++j) { o[j] = pv[j] + gt[j] * acc[ai][bj][m][0][j]; o[4 + j] = pv[4 + j] + gt[4 + j] * acc[ai][bj][m][1][j]; }
                    *(u32x4*)(rowp + bj * 128) = pack8(o); } }
        }
    }
};
constexpr float GATE_FLOOR = 1e-20f;
struct EpiMerge3 { static constexpr int MID_EVERY = 8;
    bf16_t* MB; const bf16_t* ZG;
    __device__ __forceinline__ void mid(f32x4 (&acc)[2][2][4][2], const Unit& u, int wr, int wc, int fr, int fq, int seg) const {
        const int c0 = u.pn * 256 + wc * 32 + 8 * fq;
#pragma unroll
        for (int ai = 0; ai < 2; ++ai) {
            u32x4 ga[4][2], gb[4][2];
#pragma unroll
            for (int m = 0; m < 4; ++m) { const bf16_t* gp = ZG + (size_t)(u.pm * 256 + ai * 128 + wr * 64 + m * 16 + fr) * NGATE + (seg - 1) * DM + c0;
                ga[m][0] = *(const u32x4*)gp; ga[m][1] = *(const u32x4*)(gp + 128); gb[m][0] = *(const u32x4*)(gp + DM); gb[m][1] = *(const u32x4*)(gp + DM + 128); }
            asm volatile("" : "+v"(ga[0][0]), "+v"(ga[0][1]), "+v"(ga[1][0]), "+v"(ga[1][1]), "+v"(ga[2][0]), "+v"(ga[2][1]), "+v"(ga[3][0]), "+v"(ga[3][1]),
                              "+v"(gb[0][0]), "+v"(gb[0][1]), "+v"(gb[1][0]), "+v"(gb[1][1]), "+v"(gb[2][0]), "+v"(gb[2][1]), "+v"(gb[3][0]), "+v"(gb[3][1]));
#pragma unroll
            for (int m = 0; m < 4; ++m)
#pragma unroll
                for (int bj = 0; bj < 2; ++bj) { float x[8], y[8]; unpack8(ga[m][bj], x); unpack8(gb[m][bj], y);
#pragma unroll
                    for (int j = 0; j < 4; ++j) { acc[ai][bj][m][0][j] *= fmaxf(x[j], GATE_FLOOR) * __builtin_amdgcn_rcpf(fmaxf(y[j], GATE_FLOOR)); acc[ai][bj][m][1][j] *= fmaxf(x[4 + j], GATE_FLOOR) * __builtin_amdgcn_rcpf(fmaxf(y[4 + j], GATE_FLOOR)); } }
        }
    }
    __device__ __forceinline__ void operator()(const f32x4 (&acc)[2][2][4][2], const Unit& u, int wr, int wc, int fr, int fq) const {
        const int c0 = u.pn * 256 + wc * 32 + 8 * fq;
        u32x4 g2[2][4][2];
#pragma unroll
        for (int ai = 0; ai < 2; ++ai)
#pragma unroll
            for (int m = 0; m < 4; ++m) { const bf16_t* gp = ZG + (size_t)(u.pm * 256 + ai * 128 + wr * 64 + m * 16 + fr) * NGATE + 2 * DM + c0; g2[ai][m][0] = *(const u32x4*)gp; g2[ai][m][1] = *(const u32x4*)(gp + 128); }
        asm volatile("" : "+v"(g2[0][0][0]), "+v"(g2[0][0][1]), "+v"(g2[0][1][0]), "+v"(g2[0][1][1]), "+v"(g2[0][2][0]), "+v"(g2[0][2][1]), "+v"(g2[0][3][0]), "+v"(g2[0][3][1]),
                          "+v"(g2[1][0][0]), "+v"(g2[1][0][1]), "+v"(g2[1][1][0]), "+v"(g2[1][1][1]), "+v"(g2[1][2][0]), "+v"(g2[1][2][1]), "+v"(g2[1][3][0]), "+v"(g2[1][3][1]));
        EPI_ROWS_BEGIN
            bf16_t* rowp = MB + (size_t)r * DM + c0;
#pragma unroll
            for (int bj = 0; bj < 2; ++bj) { float gt[8], o[8]; unpack8(g2[ai][m][bj], gt);
#pragma unroll
                for (int j = 0; j < 4; ++j) { o[j] = fmaxf(gt[j], GATE_FLOOR) * acc[ai][bj][m][0][j]; o[4 + j] = fmaxf(gt[4 + j], GATE_FLOOR) * acc[ai][bj][m][1][j]; }
                *(u32x4*)(rowp + bj * 128) = pack8(o); }
        EPI_ROWS_END
    }
};
struct EpiResid { static constexpr int MID_EVERY = 0;
    bf16_t* HB; float* ssn; LAS float* red;
    __device__ __forceinline__ void operator()(const f32x4 (&acc)[2][2][4][2], const Unit& u, int wr, int wc, int fr, int fq) const {
        const int c0 = u.pn * 256 + wc * 32 + 8 * fq;
        u32x4 hraw[2][4][2];
#pragma unroll
        for (int ai = 0; ai < 2; ++ai)
#pragma unroll
            for (int m = 0; m < 4; ++m) { const bf16_t* rp = HB + (size_t)(u.pm * 256 + ai * 128 + wr * 64 + m * 16 + fr) * DM + c0; hraw[ai][m][0] = *(const u32x4*)rp; hraw[ai][m][1] = *(const u32x4*)(rp + 128); }
        asm volatile("" : "+v"(hraw[0][0][0]), "+v"(hraw[0][0][1]), "+v"(hraw[0][1][0]), "+v"(hraw[0][1][1]), "+v"(hraw[0][2][0]), "+v"(hraw[0][2][1]), "+v"(hraw[0][3][0]), "+v"(hraw[0][3][1]),
                          "+v"(hraw[1][0][0]), "+v"(hraw[1][0][1]), "+v"(hraw[1][1][0]), "+v"(hraw[1][1][1]), "+v"(hraw[1][2][0]), "+v"(hraw[1][2][1]), "+v"(hraw[1][3][0]), "+v"(hraw[1][3][1]));
        EPI_ROWS_BEGIN
            bf16_t* rowp = HB + (size_t)r * DM + c0; float sq = 0.f;
#pragma unroll
            for (int bj = 0; bj < 2; ++bj) {
                float hv[8]; unpack8(hraw[ai][m][bj], hv);
#pragma unroll
                for (int j = 0; j < 4; ++j) { hv[j] += acc[ai][bj][m][0][j]; hv[4 + j] += acc[ai][bj][m][1][j]; }
                const u32x4 w = pack8(hv); *(u32x4*)(rowp + bj * 128) = w;
                float rv[8]; unpack8(w, rv);
#pragma unroll
                for (int j = 0; j < 8; ++j) sq += rv[j] * rv[j]; }
            { const int ln = fq * 16 + fr; sq += __builtin_bit_cast(float, __builtin_amdgcn_ds_bpermute((ln ^ 16) << 2, __builtin_bit_cast(int, sq))); sq += __builtin_bit_cast(float, __builtin_amdgcn_ds_bpermute((ln ^ 32) << 2, __builtin_bit_cast(int, sq))); }
            if (fq == 0) red[(ai * 128 + wr * 64 + m * 16 + fr) * 4 + wc] = sq;
        EPI_ROWS_END
        asm volatile("s_waitcnt lgkmcnt(0)" ::: "memory"); __builtin_amdgcn_s_barrier(); asm volatile("" ::: "memory");
        { const int t = (wr * 4 + wc) * 64 + fq * 16 + fr;
          if (t < 256) { const f32x4 p = *(const LAS f32x4*)(red + t * 4); ssn[(size_t)(u.pm * 256 + t) * 4 + u.pn] = (p[0] + p[1]) + (p[2] + p[3]); } }
    }
};
struct EpiSwiglu { static constexpr int MID_EVERY = 0;
    bf16_t* HID; const float* ss; const int* slot_tok; int row0;
    __device__ __forceinline__ void operator()(const f32x4 (&acc)[2][2][4][2], const Unit& u, int wr, int wc, int fr, int fq) const {
        const int c0 = u.pn * 128 + wc * 32 + 8 * fq;
        float rsv[2][4];
        if (slot_tok) {
#pragma unroll
            for (int ai = 0; ai < 2; ++ai)
#pragma unroll
                for (int m = 0; m < 4; ++m) rsv[ai][m] = ss[u.pm * 256 + ai * 128 + wr * 64 + m * 16 + fr];
            asm volatile("" : "+v"(rsv[0][0]), "+v"(rsv[0][1]), "+v"(rsv[0][2]), "+v"(rsv[0][3]), "+v"(rsv[1][0]), "+v"(rsv[1][1]), "+v"(rsv[1][2]), "+v"(rsv[1][3]));
        } else { EPI_RSTD8(rs2, ss)
#pragma unroll
            for (int ai = 0; ai < 2; ++ai)
#pragma unroll
                for (int m = 0; m < 4; ++m) rsv[ai][m] = rs2[ai][m]; }
        EPI_ROWS_BEGIN
            const float rs = rsv[ai][m]; const int orow = slot_tok ? r - row0 : r;
            const f32x4 g0 = acc[ai][0][m][0] * rs, g1 = acc[ai][0][m][1] * rs, u0 = acc[ai][1][m][0] * rs, u1 = acc[ai][1][m][1] * rs;
            float o[8];
#pragma unroll
            for (int j = 0; j < 4; ++j) { o[j] = g0[j] * fast_sigmoid(g0[j]) * u0[j]; o[4 + j] = g1[j] * fast_sigmoid(g1[j]) * u1[j]; }
            *(u32x4*)(HID + (size_t)orow * DFF + c0) = pack8(o);
        EPI_ROWS_END
    }
};
struct EpiStore { static constexpr int MID_EVERY = 0;
    bf16_t* O; int ldo;
    __device__ __forceinline__ void operator()(const f32x4 (&acc)[2][2][4][2], const Unit& u, int wr, int wc, int fr, int fq) const {
        const int c0 = u.pn * 256 + wc * 32 + 8 * fq;
        EPI_ROWS_BEGIN
            bf16_t* rowp = O + (size_t)r * ldo + c0;
#pragma unroll
            for (int bj = 0; bj < 2; ++bj) { const f32x4 v0 = acc[ai][bj][m][0], v1 = acc[ai][bj][m][1];
                u32x4 w; w.x = cvt_pk_bf16(v0[0], v0[1]); w.y = cvt_pk_bf16(v0[2], v0[3]); w.z = cvt_pk_bf16(v1[0], v1[1]); w.w = cvt_pk_bf16(v1[2], v1[3]); *(u32x4*)(rowp + bj * 128) = w; }
        EPI_ROWS_END
    }
};

#define XB_TMO      128
#define XB_XCNT(j)  (256  + 64 * (j))
#define XB_XSUB(j)  (1280 + 64 * (j))
#define XB_XGEN(j)  (2304 + 64 * (j))
#define XB_TOP      3328
#define XB_TOPGEN   3392
#define XCD_BAR_WORDS 3456
#define XB_SPIN_CAP (1u << 18)
__device__ __forceinline__ unsigned xb_ld(unsigned* p)              { return __hip_atomic_load(p, __ATOMIC_RELAXED, __HIP_MEMORY_SCOPE_AGENT); }
__device__ __forceinline__ unsigned xb_add(unsigned* p, unsigned v) { return __hip_atomic_fetch_add(p, v, __ATOMIC_RELAXED, __HIP_MEMORY_SCOPE_AGENT); }
__device__ __forceinline__ unsigned xb_xcc_id() { return (unsigned)__builtin_amdgcn_s_getreg((3 << 11) | 20) & 0xFu; }
#define XB_SPIN(cond, bar) do { unsigned _sp = 0; while (cond) { __builtin_amdgcn_s_sleep(1); \
    if ((++_sp & 255u) == 0u) { if (xb_ld(&(bar)[XB_TMO])) break; if (_sp > XB_SPIN_CAP) { atomicAdd(&(bar)[XB_TMO], 1u); break; } } } } while (0)
struct XcdBarrier { unsigned* bar; unsigned x; volatile LAS unsigned* st; };
__device__ __forceinline__ XcdBarrier xcd_barrier_post(unsigned* bar, volatile LAS unsigned* st) {
    XcdBarrier b; b.bar = bar; b.x = xb_xcc_id(); b.st = st;
    if (threadIdx.x == 0) (void)xb_add(&bar[XB_XCNT(b.x)], 1u);
    return b;
}
__device__ __forceinline__ void xcd_barrier_complete(unsigned* bar, unsigned x, unsigned& nloc, unsigned& nx) {
    const unsigned G = gridDim.x * gridDim.y * gridDim.z;
    unsigned sum, cnt, mine, sp = 0u;
    for (;;) {
        sum = 0u; cnt = 0u; mine = 0u;
#pragma unroll
        for (unsigned j = 0; j < 16; ++j) { const unsigned c = xb_ld(&bar[XB_XCNT(j)]); sum += c; cnt += (c > 0u) ? 1u : 0u; mine = (j == x) ? c : mine; }
        if (sum == G) break;
        __builtin_amdgcn_s_sleep(1);
        if ((++sp & 255u) == 0u) { if (xb_ld(&bar[XB_TMO])) break; if (sp > XB_SPIN_CAP) { atomicAdd(&bar[XB_TMO], 1u); break; } }
    }
    nloc = mine > 0u ? mine : 1u; nx = cnt > 0u ? cnt : 1u;
}
__device__ __forceinline__ void xcd_barrier(const XcdBarrier& b, int wave_id) {
    asm volatile("s_waitcnt vmcnt(0)" ::: "memory");
    __syncthreads();
    int lane_; asm volatile("v_mbcnt_lo_u32_b32 %0, -1, 0\n\tv_mbcnt_hi_u32_b32 %0, -1, %0" : "=v"(lane_));
    if (wave_id == 0 && lane_ == 0) {
        unsigned* bar = b.bar;
        __builtin_amdgcn_s_waitcnt(0);
        unsigned nloc = b.st[0], nx = b.st[1];
        if (nloc == 0u) { xcd_barrier_complete(bar, b.x, nloc, nx); b.st[0] = nloc; b.st[1] = nx; }
        const unsigned old = xb_add(&bar[XB_XSUB(b.x)], 1u);
        const unsigned gen = old / nloc;
        if (old + 1u == (gen + 1u) * nloc) {
            __builtin_amdgcn_fence(__ATOMIC_RELEASE, "agent");
            asm volatile("s_waitcnt vmcnt(0)" ::: "memory");
            const unsigned og = xb_add(&bar[XB_TOP], 1u);
            const unsigned tg = og / nx;
            if (og + 1u == (tg + 1u) * nx) xb_add(&bar[XB_TOPGEN], 1u);
            else XB_SPIN(xb_ld(&bar[XB_TOPGEN]) == tg, bar);
            __builtin_amdgcn_fence(__ATOMIC_ACQUIRE, "agent");
            xb_add(&bar[XB_XGEN(b.x)], 1u);
            asm volatile("s_waitcnt vmcnt(0)" ::: "memory");
        } else {
            XB_SPIN(xb_ld(&bar[XB_XGEN(b.x)]) == gen, bar);
            __builtin_amdgcn_fence(__ATOMIC_ACQUIRE, "agent");
            asm volatile("s_waitcnt vmcnt(0)" ::: "memory");
        }
    }
    __syncthreads();
}

struct Args { const float* in[36]; float* out; unsigned char* ws; int ph_lo, ph_hi, li, pad; };
enum { I_X = 0, I_META, I_MIXG, I_WIN, I_GATEB, I_MU, I_W0, I_W2, I_A0, I_A2, I_G2, I_KK, I_KA, I_RK, I_LNXW, I_LNXB, I_CONVW, I_CONVB, I_BLNG, I_BLNB, I_POOLW, I_CSCALE,
       I_PROJA, I_PROJB, I_PROJC, I_WOUT, I_FFNG, I_FGATE, I_FUP, I_FDOWN, I_RW, I_RB, I_EGATE, I_EUP, I_EDOWN, I_FINALG };
constexpr int PTR_OFF = LDSCTL_OFF + 64;
__device__ __forceinline__ GAS unsigned char* lds_ptr(LAS unsigned char* lds, int i) {
    const LAS unsigned* p = (const LAS unsigned*)(lds + PTR_OFF + 8 * i);
    const unsigned lo = __builtin_amdgcn_readfirstlane(p[0]), hi = __builtin_amdgcn_readfirstlane(p[1]);
    return (GAS unsigned char*)(((unsigned long long)hi << 32) | lo);
}
struct Frame {
    LAS unsigned char* lds; int tid, lane, wave, G, bid;
    unsigned char* ws;
    bf16_t* W; bf16_t* WE; bf16_t* HB; bf16_t* R1; bf16_t* R2; bf16_t* R3; bf16_t* YS; float* SS;
};
__device__ __forceinline__ void frame_ptrs(Frame& F) {
    GAS unsigned char* ws = lds_ptr(F.lds, 37); F.ws = (unsigned char*)ws;
    F.W = (bf16_t*)(ws + WS_W); F.WE = (bf16_t*)(ws + WS_WE); F.HB = (bf16_t*)(ws + WS_HB); F.R1 = (bf16_t*)(ws + WS_R1); F.R2 = (bf16_t*)(ws + WS_R2); F.R3 = (bf16_t*)(ws + WS_R3);
    F.YS = (bf16_t*)(ws + WS_YS); F.SS = (float*)(ws + WS_SS);
}
__device__ __forceinline__ const float* in_ptr(const Frame& F, int i) { return (const float*)lds_ptr(F.lds, i); }
#define LDS_WAIT() asm volatile("s_waitcnt lgkmcnt(0)" ::: "memory")
#define PHASE_ENTER(F) do { int l_; int w_ = (F).wave, g_ = (F).G, b_ = (F).bid; asm volatile("v_mbcnt_lo_u32_b32 %0, -1, 0\n\tv_mbcnt_hi_u32_b32 %0, -1, %0" : "=v"(l_), "+s"(w_), "+s"(g_), "+s"(b_) :: "memory"); (F).lane = l_; (F).wave = w_; (F).G = g_; (F).bid = b_; (F).tid = w_ * 64 + l_; frame_ptrs(F); } while (0)


__device__ __forceinline__ int row_of(int b, int l) { return l < NMETA ? MBASE + l : b * SEQ + (l - NMETA); }
__device__ __forceinline__ int prev_row(int r) { if (r >= MBASE) return r > MBASE ? r - 1 : -1; return (r & (SEQ - 1)) ? r - 1 : MBASE + NMETA - 1; }

struct ConvJob { const float* src; int K, srcN, col0, ncols; bf16_t* dst; int dld, dcol0, mode; const float* sc; };
__device__ __forceinline__ int conv_items(const ConvJob& j) { return (j.K / 64) * (j.ncols / 32); }
__device__ __forceinline__ void conv_item(const ConvJob& j, LAS float* scr, int item, int lane) {
    const int nblk = j.ncols / 32, kb = item / nblk, nb = item % nblk, k0 = 64 * kb, n0 = 32 * nb;
    float vv[32];
#pragma unroll
    for (int i = 0; i < 32; ++i) { const int kk = 2 * i + (lane >> 5); vv[i] = j.src[(size_t)(k0 + kk) * j.srcN + j.col0 + n0 + (lane & 31)]; }
    if (j.sc) {
#pragma unroll
        for (int i = 0; i < 32; ++i) vv[i] *= j.sc[k0 + 2 * i + (lane >> 5)]; }
#pragma unroll
    for (int i = 0; i < 32; ++i) { const int kk = 2 * i + (lane >> 5); scr[kk * 33 + (lane & 31)] = vv[i]; }
    LDS_WAIT(); asm volatile("" ::: "memory");
    const int c = lane & 7;
    int drow0 = n0; if (j.mode == 1) drow0 = 256 * (n0 / 128) + (n0 % 128); else if (j.mode == 2) drow0 = 256 * (n0 / 128) + 128 + (n0 % 128);
#pragma unroll
    for (int jj = 0; jj < 4; ++jj) { const int n = (lane >> 3) + 8 * jj; const LAS float* s = scr + (8 * c) * 33 + n;
        u32x4 o; o.x = cvt_pk_bf16(s[0 * 33], s[1 * 33]); o.y = cvt_pk_bf16(s[2 * 33], s[3 * 33]); o.z = cvt_pk_bf16(s[4 * 33], s[5 * 33]); o.w = cvt_pk_bf16(s[6 * 33], s[7 * 33]);
        *(u32x4*)(j.dst + (size_t)(drow0 + n) * j.dld + j.dcol0 + k0 + 8 * c) = o; }
    LDS_WAIT(); asm volatile("" ::: "memory");
}
__device__ __forceinline__ void conv_run(Frame& F, const ConvJob& j) {
    LAS float* scr = (LAS float*)(F.lds + F.wave * 16384);
    const int gw = F.bid * 8 + F.wave, NGW = F.G * 8, n = conv_items(j);
    for (int it = gw; it < n; it += NGW) conv_item(j, scr, it, F.lane);
}
__device__ __forceinline__ void convert_common(Frame& F) {
    PHASE_ENTER(F);
    for (int l = 0; l < 2; ++l) {
        bf16_t* WL = F.W + (size_t)l * WL_SIZE; const float* mg = in_ptr(F, I_MIXG) + l * DM;
        const float* win = in_ptr(F, I_WIN) + (size_t)l * DM * 6400;
        conv_run(F, ConvJob{win, DM, 6400, 0, NABC, WL + WL_ABC, DM, 0, 0, mg});
        conv_run(F, ConvJob{win, DM, 6400, NABC, NGATE, WL + WL_G, DM, 0, 0, mg});
        conv_run(F, ConvJob{in_ptr(F, I_PROJA) + (size_t)l * AW * DM, AW, DM, 0, DM, WL + WL_P, NY, 0, 0, nullptr});
        conv_run(F, ConvJob{in_ptr(F, I_PROJB) + (size_t)l * AW * DM, AW, DM, 0, DM, WL + WL_P, NY, AW, 0, nullptr});
        conv_run(F, ConvJob{in_ptr(F, I_PROJC) + (size_t)l * AW * DM, AW, DM, 0, DM, WL + WL_P, NY, 2 * AW, 0, nullptr});
        conv_run(F, ConvJob{in_ptr(F, I_WOUT) + (size_t)l * DM * DM, DM, DM, 0, DM, WL + WL_OUT, DM, 0, 0, nullptr});
        conv_run(F, ConvJob{in_ptr(F, I_W2) + (size_t)l * 64 * AW, 64, AW, 0, AW, WL + WL_W2, 64, 0, 0, nullptr});
        conv_run(F, ConvJob{in_ptr(F, I_A2) + (size_t)l * 64 * AW, 64, AW, 0, AW, WL + WL_A2, 64, 0, 0, nullptr});
        conv_run(F, ConvJob{in_ptr(F, I_G2) + (size_t)l * 128 * AW, 128, AW, 0, AW, WL + WL_G2, 128, 0, 0, nullptr});
        for (int g = 0; g < 4; ++g) conv_run(F, ConvJob{in_ptr(F, I_POOLW) + ((size_t)l * 4 + g) * 128 * 128, 128, 128, 0, 128, WL + WL_PW + (size_t)g * 128 * 128, 128, 0, 0, nullptr});
    }
    const float* fg = in_ptr(F, I_FFNG);
    conv_run(F, ConvJob{in_ptr(F, I_FGATE), DM, DFF, 0, DFF, F.W + WF_GU, DM, 0, 1, fg});
    conv_run(F, ConvJob{in_ptr(F, I_FUP), DM, DFF, 0, DFF, F.W + WF_GU, DM, 0, 2, fg});
    conv_run(F, ConvJob{in_ptr(F, I_FDOWN), DFF, DM, 0, DM, F.W + WF_D, DFF, 0, 0, nullptr});
}
__device__ __forceinline__ void convert_experts(Frame& F) {
    PHASE_ENTER(F);
    const float* fg = in_ptr(F, I_FFNG) + DM;
    for (int e = 0; e < NEXP; ++e) {
        conv_run(F, ConvJob{in_ptr(F, I_EGATE) + (size_t)e * DM * DFF, DM, DFF, 0, DFF, F.WE + WE_GU + (size_t)e * NGU * DM, DM, 0, 1, fg});
        conv_run(F, ConvJob{in_ptr(F, I_EUP) + (size_t)e * DM * DFF, DM, DFF, 0, DFF, F.WE + WE_GU + (size_t)e * NGU * DM, DM, 0, 2, fg});
        conv_run(F, ConvJob{in_ptr(F, I_EDOWN) + (size_t)e * DFF * DM, DFF, DM, 0, DM, F.WE + WE_D + (size_t)e * DM * DFF, DFF, 0, 0, nullptr});
    }
}
__device__ __forceinline__ void x_to_hb(Frame& F) {
    PHASE_ENTER(F);
    const int gw = F.bid * 8 + F.wave, NGW = F.G * 8;
    for (int r = gw; r < NROWS; r += NGW) {
        const float* src = r < NREAL ? in_ptr(F, I_X) + (size_t)r * DM : in_ptr(F, I_META) + (size_t)(r - MBASE) * DM;
        const f32x4* xr = (const f32x4*)src + F.lane; u32x2* o = (u32x2*)(F.HB + (size_t)r * DM) + F.lane; float sq = 0.f;
#pragma unroll
        for (int j = 0; j < 4; ++j) { const f32x4 v = xr[64 * j]; u32x2 w; w.x = cvt_pk_bf16(v[0], v[1]); w.y = cvt_pk_bf16(v[2], v[3]); o[64 * j] = w;
            const float a = bf_lo(w.x), b = bf_hi(w.x), c = bf_lo(w.y), d = bf_hi(w.y); sq += (a * a + b * b) + (c * c + d * d); }
        sq = wave_sum(sq);
        if (r < NREAL && F.lane < 4) F.SS[(size_t)r * 4 + F.lane] = F.lane == 0 ? sq : 0.f;
    }
}

__device__ __forceinline__ float meta_tile(Frame& F, const bf16_t* A16, int lda, const bf16_t* Bt, int ldb, int K, int brow0) {
    LAS float* red = (LAS float*)F.lds;
    const int kw = K / 8, k0 = F.wave * kw, fr = F.lane & 15, fq = F.lane >> 4;
    f32x4 acc = (f32x4){0.f, 0.f, 0.f, 0.f};
    const bf16_t* ap = A16 + (size_t)fr * lda + k0 + 8 * fq; const bf16_t* bp = Bt + (size_t)(brow0 + fr) * ldb + k0 + 8 * fq;
    for (int k = 0; k < kw; k += 32) { const bf16x8 a = *(const bf16x8*)(ap + k), b = *(const bf16x8*)(bp + k); acc = __builtin_amdgcn_mfma_f32_16x16x32_bf16(b, a, acc, 0, 0, 0); }
#pragma unroll
    for (int j = 0; j < 4; ++j) red[F.wave * 256 + fr * 16 + 4 * fq + j] = acc[j];
    __syncthreads();
    float v = 0.f;
    if (F.tid < 256) {
#pragma unroll
        for (int w = 0; w < 8; ++w) v += red[w * 256 + F.tid];
    }
    __syncthreads();
    return v;
}


__device__ __forceinline__ void meta_rstd_setup(Frame& F) {
    LAS float* mrs = (LAS float*)(F.lds + 8192);
#pragma unroll
    for (int i = 0; i < 2; ++i) { const int row = 2 * F.wave + i; float hv[16]; const bf16_t* hp = F.HB + (size_t)(MBASE + row) * DM + 16 * F.lane;
        unpack8(*(const u32x4*)hp, *(float(*)[8])&hv[0]); unpack8(*(const u32x4*)(hp + 8), *(float(*)[8])&hv[8]); float sq = 0.f;
#pragma unroll
        for (int j = 0; j < 16; ++j) sq += hv[j] * hv[j];
        sq = wave_sum(sq); if (F.lane == 0) mrs[row] = __builtin_amdgcn_rsqf(sq * (1.0f / DM) + RMS_EPS); }
    __syncthreads();
}
#define META_RS(F, row16) (((const LAS float*)((F).lds + 8192))[row16])

__device__ __forceinline__ void prep_afrags(bf16x8 (&af)[8], const bf16_t* U, const float* mu, int row, int fq) {
    const int prow = prev_row(row), pr = prow >= 0 ? prow : row; const float pm = prow >= 0 ? 1.0f : 0.0f;
    u32x4 rc[8], rp[8];
#pragma unroll
    for (int s = 0; s < 8; ++s) { const int col = 1536 + 32 * s + 8 * fq; rc[s] = *(const u32x4*)(U + (size_t)row * NABC + col); rp[s] = *(const u32x4*)(U + (size_t)pr * NABC + col); }
#pragma unroll
    for (int s = 0; s < 8; ++s) {
        const int col = 1536 + 32 * s + 8 * fq;
        float cur[8], prv[8]; unpack8(rc[s], cur); unpack8(rp[s], prv);
        const f32x4 m0 = *(const f32x4*)(mu + col), m1 = *(const f32x4*)(mu + col + 4);
        float x[8];
#pragma unroll
        for (int j = 0; j < 8; ++j) { const float mm = j < 4 ? m0[j] : m1[j - 4]; float v = cur[j] + (pm * prv[j] - cur[j]) * mm;
            if (s < 2) v = 1.0f - 2.0f * __builtin_amdgcn_rcpf(1.0f + __expf(2.0f * v));
            else if (s >= 4) v = fast_sigmoid(v);
            x[j] = v; }
        const u32x4 p = pack8(x); af[s] = __builtin_bit_cast(bf16x8, p);
    }
}
template <int NG> __device__ __forceinline__ void prep_tile(const bf16x8 (&af)[NG][8], const int (&rows)[NG], int ct, int fr, int fq, const bf16_t* w2t, const bf16_t* a2t, const bf16_t* g2t,
                                                            const float* w0, const float* a0, bf16_t* WAw, bf16_t* WAa, bf16_t* Y) {
    const bf16_t* bw = w2t + (size_t)(16 * ct + fr) * 64 + 8 * fq; const bf16_t* ba = a2t + (size_t)(16 * ct + fr) * 64 + 8 * fq; const bf16_t* bg = g2t + (size_t)(16 * ct + fr) * 128 + 8 * fq;
    bf16x8 fw[2], fa[2], fg[4];
#pragma unroll
    for (int s = 0; s < 2; ++s) { fw[s] = *(const bf16x8*)(bw + 32 * s); fa[s] = *(const bf16x8*)(ba + 32 * s); }
#pragma unroll
    for (int s = 0; s < 4; ++s) fg[s] = *(const bf16x8*)(bg + 32 * s);
    const int c = 16 * ct + 4 * fq;
    const f32x4 w0v = *(const f32x4*)(w0 + c), a0v = *(const f32x4*)(a0 + c);
#pragma unroll
    for (int gi = 0; gi < NG; ++gi) {
        f32x4 aw = (f32x4){0.f, 0.f, 0.f, 0.f}, aa = aw, ag = aw;
#pragma unroll
        for (int s = 0; s < 2; ++s) { aw = __builtin_amdgcn_mfma_f32_16x16x32_bf16(fw[s], af[gi][s], aw, 0, 0, 0); aa = __builtin_amdgcn_mfma_f32_16x16x32_bf16(fa[s], af[gi][2 + s], aa, 0, 0, 0); }
#pragma unroll
        for (int s = 0; s < 4; ++s) ag = __builtin_amdgcn_mfma_f32_16x16x32_bf16(fg[s], af[gi][4 + s], ag, 0, 0, 0);
        u32x2 ow, oa, og;
        ow.x = cvt_pk_bf16(0.60653066f * fast_sigmoid(aw[0] + w0v[0]), 0.60653066f * fast_sigmoid(aw[1] + w0v[1])); ow.y = cvt_pk_bf16(0.60653066f * fast_sigmoid(aw[2] + w0v[2]), 0.60653066f * fast_sigmoid(aw[3] + w0v[3]));
        oa.x = cvt_pk_bf16(fast_sigmoid(aa[0] + a0v[0]), fast_sigmoid(aa[1] + a0v[1])); oa.y = cvt_pk_bf16(fast_sigmoid(aa[2] + a0v[2]), fast_sigmoid(aa[3] + a0v[3]));
        og.x = cvt_pk_bf16(ag[0], ag[1]); og.y = cvt_pk_bf16(ag[2], ag[3]);
        const size_t row = rows[gi];
        *(u32x2*)(WAw + row * AW + c) = ow; *(u32x2*)(WAa + row * AW + c) = oa; *(u32x2*)(Y + row * NY + AW + c) = og;
    }
}
__device__ __forceinline__ void phase_prep(Frame& F, int l) {
    PHASE_ENTER(F);
    const bf16_t* U = F.R1; bf16_t* WAw = F.R2; bf16_t* WAa = F.R2 + (size_t)NROWS * AW; bf16_t* Y = F.R3;
    const bf16_t* WL = F.W + (size_t)l * WL_SIZE; const bf16_t* w2t = WL + WL_W2; const bf16_t* a2t = WL + WL_A2; const bf16_t* g2t = WL + WL_G2;
    const float* mu = in_ptr(F, I_MU) + l * AIN; const float* w0 = in_ptr(F, I_W0) + l * AW; const float* a0 = in_ptr(F, I_A0) + l * AW;
    const int fr = F.lane & 15, fq = F.lane >> 4;
    const int gw = F.bid * 8 + F.wave, NGW = F.G * 8;
    for (int grp = gw; grp < NREAL / 16; grp += 2 * NGW) {
        const int grp2 = grp + NGW;
        if (grp2 < NREAL / 16) {
            bf16x8 af[2][8]; const int rows[2] = {grp * 16 + fr, grp2 * 16 + fr};
            prep_afrags(af[0], U, mu, rows[0], fq); prep_afrags(af[1], U, mu, rows[1], fq);
#pragma unroll 2
            for (int ct = 0; ct < 32; ++ct) prep_tile<2>(af, rows, ct, fr, fq, w2t, a2t, g2t, w0, a0, WAw, WAa, Y);
        } else {
            bf16x8 af[1][8]; const int rows[1] = {grp * 16 + fr};
            prep_afrags(af[0], U, mu, rows[0], fq);
#pragma unroll 2
            for (int ct = 0; ct < 32; ++ct) prep_tile<1>(af, rows, ct, fr, fq, w2t, a2t, g2t, w0, a0, WAw, WAa, Y);
        }
    }
    for (int hi = gw; hi < NB * 256; hi += NGW) { const int hb = hi >> 8, hc = (hi & 255) + 1; const int src = hc == 1 ? MBASE + NMETA - 1 : hb * SEQ + 32 * (hc - 1) - 1;
        bf16_t* hd = (bf16_t*)(F.ws + WS_HALO) + (size_t)hi * 1536;
#pragma unroll
        for (int j = 0; j < 3; ++j) *(u32x4*)(hd + 512 * j + 8 * F.lane) = *(const u32x4*)(U + (size_t)src * NABC + 512 * j + 8 * F.lane); }
    if (gw < 32) { bf16x8 af[1][8]; const int rows[1] = {MBASE + fr}; prep_afrags(af[0], U, mu, rows[0], fq); prep_tile<1>(af, rows, gw, fr, fq, w2t, a2t, g2t, w0, a0, WAw, WAa, Y); }
}

constexpr int SC_TOK = 32, SC_VEC = SC_TOK * 64, SC_BUF_F = 5 * SC_VEC + SC_TOK * 16 * 4, SC_BUF = SC_BUF_F * 4, SC_YB = 2 * SC_BUF, SC_NCH = 1 + SEQ / SC_TOK;
template <int N> __device__ __forceinline__ float ror16(float v) { return __builtin_bit_cast(float, __builtin_amdgcn_update_dpp(0, __builtin_bit_cast(int, v), 0x120 + N, 0xf, 0xf, false)); }
__device__ __forceinline__ float allreduce16(float v) { v += ror16<8>(v); v += ror16<4>(v); v += ror16<2>(v); v += ror16<1>(v); return v; }
struct ScanRegs { u32x4 zr, zrp, zk, zkp, ww, aa, zv, zvp; };
__device__ __forceinline__ void scan_load(ScanRegs& R, const bf16_t* U, const bf16_t* WAw, const bf16_t* WAa, int b, int h, int q, int c, int sw, int lane) {
    c = c < SC_NCH ? c : SC_NCH - 1;
    const int ntok = c == 0 ? NMETA : SC_TOK, p0 = c == 0 ? 0 : NMETA + SC_TOK * (c - 1), per = ntok / 4, i0 = lane >> 3, i = i0 < per ? i0 : per - 1, o = lane & 7;
    const int p = p0 + sw * per + i, row = row_of(b, p), prow = row_of(b, p > 0 ? p - 1 : 0), ch = h * 64 + 8 * o, cv = 1024 + h * 64 + 16 * q + 8 * (o & 1);
    R.zr = *(const u32x4*)(U + (size_t)row * NABC + ch); R.zk = *(const u32x4*)(U + (size_t)row * NABC + 512 + ch);
    R.ww = *(const u32x4*)(WAw + (size_t)row * AW + ch); R.aa = *(const u32x4*)(WAa + (size_t)row * AW + ch);
    R.zv = *(const u32x4*)(U + (size_t)row * NABC + cv);
    R.zrp = *(const u32x4*)(U + (size_t)prow * NABC + ch); R.zkp = *(const u32x4*)(U + (size_t)prow * NABC + 512 + ch); R.zvp = *(const u32x4*)(U + (size_t)prow * NABC + cv);
}
__device__ __forceinline__ void scan_stage(const ScanRegs& R, LAS float* buf, int c, int sw, int lane, const float (&mur)[8], const float (&muk)[8], const float (&muv)[8], const float (&kkc)[8], const float (&kac)[8]) {
    const int ntok = c == 0 ? NMETA : SC_TOK, per = ntok / 4, i = lane >> 3, o = lane & 7;
    if (i < per) {
        const int tt = sw * per + i;
        float zr[8], zrp[8], zk[8], zkp[8], ww[8], aa[8];
        unpack8(R.zr, zr); unpack8(R.zrp, zrp); unpack8(R.zk, zk); unpack8(R.zkp, zkp); unpack8(R.ww, ww); unpack8(R.aa, aa);
        const bool first = (c == 0 && tt == 0);
        if (first) {
#pragma unroll
            for (int j = 0; j < 8; ++j) { zrp[j] = 0.f; zkp[j] = 0.f; } }
        float r[8], kx[8], kk[8], ss = 0.f;
#pragma unroll
        for (int j = 0; j < 8; ++j) { r[j] = zr[j] + (zrp[j] - zr[j]) * mur[j]; kx[j] = zk[j] + (zkp[j] - zk[j]) * muk[j]; kk[j] = kx[j] * kkc[j]; ss += kk[j] * kk[j]; }
        ss = allreduce8(ss);
        const float inv = 1.0f / fmaxf(sqrtf(ss), 1e-12f);
        float av[8], bv[8], dv[8], k2[8], rd[8], br = 0.f, kr = 0.f;
#pragma unroll
        for (int j = 0; j < 8; ++j) { const float kn = kk[j] * inv; av[j] = -kn; bv[j] = kn * aa[j]; dv[j] = __expf(-ww[j]); k2[j] = kx[j] * (1.0f + (aa[j] - 1.0f) * kac[j]); rd[j] = dv[j] * r[j];
            br += bv[j] * r[j]; kr += k2[j] * r[j]; }
        br = allreduce8(br); kr = allreduce8(kr);
        LAS float* dst = buf + tt * 64 + 8 * o;
        *(LAS f32x4*)(dst + 0 * SC_VEC) = (f32x4){av[0], av[1], av[2], av[3]}; *(LAS f32x4*)(dst + 0 * SC_VEC + 4) = (f32x4){av[4], av[5], av[6], av[7]};
        *(LAS f32x4*)(dst + 1 * SC_VEC) = (f32x4){bv[0], bv[1], bv[2], bv[3]}; *(LAS f32x4*)(dst + 1 * SC_VEC + 4) = (f32x4){bv[4], bv[5], bv[6], bv[7]};
        *(LAS f32x4*)(dst + 2 * SC_VEC) = (f32x4){dv[0], dv[1], dv[2], dv[3]}; *(LAS f32x4*)(dst + 2 * SC_VEC + 4) = (f32x4){dv[4], dv[5], dv[6], dv[7]};
        *(LAS f32x4*)(dst + 3 * SC_VEC) = (f32x4){k2[0], k2[1], k2[2], k2[3]}; *(LAS f32x4*)(dst + 3 * SC_VEC + 4) = (f32x4){k2[4], k2[5], k2[6], k2[7]};
        *(LAS f32x4*)(dst + 4 * SC_VEC) = (f32x4){rd[0], rd[1], rd[2], rd[3]}; *(LAS f32x4*)(dst + 4 * SC_VEC + 4) = (f32x4){rd[4], rd[5], rd[6], rd[7]};
        if (o < 2) { float zv[8], zvp[8]; unpack8(R.zv, zv); unpack8(R.zvp, zvp); float v[8];
            if (first) {
#pragma unroll
                for (int j = 0; j < 8; ++j) zvp[j] = 0.f; }
#pragma unroll
            for (int j = 0; j < 8; ++j) { v[j] = zv[j] + (zvp[j] - zv[j]) * muv[j]; }
            LAS float* vd = buf + 5 * SC_VEC + (tt * 16 + 8 * o) * 4;
#pragma unroll
            for (int j = 0; j < 8; ++j) *(LAS f32x4*)(vd + 4 * j) = (f32x4){v[j], br, kr, 0.f}; }
    }
}
struct StepIn { f32x4 a, b, d, k, rd, vs; };
template <int J> __device__ __forceinline__ void step_load(StepIn& I, unsigned avec, unsigned avs) {
    asm volatile("ds_read_b128 %0, %1 offset:%2" : "=v"(I.a) : "v"(avec), "n"(J * 256));
    asm volatile("ds_read_b128 %0, %1 offset:%2" : "=v"(I.b) : "v"(avec), "n"(J * 256 + 8192));
    asm volatile("ds_read_b128 %0, %1 offset:%2" : "=v"(I.d) : "v"(avec), "n"(J * 256 + 16384));
    asm volatile("ds_read_b128 %0, %1 offset:%2" : "=v"(I.k) : "v"(avec), "n"(J * 256 + 24576));
    asm volatile("ds_read_b128 %0, %1 offset:%2" : "=v"(I.rd) : "v"(avec), "n"(J * 256 + 32768));
    asm volatile("ds_read_b128 %0, %1 offset:%2" : "=v"(I.vs) : "v"(avs), "n"(J * 256));
}
#define STEP_WAIT(I, n) asm volatile("s_waitcnt lgkmcnt(" #n ")" : "+v"(I.a), "+v"(I.b), "+v"(I.d), "+v"(I.k), "+v"(I.rd), "+v"(I.vs))
static_assert(SC_VEC * 4 == 8192, "asm offsets");
__device__ __forceinline__ float step_compute(const StepIn& I, f32x2& S01, f32x2& S23) {
    const f32x2 a01 = {I.a[0], I.a[1]}, a23 = {I.a[2], I.a[3]}, r01 = {I.rd[0], I.rd[1]}, r23 = {I.rd[2], I.rd[3]};
    f32x2 q = S01 * a01; q = S23 * a23 + q; f32x2 w = S01 * r01; w = S23 * r23 + w;
    float p1 = q.x + q.y, p2 = w.x + w.y;
    p1 = allreduce16(p1); p2 = allreduce16(p2);
    const float y = p2 + (p1 * I.vs[1] + I.vs[0] * I.vs[2]);
    const f32x2 pv = {p1, p1}, vv = {I.vs[0], I.vs[0]}, b01 = {I.b[0], I.b[1]}, b23 = {I.b[2], I.b[3]}, k01 = {I.k[0], I.k[1]}, k23 = {I.k[2], I.k[3]}, d01 = {I.d[0], I.d[1]}, d23 = {I.d[2], I.d[3]};
    S01 = S01 * d01 + (pv * b01 + vv * k01); S23 = S23 * d23 + (pv * b23 + vv * k23);
    return y;
}
__device__ __forceinline__ void phase_scan(Frame& F, int l) {
    PHASE_ENTER(F);
    const bf16_t* U = F.R1; const bf16_t* WAw = F.R2; const bf16_t* WAa = F.R2 + (size_t)NROWS * AW; bf16_t* Y = F.R3;
    const float* mu = in_ptr(F, I_MU) + l * AIN; const float* kkp = in_ptr(F, I_KK) + l * AW; const float* kap = in_ptr(F, I_KA) + l * AW;
    const int lane = F.lane, wave = F.wave;
    constexpr int NIT = SC_NCH + 4;
    static_assert(NIT % 3 == 0, "NIT");
    for (int unit = F.bid; unit < NB * 8 * 4; unit += F.G) {
        const int b = unit >> 5, h = (unit >> 2) & 7, q = unit & 3;
        __syncthreads();
        if (wave >= 4) {
            const int sw = wave - 4, o = lane & 7, ch = h * 64 + 8 * o, cv = 1024 + h * 64 + 16 * q + 8 * (o & 1);
            float mur[8], muk[8], muv[8], kkc[8], kac[8];
#pragma unroll
            for (int j = 0; j < 8; ++j) { mur[j] = mu[ch + j]; muk[j] = mu[512 + ch + j]; muv[j] = mu[cv + j]; kkc[j] = kkp[ch + j]; kac[j] = kap[ch + j]; }
            ScanRegs R0, R1, R2; scan_load(R0, U, WAw, WAa, b, h, q, 0, sw, lane); scan_load(R1, U, WAw, WAa, b, h, q, 1, sw, lane);
#define SC_FLUSH(kk_) do { const int c_ = (kk_) - 2; if (c_ >= 0 && c_ < SC_NCH) { const int ntok_ = c_ == 0 ? NMETA : SC_TOK, p0_ = c_ == 0 ? 0 : NMETA + SC_TOK * (c_ - 1); \
                const LAS float* yb_ = (const LAS float*)(F.lds + SC_YB + (c_ & 1) * (SC_TOK * 16 * 4)); const int t2_ = sw * 64 + lane, tt_ = t2_ >> 3, pr_ = t2_ & 7; \
                if (tt_ < ntok_ && (b == 0 || c_ > 0)) { const int row_ = row_of(b, p0_ + tt_); \
                    *(unsigned*)(Y + (size_t)row_ * NY + h * 64 + 16 * q + 2 * pr_) = cvt_pk_bf16(yb_[tt_ * 16 + 2 * pr_], yb_[tt_ * 16 + 2 * pr_ + 1]); } } } while (0)
#define SC_SUBIT(kk_, RC_, RL_) do { scan_load(RL_, U, WAw, WAa, b, h, q, (kk_) + 2, sw, lane); \
                if ((kk_) < SC_NCH) scan_stage(RC_, (LAS float*)(F.lds + ((kk_) & 1) * SC_BUF), (kk_), sw, lane, mur, muk, muv, kkc, kac); \
                SC_FLUSH(kk_); LDS_WAIT(); __builtin_amdgcn_s_barrier(); asm volatile("" ::: "memory"); } while (0)
            for (int k = 0; k < NIT; k += 3) { SC_SUBIT(k, R0, R2); SC_SUBIT(k + 1, R1, R0); SC_SUBIT(k + 2, R2, R1); }
#undef SC_SUBIT
#undef SC_FLUSH
        } else {
            const int rr = lane >> 4, kq = lane & 15, row16 = 4 * wave + rr;
            f32x2 S01 = {0.f, 0.f}, S23 = {0.f, 0.f};
            for (int k = 0; k < NIT; ++k) {
                if (k >= 1 && k <= SC_NCH) {
                    const int c = k - 1, ntok = c == 0 ? NMETA : SC_TOK;
                    const LAS float* buf = (const LAS float*)(F.lds + (c & 1) * SC_BUF);
                    LAS float* yb = (LAS float*)(F.lds + SC_YB + (c & 1) * (SC_TOK * 16 * 4));
                    const unsigned bvec = (unsigned)(size_t)buf + 16u * kq, bvs = (unsigned)(size_t)buf + (5 * SC_VEC + row16 * 4) * 4u;
                    for (int t0 = 0; t0 < ntok; t0 += 16) {
                        float yk = 0.f; StepIn I0, I1, I2;
                        const unsigned v0 = bvec + t0 * 256u, w0 = bvs + t0 * 256u;
#define SC_LD(I, j) step_load<j>(I, v0, w0)
#define SC_ST(I, j, n) do { STEP_WAIT(I, n); const float y_ = step_compute(I, S01, S23); yk = (kq == (j)) ? y_ : yk; } while (0)
                        SC_LD(I0, 0); SC_LD(I1, 1);
                        SC_LD(I2, 2); SC_ST(I0, 0, 12); SC_LD(I0, 3); SC_ST(I1, 1, 12); SC_LD(I1, 4); SC_ST(I2, 2, 12);
                        SC_LD(I2, 5); SC_ST(I0, 3, 12); SC_LD(I0, 6); SC_ST(I1, 4, 12); SC_LD(I1, 7); SC_ST(I2, 5, 12);
                        SC_LD(I2, 8); SC_ST(I0, 6, 12); SC_LD(I0, 9); SC_ST(I1, 7, 12); SC_LD(I1, 10); SC_ST(I2, 8, 12);
                        SC_LD(I2, 11); SC_ST(I0, 9, 12); SC_LD(I0, 12); SC_ST(I1, 10, 12); SC_LD(I1, 13); SC_ST(I2, 11, 12);
                        SC_LD(I2, 14); SC_ST(I0, 12, 12); SC_LD(I0, 15); SC_ST(I1, 13, 12); SC_ST(I2, 14, 6); SC_ST(I0, 15, 0);
#undef SC_LD
#undef SC_ST
                        yb[(t0 + kq) * 16 + row16] = yk;
                    }
                }
                LDS_WAIT(); __builtin_amdgcn_s_barrier(); asm volatile("" ::: "memory");
            }
        }
    }
}

#define LD8(dst, p) float dst[8]; { const f32x4 x0_ = *(const f32x4*)(p), x1_ = *(const f32x4*)((p) + 4); dst[0] = x0_[0]; dst[1] = x0_[1]; dst[2] = x0_[2]; dst[3] = x0_[3]; dst[4] = x1_[0]; dst[5] = x1_[1]; dst[6] = x1_[2]; dst[7] = x1_[3]; }
namespace p2 {
constexpr int X_AT = 0, X_RT = 4096, X_BT = 8192, X_KT = 12288, X_VT = 16384, X_AAB = 20480, X_AAK = 24576, X_MRK = 26624, X_TT = 28672, X_A21 = 30720, X_TC11 = 31232, X_Z1T = 31744, SZ = 32256, NW = 4;
constexpr int G_TT = 0, G_MRB = 2048, G_XA = 4096, G_FA = 8192, G_SZ = 12288;
static_assert(NW * SZ <= LDSCTL_OFF && X_AAK == X_AAB + 4096 && X_MRK == X_AAK + 2048 && X_TT == X_MRK + 2048, "prep2 LDS");
}
constexpr int P2_UNITS = 8 * (1 + NB * 256);
static_assert((size_t)P2_UNITS * p2::G_SZ <= (size_t)NREAL * DM * 4, "scan side blocks");
__device__ __forceinline__ int p2_unit(int b, int h, int c) { return (c == 0 ? 0 : 1 + b * 256 + (c - 1)) * 8 + h; }
namespace ck {
constexpr int PSZ = 26880, NSLOT = 4, O_AT = 0, O_RT = 4096, O_TT = 8192, O_MRB = 10240, O_XA = 12288, O_FA = 14336, O_BT = 16384, O_KT = 20992, BK_LD = 72  , O_VV = 25600  , O_GV = 26624;
constexpr int C_BASE = 132096, O_ST = 0, O_U0T = 2048, O_WT = 3072, O_FLAG = 4096, NCH = 1 + SEQ / 32;
static_assert(NSLOT * PSZ <= LDSCTL_OFF && C_BASE + O_FLAG + 64 <= LDS_BYTES && C_BASE >= PTR_OFF + 8 * 40, "chunked-scan LDS map");
typedef float f32x4v __attribute__((ext_vector_type(4)));
__device__ __forceinline__ f32x4 mma(bf16x8 a, bf16x8 b, f32x4 c) { return __builtin_amdgcn_mfma_f32_16x16x32_bf16(a, b, c, 0, 0, 0); }
__device__ __forceinline__ bf16x8 frag(const LAS unsigned char* base, int ld, int row0, int k0, int lane) { return *(const LAS bf16x8*)(base + ((row0 + (lane & 15)) * ld + k0 + 8 * (lane >> 4)) * 2); }
__device__ __forceinline__ bf16x8 frag16(const LAS unsigned char* base, int ld, int row0, int lane) { const bf16x8 z = {0, 0, 0, 0, 0, 0, 0, 0}; const int q = lane >> 4; bf16x8 v = *(const LAS bf16x8*)(base + ((row0 + (lane & 15)) * ld + 8 * (q & 1)) * 2); return q < 2 ? v : z; }
__device__ __forceinline__ void lds_spin(volatile LAS unsigned* p, unsigned want) { while (*p < want) __builtin_amdgcn_s_sleep(1); }
__device__ __forceinline__ bf16x8 frag_tr(const LAS unsigned char* base, int pitch, int k0, int n0, int lane) {
    const unsigned a0 = (unsigned)(size_t)base + (unsigned)((k0 + 8 * (lane >> 4) + ((lane >> 2) & 3)) * pitch + n0 * 2 + 8 * (lane & 3)), a1 = a0 + 4u * (unsigned)pitch;
    u32x2 lo, hi; asm volatile("ds_read_b64_tr_b16 %0, %2\n\tds_read_b64_tr_b16 %1, %3\n\ts_waitcnt lgkmcnt(0)" : "=&v"(lo), "=&v"(hi) : "v"(a0), "v"(a1) : "memory");
    const u32x4 v = {lo.x, lo.y, hi.x, hi.y}; return __builtin_bit_cast(bf16x8, v);
}
}
#define LD8G(dst, p) float dst[8]; { const f32x4 x0_ = *(const GAS f32x4*)(p), x1_ = *(const GAS f32x4*)((p) + 4); dst[0] = x0_[0]; dst[1] = x0_[1]; dst[2] = x0_[2]; dst[3] = x0_[3]; dst[4] = x1_[0]; dst[5] = x1_[1]; dst[6] = x1_[2]; dst[7] = x1_[3]; }
__device__ __forceinline__ bf16x8 pack_acc(f32x4 a, f32x4 b) { const u32x4 v = {cvt_pk_bf16(a[0], a[1]), cvt_pk_bf16(a[2], a[3]), cvt_pk_bf16(b[0], b[1]), cvt_pk_bf16(b[2], b[3])}; return __builtin_bit_cast(bf16x8, v); }
struct TrF { u32x2 lo, hi; };
__device__ __forceinline__ void tr_issue(TrF& f, const LAS unsigned char* base, int pitch, int k0, int n0, int step, int lane) {
    const unsigned a0 = (unsigned)(size_t)base + (unsigned)((k0 + step * (lane >> 4) + ((lane >> 2) & 3)) * pitch + n0 * 2 + 8 * (lane & 3)), a1 = a0 + (unsigned)((step == 8 ? 4 : 16) * pitch);
    asm volatile("ds_read_b64_tr_b16 %0, %2\n\tds_read_b64_tr_b16 %1, %3" : "=&v"(f.lo), "=&v"(f.hi) : "v"(a0), "v"(a1) : "memory");
}
__device__ __forceinline__ bf16x8 tr_get(const TrF& f) { const u32x4 v = {f.lo.x, f.lo.y, f.hi.x, f.hi.y}; return __builtin_bit_cast(bf16x8, v); }
#define TR_WAIT4(a, b, c, d) asm volatile("s_waitcnt lgkmcnt(0)" : "+v"(a.lo), "+v"(a.hi), "+v"(b.lo), "+v"(b.hi), "+v"(c.lo), "+v"(c.hi), "+v"(d.lo), "+v"(d.hi) :: "memory")
#define TR_WAIT5(a, b, c, d, e) asm volatile("s_waitcnt lgkmcnt(0)" : "+v"(a.lo), "+v"(a.hi), "+v"(b.lo), "+v"(b.hi), "+v"(c.lo), "+v"(c.hi), "+v"(d.lo), "+v"(d.hi), "+v"(e.lo), "+v"(e.hi) :: "memory")
__device__ __forceinline__ void ck_fetch(u32x4 (&PR)[24], const bf16_t* U, const bf16_t* WAw, const bf16_t* WAa, const float* GC, const unsigned char* CKX, int b, int h, int q, int c, int lane) {
    c = c < ck::NCH ? c : ck::NCH - 1;
    const int o = lane & 7, ti = lane >> 3, ch = h * 64 + 8 * o; const int p0 = c == 0 ? 0 : NMETA + 32 * (c - 1), nreal = c == 0 ? NMETA : 32;
#pragma unroll
    for (int p = 0; p < 4; ++p) { const int t = 8 * p + ti; const size_t row = (size_t)row_of(b, p0 + (t < nreal ? t : 0));
        PR[p] = *(const GAS u32x4*)(WAw + row * AW + ch); PR[4 + p] = *(const GAS u32x4*)(WAa + row * AW + ch);
        PR[8 + p] = *(const GAS u32x4*)(U + row * NABC + ch); PR[12 + p] = *(const GAS u32x4*)(U + row * NABC + 512 + ch); }
    { const int t = lane >> 1; PR[16] = *(const GAS u32x4*)(U + (size_t)row_of(b, p0 + (t < nreal ? t : 0)) * NABC + 1024 + h * 64 + 16 * q + 8 * (lane & 1)); }
    const unsigned char* gx = CKX + (size_t)p2_unit(b, h, c) * p2::G_SZ;
    PR[17] = *(const GAS u32x4*)(gx + p2::G_TT + lane * 32); PR[18] = *(const GAS u32x4*)(gx + p2::G_TT + lane * 32 + 16);
    PR[19] = *(const GAS u32x4*)(gx + p2::G_MRB + lane * 32); PR[20] = *(const GAS u32x4*)(gx + p2::G_MRB + lane * 32 + 16);
    { const u32x2 x0 = *(const GAS u32x2*)(gx + p2::G_XA + ((q * 2 + 0) * 64 + lane) * 8), x1 = *(const GAS u32x2*)(gx + p2::G_XA + ((q * 2 + 1) * 64 + lane) * 8);
      const u32x2 f0 = *(const GAS u32x2*)(gx + p2::G_FA + ((q * 2 + 0) * 64 + lane) * 8), f1 = *(const GAS u32x2*)(gx + p2::G_FA + ((q * 2 + 1) * 64 + lane) * 8);
      PR[21] = (u32x4){x0.x, x0.y, x1.x, x1.y}; PR[22] = (u32x4){f0.x, f0.y, f1.x, f1.y}; }
    PR[23] = *(const GAS u32x4*)(GC + ((size_t)((c == 0 ? 0 : b) * 8 + h) * 257 + c) * 64 + 4 * (lane & 15));
}
__device__ __forceinline__ void ck_put(LAS unsigned char* pb, const u32x4 (&PR)[24], int c, int lane) {
    using namespace ck;
    const int o = lane & 7, ti = lane >> 3; const int nreal = c == 0 ? NMETA : 32; const u32x4 z4 = {0u, 0u, 0u, 0u};
    const int o4 = o & 3, gl = (4 * (o4 & 1) + (o4 >> 1)) * 8 + (o >> 2) * 64;
#pragma unroll
    for (int p = 0; p < 4; ++p) { const int t = 8 * p + ti; const bool real = t < nreal; const u32x4 xa = real ? PR[p] : z4, xr = real ? PR[8 + p] : z4;
        *(LAS u32x2*)(pb + O_AT + t * 128 + gl) = (u32x2){xa.x, xa.y}; *(LAS u32x2*)(pb + O_AT + t * 128 + gl + 16) = (u32x2){xa.z, xa.w};
        *(LAS u32x2*)(pb + O_RT + t * 128 + gl) = (u32x2){xr.x, xr.y}; *(LAS u32x2*)(pb + O_RT + t * 128 + gl + 16) = (u32x2){xr.z, xr.w};
        *(LAS u32x4*)(pb + O_BT + (t * BK_LD + 8 * o) * 2) = real ? PR[4 + p] : z4; *(LAS u32x4*)(pb + O_KT + (t * BK_LD + 8 * o) * 2) = real ? PR[12 + p] : z4; }
    *(LAS u32x4*)(pb + O_VV + lane * 16) = (lane >> 1) < nreal ? PR[16] : z4;
    { const int trow = lane >> 1, hf = lane & 1;
#pragma unroll
      for (int e = 0; e < 2; ++e) { const int o5 = 2 * hf + e, g5 = (4 * (o5 & 1) + (o5 >> 1)) * 8; const u32x4 xt = PR[17 + e], xm = PR[19 + e];
          *(LAS u32x2*)(pb + O_TT + trow * 64 + g5) = (u32x2){xt.x, xt.y}; *(LAS u32x2*)(pb + O_TT + trow * 64 + g5 + 16) = (u32x2){xt.z, xt.w};
          *(LAS u32x2*)(pb + O_MRB + trow * 64 + g5) = (u32x2){xm.x, xm.y}; *(LAS u32x2*)(pb + O_MRB + trow * 64 + g5 + 16) = (u32x2){xm.z, xm.w}; } }
    { const u32x4 x = PR[21], f = PR[22];
      *(LAS u32x4*)(pb + O_XA + lane * 16) = (u32x4){x.x << 16, x.x & 0xffff0000u, x.y << 16, x.y & 0xffff0000u}; *(LAS u32x4*)(pb + O_XA + (64 + lane) * 16) = (u32x4){x.z << 16, x.z & 0xffff0000u, x.w << 16, x.w & 0xffff0000u};
      *(LAS u32x4*)(pb + O_FA + lane * 16) = (u32x4){f.x << 16, f.x & 0xffff0000u, f.y << 16, f.y & 0xffff0000u}; *(LAS u32x4*)(pb + O_FA + (64 + lane) * 16) = (u32x4){f.z << 16, f.z & 0xffff0000u, f.w << 16, f.w & 0xffff0000u}; }
    if (lane < 16) *(LAS u32x4*)(pb + O_GV + lane * 16) = PR[23];
}
__device__ __forceinline__ void phase_scan_chunked(Frame& F, int l) {
    PHASE_ENTER(F);
    using namespace ck;
    const bf16_t* U = F.R1; const bf16_t* WAw = F.R2; const bf16_t* WAa = F.R2 + (size_t)NROWS * AW; bf16_t* Y = F.R3;
    const float* GC = (const float*)(F.ws + WS_GC); const unsigned char* CKX = (const unsigned char*)lds_ptr(F.lds, 36);
    const int lane = F.lane, wave = F.wave, fr = lane & 15, fq = lane >> 4;
    LAS unsigned char* cb = F.lds + C_BASE; volatile LAS unsigned* flags = (volatile LAS unsigned*)(cb + O_FLAG);
    for (int u0 = F.bid; u0 < NB * 8 * 4; u0 += F.G) {
        const int unit = F.G == 256 ? (u0 & 7) * 32 + (u0 >> 3) : u0;
        const int b = unit >> 5, h = (unit >> 2) & 7, q = unit & 3;
        __syncthreads();
        if (F.tid < 16) flags[F.tid] = 0u;
        for (int i = F.tid; i < 1024; i += 512) ((LAS unsigned*)(cb + O_ST))[i] = 0u;
        __syncthreads();
        if (wave >= 1 && wave <= NSLOT) {
            const int sl = wave - 1; LAS unsigned char* pb = F.lds + sl * PSZ;
            unsigned n = 0; u32x4 PR[24]; ck_fetch(PR, U, WAw, WAa, GC, CKX, b, h, q, sl, lane);
            for (int c = sl; c < NCH; c += NSLOT, ++n) {
                lds_spin(flags + 4 + sl, n);
                asm volatile("" ::: "memory");
                ck_put(pb, PR, c, lane);
                ck_fetch(PR, U, WAw, WAa, GC, CKX, b, h, q, c + NSLOT, lane);
                asm volatile("s_waitcnt lgkmcnt(0)" ::: "memory");
                if (lane == 0) flags[sl] = n + 1;
            }
        } else if (wave == 0) {
            f32x4 accS[4];
#pragma unroll
            for (int kt = 0; kt < 4; ++kt) accS[kt] = (f32x4){0.f, 0.f, 0.f, 0.f};
            for (int c = 0; c < NCH; ++c) {
                const int s = c & (NSLOT - 1); const unsigned n = (unsigned)(c >> 2);
                const LAS unsigned char* sb = F.lds + s * PSZ;
                lds_spin(flags + s, n + 1);
                asm volatile("" ::: "memory");
                f32x4 u0 = *(const LAS f32x4*)(sb + O_XA + lane * 16), u1 = *(const LAS f32x4*)(sb + O_XA + (64 + lane) * 16);
                const bf16x8 a00 = frag(sb + O_AT, 64, 0, 0, lane), a01 = frag(sb + O_AT, 64, 0, 32, lane), a10 = frag(sb + O_AT, 64, 16, 0, lane), a11 = frag(sb + O_AT, 64, 16, 32, lane);
                const bf16x8 t0 = frag(sb + O_TT, 32, 0, 0, lane), t1 = frag(sb + O_TT, 32, 16, 0, lane);
                const bf16x8 pA = pack_acc(accS[0], accS[1]), pB = pack_acc(accS[2], accS[3]);
                asm volatile("" ::: "memory");
                f32x4 y0 = *(const LAS f32x4*)(sb + O_FA + lane * 16), y1 = *(const LAS f32x4*)(sb + O_FA + (64 + lane) * 16);
                const bf16x8 r00 = frag(sb + O_RT, 64, 0, 0, lane), r01 = frag(sb + O_RT, 64, 0, 32, lane), r10 = frag(sb + O_RT, 64, 16, 0, lane), r11 = frag(sb + O_RT, 64, 16, 32, lane);
                const bf16x8 m0 = frag(sb + O_MRB, 32, 0, 0, lane), m1 = frag(sb + O_MRB, 32, 16, 0, lane);
                f32x4 g[4];
#pragma unroll
                for (int kt = 0; kt < 4; ++kt) g[kt] = *(const LAS f32x4*)(sb + O_GV + (16 * kt + 4 * fq) * 4);
                u0 = mma(a00, pA, u0); u1 = mma(a10, pA, u1); u0 = mma(a01, pB, u0); u1 = mma(a11, pB, u1);
                y0 = mma(pA, r00, y0); y1 = mma(pA, r10, y1); y0 = mma(pB, r01, y0); y1 = mma(pB, r11, y1);
                TrF fv, fk[4], fb[4];
                tr_issue(fv, sb + O_VV, 32, 0, 0, 8, lane);
#pragma unroll
                for (int kt = 0; kt < 4; ++kt) tr_issue(fk[kt], sb + O_KT, 2 * BK_LD, 0, 16 * kt, 8, lane);
                const bf16x8 pU = pack_acc(u0, u1);
                f32x4 w0 = {0.f, 0.f, 0.f, 0.f}, w1 = w0; w0 = mma(t0, pU, w0); w1 = mma(t1, pU, w1);
                TR_WAIT5(fv, fk[0], fk[1], fk[2], fk[3]);
#pragma unroll
                for (int kt = 0; kt < 4; ++kt) tr_issue(fb[kt], sb + O_BT, 2 * BK_LD, 0, 16 * kt, 4, lane);
                { const bf16x8 fvv = tr_get(fv);
#pragma unroll
                  for (int kt = 0; kt < 4; ++kt) accS[kt] = mma(tr_get(fk[kt]), fvv, accS[kt]); }
                const bf16x8 pW = pack_acc(w0, w1);
                y0 = mma(pW, m0, y0); y1 = mma(pW, m1, y1);
                TR_WAIT4(fb[0], fb[1], fb[2], fb[3]);
                if (lane == 0) flags[4 + s] = n + 1;
#pragma unroll
                for (int kt = 0; kt < 4; ++kt) { accS[kt] = mma(tr_get(fb[kt]), pW, accS[kt]); accS[kt] = accS[kt] * g[kt]; }
                { const int nreal = c == 0 ? NMETA : 32, p0 = c == 0 ? 0 : NMETA + 32 * (c - 1);
                  if (fr < nreal && (b == 0 || c > 0)) *(u32x2*)(Y + (size_t)row_of(b, p0 + fr) * NY + h * 64 + 16 * q + 4 * fq) = (u32x2){cvt_pk_bf16(y0[0], y0[1]), cvt_pk_bf16(y0[2], y0[3])};
                  if (16 + fr < nreal && (b == 0 || c > 0)) *(u32x2*)(Y + (size_t)row_of(b, p0 + 16 + fr) * NY + h * 64 + 16 * q + 4 * fq) = (u32x2){cvt_pk_bf16(y1[0], y1[1]), cvt_pk_bf16(y1[2], y1[3])}; }
            }
        }
    }
    __syncthreads();
}

template <int WIN> __device__ __forceinline__ void pool_group(const bf16_t* U, bf16_t* Y, const bf16_t* pwt, const float* csc, int b, int pbase, int g, int lane) {
    const int fr = lane & 15, fq = lane >> 4, p = pbase + fr, row = row_of(b, p), cnt = (p + 1) < WIN ? (p + 1) : WIN;
    const float inv = 1.0f / (float)cnt;
    int rows[WIN];
#pragma unroll
    for (int i = 0; i < WIN; ++i) rows[i] = row_of(b, p - i > 0 ? p - i : 0);
    bf16x8 af[4];
#pragma unroll
    for (int ks = 0; ks < 4; ++ks) {
        const int col = AIN + 1024 + g * 128 + 32 * ks + 8 * fq;
        float sum[8], z0[8];
        constexpr int NB8 = WIN < 8 ? WIN : 8;
#pragma unroll
        for (int i0 = 0; i0 < WIN; i0 += NB8) {
            u32x4 raw[NB8];
#pragma unroll
            for (int i = 0; i < NB8; ++i) raw[i] = *(const u32x4*)(U + (size_t)rows[i0 + i] * NABC + col);
#pragma unroll
            for (int i = 0; i < NB8; ++i) { float zz[8]; unpack8(raw[i], zz);
                if (i0 + i == 0) {
#pragma unroll
                    for (int j = 0; j < 8; ++j) { z0[j] = zz[j]; sum[j] = zz[j]; } }
                else { const float m = (i0 + i) < cnt ? 1.0f : 0.0f;
#pragma unroll
                    for (int j = 0; j < 8; ++j) sum[j] += m * zz[j]; } }
        }
#pragma unroll
        for (int j = 0; j < 8; ++j) sum[j] = sum[j] * inv - z0[j];
        const u32x4 pk = pack8(sum); af[ks] = __builtin_bit_cast(bf16x8, pk);
    }
    const bf16_t* bw = pwt + (size_t)g * 128 * 128;
#pragma unroll 2
    for (int ctile = 0; ctile < 8; ++ctile) {
        f32x4 acc = (f32x4){0.f, 0.f, 0.f, 0.f};
#pragma unroll
        for (int ks = 0; ks < 4; ++ks) acc = __builtin_amdgcn_mfma_f32_16x16x32_bf16(*(const bf16x8*)(bw + (size_t)(16 * ctile + fr) * 128 + 32 * ks + 8 * fq), af[ks], acc, 0, 0, 0);
        const int c = g * 128 + 16 * ctile + 4 * fq; const f32x4 sc = *(const f32x4*)(csc + c);
        u32x2 o; o.x = cvt_pk_bf16(acc[0] * sc[0], acc[1] * sc[1]); o.y = cvt_pk_bf16(acc[2] * sc[2], acc[3] * sc[3]);
        *(u32x2*)(Y + (size_t)row * NY + 2 * AW + c) = o;
    }
}
constexpr int PB_CW = 0, PB_CT = 31 * 512 * 4, PB_NUNIT = NREAL / 32 + 1;
#ifndef PB_REP
#define PB_REP 0
#endif
__device__ __forceinline__ void pb_unit(int u, int& b, int& p0, int& ntok) { const bool meta = (u == PB_NUNIT - 1); b = meta ? 0 : (u >> 8); p0 = meta ? 0 : NMETA + 32 * (u & 255); ntok = meta ? NMETA : 32; }
template <bool DRY> __device__ __forceinline__ void postbc_a(Frame& F, int l) {
    PHASE_ENTER(F);
    const bf16_t* U = F.R1; const float* BS = (const float*)(F.ws + WS_BS); bf16_t* Y = F.R3;
    const int lane = F.lane, wave = F.wave, c8 = 8 * lane;
    float lxw[8], lxb[8];
#pragma unroll
    for (int j = 0; j < 8; ++j) { lxw[j] = in_ptr(F, I_LNXW)[l * AW + c8 + j]; lxb[j] = in_ptr(F, I_LNXB)[l * AW + c8 + j]; }
    for (int u = F.bid; u < PB_NUNIT; u += F.G) {
        int b, p0, ntok; pb_unit(u, b, p0, ntok);
        for (int tt = wave; tt < ntok; tt += 8) {
            const int p = p0 + tt, row = row_of(b, p);
            float y[8], zv[8], gv[8];
            unpack8(*(const u32x4*)(Y + (size_t)row * NY + c8), y); unpack8(*(const u32x4*)(Y + (size_t)row * NY + AW + c8), gv);
            unpack8(*(const u32x4*)(U + (size_t)row * NABC + 1024 + c8), zv);
            const float bs = BS[(size_t)row * 8 + (lane >> 3)];
            float s = 0.f;
#pragma unroll
            for (int j = 0; j < 8; ++j) s += y[j];
            s = allreduce8(s);
            const float mean = s * (1.0f / 64.0f); float qv = 0.f;
#pragma unroll
            for (int j = 0; j < 8; ++j) { y[j] -= mean; qv += y[j] * y[j]; }
            qv = allreduce8(qv);
            const float rstd = __builtin_amdgcn_rsqf(qv * (1.0f / 64.0f) + LNX_EPS);
            float o[8];
#pragma unroll
            for (int j = 0; j < 8; ++j) o[j] = (y[j] * rstd * lxw[j] + lxb[j] + bs * zv[j]) * gv[j];
            if (DRY) *(u32x4*)((bf16_t*)(F.ws + 962 * MiB) + (size_t)(row & 32767) * AW + c8) = pack8(o); else *(u32x4*)(Y + (size_t)row * NY + c8) = pack8(o);
        }
    }
}
__device__ __forceinline__ void postbc_b(Frame& F, int l) {
    PHASE_ENTER(F);
    const bf16_t* U = F.R1; bf16_t* Y = F.R3;
    LAS float* cw = (LAS float*)(F.lds + PB_CW); LAS bf16_t* ct = (LAS bf16_t*)(F.lds + PB_CT);
    const int lane = F.lane, wave = F.wave, c8 = 8 * lane;
    __syncthreads();
    for (int i = F.tid; i < 31 * 512; i += 512) cw[i] = in_ptr(F, I_CONVW)[(size_t)l * 31 * 512 + i];
    float cvb[8], lng[8], lnb[8];
#pragma unroll
    for (int j = 0; j < 8; ++j) { cvb[j] = in_ptr(F, I_CONVB)[l * AW + c8 + j]; lng[j] = in_ptr(F, I_BLNG)[l * AW + c8 + j]; lnb[j] = in_ptr(F, I_BLNB)[l * AW + c8 + j]; }
    for (int u = F.bid; u < PB_NUNIT; u += F.G) {
        int b, p0, ntok; pb_unit(u, b, p0, ntok);
        __syncthreads();
        {
            u32x4 r1[8], r2[8];
#pragma unroll
            for (int it = 0; it < 8; ++it) { const int idx = F.tid + it * 512, i = idx >> 6, oc = idx & 63, p = p0 - 30 + i; const int row = row_of(b, p > 0 ? p : 0);
                r1[it] = *(const u32x4*)(U + (size_t)row * NABC + AIN + 8 * oc); r2[it] = *(const u32x4*)(U + (size_t)row * NABC + AIN + 512 + 8 * oc); }
#pragma unroll
            for (int it = 0; it < 8; ++it) { const int idx = F.tid + it * 512, i = idx >> 6, oc = idx & 63, p = p0 - 30 + i;
                if (i < 30 + ntok) { float z1[8], z2[8]; unpack8(r1[it], z1); unpack8(r2[it], z2); const float m = p >= 0 ? 1.0f : 0.0f;
#pragma unroll
                    for (int j = 0; j < 8; ++j) z1[j] *= m * fast_sigmoid(z2[j]);
                    *(LAS u32x4*)(ct + i * 512 + 8 * oc) = pack8(z1); } }
        }
        __syncthreads();
        const int TPW = ntok / 8, t0w = wave * TPW;
        {
            float acc[4][8];
#pragma unroll
            for (int i = 0; i < 4; ++i)
#pragma unroll
                for (int j = 0; j < 8; ++j) acc[i][j] = cvb[j];
            float win[4][8];
#pragma unroll
            for (int i = 0; i < 3; ++i) unpack8(*(const LAS u32x4*)(ct + (t0w + i) * 512 + c8), win[i + 1]);
#pragma unroll 2
            for (int jt = 0; jt < 31; ++jt) {
#pragma unroll
                for (int i = 0; i < 3; ++i)
#pragma unroll
                    for (int j = 0; j < 8; ++j) win[i][j] = win[i + 1][j];
                unpack8(*(const LAS u32x4*)(ct + (t0w + jt + 3) * 512 + c8), win[3]);
                const f32x4 w0 = *(const LAS f32x4*)(cw + jt * 512 + c8), w1 = *(const LAS f32x4*)(cw + jt * 512 + c8 + 4);
#pragma unroll
                for (int i = 0; i < 4; ++i)
#pragma unroll
                    for (int j = 0; j < 4; ++j) { acc[i][j] += win[i][j] * w0[j]; acc[i][4 + j] += win[i][4 + j] * w1[j]; }
            }
#pragma unroll
            for (int i = 0; i < 4; ++i) {
                if (i < TPW) {
                    const int row = row_of(b, p0 + t0w + i);
                    float s = 0.f;
#pragma unroll
                    for (int j = 0; j < 8; ++j) s += acc[i][j];
                    const float mean = wave_sum(s) * (1.0f / 512.0f); float qv = 0.f;
#pragma unroll
                    for (int j = 0; j < 8; ++j) { acc[i][j] -= mean; qv += acc[i][j] * acc[i][j]; }
                    const float rstd = __builtin_amdgcn_rsqf(wave_sum(qv) * (1.0f / 512.0f) + LN_EPS);
                    float o[8];
#pragma unroll
                    for (int j = 0; j < 8; ++j) { const float x = acc[i][j] * rstd * lng[j] + lnb[j]; o[j] = x * fast_sigmoid(x); }
                    *(u32x4*)(Y + (size_t)row * NY + AW + c8) = pack8(o);
                }
            }
        }
    }
    __syncthreads();
}
__device__ __forceinline__ void postbc_c(Frame& F, int l) {
    PHASE_ENTER(F);
    const bf16_t* U = F.R1; bf16_t* Y = F.R3; const bf16_t* pwt = F.W + (size_t)l * WL_SIZE + WL_PW; const float* csc = in_ptr(F, I_CSCALE) + l * AW;
    const int lane = F.lane, rg = F.wave & 1, g = F.wave >> 1, fr = lane & 15, fq = lane >> 4;
    LAS unsigned char* tile = F.lds;
    for (int u = F.bid; u < PB_NUNIT; u += F.G) {
        int b, p0, ntok; pb_unit(u, b, p0, ntok);
        __syncthreads();
        {
            u32x4 rr[6];
#pragma unroll
            for (int it = 0; it < 6; ++it) { const int idx = F.tid + it * 512, i = idx >> 6, oc = idx & 63, p = p0 - 15 + i; const int row = row_of(b, p > 0 ? (p < NMETA + SEQ ? p : 0) : 0);
                rr[it] = *(const GAS u32x4*)(U + (size_t)row * NABC + AIN + 1024 + 8 * oc); }
#pragma unroll
            for (int it = 0; it < 6; ++it) { const int idx = F.tid + it * 512, i = idx >> 6, oc = idx & 63, p = p0 - 15 + i;
                if (i < 15 + ntok) *(LAS u32x4*)(tile + (i * 512 + 8 * oc) * 2) = p >= 0 ? rr[it] : (u32x4){0u, 0u, 0u, 0u}; }
        }
        __syncthreads();
        if (rg * 16 < ntok) {
            const int win = 2 << g, t = rg * 16 + fr, p = p0 + t, cnt = (p + 1) < win ? (p + 1) : win; const float inv = 1.0f / (float)cnt;
            const bf16_t* bwp = pwt + (size_t)g * 128 * 128 + (size_t)fr * 128 + 8 * fq;
            bf16x8 bfr[4][4];
#pragma unroll
            for (int ctile = 0; ctile < 4; ++ctile)
#pragma unroll
                for (int ks = 0; ks < 4; ++ks) bfr[ctile][ks] = *(const GAS bf16x8*)(bwp + (size_t)(16 * ctile) * 128 + 32 * ks);
            bf16x8 af[4];
#pragma unroll
            for (int ks = 0; ks < 4; ++ks) {
                const LAS unsigned char* cp = tile + ((15 + t) * 512 + g * 128 + 32 * ks + 8 * fq) * 2;
                float z0[8], sum[8]; unpack8(*(const LAS u32x4*)cp, z0);
#pragma unroll
                for (int j = 0; j < 8; ++j) sum[j] = z0[j];
#pragma unroll 1
                for (int i = 1; i < win; ++i) { float zz[8]; unpack8(*(const LAS u32x4*)(cp - i * 1024), zz);
#pragma unroll
                    for (int j = 0; j < 8; ++j) sum[j] += zz[j]; }
#pragma unroll
                for (int j = 0; j < 8; ++j) sum[j] = sum[j] * inv - z0[j];
                const u32x4 pk = pack8(sum); af[ks] = __builtin_bit_cast(bf16x8, pk);
            }
            const int row = row_of(b, p);
#pragma unroll
            for (int half = 0; half < 2; ++half) {
                if (half == 1) {
#pragma unroll
                    for (int ctile = 0; ctile < 4; ++ctile)
#pragma unroll
                        for (int ks = 0; ks < 4; ++ks) bfr[ctile][ks] = *(const GAS bf16x8*)(bwp + (size_t)(16 * (4 + ctile)) * 128 + 32 * ks);
                }
#pragma unroll
                for (int ct4 = 0; ct4 < 4; ++ct4) {
                    const int ctile = 4 * half + ct4;
                    f32x4 acc = (f32x4){0.f, 0.f, 0.f, 0.f};
#pragma unroll
                    for (int ks = 0; ks < 4; ++ks) acc = __builtin_amdgcn_mfma_f32_16x16x32_bf16(bfr[ct4][ks], af[ks], acc, 0, 0, 0);
                    const int c = g * 128 + 16 * ctile + 4 * fq; const f32x4 sc = *(const GAS f32x4*)(csc + c);
                    u32x2 o; o.x = cvt_pk_bf16(acc[0] * sc[0], acc[1] * sc[1]); o.y = cvt_pk_bf16(acc[2] * sc[2], acc[3] * sc[3]);
                    *(u32x2*)(Y + (size_t)row * NY + 2 * AW + c) = o;
                }
            }
        }
    }
    __syncthreads();
}
__device__ __forceinline__ void phase_postbc(Frame& F, int l) {
    if (PB_REP & 4) postbc_a<true>(F, l); postbc_a<false>(F, l); postbc_b(F, l); if (PB_REP & 1) postbc_b(F, l); postbc_c(F, l); if (PB_REP & 2) postbc_c(F, l);
}

__device__ __forceinline__ void phase_prep2(Frame& F, int l) {
    PHASE_ENTER(F);
    using namespace p2; using ck::frag; using ck::frag16; using ck::frag_tr; using ck::mma;
    bf16_t* U = F.R1; bf16_t* WAw = F.R2; bf16_t* WAa = F.R2 + (size_t)NROWS * AW;
    const bf16_t* HALO = (const bf16_t*)(F.ws + WS_HALO); float* GC = (float*)(F.ws + WS_GC); float* BS = (float*)(F.ws + WS_BS);
    const float* mu = in_ptr(F, I_MU) + l * AIN; const float* kkp = in_ptr(F, I_KK) + l * AW; const float* kap = in_ptr(F, I_KA) + l * AW; const float* rkp = in_ptr(F, I_RK) + l * AW;
    const int lane = F.lane, o = lane & 7, ti = lane >> 3;
    if (F.wave < NW) {
    LAS unsigned char* pb = F.lds + F.wave * SZ; LAS float* cwb = (LAS float*)(pb + X_AAB);
    for (int un = F.bid * NW + F.wave; un < P2_UNITS; un += F.G * NW) {
        const int h = un & 7, rest = un >> 3; const int b = rest == 0 ? 0 : (rest - 1) >> 8, c = rest == 0 ? 0 : ((rest - 1) & 255) + 1;
        const int ch = h * 64 + 8 * o, p0 = c == 0 ? 0 : NMETA + 32 * (c - 1), nreal = c == 0 ? NMETA : 32;
        const bool real = 4 * ti < nreal; const int row0 = row_of(b, p0 + (real ? 4 * ti : 0));
        u32x4 zr[5], zk[5], zv[5], ww[4], aa[4];
        { const bf16_t* prow = (real ? ti : 0) == 0 ? HALO + (size_t)(b * 256 + (c > 0 ? c - 1 : 0)) * 1536 : U + (size_t)(row0 - 1) * NABC;
          zr[0] = *(const GAS u32x4*)(prow + ch); zk[0] = *(const GAS u32x4*)(prow + 512 + ch); zv[0] = *(const GAS u32x4*)(prow + 1024 + ch); }
        { const bf16_t* ur = U + (size_t)row0 * NABC + ch; const bf16_t* wr = WAw + (size_t)row0 * AW + ch; const bf16_t* ar = WAa + (size_t)row0 * AW + ch;
#pragma unroll
          for (int p = 0; p < 4; ++p) { zr[p + 1] = *(const GAS u32x4*)(ur + p * NABC); zk[p + 1] = *(const GAS u32x4*)(ur + p * NABC + 512); zv[p + 1] = *(const GAS u32x4*)(ur + p * NABC + 1024);
              ww[p] = *(const GAS u32x4*)(wr + p * AW); aa[p] = *(const GAS u32x4*)(ar + p * AW); } }
        { const float msk = real ? 1.0f : 0.0f;
#pragma unroll
          for (int p = 0; p < 4; ++p) { float w8[8]; unpack8(ww[p], w8); LAS float* cw = cwb + (4 * ti + p) * 64 + 8 * o;
            *(LAS f32x4*)cw = (f32x4){msk * w8[0], msk * w8[1], msk * w8[2], msk * w8[3]}; *(LAS f32x4*)(cw + 4) = (f32x4){msk * w8[4], msk * w8[5], msk * w8[6], msk * w8[7]}; } }
        LDS_WAIT();
        { LAS float* cw = cwb + lane; float cv_[32];
#pragma unroll
          for (int i = 0; i < 32; ++i) cv_[i] = cw[i * 64];
          asm volatile("" ::: "memory");
#pragma unroll
          for (int i = 1; i < 32; ++i) cv_[i] += cv_[i - 1];
#pragma unroll
          for (int i = 0; i < 32; ++i) cw[i * 64] = cv_[i]; }
        LDS_WAIT();
        float cx[8];
        { const LAS float* cwp = cwb + (ti > 0 ? 4 * ti - 1 : 0) * 64 + 8 * o; const f32x4 x0 = *(const LAS f32x4*)cwp, x1 = *(const LAS f32x4*)(cwp + 4);
#pragma unroll
          for (int j = 0; j < 8; ++j) cx[j] = ti > 0 ? (j < 4 ? x0[j] : x1[j - 4]) : 0.f; }
        {
        LD8G(mur, mu + ch) LD8G(muk, mu + 512 + ch) LD8G(muv, mu + 1024 + ch) LD8G(kkc, kkp + ch) LD8G(kac, kap + ch) LD8G(rkc, rkp + ch)
        int row0s = row0; asm volatile("" : "+v"(row0s));
        bf16_t* ud = U + (size_t)row0s * NABC + ch; bf16_t* wd = WAw + (size_t)row0s * AW + ch; bf16_t* ad = WAa + (size_t)row0s * AW + ch;
        const float msk = real ? 1.0f : 0.0f;
#pragma unroll
        for (int p = 0; p < 4; ++p) {
            const float pm = (c == 0 && ti == 0 && p == 0) ? 0.0f : 1.0f; const int t = 4 * ti + p;
            float r8[8], rp8[8], k8[8], kp8[8], a8[8], v8[8], vp8[8];
            unpack8(zr[p + 1], r8); unpack8(zr[p], rp8); unpack8(zk[p + 1], k8); unpack8(zk[p], kp8); unpack8(aa[p], a8); unpack8(zv[p + 1], v8); unpack8(zv[p], vp8);
            float A[8], B[8], K[8], R[8], V[8], kx[8], kk[8], ss = 0.f, bsum = 0.f;
#pragma unroll
            for (int j = 0; j < 8; ++j) { R[j] = msk * (r8[j] + (pm * rp8[j] - r8[j]) * mur[j]); kx[j] = k8[j] + (pm * kp8[j] - k8[j]) * muk[j]; kk[j] = kx[j] * kkc[j]; ss += kk[j] * kk[j]; V[j] = msk * (v8[j] + (pm * vp8[j] - v8[j]) * muv[j]); }
            ss = allreduce8(ss);
            const float inv = msk / fmaxf(sqrtf(ss), 1e-12f);
#pragma unroll
            for (int j = 0; j < 8; ++j) { const float kn = kk[j] * inv; A[j] = -kn; B[j] = kn * a8[j]; K[j] = msk * kx[j] * (1.0f + (a8[j] - 1.0f) * kac[j]); bsum += R[j] * K[j] * rkc[j]; }
            bsum = allreduce8(bsum);
            const LAS float* cw = cwb + t * 64 + 8 * o; const f32x4 c0 = *(const LAS f32x4*)cw, c1 = *(const LAS f32x4*)(cw + 4);
            float at[8], rt[8], bt[8], kt[8], en[8];
#pragma unroll
            for (int j = 0; j < 8; ++j) { const float ci = j < 4 ? c0[j] : c1[j - 4]; const float ep = __expf(ci); en[j] = __builtin_amdgcn_rcpf(ep);
                at[j] = A[j] * __expf(-cx[j]); rt[j] = R[j] * en[j]; bt[j] = B[j] * ep; kt[j] = K[j] * ep; cx[j] = ci; }
            const u32x4 pa = pack8(at), pr = pack8(rt), pbv = pack8(bt), pk = pack8(kt), pv = pack8(V);
            *(LAS u32x4*)(pb + X_AT + (t * 64 + 8 * o) * 2) = pa; *(LAS u32x4*)(pb + X_RT + (t * 64 + 8 * o) * 2) = pr; *(LAS u32x4*)(pb + X_BT + (t * 64 + 8 * o) * 2) = pbv;
            *(LAS u32x4*)(pb + X_KT + (t * 64 + 8 * o) * 2) = pk; *(LAS u32x4*)(pb + X_VT + (t * 64 + 8 * o) * 2) = pv;
            if (real) {
                *(u32x4*)(wd + p * AW) = pa; *(u32x4*)(ad + p * AW) = pbv; *(u32x4*)(ud + p * NABC) = pr; *(u32x4*)(ud + p * NABC + 512) = pk; *(u32x4*)(ud + p * NABC + 1024) = pv;
                if (o == 0) BS[(size_t)(row0s + p) * 8 + h] = bsum;
            }
            if (p == 3 && ti == 7) { float* gv = GC + ((size_t)(b * 8 + h) * 257 + c) * 64 + 8 * o; *(f32x4*)gv = (f32x4){en[0], en[1], en[2], en[3]}; *(f32x4*)(gv + 4) = (f32x4){en[4], en[5], en[6], en[7]}; }
        }
        }
        LDS_WAIT();
        int ln; asm volatile("v_mbcnt_lo_u32_b32 %0, -1, 0\n\tv_mbcnt_hi_u32_b32 %0, -1, %0" : "=v"(ln)); const int fr = ln & 15, fq = ln >> 4;
        unsigned char* gx0 = (unsigned char*)lds_ptr(F.lds, 36) + (size_t)un * G_SZ; asm volatile("" : "+s"(gx0)); GAS unsigned char* gx = (GAS unsigned char*)gx0;
#pragma unroll
        for (int it = 0; it < 2; ++it)
#pragma unroll
            for (int jt = 0; jt < 2; ++jt) {
                f32x4 ab = {0.f, 0.f, 0.f, 0.f}, ak = ab, rb = ab, rk = ab;
                if (jt <= it) {
#pragma unroll
                    for (int s = 0; s < 2; ++s) { const bf16x8 fb = frag(pb + X_BT, 64, 16 * jt, 32 * s, ln), fk = frag(pb + X_KT, 64, 16 * jt, 32 * s, ln), fa = frag(pb + X_AT, 64, 16 * it, 32 * s, ln), frr = frag(pb + X_RT, 64, 16 * it, 32 * s, ln);
                        ab = mma(fb, fa, ab); ak = mma(fk, fa, ak); rb = mma(fb, frr, rb); rk = mma(fk, frr, rk); }
                }
                const int i = 16 * it + fr, j0 = 16 * jt + 4 * fq;
#pragma unroll
                for (int jj = 0; jj < 4; ++jj) { const bool st = (j0 + jj) < i, inc = (j0 + jj) <= i; ab[jj] = st ? ab[jj] : 0.f; ak[jj] = st ? ak[jj] : 0.f; rb[jj] = inc ? rb[jj] : 0.f; rk[jj] = inc ? rk[jj] : 0.f; }
                asm volatile("" : "+v"(ab), "+v"(ak), "+v"(rb), "+v"(rk));
                *(LAS f32x4*)(pb + X_AAB + (i * 32 + j0) * 4) = ab;
                *(LAS u32x2*)(pb + X_AAK + (i * 32 + j0) * 2) = (u32x2){cvt_pk_bf16(ak[0], ak[1]), cvt_pk_bf16(ak[2], ak[3])};
                *(LAS u32x2*)(pb + X_MRK + (i * 32 + j0) * 2) = (u32x2){cvt_pk_bf16(rk[0], rk[1]), cvt_pk_bf16(rk[2], rk[3])};
                *(u32x2*)(gx + G_MRB + (i * 32 + j0) * 2) = (u32x2){cvt_pk_bf16(rb[0], rb[1]), cvt_pk_bf16(rb[2], rb[3])};
            }
        LDS_WAIT();
        {
            const int blk = (ln >> 4) & 1, jc = ln & 15; float t[16];
            const LAS float* arow = (const LAS float*)(pb + X_AAB) + (16 * blk) * 32 + 16 * blk;
#pragma unroll
            for (int i = 0; i < 16; ++i) { float acc = (i == jc) ? 1.0f : 0.f;
#pragma unroll
                for (int m4 = 0; m4 < 4; ++m4) { if (4 * m4 < i) { const f32x4 a4 = *(const LAS f32x4*)(arow + i * 32 + 4 * m4);
#pragma unroll
                    for (int mm = 0; mm < 4; ++mm) if (4 * m4 + mm < i) acc += a4[mm] * t[4 * m4 + mm]; } }
                t[i] = acc; if ((i & 3) == 3) asm volatile("" ::: "memory"); }
            { const int ar = ln >> 2, ac = 4 * (ln & 3); const f32x4 a4 = *(const LAS f32x4*)(pb + X_AAB + ((16 + ar) * 32 + ac) * 4);
              asm volatile("" ::: "memory");
              *(LAS u32x2*)(pb + X_A21 + (ar * 16 + ac) * 2) = (u32x2){cvt_pk_bf16(a4[0], a4[1]), cvt_pk_bf16(a4[2], a4[3])}; }
            if (ln < 32) {
#pragma unroll
                for (int i = 0; i < 16; ++i) *(LAS unsigned short*)(pb + X_TT + ((16 * blk + i) * 32 + 16 * blk + jc) * 2) = f2bf(t[i]);
                if (blk == 0) {
#pragma unroll
                    for (int i = 0; i < 16; ++i) *(LAS unsigned short*)(pb + X_TT + (i * 32 + 16 + jc) * 2) = 0;
                    u32x4 lo, hi; lo.x = cvt_pk_bf16(t[0], t[1]); lo.y = cvt_pk_bf16(t[2], t[3]); lo.z = cvt_pk_bf16(t[4], t[5]); lo.w = cvt_pk_bf16(t[6], t[7]);
                    hi.x = cvt_pk_bf16(t[8], t[9]); hi.y = cvt_pk_bf16(t[10], t[11]); hi.z = cvt_pk_bf16(t[12], t[13]); hi.w = cvt_pk_bf16(t[14], t[15]);
                    *(LAS u32x4*)(pb + X_TC11 + jc * 32) = lo; *(LAS u32x4*)(pb + X_TC11 + jc * 32 + 16) = hi;
                }
            }
            LDS_WAIT();
            { f32x4 z = {0.f, 0.f, 0.f, 0.f}; z = mma(frag16(pb + X_A21, 16, 0, ln), frag16(pb + X_TC11, 16, 0, ln), z);
              *(LAS u32x2*)(pb + X_Z1T + (fr * 16 + 4 * fq) * 2) = (u32x2){cvt_pk_bf16(z[0], z[1]), cvt_pk_bf16(z[2], z[3])}; }
            LDS_WAIT();
            { f32x4 d = {0.f, 0.f, 0.f, 0.f}; const bf16x8 zz = {0, 0, 0, 0, 0, 0, 0, 0};
              bf16x8 t22 = *(const LAS bf16x8*)(pb + X_TT + ((16 + fr) * 32 + 16 + 8 * (fq & 1)) * 2); t22 = fq < 2 ? t22 : zz;
              d = mma(frag16(pb + X_Z1T, 16, 0, ln), t22, d);
              *(LAS u32x2*)(pb + X_TT + ((16 + fr) * 32 + 4 * fq) * 2) = (u32x2){cvt_pk_bf16(d[0], d[1]), cvt_pk_bf16(d[2], d[3])}; }
            LDS_WAIT();
            { const u32x4 t0 = *(const LAS u32x4*)(pb + X_TT + ln * 32), t1 = *(const LAS u32x4*)(pb + X_TT + ln * 32 + 16); *(u32x4*)(gx + G_TT + ln * 32) = t0; *(u32x4*)(gx + G_TT + ln * 32 + 16) = t1; }
        }
#pragma unroll 1
        for (int vq = 0; vq < 4; ++vq) {
            const bf16x8 fvt = frag_tr(pb + X_VT, 128, 0, 16 * vq, ln);
#pragma unroll
            for (int tt2 = 0; tt2 < 2; ++tt2) {
                f32x4 x = {0.f, 0.f, 0.f, 0.f}, f = x;
                x = mma(frag(pb + X_AAK, 32, 16 * tt2, 0, ln), fvt, x);
                f = mma(fvt, frag(pb + X_MRK, 32, 16 * tt2, 0, ln), f);
                *(u32x2*)(gx + G_XA + ((vq * 2 + tt2) * 64 + ln) * 8) = (u32x2){cvt_pk_bf16(x[0], x[1]), cvt_pk_bf16(x[2], x[3])};
                *(u32x2*)(gx + G_FA + ((vq * 2 + tt2) * 64 + ln) * 8) = (u32x2){cvt_pk_bf16(f[0], f[1]), cvt_pk_bf16(f[2], f[3])};
            }
        }
        LDS_WAIT();
    }
    }
}

__device__ __forceinline__ void phase_router(Frame& F) {
    PHASE_ENTER(F);
    LAS int* hist = (LAS int*)(F.lds + 32768);
    const float* ss = F.SS + 3 * SS_STRIDE;
    u32x4* tokinfo = (u32x4*)(F.ws + RT_TOKINFO); int* slot_tok = (int*)(F.ws + RT_SLOTTOK); int* cnt = (int*)(F.ws + RT_CNT);
    const int lane = F.lane;
    f32x4 wr[16][2];
    { const float* RW = in_ptr(F, I_RW) + (size_t)(16 * lane) * NEXP; const float* fgp = in_ptr(F, I_FFNG) + DM + 16 * lane;
#pragma unroll
      for (int k = 0; k < 16; ++k) { const float gk = fgp[k]; wr[k][0] = *(const f32x4*)(RW + NEXP * k) * gk; wr[k][1] = *(const f32x4*)(RW + NEXP * k + 4) * gk; } }
    for (int blk = F.bid; blk < NREAL / 256; blk += F.G) {
        __syncthreads();
        if (F.tid < NEXP) hist[F.tid] = 0;
        for (int i = F.tid; i < MAXBLK; i += 512) { slot_tok[blk * MAXBLK + i] = -1; ((float*)(F.ws + RT_SLOTRS))[blk * MAXBLK + i] = 0.f; }
        __syncthreads();
        for (int t = F.wave; t < 256; t += 16) {
            const int tok0 = blk * 256 + t, tok1 = tok0 + 8;
            u32x4 raw[2][2];
            raw[0][0] = *(const u32x4*)(F.HB + (size_t)tok0 * DM + 16 * lane); raw[0][1] = *(const u32x4*)(F.HB + (size_t)tok0 * DM + 16 * lane + 8);
            raw[1][0] = *(const u32x4*)(F.HB + (size_t)tok1 * DM + 16 * lane); raw[1][1] = *(const u32x4*)(F.HB + (size_t)tok1 * DM + 16 * lane + 8);
            const float rs2[2] = {rstd_of(ss, tok0), rstd_of(ss, tok1)};
#pragma unroll
            for (int q = 0; q < 2; ++q) {
                const int tok = q == 0 ? tok0 : tok1;
                float hv[16]; unpack8(raw[q][0], *(float(*)[8])&hv[0]); unpack8(raw[q][1], *(float(*)[8])&hv[8]);
                float lg[8];
#pragma unroll
                for (int e = 0; e < 8; ++e) lg[e] = 0.f;
#pragma unroll
                for (int k = 0; k < 16; ++k) {
#pragma unroll
                    for (int e = 0; e < 4; ++e) { lg[e] += hv[k] * wr[k][0][e]; lg[4 + e] += hv[k] * wr[k][1][e]; } }
                const float rs = rs2[q];
#pragma unroll
                for (int e = 0; e < 8; ++e) lg[e] = wave_sum(lg[e]) * rs + in_ptr(F, I_RB)[e];
                int e1 = 0; float l1 = lg[0];
#pragma unroll
                for (int e = 1; e < 8; ++e) if (lg[e] > l1) { l1 = lg[e]; e1 = e; }
                int e2 = -1; float l2 = -3.0e38f;
#pragma unroll
                for (int e = 0; e < 8; ++e) if (e != e1 && lg[e] > l2) { l2 = lg[e]; e2 = e; }
                const float g2 = 1.0f / (1.0f + __expf(l1 - l2)), g1 = 1.0f - g2;
                if (lane == 0) { tokinfo[tok] = (u32x4){(unsigned)(e1 | (e2 << 8)), __float_as_uint(g1), __float_as_uint(g2), 0u}; __hip_atomic_fetch_add(&hist[e1], 1, __ATOMIC_RELAXED, __HIP_MEMORY_SCOPE_WORKGROUP); __hip_atomic_fetch_add(&hist[e2], 1, __ATOMIC_RELAXED, __HIP_MEMORY_SCOPE_WORKGROUP); }
            }
        }
        __syncthreads();
        if (F.tid < NEXP) cnt[blk * NEXP + F.tid] = hist[F.tid];
    }
    __syncthreads();
}
__device__ __forceinline__ void phase_assign(Frame& F) {
    PHASE_ENTER(F);
    LAS int* L = (LAS int*)F.lds;
    const u32x4* tokinfo = (const u32x4*)(F.ws + RT_TOKINFO); int* slot_tok = (int*)(F.ws + RT_SLOTTOK); const int* cnt = (const int*)(F.ws + RT_CNT);
    int* block_e = (int*)(F.ws + RT_CNT + 16384); int* nblkp = (int*)(F.ws + RT_CNT + 32768); int* tokslot = (int*)(F.ws + RT_TOKSLOT);
    for (int blk = F.bid; blk < NREAL / 256; blk += F.G) {
        __syncthreads();
        if (F.tid < 256) {
            const u32x4 c0 = *(const u32x4*)(cnt + F.tid * NEXP), c1 = *(const u32x4*)(cnt + F.tid * NEXP + 4); const unsigned cc[8] = {c0.x, c0.y, c0.z, c0.w, c1.x, c1.y, c1.z, c1.w};
            const float inf = F.tid < blk ? 1.0f : 0.0f;
#pragma unroll
            for (int e = 0; e < NEXP; ++e) { const float tt = wave_sum((float)cc[e]), pp = wave_sum(inf * (float)cc[e]); if (F.lane == 0) { L[64 + F.wave * 16 + e] = (int)tt; L[64 + F.wave * 16 + 8 + e] = (int)pp; } }
        }
        __syncthreads();
        if (F.tid < NEXP) { int tot = 0, pre = 0;
#pragma unroll
            for (int w = 0; w < 4; ++w) { tot += L[64 + w * 16 + F.tid]; pre += L[64 + w * 16 + 8 + F.tid]; } L[F.tid] = tot; L[8 + F.tid] = pre; }
        __syncthreads();
        if (F.tid == 0) { int start = 0; for (int e = 0; e < NEXP; ++e) { L[16 + e] = start; start += (L[e] + 255) & ~255; L[24 + e] = start; }
            if (blk == 0) *nblkp = start >> 8; }
        __syncthreads();
        if (blk == 0) { const int nb_ = L[24 + NEXP - 1] >> 8;
            for (int j = F.tid; j < nb_; j += 512) { int e = 0; while (e < NEXP - 1 && L[24 + e] <= j * 256) ++e; block_e[j] = e; } }
        int e1 = 0, e2 = 0, r1 = 0, r2 = 0; const int w = F.wave, lane = F.lane;
        if (F.tid < 256) {
            const unsigned ee = tokinfo[blk * 256 + F.tid].x; e1 = ee & 0xff; e2 = (ee >> 8) & 0xff;
            const unsigned long long lt = (1ull << lane) - 1ull;
#pragma unroll
            for (int e = 0; e < NEXP; ++e) { const unsigned long long m1 = __ballot(e1 == e), m2 = __ballot(e2 == e);
                if (e1 == e) r1 = __popcll(m1 & lt); if (e2 == e) r2 = __popcll(m1) + __popcll(m2 & lt);
                if (lane == 0) L[32 + w * 8 + e] = __popcll(m1) + __popcll(m2); }
        }
        __syncthreads();
        if (F.tid < 256) {
            int o1 = L[16 + e1] + L[8 + e1], o2 = L[16 + e2] + L[8 + e2];
            for (int ww = 0; ww < w; ++ww) { o1 += L[32 + ww * 8 + e1]; o2 += L[32 + ww * 8 + e2]; }
            const int s1 = o1 + r1, s2 = o2 + r2, tok = blk * 256 + F.tid;
            slot_tok[s1] = tok; slot_tok[s2] = tok; tokslot[2 * tok] = s1; tokslot[2 * tok + 1] = s2;
            { const float rs = rstd_of(F.SS + 3 * SS_STRIDE, tok); float* srs = (float*)(F.ws + RT_SLOTRS); srs[s1] = rs; srs[s2] = rs; }
        }
    }
    __syncthreads();
}
__device__ __forceinline__ void phase_combine(Frame& F) {
    PHASE_ENTER(F);
    const u32x4* tokinfo = (const u32x4*)(F.ws + RT_TOKINFO); const int* tokslot = (const int*)(F.ws + RT_TOKSLOT);
    const int gw = F.bid * 8 + F.wave, NGW = F.G * 8, lane = F.lane;
    f32x4 gf[4];
#pragma unroll
    for (int j = 0; j < 4; ++j) gf[j] = *(const f32x4*)(in_ptr(F, I_FINALG) + 4 * lane + 256 * j);
    float* outp = (float*)lds_ptr(F.lds, 36);
    int tokA = gw, tokB = gw + NGW;
    u32x4 tiA = tokinfo[tokA < NREAL ? tokA : 0], tiB = tokinfo[tokB < NREAL ? tokB : 0];
    u32x2 slA = *(const u32x2*)(tokslot + 2 * (tokA < NREAL ? tokA : 0)), slB = *(const u32x2*)(tokslot + 2 * (tokB < NREAL ? tokB : 0));
    for (; tokA < NREAL; tokA += 2 * NGW, tokB += 2 * NGW) {
        const int nA = tokA + 2 * NGW, nB = tokB + 2 * NGW;
        const u32x4 tinA = tokinfo[nA < NREAL ? nA : 0], tinB = tokinfo[nB < NREAL ? nB : 0];
        const u32x2 slnA = *(const u32x2*)(tokslot + 2 * (nA < NREAL ? nA : 0)), slnB = *(const u32x2*)(tokslot + 2 * (nB < NREAL ? nB : 0));
        const bool hasB = tokB < NREAL; const int tB = hasB ? tokB : tokA;
        const u32x2* hpA = (const u32x2*)(F.HB + (size_t)tokA * DM) + lane; const u32x2* y1A = (const u32x2*)(F.YS + (size_t)slA.x * DM) + lane; const u32x2* y2A = (const u32x2*)(F.YS + (size_t)slA.y * DM) + lane;
        const u32x2* hpB = (const u32x2*)(F.HB + (size_t)tB * DM) + lane; const u32x2* y1B = (const u32x2*)(F.YS + (size_t)(hasB ? slB.x : slA.x) * DM) + lane; const u32x2* y2B = (const u32x2*)(F.YS + (size_t)(hasB ? slB.y : slA.y) * DM) + lane;
        u32x2 hA[4], aA[4], bA[4], hB[4], aB[4], bB[4];
#pragma unroll
        for (int j = 0; j < 4; ++j) { hA[j] = hpA[64 * j]; aA[j] = y1A[64 * j]; bA[j] = y2A[64 * j]; hB[j] = hpB[64 * j]; aB[j] = y1B[64 * j]; bB[j] = y2B[64 * j]; }
#define CMB_ONE(TOK, TI, H, A, B) do { const float g1 = __uint_as_float((TI).y), g2 = __uint_as_float((TI).z); f32x4 v[4]; float sq = 0.f; \
        _Pragma("unroll") for (int j = 0; j < 4; ++j) { \
            v[j][0] = bf_lo(H[j].x) + g1 * bf_lo(A[j].x) + g2 * bf_lo(B[j].x); v[j][1] = bf_hi(H[j].x) + g1 * bf_hi(A[j].x) + g2 * bf_hi(B[j].x); \
            v[j][2] = bf_lo(H[j].y) + g1 * bf_lo(A[j].y) + g2 * bf_lo(B[j].y); v[j][3] = bf_hi(H[j].y) + g1 * bf_hi(A[j].y) + g2 * bf_hi(B[j].y); \
            sq += (v[j][0] * v[j][0] + v[j][1] * v[j][1]) + (v[j][2] * v[j][2] + v[j][3] * v[j][3]); } \
        const float rs = __builtin_amdgcn_rsqf(wave_sum(sq) * (1.0f / DM) + RMS_EPS); \
        f32x4* op = (f32x4*)(outp + (size_t)(TOK) * DM) + lane; \
        _Pragma("unroll") for (int j = 0; j < 4; ++j) op[64 * j] = v[j] * rs * gf[j]; } while (0)
        CMB_ONE(tokA, tiA, hA, aA, bA);
        if (hasB) CMB_ONE(tokB, tiB, hB, aB, bB);
#undef CMB_ONE
        tiA = tinA; tiB = tinB; slA = slnA; slB = slnB;
    }
}

__device__ __forceinline__ SchedGrid grid_sched(Frame& F, int nN, int lda, int ldb, int rev = 0) { return SchedGrid{NREAL / 256, nN, F.G, F.bid, (size_t)256 * lda * 2, (size_t)256 * ldb * 2, rev}; }
__device__ __forceinline__ void phase_g1(Frame& F, int l) {
    PHASE_ENTER(F);
    const bf16_t* Wt = F.W + (size_t)l * WL_SIZE + WL_ABC; const float* ss = F.SS + (size_t)(2 * l) * SS_STRIDE; bf16_t* U = F.R1;
    meta_rstd_setup(F);
    for (int j = F.bid; j < NABC / 16; j += F.G) { const float v = meta_tile(F, F.HB + (size_t)MBASE * DM, DM, Wt, DM, DM, 16 * j);
        if (F.tid < 256) { const int row = MBASE + (F.tid >> 4); U[(size_t)row * NABC + 16 * j + (F.tid & 15)] = f2bf(v * META_RS(F, F.tid >> 4)); } }
    __syncthreads();
    pg8::gemm_phase<EpiScale, SchedGrid, false>(F.lds, F.wave, GemmD{F.HB, Wt, DM, DM, DM}, grid_sched(F, NABC / 256, DM, DM), EpiScale{U, NABC, ss});
}
__device__ __forceinline__ void phase_g2(Frame& F, int l) {
    PHASE_ENTER(F);
    const bf16_t* Wt = F.W + (size_t)l * WL_SIZE + WL_G; const float* ss = F.SS + (size_t)(2 * l) * SS_STRIDE; bf16_t* ZG = F.R1; const float* gb = in_ptr(F, I_GATEB) + l * NGATE;
    if (l == 0) { meta_rstd_setup(F); for (int j = F.bid; j < NGATE / 16; j += F.G) { const float v = meta_tile(F, F.HB + (size_t)MBASE * DM, DM, Wt, DM, DM, 16 * j);
        if (F.tid < 256) { const int row = MBASE + (F.tid >> 4), col = 16 * j + (F.tid & 15); ZG[(size_t)row * NGATE + col] = f2bf(fast_sigmoid(v * META_RS(F, F.tid >> 4) + gb[col])); } }
        __syncthreads(); }
    pg8::gemm_phase<EpiGate, SchedGrid, false>(F.lds, F.wave, GemmD{F.HB, Wt, DM, DM, DM}, grid_sched(F, NGATE / 256, DM, DM), EpiGate{ZG, NGATE, ss, gb});
}
__device__ __forceinline__ void phase_g3(Frame& F, int l) {
    PHASE_ENTER(F);
    const bf16_t* Pt = F.W + (size_t)l * WL_SIZE + WL_P; const bf16_t* ZG = F.R1; const bf16_t* Y = F.R3; bf16_t* MB = F.R2;
    if (l == 0) for (int j = F.bid; j < DM / 16; j += F.G) { float tot = 0.f;
        for (int br = 0; br < 3; ++br) { const float v = meta_tile(F, Y + (size_t)MBASE * NY + br * AW, NY, Pt + br * AW, NY, AW, 16 * j);
            if (F.tid < 256) tot += v * bf2f(ZG[(size_t)(MBASE + (F.tid >> 4)) * NGATE + br * DM + 16 * j + (F.tid & 15)]); }
        if (F.tid < 256) MB[(size_t)(MBASE + (F.tid >> 4)) * DM + 16 * j + (F.tid & 15)] = f2bf(tot); }
    pg8::gemm_phase<EpiMerge3, SchedGrid, false>(F.lds, F.wave, GemmD{Y, Pt, NY, NY, NY}, grid_sched(F, DM / 256, NY, NY, 1), EpiMerge3{MB, ZG});
}
__device__ __forceinline__ void phase_resid(Frame& F, const bf16_t* Amat, int K, const bf16_t* Wt, float* ssn, bool do_meta) {
    PHASE_ENTER(F);
    if (do_meta) for (int j = F.bid; j < DM / 16; j += F.G) { const float v = meta_tile(F, Amat + (size_t)MBASE * K, K, Wt, K, K, 16 * j);
        if (F.tid < 256) { const int row = MBASE + (F.tid >> 4); bf16_t* hp = F.HB + (size_t)row * DM + 16 * j + (F.tid & 15); *hp = f2bf(bf2f(*hp) + v); } }
    pg8::gemm_phase<EpiResid, SchedGrid, false>(F.lds, F.wave, GemmD{Amat, Wt, K, K, K}, grid_sched(F, DM / 256, K, K, K == DFF ? 1 : 0), EpiResid{F.HB, ssn, (LAS float*)(F.lds + 139264)});
}
__device__ __forceinline__ void phase_g5(Frame& F) {
    PHASE_ENTER(F);
    const bf16_t* Wt = F.W + WF_GU; const float* ss = F.SS + SS_STRIDE; bf16_t* HID = F.R1;
    meta_rstd_setup(F);
    for (int j = F.bid; j < DFF / 16; j += F.G) { const int c0 = 16 * j, br = 256 * (c0 / 128) + (c0 % 128);
        const float vg = meta_tile(F, F.HB + (size_t)MBASE * DM, DM, Wt, DM, DM, br), vu = meta_tile(F, F.HB + (size_t)MBASE * DM, DM, Wt, DM, DM, br + 128);
        if (F.tid < 256) { const int row = MBASE + (F.tid >> 4); const float rs = META_RS(F, F.tid >> 4), g = vg * rs, u = vu * rs; HID[(size_t)row * DFF + c0 + (F.tid & 15)] = f2bf(g * fast_sigmoid(g) * u); } }
    __syncthreads();
    pg8::gemm_phase<EpiSwiglu, SchedGrid, false>(F.lds, F.wave, GemmD{F.HB, Wt, DM, DM, DM}, grid_sched(F, NGU / 256, DM, DM), EpiSwiglu{HID, ss, nullptr, 0});
}
__device__ __forceinline__ void moe_range(Frame& F, int pass, int& blk0, int& nb) {
    const int nblk = *(const int*)(F.ws + RT_CNT + 32768); blk0 = pass * PASS0; nb = nblk - blk0; if (nb > (pass == 0 ? PASS0 : MAXBLK - PASS0)) nb = (pass == 0 ? PASS0 : MAXBLK - PASS0); if (nb < 0) nb = 0;
}
__device__ __forceinline__ void phase_g5m(Frame& F, int pass) {
    int blk0, nb; moe_range(F, pass, blk0, nb);
    const int* block_e = (const int*)(F.ws + RT_CNT + 16384); const int* slot_tok = (const int*)(F.ws + RT_SLOTTOK);
    pg8::gemm_phase<EpiSwiglu, SchedMoe, true>(F.lds, F.wave, GemmD{F.HB, F.WE + WE_GU, DM, DM, DM},
        SchedMoe{blk0, nb, NGU / 256, F.G, F.bid, block_e, slot_tok, 0, (size_t)256 * DM * 2, (size_t)NGU * DM * 2, 0}, EpiSwiglu{F.R1, (const float*)(F.ws + RT_SLOTRS), slot_tok, blk0 * 256});
}
__device__ __forceinline__ void phase_g6m(Frame& F, int pass) {
    int blk0, nb; moe_range(F, pass, blk0, nb);
    const int* block_e = (const int*)(F.ws + RT_CNT + 16384); const int* slot_tok = (const int*)(F.ws + RT_SLOTTOK);
    pg8::gemm_phase<EpiStore, SchedMoe, false>(F.lds, F.wave, GemmD{F.R1, F.WE + WE_D, DFF, DFF, DFF},
        SchedMoe{blk0, nb, DM / 256, F.G, F.bid, block_e, slot_tok, (size_t)256 * DFF * 2, (size_t)256 * DFF * 2, (size_t)DM * DFF * 2, 1}, EpiStore{F.YS, DM});
}

#ifndef CK_MODE
#define CK_MODE 1
#endif
constexpr int N_PHASES = 24;
__global__ void __launch_bounds__(512, 2) fwd_kernel(Args args) {
    extern __shared__ __attribute__((aligned(16))) unsigned char lds[];
    Frame F;
    F.lds = (LAS unsigned char*)lds; F.tid = threadIdx.x; F.lane = F.tid & 63; F.wave = __builtin_amdgcn_readfirstlane(F.tid >> 6); F.G = gridDim.x; F.bid = blockIdx.x;
    volatile LAS unsigned* MISC = (volatile LAS unsigned*)(F.lds + LDSCTL_OFF);
    for (int u = F.tid; u < (LDS_BYTES - LDSCTL_OFF) / 4; u += 512) MISC[u] = 0u;
    __syncthreads();
    if (F.tid < 38) { const unsigned long long pv = F.tid < 36 ? (unsigned long long)args.in[F.tid] : (F.tid == 36 ? (unsigned long long)args.out : (unsigned long long)args.ws);
        *(LAS unsigned long long*)(F.lds + PTR_OFF + 8 * F.tid) = pv; }
    __syncthreads();
    frame_ptrs(F);
    const int lo = args.ph_lo, hi = args.ph_hi;
    XcdBarrier bar; bar.bar = (unsigned*)F.ws + CW_BAR + args.li * XCD_BAR_WORDS; bar.x = 0; bar.st = MISC + 8;
    if (hi - lo > 1) bar = xcd_barrier_post((unsigned*)F.ws + CW_BAR + args.li * XCD_BAR_WORDS, MISC + 8);
#ifdef ONLY_PH
#define PH(p) ((p) == ONLY_PH || ((p) - 9) == ONLY_PH)
#else
#define PH(p) (lo <= (p) && (p) < hi)
#endif
#ifndef REP_MASK
#define REP_MASK 0ull
#endif
#define REPS(p) ((REP_MASK >> (p)) & 1ull)
#define SEAM(p) do { if (PH(p) && PH((p) + 1)) { XcdBarrier b2_ = bar; asm volatile("" : "+s"(b2_.bar)); xcd_barrier(b2_, F.wave); } } while (0)
    if (PH(0)) { convert_common(F); x_to_hb(F); if (REPS(0)) { convert_common(F); x_to_hb(F); } } SEAM(0);
    for (int l = 0; l < 2; ++l) {
        const int pb = 1 + 9 * l;
        if (PH(pb + 0)) { phase_g1(F, l); if (REPS(pb + 0)) phase_g1(F, l); } SEAM(pb + 0);
        if (PH(pb + 1)) { phase_prep(F, l); { XcdBarrier b2_ = bar; asm volatile("" : "+s"(b2_.bar)); xcd_barrier(b2_, F.wave); } phase_prep2(F, l); } SEAM(pb + 1);
        if (PH(pb + 2)) { if (CK_MODE != 1) phase_scan(F, l); if (CK_MODE != 0) phase_scan_chunked(F, l); } SEAM(pb + 2);
        if (PH(pb + 3)) phase_postbc(F, l); SEAM(pb + 3);
        if (PH(pb + 4)) { phase_g2(F, l); if (REPS(pb + 4)) phase_g2(F, l); } SEAM(pb + 4);
        if (PH(pb + 5)) { phase_g3(F, l); if (REPS(pb + 5)) phase_g3(F, l); } SEAM(pb + 5);
        if (PH(pb + 6)) phase_resid(F, F.R2, DM, F.W + (size_t)l * WL_SIZE + WL_OUT, F.SS + (size_t)(2 * l + 1) * SS_STRIDE, l == 0); SEAM(pb + 6);
        if (l == 0) {
            if (PH(8)) { phase_g5(F); if (REPS(8)) phase_g5(F); } SEAM(8);
            if (PH(9)) phase_resid(F, F.R1, DFF, F.W + WF_D, F.SS + 2 * SS_STRIDE, true); SEAM(9);
        }
    }
    if (PH(17)) { convert_experts(F); phase_router(F); if (REPS(17)) { convert_experts(F); phase_router(F); } } SEAM(17);
    if (PH(18)) { phase_assign(F); if (REPS(18)) phase_assign(F); } SEAM(18);
    for (int pass = 0; pass < 2; ++pass) {
        if (PH(19 + 2 * pass)) { phase_g5m(F, pass); if (REPS(19 + 2 * pass)) phase_g5m(F, pass); } SEAM(19 + 2 * pass);
        if (PH(20 + 2 * pass)) { phase_g6m(F, pass); if (REPS(20 + 2 * pass)) phase_g6m(F, pass); } SEAM(20 + 2 * pass);
    }
    if (PH(23)) { phase_combine(F); if (REPS(23)) phase_combine(F); }
#undef PH
#undef SEAM
}

#ifndef MK_N_LAUNCHES
#define MK_N_LAUNCHES 1
#endif
extern "C" void kernel_launch(void* const* d_in, const int* in_sizes, int n_in, void* d_out, int out_size, void* d_ws, size_t ws_size, hipStream_t stream) {
    static int grid = 0;
    if (grid == 0) {
        if (n_in != 36 || in_sizes[0] != NREAL * DM || out_size != NREAL * DM || ws_size < WS_END) {
            fprintf(stderr, "kernel_launch: unexpected problem (n_in %d, in0 %d, out %d, ws %zu; need ws >= %zu); nothing launched\n", n_in, n_in > 0 ? in_sizes[0] : -1, out_size, ws_size, (size_t)WS_END); grid = -1; return; }
        int dev = 0, cus = 0, per_cu = 0;
        if (hipGetDevice(&dev) != hipSuccess || hipDeviceGetAttribute(&cus, hipDeviceAttributeMultiprocessorCount, dev) != hipSuccess) { grid = -1; return; }
        if (hipFuncSetAttribute((const void*)fwd_kernel, hipFuncAttributeMaxDynamicSharedMemorySize, LDS_BYTES) != hipSuccess) { fprintf(stderr, "kernel_launch: hipFuncSetAttribute failed\n"); grid = -1; return; }
        if (hipOccupancyMaxActiveBlocksPerMultiprocessor(&per_cu, (const void*)fwd_kernel, 512, LDS_BYTES) != hipSuccess || per_cu < 1) { fprintf(stderr, "kernel_launch: occupancy query says %d blocks per CU\n", per_cu); (void)hipGetLastError(); grid = -1; return; }
        grid = cus;
    }
    if (grid < 0) return;
    if (hipMemsetAsync((char*)d_ws + WS_CTL, 0, CTL_ZERO_BYTES, stream) != hipSuccess) return;
    Args a{};
    for (int i = 0; i < 36; ++i) a.in[i] = (const float*)d_in[i];
    a.out = (float*)d_out; a.ws = (unsigned char*)d_ws;
    if (MK_N_LAUNCHES == 1) { a.ph_lo = 0; a.ph_hi = N_PHASES; a.li = 0; hipLaunchKernelGGL(fwd_kernel, dim3(grid), dim3(512), LDS_BYTES, stream, a); }
    else for (int p = 0; p < N_PHASES; ++p) { a.ph_lo = p; a.ph_hi = p + 1; a.li = 0; hipLaunchKernelGGL(fwd_kernel, dim3(grid), dim3(512), LDS_BYTES, stream, a); }
}
```

```cpp
#include <hip/hip_runtime.h>
#include <cstdio>
#include <cstdint>

#define LAS __attribute__((address_space(3)))
#define GAS __attribute__((address_space(1)))
typedef unsigned short bf16_t;
typedef short bf16x8 __attribute__((ext_vector_type(8)));
typedef float f32x4 __attribute__((ext_vector_type(4)));
typedef float f32x2 __attribute__((ext_vector_type(2)));
typedef unsigned u32x4 __attribute__((ext_vector_type(4)));
typedef unsigned u32x2 __attribute__((ext_vector_type(2)));

constexpr int NB = 8, SEQ = 8192, DM = 1024, NMETA = 16;
constexpr int NREAL = NB * SEQ;
constexpr int MBASE = NREAL;
constexpr int NROWS = NREAL + NMETA;
constexpr int AW = 512, AIN = 1792, NABC = 3328, NGATE = 3072, NY = 1536, DFF = 2816, NGU = 5632, NEXP = 8;
constexpr int MAXBLK = 520, PASS0 = 256;
constexpr float RMS_EPS = 1e-6f, LN_EPS = 1e-5f, LNX_EPS = 64e-5f;

constexpr size_t MiB = 1u << 20;
constexpr size_t WS_CTL = 0, CTL_ZERO_BYTES = 1 * MiB;
constexpr size_t WS_SS = 8 * MiB, SS_STRIDE = (size_t)NREAL * 4;
constexpr size_t WS_RT = 4 * MiB;
constexpr size_t WS_HALO = 1 * MiB;
constexpr size_t WS_GC = 12 * MiB, WS_BS = 17 * MiB;
constexpr size_t RT_SLOTRS = WS_RT + 3 * MiB;
constexpr size_t RT_TOKINFO = WS_RT, RT_SLOTTOK = WS_RT + 1 * MiB, RT_CNT = WS_RT + 2 * MiB, RT_TOKSLOT = WS_RT + 3 * MiB - 512 * 1024;
constexpr size_t WS_W = 24 * MiB, WS_HB = 78 * MiB, WS_R1 = 207 * MiB, WS_R2 = 624 * MiB, WS_R3 = 753 * MiB;
constexpr size_t WS_YS = 570 * MiB, WS_WE = 830 * MiB, WS_END = 962 * MiB;
constexpr size_t WL_ABC = 0, WL_G = WL_ABC + (size_t)NABC * DM, WL_P = WL_G + (size_t)NGATE * DM, WL_OUT = WL_P + (size_t)DM * NY,
                 WL_W2 = WL_OUT + (size_t)DM * DM, WL_A2 = WL_W2 + 512 * 64, WL_G2 = WL_A2 + 512 * 64, WL_PW = WL_G2 + 512 * 128, WL_SIZE = WL_PW + 4 * 128 * 128;
constexpr size_t WF_GU = 2 * WL_SIZE, WF_D = WF_GU + (size_t)NGU * DM, W_TOTAL = WF_D + (size_t)DM * DFF;
static_assert(W_TOTAL * 2 <= 54 * MiB, "weights region");
constexpr size_t WE_GU = 0, WE_D = (size_t)NEXP * NGU * DM;
static_assert((WE_D + (size_t)NEXP * DM * DFF) * 2 <= 132 * MiB, "expert region");
static_assert((size_t)NROWS * NABC * 2 <= 417 * MiB && (size_t)NROWS * NGATE * 2 <= 417 * MiB && (size_t)(MAXBLK - PASS0) * 256 * DFF * 2 <= 363 * MiB, "R1");
static_assert((size_t)NROWS * 1024 * 2 <= 129 * MiB && (size_t)NROWS * NY * 2 <= 193 * MiB && (size_t)MAXBLK * 256 * 1024 * 2 <= 260 * MiB, "R2/R3/YS");
constexpr int CW_BAR = 4096;

constexpr int RING_BYTES = 131072, LDSCTL_OFF = RING_BYTES, LDS_BYTES = 147456;

typedef __bf16 bf16x2_t __attribute__((ext_vector_type(2)));
__device__ __forceinline__ unsigned cvt_pk_bf16(float lo, float hi) { const f32x2 v = {lo, hi}; return __builtin_bit_cast(unsigned, __builtin_convertvector(v, bf16x2_t)); }
__device__ __forceinline__ float bf_lo(unsigned u) { return __uint_as_float(u << 16); }
__device__ __forceinline__ float bf_hi(unsigned u) { return __uint_as_float(u & 0xffff0000u); }
__device__ __forceinline__ float bf2f(bf16_t b) { return __uint_as_float(((unsigned)b) << 16); }
__device__ __forceinline__ bf16_t f2bf(float f) { return (bf16_t)(cvt_pk_bf16(f, 0.f) & 0xffffu); }
__device__ __forceinline__ float fast_sigmoid(float x) { return __builtin_amdgcn_rcpf(1.0f + __expf(-x)); }
template <int CTRL> __device__ __forceinline__ float dpp_mov(float v) { return __builtin_bit_cast(float, __builtin_amdgcn_update_dpp(0, __builtin_bit_cast(int, v), CTRL, 0xf, 0xf, false)); }
__device__ __forceinline__ float allreduce8(float v) { v += dpp_mov<0xB1>(v); v += dpp_mov<0x4E>(v); v += dpp_mov<0x141>(v); return v; }
__device__ __forceinline__ float wave_sum(float v) {
    v = allreduce8(v); v += dpp_mov<0x140>(v);
    const int iv = __builtin_bit_cast(int, v);
    const float a = __builtin_bit_cast(float, __builtin_amdgcn_readlane(iv, 0)), b = __builtin_bit_cast(float, __builtin_amdgcn_readlane(iv, 16)),
                c = __builtin_bit_cast(float, __builtin_amdgcn_readlane(iv, 32)), d = __builtin_bit_cast(float, __builtin_amdgcn_readlane(iv, 48));
    return (a + b) + (c + d);
}
__device__ __forceinline__ void unpack8(const u32x4 w, float (&f)[8]) {
    f[0] = bf_lo(w.x); f[1] = bf_hi(w.x); f[2] = bf_lo(w.y); f[3] = bf_hi(w.y); f[4] = bf_lo(w.z); f[5] = bf_hi(w.z); f[6] = bf_lo(w.w); f[7] = bf_hi(w.w);
}
__device__ __forceinline__ u32x4 pack8(const float (&f)[8]) {
    u32x4 w; w.x = cvt_pk_bf16(f[0], f[1]); w.y = cvt_pk_bf16(f[2], f[3]); w.z = cvt_pk_bf16(f[4], f[5]); w.w = cvt_pk_bf16(f[6], f[7]); return w;
}

namespace pg8 {
constexpr int BM = 256, BK = 64, HALF = 128, HTB = HALF * BK * 2, STAGE_BYTES = 8 * HTB, NXCD = 8, WGM = 8;
__host__ __device__ __forceinline__ int lds_byte(int r, int c) { const int st = (r >> 4) * 2 + (c >> 5), rr = r & 15, cc = c & 31, ob = rr * 64 + cc * 2; return st * 1024 + (ob ^ (((ob >> 9) & 1) << 5)); }
__host__ __device__ __forceinline__ void stage_rc(int b, int& R, int& C) { const int st = b / 1024, sb = b % 1024, swz = sb ^ (((sb >> 9) & 1) << 5); R = (st >> 1) * 16 + swz / 64; C = (st & 1) * 32 + (swz % 64) / 2; }
__host__ __device__ __forceinline__ int perm32(int rho) { const int n = rho >> 4, i = rho & 15; return 8 * (i >> 2) + 4 * n + (i & 3); }

struct Unit { int pm, pn, aux; };
struct GemmD { const bf16_t* A; const bf16_t* Bt; int lda, ldb, K; };

__device__ __forceinline__ void tile_of(int wgid, int nM, int nN, int& pm, int& pn) {
    const int nwg = nM * nN;
    { const int q = nwg / NXCD, r = nwg % NXCD, xcd = wgid % NXCD, off = wgid / NXCD; wgid = (xcd < r ? xcd * (q + 1) : r * (q + 1) + (xcd - r) * q) + off; }
    const int nig = WGM * nN, gid = wgid / nig, fm = gid * WGM, gsz = (nM - fm) < WGM ? (nM - fm) : WGM;
    pm = fm + ((wgid % nig) % gsz); pn = (wgid % nig) / gsz;
}

template <class Epi, class Sched, bool GATHER>
__device__ __forceinline__ void gemm_phase(LAS unsigned char* lds, int wave_id, const GemmD g, const Sched& S, const Epi& E) {
    int lane; asm volatile("v_mbcnt_lo_u32_b32 %0, -1, 0\n\tv_mbcnt_hi_u32_b32 %0, -1, %0" : "=v"(lane), "+s"(wave_id));
    const int wid = wave_id, tid = wid * 64 + lane, wr = wid >> 2, wc = wid & 3, fr = lane & 15, fq = lane >> 4;
    const int K = g.K, nt = K / BK;
    int Rst[2], Cst[2];
    unsigned voffB[2];
#pragma unroll
    for (int i = 0; i < 2; ++i) { int R, C; stage_rc(tid * 16 + i * 8192, R, C); Rst[i] = R; Cst[i] = C; const int Rb = (R & ~31) + perm32(R & 31); voffB[i] = (unsigned)(Rb * g.ldb + C) * 2u; }
    const size_t kstep = (size_t)(BK * 2);
    const size_t hstepB = (size_t)HALF * g.ldb * 2;
    const unsigned ldsw = (unsigned)wid * 1024u;
    const int aoff = lds_byte(wr * 64 + fr, fq * 8), boff = lds_byte(wc * 32 + fr, fq * 8);
#define PG8_SA(b, h) (((b) * 2 + (h)) * HTB)
#define PG8_SB(b, h) ((4 + (b) * 2 + (h)) * HTB)
#define PG8_STAGE(bufoff, gbase, v0, v1) do { \
        __builtin_amdgcn_global_load_lds((const unsigned*)((const char*)(gbase) + (v0)), (LAS unsigned*)(lds + (bufoff) + ldsw), 16, 0, 0); \
        __builtin_amdgcn_global_load_lds((const unsigned*)((const char*)(gbase) + (v1)), (LAS unsigned*)(lds + (bufoff) + ldsw + 8192), 16, 0, 0); } while (0)
#define PG8_STAGE_B(bufoff, gbase) PG8_STAGE(bufoff, gbase, voffB[0], voffB[1])
#define PG8_LDA(dst, b, h) do { _Pragma("unroll") for (int m = 0; m < 4; ++m) _Pragma("unroll") for (int k = 0; k < 2; ++k) dst[m][k] = *(const LAS bf16x8*)(lds + PG8_SA(b, h) + aoff + m * 2048 + k * 1024); } while (0)
#define PG8_LDB(dst, b, h) do { _Pragma("unroll") for (int n = 0; n < 2; ++n) _Pragma("unroll") for (int k = 0; k < 2; ++k) dst[n][k] = *(const LAS bf16x8*)(lds + PG8_SB(b, h) + boff + n * 2048 + k * 1024); } while (0)
#define PG8_MMA(ai, bj, At, Bt) do { __builtin_amdgcn_s_setprio(1); _Pragma("unroll") for (int m = 0; m < 4; ++m) _Pragma("unroll") for (int n = 0; n < 2; ++n) _Pragma("unroll") for (int k = 0; k < 2; ++k) \
        acc[ai][bj][m][n] = __builtin_amdgcn_mfma_f32_16x16x32_bf16(Bt[n][k], At[m][k], acc[ai][bj][m][n], 0, 0, 0); __builtin_amdgcn_s_setprio(0); } while (0)
#define PG8_WAIT_V(n) asm volatile("s_waitcnt vmcnt(" #n ")" ::: "memory")
#define PG8_WAIT_L(n) asm volatile("s_waitcnt lgkmcnt(" #n ")" ::: "memory")
#define PG8_BAR __builtin_amdgcn_s_barrier()
#define PG8_SCHED __builtin_amdgcn_sched_barrier(0)
    Unit cur, nxt; int ui = 0;
    if (!S.next(0, cur)) return;
    bool has_next = S.next(1, nxt);
    unsigned vAc[2][2], vAn[2][2];
#pragma unroll
    for (int h = 0; h < 2; ++h)
#pragma unroll
        for (int i = 0; i < 2; ++i) {
            const int rl = h * HALF + Rst[i];
            if constexpr (GATHER) { vAc[h][i] = (unsigned)(S.a_row(cur, rl) * g.lda + Cst[i]) * 2u; vAn[h][i] = has_next ? (unsigned)(S.a_row(nxt, rl) * g.lda + Cst[i]) * 2u : vAc[h][i]; }
            else { vAc[h][i] = (unsigned)(rl * g.lda + Cst[i]) * 2u; vAn[h][i] = vAc[h][i]; }
        }
    f32x4 acc[2][2][4][2];
#pragma unroll
    for (int a = 0; a < 2; ++a)
#pragma unroll
        for (int b = 0; b < 2; ++b)
#pragma unroll
            for (int m = 0; m < 4; ++m)
#pragma unroll
                for (int n = 0; n < 2; ++n) acc[a][b][m][n] = (f32x4){0.f, 0.f, 0.f, 0.f};
    bf16x8 At[4][2], B0[2][2], B1[2][2];
    const char* cA = (const char*)g.A + S.a_off(cur); const char* cB = (const char*)g.Bt + S.b_off(cur);
    PG8_STAGE_B(PG8_SB(0, 0), cB); PG8_STAGE_B(PG8_SB(0, 1), cB + hstepB); PG8_STAGE(PG8_SA(0, 0), cA, vAc[0][0], vAc[0][1]); PG8_STAGE(PG8_SA(0, 1), cA, vAc[1][0], vAc[1][1]);
    if (wr == 1) PG8_BAR;
    PG8_WAIT_V(2); PG8_BAR;
    PG8_STAGE_B(PG8_SB(1, 0), cB + kstep); PG8_STAGE(PG8_SA(1, 0), cA + kstep, vAc[0][0], vAc[0][1]); PG8_STAGE_B(PG8_SB(1, 1), cB + hstepB + kstep);
    PG8_WAIT_V(6); PG8_BAR;
    for (;;) {
        const char* nA = has_next ? (const char*)g.A + S.a_off(nxt) : cA; const char* nB = has_next ? (const char*)g.Bt + S.b_off(nxt) : cB;
        for (int t = 0; t < nt; t += 2) {
            const bool last = (t == nt - 2);
            if constexpr (Epi::MID_EVERY > 0) { if (t > 0 && t % Epi::MID_EVERY == 0) E.mid(acc, cur, wr, wc, fr, fq, t / Epi::MID_EVERY); }
            const char* a1 = cA + (size_t)(t + 1) * kstep;
            const char* a2 = last ? nA : cA + (size_t)(t + 2) * kstep; const char* b2 = last ? nB : cB + (size_t)(t + 2) * kstep;
            const char* a3 = a2 + kstep; const char* b3 = b2 + kstep;
            unsigned v2[2][2];
#pragma unroll
            for (int h = 0; h < 2; ++h)
#pragma unroll
                for (int i = 0; i < 2; ++i) v2[h][i] = (GATHER && last) ? vAn[h][i] : vAc[h][i];
            PG8_LDB(B0, 0, 0); PG8_LDB(B1, 0, 1); PG8_SCHED; PG8_LDA(At, 0, 0); PG8_STAGE(PG8_SA(1, 1), a1, vAc[1][0], vAc[1][1]);
            PG8_WAIT_V(8); PG8_WAIT_L(0); PG8_BAR; PG8_MMA(0, 0, At, B0); PG8_MMA(0, 1, At, B1); PG8_BAR; PG8_SCHED;
            PG8_LDA(At, 0, 1); PG8_STAGE_B(PG8_SB(0, 0), b2); PG8_STAGE_B(PG8_SB(0, 1), b2 + hstepB); PG8_STAGE(PG8_SA(0, 0), a2, v2[0][0], v2[0][1]);
            PG8_WAIT_V(8); PG8_WAIT_L(0); PG8_BAR; PG8_MMA(1, 0, At, B0); PG8_MMA(1, 1, At, B1); PG8_BAR; PG8_SCHED;
            PG8_LDB(B0, 1, 0); PG8_LDB(B1, 1, 1); PG8_SCHED; PG8_LDA(At, 1, 0); PG8_STAGE(PG8_SA(0, 1), a2, v2[1][0], v2[1][1]);
            PG8_WAIT_V(8); PG8_WAIT_L(0); PG8_BAR; PG8_MMA(0, 0, At, B0); PG8_MMA(0, 1, At, B1); PG8_BAR; PG8_SCHED;
            PG8_LDA(At, 1, 1); PG8_STAGE_B(PG8_SB(1, 0), b3); PG8_STAGE_B(PG8_SB(1, 1), b3 + hstepB); PG8_STAGE(PG8_SA(1, 0), a3, v2[0][0], v2[0][1]);
            PG8_WAIT_V(8); PG8_WAIT_L(0); PG8_BAR; PG8_MMA(1, 0, At, B0); PG8_MMA(1, 1, At, B1); PG8_BAR; PG8_SCHED;
        }
        if (wr == 0) PG8_BAR;
        E(acc, cur, wr, wc, fr, fq);
        if (!has_next) break;
#pragma unroll
        for (int a = 0; a < 2; ++a)
#pragma unroll
            for (int b = 0; b < 2; ++b)
#pragma unroll
                for (int m = 0; m < 4; ++m)
#pragma unroll
                    for (int n = 0; n < 2; ++n) acc[a][b][m][n] = (f32x4){0.f, 0.f, 0.f, 0.f};
        cur = nxt; cA = nA; cB = nB; ++ui;
        has_next = S.next(ui + 1, nxt);
        if constexpr (GATHER) {
#pragma unroll
            for (int h = 0; h < 2; ++h)
#pragma unroll
                for (int i = 0; i < 2; ++i) { vAc[h][i] = vAn[h][i]; if (has_next) vAn[h][i] = (unsigned)(S.a_row(nxt, h * HALF + Rst[i]) * g.lda + Cst[i]) * 2u; }
        }
        if (wr == 1) PG8_BAR;
    }
    PG8_WAIT_V(0);
    PG8_BAR;
#undef PG8_SA
#undef PG8_SB
#undef PG8_STAGE
#undef PG8_STAGE_B
#undef PG8_LDA
#undef PG8_LDB
#undef PG8_MMA
#undef PG8_WAIT_V
#undef PG8_WAIT_L
#undef PG8_BAR
#undef PG8_SCHED
}
}

using pg8::Unit; using pg8::GemmD;
struct SchedGrid {
    int nM, nN, G, c; size_t a_tile, b_tile; int rev;
    __device__ __forceinline__ bool next(int i, Unit& u) const { const long L = (long)i * G + c; if (L >= (long)nM * nN) return false; pg8::tile_of((int)L, nM, nN, u.pm, u.pn); if (rev) u.pm = nM - 1 - u.pm; u.aux = 0; return true; }
    __device__ __forceinline__ size_t a_off(const Unit& u) const { return (size_t)u.pm * a_tile; }
    __device__ __forceinline__ size_t b_off(const Unit& u) const { return (size_t)u.pn * b_tile; }
    __device__ __forceinline__ int a_row(const Unit&, int) const { return 0; }
};
struct SchedMerge {
    int nM, nN, G, c; size_t a_tile, b_tile;
    __device__ __forceinline__ bool next(int i, Unit& u) const { const long L = (long)(i / 3) * G + c; if (L >= (long)nM * nN) return false; pg8::tile_of((int)L, nM, nN, u.pm, u.pn); u.aux = i % 3; return true; }
    __device__ __forceinline__ size_t a_off(const Unit& u) const { return (size_t)u.pm * a_tile + (size_t)u.aux * (AW * 2); }
    __device__ __forceinline__ size_t b_off(const Unit& u) const { return (size_t)u.pn * b_tile + (size_t)u.aux * (AW * 2); }
    __device__ __forceinline__ int a_row(const Unit&, int) const { return 0; }
};
struct SchedMoe {
    int blk0, nblk, nN, G, c; const int* block_e; const int* slot_tok; size_t a_tile, b_tile, b_exp; int rev;
    __device__ __forceinline__ bool next(int i, Unit& u) const { const long L = (long)i * G + c; if (L >= (long)nblk * nN) return false; int pm, pn; pg8::tile_of((int)L, nblk, nN, pm, pn); u.pm = blk0 + (rev ? nblk - 1 - pm : pm); u.pn = pn; u.aux = block_e[u.pm]; return true; }
    __device__ __forceinline__ size_t a_off(const Unit& u) const { return (size_t)(u.pm - blk0) * a_tile; }
    __device__ __forceinline__ size_t b_off(const Unit& u) const { return (size_t)u.aux * b_exp + (size_t)u.pn * b_tile; }
    __device__ __forceinline__ int a_row(const Unit& u, int r) const { const int t = slot_tok[u.pm * 256 + r]; return t < 0 ? 0 : t; }
};

#define EPI_ROWS_BEGIN _Pragma("unroll") for (int ai = 0; ai < 2; ++ai) _Pragma("unroll") for (int m = 0; m < 4; ++m) { const int r = u.pm * 256 + ai * 128 + wr * 64 + m * 16 + fr;
#define EPI_ROWS_END }
__device__ __forceinline__ float rstd_of(const float* ss, int r) {
    const f32x4 a = *(const f32x4*)(ss + (size_t)r * 4);
    return __builtin_amdgcn_rsqf(((a[0] + a[1]) + (a[2] + a[3])) * (1.0f / DM) + RMS_EPS);
}

#define EPI_RSTD8(rsv, ss)  float rsv[2][4]; { f32x4 raw_[2][4]; \
    _Pragma("unroll") for (int ai = 0; ai < 2; ++ai) _Pragma("unroll") for (int m = 0; m < 4; ++m) raw_[ai][m] = *(const f32x4*)((ss) + (size_t)(u.pm * 256 + ai * 128 + wr * 64 + m * 16 + fr) * 4); \
    asm volatile("" : "+v"(raw_[0][0]), "+v"(raw_[0][1]), "+v"(raw_[0][2]), "+v"(raw_[0][3]), "+v"(raw_[1][0]), "+v"(raw_[1][1]), "+v"(raw_[1][2]), "+v"(raw_[1][3])); \
    _Pragma("unroll") for (int ai = 0; ai < 2; ++ai) _Pragma("unroll") for (int m = 0; m < 4; ++m) rsv[ai][m] = __builtin_amdgcn_rsqf(((raw_[ai][m][0] + raw_[ai][m][1]) + (raw_[ai][m][2] + raw_[ai][m][3])) * (1.0f / DM) + RMS_EPS); }
struct EpiScale { static constexpr int MID_EVERY = 0;
    bf16_t* O; int ldo; const float* ss;
    __device__ __forceinline__ void operator()(const f32x4 (&acc)[2][2][4][2], const Unit& u, int wr, int wc, int fr, int fq) const {
        const int c0 = u.pn * 256 + wc * 32 + 8 * fq;
        EPI_RSTD8(rsv, ss)
        EPI_ROWS_BEGIN
            const float rs = rsv[ai][m]; bf16_t* rowp = O + (size_t)r * ldo + c0;
#pragma unroll
            for (int bj = 0; bj < 2; ++bj) { const f32x4 v0 = acc[ai][bj][m][0] * rs, v1 = acc[ai][bj][m][1] * rs;
                u32x4 w; w.x = cvt_pk_bf16(v0[0], v0[1]); w.y = cvt_pk_bf16(v0[2], v0[3]); w.z = cvt_pk_bf16(v1[0], v1[1]); w.w = cvt_pk_bf16(v1[2], v1[3]); *(u32x4*)(rowp + bj * 128) = w; }
        EPI_ROWS_END
    }
};
struct EpiGate { static constexpr int MID_EVERY = 0;
    bf16_t* O; int ldo; const float* ss; const float* bias;
    __device__ __forceinline__ void operator()(const f32x4 (&acc)[2][2][4][2], const Unit& u, int wr, int wc, int fr, int fq) const {
        const int c0 = u.pn * 256 + wc * 32 + 8 * fq;
        f32x4 bv[2][2];
#pragma unroll
        for (int bj = 0; bj < 2; ++bj) { bv[bj][0] = *(const f32x4*)(bias + c0 + bj * 128); bv[bj][1] = *(const f32x4*)(bias + c0 + bj * 128 + 4); }
        EPI_RSTD8(rsv, ss)
        EPI_ROWS_BEGIN
            const float rs = rsv[ai][m]; bf16_t* rowp = O + (size_t)r * ldo + c0;
#pragma unroll
            for (int bj = 0; bj < 2; ++bj) { f32x4 v0 = acc[ai][bj][m][0] * rs + bv[bj][0], v1 = acc[ai][bj][m][1] * rs + bv[bj][1];
#pragma unroll
                for (int j = 0; j < 4; ++j) { v0[j] = fast_sigmoid(v0[j]); v1[j] = fast_sigmoid(v1[j]); }
                u32x4 w; w.x = cvt_pk_bf16(v0[0], v0[1]); w.y = cvt_pk_bf16(v0[2], v0[3]); w.z = cvt_pk_bf16(v1[0], v1[1]); w.w = cvt_pk_bf16(v1[2], v1[3]); *(u32x4*)(rowp + bj * 128) = w; }
        EPI_ROWS_END
    }
};
struct EpiMerge { static constexpr int MID_EVERY = 0;
    bf16_t* MB; const bf16_t* ZG;
    __device__ __forceinline__ void operator()(const f32x4 (&acc)[2][2][4][2], const Unit& u, int wr, int wc, int fr, int fq) const {
        const int c0 = u.pn * 256 + wc * 32 + 8 * fq; const int br = u.aux;
#pragma unroll
        for (int ai = 0; ai < 2; ++ai) {
            u32x4 graw[4][2], praw[4][2];
#pragma unroll
            for (int m = 0; m < 4; ++m) { const int r = u.pm * 256 + ai * 128 + wr * 64 + m * 16 + fr; const bf16_t* gp = ZG + (size_t)r * NGATE + br * DM + c0; const bf16_t* pp = MB + (size_t)r * DM + c0;
                graw[m][0] = *(const u32x4*)gp; graw[m][1] = *(const u32x4*)(gp + 128);
                if (br > 0) { praw[m][0] = *(const u32x4*)pp; praw[m][1] = *(const u32x4*)(pp + 128); } else { praw[m][0] = (u32x4){0u, 0u, 0u, 0u}; praw[m][1] = praw[m][0]; } }
            asm volatile("" : "+v"(graw[0][0]), "+v"(graw[0][1]), "+v"(graw[1][0]), "+v"(graw[1][1]), "+v"(graw[2][0]), "+v"(graw[2][1]), "+v"(graw[3][0]), "+v"(graw[3][1]),
                              "+v"(praw[0][0]), "+v"(praw[0][1]), "+v"(praw[1][0]), "+v"(praw[1][1]), "+v"(praw[2][0]), "+v"(praw[2][1]), "+v"(praw[3][0]), "+v"(praw[3][1]));
#pragma unroll
            for (int m = 0; m < 4; ++m) { const int r = u.pm * 256 + ai * 128 + wr * 64 + m * 16 + fr; bf16_t* rowp = MB + (size_t)r * DM + c0;
#pragma unroll
                for (int bj = 0; bj < 2; ++bj) {
                    float gt[8], pv[8]; unpack8(graw[m][bj], gt); unpack8(praw[m][bj], pv);
                    float o[8];
#pragma unroll
                    for (int j = 0; j < 4; ++j) { o[j] = pv[j] + gt[j] * acc[ai][bj][m][0][j]; o[4 + j] = pv[4 + j] + gt[4 + j] * acc[ai][bj][m][1][j]; }
                    *(u32x4*)(rowp + bj * 128) = pack8(o); } }
        }
    }
};
constexpr float GATE_FLOOR = 1e-20f;
struct EpiMerge3 { static constexpr int MID_EVERY = 8;
    bf16_t* MB; const bf16_t* ZG;
    __device__ __forceinline__ void mid(f32x4 (&acc)[2][2][4][2], const Unit& u, int wr, int wc, int fr, int fq, int seg) const {
        const int c0 = u.pn * 256 + wc * 32 + 8 * fq;
#pragma unroll
        for (int ai = 0; ai < 2; ++ai) {
            u32x4 ga[4][2], gb[4][2];
#pragma unroll
            for (int m = 0; m < 4; ++m) { const bf16_t* gp = ZG + (size_t)(u.pm * 256 + ai * 128 + wr * 64 + m * 16 + fr) * NGATE + (seg - 1) * DM + c0;
                ga[m][0] = *(const u32x4*)gp; ga[m][1] = *(const u32x4*)(gp + 128); gb[m][0] = *(const u32x4*)(gp + DM); gb[m][1] = *(const u32x4*)(gp + DM + 128); }
            asm volatile("" : "+v"(ga[0][0]), "+v"(ga[0][1]), "+v"(ga[1][0]), "+v"(ga[1][1]), "+v"(ga[2][0]), "+v"(ga[2][1]), "+v"(ga[3][0]), "+v"(ga[3][1]),
                              "+v"(gb[0][0]), "+v"(gb[0][1]), "+v"(gb[1][0]), "+v"(gb[1][1]), "+v"(gb[2][0]), "+v"(gb[2][1]), "+v"(gb[3][0]), "+v"(gb[3][1]));
#pragma unroll
            for (int m = 0; m < 4; ++m)
#pragma unroll
                for (int bj = 0; bj < 2; ++bj) { float x[8], y[8]; unpack8(ga[m][bj], x); unpack8(gb[m][bj], y);
#pragma unroll
                    for (int j = 0; j < 4; ++j) { acc[ai][bj][m][0][j] *= fmaxf(x[j], GATE_FLOOR) * __builtin_amdgcn_rcpf(fmaxf(y[j], GATE_FLOOR)); acc[ai][bj][m][1][j] *= fmaxf(x[4 + j], GATE_FLOOR) * __builtin_amdgcn_rcpf(fmaxf(y[4 + j], GATE_FLOOR)); } }
        }
    }
    __device__ __forceinline__ void operator()(const f32x4 (&acc)[2][2][4][2], const Unit& u, int wr, int wc, int fr, int fq) const {
        const int c0 = u.pn * 256 + wc * 32 + 8 * fq;
        u32x4 g2[2][4][2];
#pragma unroll
        for (int ai = 0; ai < 2; ++ai)
#pragma unroll
            for (int m = 0; m < 4; ++m) { const bf16_t* gp = ZG + (size_t)(u.pm * 256 + ai * 128 + wr * 64 + m * 16 + fr) * NGATE + 2 * DM + c0; g2[ai][m][0] = *(const u32x4*)gp; g2[ai][m][1] = *(const u32x4*)(gp + 128); }
        asm volatile("" : "+v"(g2[0][0][0]), "+v"(g2[0][0][1]), "+v"(g2[0][1][0]), "+v"(g2[0][1][1]), "+v"(g2[0][2][0]), "+v"(g2[0][2][1]), "+v"(g2[0][3][0]), "+v"(g2[0][3][1]),
                          "+v"(g2[1][0][0]), "+v"(g2[1][0][1]), "+v"(g2[1][1][0]), "+v"(g2[1][1][1]), "+v"(g2[1][2][0]), "+v"(g2[1][2][1]), "+v"(g2[1][3][0]), "+v"(g2[1][3][1]));
        EPI_ROWS_BEGIN
            bf16_t* rowp = MB + (size_t)r * DM + c0;
#pragma unroll
            for (int bj = 0; bj < 2; ++bj) { float gt[8], o[8]; unpack8(g2[ai][m][bj], gt);
#pragma unroll
                for (int j = 0; j < 4; ++j) { o[j] = fmaxf(gt[j], GATE_FLOOR) * acc[ai][bj][m][0][j]; o[4 + j] = fmaxf(gt[4 + j], GATE_FLOOR) * acc[ai][bj][m][1][j]; }
                *(u32x4*)(rowp + bj * 128) = pack8(o); }
        EPI_ROWS_END
    }
};
struct EpiResid { static constexpr int MID_EVERY = 0;
    bf16_t* HB; float* ssn; LAS float* red;
    __device__ __forceinline__ void operator()(const f32x4 (&acc)[2][2][4][2], const Unit& u, int wr, int wc, int fr, int fq) const {
        const int c0 = u.pn * 256 + wc * 32 + 8 * fq;
        u32x4 hraw[2][4][2];
#pragma unroll
        for (int ai = 0; ai < 2; ++ai)
#pragma unroll
            for (int m = 0; m < 4; ++m) { const bf16_t* rp = HB + (size_t)(u.pm * 256 + ai * 128 + wr * 64 + m * 16 + fr) * DM + c0; hraw[ai][m][0] = *(const u32x4*)rp; hraw[ai][m][1] = *(const u32x4*)(rp + 128); }
        asm volatile("" : "+v"(hraw[0][0][0]), "+v"(hraw[0][0][1]), "+v"(hraw[0][1][0]), "+v"(hraw[0][1][1]), "+v"(hraw[0][2][0]), "+v"(hraw[0][2][1]), "+v"(hraw[0][3][0]), "+v"(hraw[0][3][1]),
                          "+v"(hraw[1][0][0]), "+v"(hraw[1][0][1]), "+v"(hraw[1][1][0]), "+v"(hraw[1][1][1]), "+v"(hraw[1][2][0]), "+v"(hraw[1][2][1]), "+v"(hraw[1][3][0]), "+v"(hraw[1][3][1]));
        EPI_ROWS_BEGIN
            bf16_t* rowp = HB + (size_t)r * DM + c0; float sq = 0.f;
#pragma unroll
            for (int bj = 0; bj < 2; ++bj) {
                float hv[8]; unpack8(hraw[ai][m][bj], hv);
#pragma unroll
                for (int j = 0; j < 4; ++j) { hv[j] += acc[ai][bj][m][0][j]; hv[4 + j] += acc[ai][bj][m][1][j]; }
                const u32x4 w = pack8(hv); *(u32x4*)(rowp + bj * 128) = w;
                float rv[8]; unpack8(w, rv);
#pragma unroll
                for (int j = 0; j < 8; ++j) sq += rv[j] * rv[j]; }
            { const int ln = fq * 16 + fr; sq += __builtin_bit_cast(float, __builtin_amdgcn_ds_bpermute((ln ^ 16) << 2, __builtin_bit_cast(int, sq))); sq += __builtin_bit_cast(float, __builtin_amdgcn_ds_bpermute((ln ^ 32) << 2, __builtin_bit_cast(int, sq))); }
            if (fq == 0) red[(ai * 128 + wr * 64 + m * 16 + fr) * 4 + wc] = sq;
        EPI_ROWS_END
        asm volatile("s_waitcnt lgkmcnt(0)" ::: "memory"); __builtin_amdgcn_s_barrier(); asm volatile("" ::: "memory");
        { const int t = (wr * 4 + wc) * 64 + fq * 16 + fr;
          if (t < 256) { const f32x4 p = *(const LAS f32x4*)(red + t * 4); ssn[(size_t)(u.pm * 256 + t) * 4 + u.pn] = (p[0] + p[1]) + (p[2] + p[3]); } }
    }
};
struct EpiSwiglu { static constexpr int MID_EVERY = 0;
    bf16_t* HID; const float* ss; const int* slot_tok; int row0;
    __device__ __forceinline__ void operator()(const f32x4 (&acc)[2][2][4][2], const Unit& u, int wr, int wc, int fr, int fq) const {
        const int c0 = u.pn * 128 + wc * 32 + 8 * fq;
        float rsv[2][4];
        if (slot_tok) {
#pragma unroll
            for (int ai = 0; ai < 2; ++ai)
#pragma unroll
                for (int m = 0; m < 4; ++m) rsv[ai][m] = ss[u.pm * 256 + ai * 128 + wr * 64 + m * 16 + fr];
            asm volatile("" : "+v"(rsv[0][0]), "+v"(rsv[0][1]), "+v"(rsv[0][2]), "+v"(rsv[0][3]), "+v"(rsv[1][0]), "+v"(rsv[1][1]), "+v"(rsv[1][2]), "+v"(rsv[1][3]));
        } else { EPI_RSTD8(rs2, ss)
#pragma unroll
            for (int ai = 0; ai < 2; ++ai)
#pragma unroll
                for (int m = 0; m < 4; ++m) rsv[ai][m] = rs2[ai][m]; }
        EPI_ROWS_BEGIN
            const float rs = rsv[ai][m]; const int orow = slot_tok ? r - row0 : r;
            const f32x4 g0 = acc[ai][0][m][0] * rs, g1 = acc[ai][0][m][1] * rs, u0 = acc[ai][1][m][0] * rs, u1 = acc[ai][1][m][1] * rs;
            float o[8];
#pragma unroll
            for (int j = 0; j < 4; ++j) { o[j] = g0[j] * fast_sigmoid(g0[j]) * u0[j]; o[4 + j] = g1[j] * fast_sigmoid(g1[j]) * u1[j]; }
            *(u32x4*)(HID + (size_t)orow * DFF + c0) = pack8(o);
        EPI_ROWS_END
    }
};
struct EpiStore { static constexpr int MID_EVERY = 0;
    bf16_t* O; int ldo;
    __device__ __forceinline__ void operator()(const f32x4 (&acc)[2][2][4][2], const Unit& u, int wr, int wc, int fr, int fq) const {
        const int c0 = u.pn * 256 + wc * 32 + 8 * fq;
        EPI_ROWS_BEGIN
            bf16_t* rowp = O + (size_t)r * ldo + c0;
#pragma unroll
            for (int bj = 0; bj < 2; ++bj) { const f32x4 v0 = acc[ai][bj][m][0], v1 = acc[ai][bj][m][1];
                u32x4 w; w.x = cvt_pk_bf16(v0[0], v0[1]); w.y = cvt_pk_bf16(v0[2], v0[3]); w.z = cvt_pk_bf16(v1[0], v1[1]); w.w = cvt_pk_bf16(v1[2], v1[3]); *(u32x4*)(rowp + bj * 128) = w; }
        EPI_ROWS_END
    }
};

#define XB_TMO      128
#define XB_XCNT(j)  (256  + 64 * (j))
#define XB_XSUB(j)  (1280 + 64 * (j))
#define XB_XGEN(j)  (2304 + 64 * (j))
#define XB_TOP      3328
#define XB_TOPGEN   3392
#define XCD_BAR_WORDS 3456
#define XB_SPIN_CAP (1u << 18)
__device__ __forceinline__ unsigned xb_ld(unsigned* p)              { return __hip_atomic_load(p, __ATOMIC_RELAXED, __HIP_MEMORY_SCOPE_AGENT); }
__device__ __forceinline__ unsigned xb_add(unsigned* p, unsigned v) { return __hip_atomic_fetch_add(p, v, __ATOMIC_RELAXED, __HIP_MEMORY_SCOPE_AGENT); }
__device__ __forceinline__ unsigned xb_xcc_id() { return (unsigned)__builtin_amdgcn_s_getreg((3 << 11) | 20) & 0xFu; }
#define XB_SPIN(cond, bar) do { unsigned _sp = 0; while (cond) { __builtin_amdgcn_s_sleep(1); \
    if ((++_sp & 255u) == 0u) { if (xb_ld(&(bar)[XB_TMO])) break; if (_sp > XB_SPIN_CAP) { atomicAdd(&(bar)[XB_TMO], 1u); break; } } } } while (0)
struct XcdBarrier { unsigned* bar; unsigned x; volatile LAS unsigned* st; };
__device__ __forceinline__ XcdBarrier xcd_barrier_post(unsigned* bar, volatile LAS unsigned* st) {
    XcdBarrier b; b.bar = bar; b.x = xb_xcc_id(); b.st = st;
    if (threadIdx.x == 0) (void)xb_add(&bar[XB_XCNT(b.x)], 1u);
    return b;
}
__device__ __forceinline__ void xcd_barrier_complete(unsigned* bar, unsigned x, unsigned& nloc, unsigned& nx) {
    const unsigned G = gridDim.x * gridDim.y * gridDim.z;
    unsigned sum, cnt, mine, sp = 0u;
    for (;;) {
        sum = 0u; cnt = 0u; mine = 0u;
#pragma unroll
        for (unsigned j = 0; j < 16; ++j) { const unsigned c = xb_ld(&bar[XB_XCNT(j)]); sum += c; cnt += (c > 0u) ? 1u : 0u; mine = (j == x) ? c : mine; }
        if (sum == G) break;
        __builtin_amdgcn_s_sleep(1);
        if ((++sp & 255u) == 0u) { if (xb_ld(&bar[XB_TMO])) break; if (sp > XB_SPIN_CAP) { atomicAdd(&bar[XB_TMO], 1u); break; } }
    }
    nloc = mine > 0u ? mine : 1u; nx = cnt > 0u ? cnt : 1u;
}
__device__ __forceinline__ void xcd_barrier(const XcdBarrier& b, int wave_id) {
    asm volatile("s_waitcnt vmcnt(0)" ::: "memory");
    __syncthreads();
    int lane_; asm volatile("v_mbcnt_lo_u32_b32 %0, -1, 0\n\tv_mbcnt_hi_u32_b32 %0, -1, %0" : "=v"(lane_));
    if (wave_id == 0 && lane_ == 0) {
        unsigned* bar = b.bar;
        __builtin_amdgcn_s_waitcnt(0);
        unsigned nloc = b.st[0], nx = b.st[1];
        if (nloc == 0u) { xcd_barrier_complete(bar, b.x, nloc, nx); b.st[0] = nloc; b.st[1] = nx; }
        const unsigned old = xb_add(&bar[XB_XSUB(b.x)], 1u);
        const unsigned gen = old / nloc;
        if (old + 1u == (gen + 1u) * nloc) {
            __builtin_amdgcn_fence(__ATOMIC_RELEASE, "agent");
            asm volatile("s_waitcnt vmcnt(0)" ::: "memory");
            const unsigned og = xb_add(&bar[XB_TOP], 1u);
            const unsigned tg = og / nx;
            if (og + 1u == (tg + 1u) * nx) xb_add(&bar[XB_TOPGEN], 1u);
            else XB_SPIN(xb_ld(&bar[XB_TOPGEN]) == tg, bar);
            __builtin_amdgcn_fence(__ATOMIC_ACQUIRE, "agent");
            xb_add(&bar[XB_XGEN(b.x)], 1u);
            asm volatile("s_waitcnt vmcnt(0)" ::: "memory");
        } else {
            XB_SPIN(xb_ld(&bar[XB_XGEN(b.x)]) == gen, bar);
            __builtin_amdgcn_fence(__ATOMIC_ACQUIRE, "agent");
            asm volatile("s_waitcnt vmcnt(0)" ::: "memory");
        }
    }
    __syncthreads();
}

struct Args { const float* in[36]; float* out; unsigned char* ws; int ph_lo, ph_hi, li, pad; };
enum { I_X = 0, I_META, I_MIXG, I_WIN, I_GATEB, I_MU, I_W0, I_W2, I_A0, I_A2, I_G2, I_KK, I_KA, I_RK, I_LNXW, I_LNXB, I_CONVW, I_CONVB, I_BLNG, I_BLNB, I_POOLW, I_CSCALE,
       I_PROJA, I_PROJB, I_PROJC, I_WOUT, I_FFNG, I_FGATE, I_FUP, I_FDOWN, I_RW, I_RB, I_EGATE, I_EUP, I_EDOWN, I_FINALG };
constexpr int PTR_OFF = LDSCTL_OFF + 64;
__device__ __forceinline__ GAS unsigned char* lds_ptr(LAS unsigned char* lds, int i) {
    const LAS unsigned* p = (const LAS unsigned*)(lds + PTR_OFF + 8 * i);
    const unsigned lo = __builtin_amdgcn_readfirstlane(p[0]), hi = __builtin_amdgcn_readfirstlane(p[1]);
    return (GAS unsigned char*)(((unsigned long long)hi << 32) | lo);
}
struct Frame {
    LAS unsigned char* lds; int tid, lane, wave, G, bid;
    unsigned char* ws;
    bf16_t* W; bf16_t* WE; bf16_t* HB; bf16_t* R1; bf16_t* R2; bf16_t* R3; bf16_t* YS; float* SS;
};
__device__ __forceinline__ void frame_ptrs(Frame& F) {
    GAS unsigned char* ws = lds_ptr(F.lds, 37); F.ws = (unsigned char*)ws;
    F.W = (bf16_t*)(ws + WS_W); F.WE = (bf16_t*)(ws + WS_WE); F.HB = (bf16_t*)(ws + WS_HB); F.R1 = (bf16_t*)(ws + WS_R1); F.R2 = (bf16_t*)(ws + WS_R2); F.R3 = (bf16_t*)(ws + WS_R3);
    F.YS = (bf16_t*)(ws + WS_YS); F.SS = (float*)(ws + WS_SS);
}
__device__ __forceinline__ const float* in_ptr(const Frame& F, int i) { return (const float*)lds_ptr(F.lds, i); }
#define LDS_WAIT() asm volatile("s_waitcnt lgkmcnt(0)" ::: "memory")
#define PHASE_ENTER(F) do { int l_; int w_ = (F).wave, g_ = (F).G, b_ = (F).bid; asm volatile("v_mbcnt_lo_u32_b32 %0, -1, 0\n\tv_mbcnt_hi_u32_b32 %0, -1, %0" : "=v"(l_), "+s"(w_), "+s"(g_), "+s"(b_) :: "memory"); (F).lane = l_; (F).wave = w_; (F).G = g_; (F).bid = b_; (F).tid = w_ * 64 + l_; frame_ptrs(F); } while (0)


__device__ __forceinline__ int row_of(int b, int l) { return l < NMETA ? MBASE + l : b * SEQ + (l - NMETA); }
__device__ __forceinline__ int prev_row(int r) { if (r >= MBASE) return r > MBASE ? r - 1 : -1; return (r & (SEQ - 1)) ? r - 1 : MBASE + NMETA - 1; }

struct ConvJob { const float* src; int K, srcN, col0, ncols; bf16_t* dst; int dld, dcol0, mode; const float* sc; };
__device__ __forceinline__ int conv_items(const ConvJob& j) { return (j.K / 64) * (j.ncols / 32); }
__device__ __forceinline__ void conv_item(const ConvJob& j, LAS float* scr, int item, int lane) {
    const int nblk = j.ncols / 32, kb = item / nblk, nb = item % nblk, k0 = 64 * kb, n0 = 32 * nb;
    float vv[32];
#pragma unroll
    for (int i = 0; i < 32; ++i) { const int kk = 2 * i + (lane >> 5); vv[i] = j.src[(size_t)(k0 + kk) * j.srcN + j.col0 + n0 + (lane & 31)]; }
    if (j.sc) {
#pragma unroll
        for (int i = 0; i < 32; ++i) vv[i] *= j.sc[k0 + 2 * i + (lane >> 5)]; }
#pragma unroll
    for (int i = 0; i < 32; ++i) { const int kk = 2 * i + (lane >> 5); scr[kk * 33 + (lane & 31)] = vv[i]; }
    LDS_WAIT(); asm volatile("" ::: "memory");
    const int c = lane & 7;
    int drow0 = n0; if (j.mode == 1) drow0 = 256 * (n0 / 128) + (n0 % 128); else if (j.mode == 2) drow0 = 256 * (n0 / 128) + 128 + (n0 % 128);
#pragma unroll
    for (int jj = 0; jj < 4; ++jj) { const int n = (lane >> 3) + 8 * jj; const LAS float* s = scr + (8 * c) * 33 + n;
        u32x4 o; o.x = cvt_pk_bf16(s[0 * 33], s[1 * 33]); o.y = cvt_pk_bf16(s[2 * 33], s[3 * 33]); o.z = cvt_pk_bf16(s[4 * 33], s[5 * 33]); o.w = cvt_pk_bf16(s[6 * 33], s[7 * 33]);
        *(u32x4*)(j.dst + (size_t)(drow0 + n) * j.dld + j.dcol0 + k0 + 8 * c) = o; }
    LDS_WAIT(); asm volatile("" ::: "memory");
}
__device__ __forceinline__ void conv_run(Frame& F, const ConvJob& j) {
    LAS float* scr = (LAS float*)(F.lds + F.wave * 16384);
    const int gw = F.bid * 8 + F.wave, NGW = F.G * 8, n = conv_items(j);
    for (int it = gw; it < n; it += NGW) conv_item(j, scr, it, F.lane);
}
__device__ __forceinline__ void convert_common(Frame& F) {
    PHASE_ENTER(F);
    for (int l = 0; l < 2; ++l) {
        bf16_t* WL = F.W + (size_t)l * WL_SIZE; const float* mg = in_ptr(F, I_MIXG) + l * DM;
        const float* win = in_ptr(F, I_WIN) + (size_t)l * DM * 6400;
        conv_run(F, ConvJob{win, DM, 6400, 0, NABC, WL + WL_ABC, DM, 0, 0, mg});
        conv_run(F, ConvJob{win, DM, 6400, NABC, NGATE, WL + WL_G, DM, 0, 0, mg});
        conv_run(F, ConvJob{in_ptr(F, I_PROJA) + (size_t)l * AW * DM, AW, DM, 0, DM, WL + WL_P, NY, 0, 0, nullptr});
        conv_run(F, ConvJob{in_ptr(F, I_PROJB) + (size_t)l * AW * DM, AW, DM, 0, DM, WL + WL_P, NY, AW, 0, nullptr});
        conv_run(F, ConvJob{in_ptr(F, I_PROJC) + (size_t)l * AW * DM, AW, DM, 0, DM, WL + WL_P, NY, 2 * AW, 0, nullptr});
        conv_run(F, ConvJob{in_ptr(F, I_WOUT) + (size_t)l * DM * DM, DM, DM, 0, DM, WL + WL_OUT, DM, 0, 0, nullptr});
        conv_run(F, ConvJob{in_ptr(F, I_W2) + (size_t)l * 64 * AW, 64, AW, 0, AW, WL + WL_W2, 64, 0, 0, nullptr});
        conv_run(F, ConvJob{in_ptr(F, I_A2) + (size_t)l * 64 * AW, 64, AW, 0, AW, WL + WL_A2, 64, 0, 0, nullptr});
        conv_run(F, ConvJob{in_ptr(F, I_G2) + (size_t)l * 128 * AW, 128, AW, 0, AW, WL + WL_G2, 128, 0, 0, nullptr});
        for (int g = 0; g < 4; ++g) conv_run(F, ConvJob{in_ptr(F, I_POOLW) + ((size_t)l * 4 + g) * 128 * 128, 128, 128, 0, 128, WL + WL_PW + (size_t)g * 128 * 128, 128, 0, 0, nullptr});
    }
    const float* fg = in_ptr(F, I_FFNG);
    conv_run(F, ConvJob{in_ptr(F, I_FGATE), DM, DFF, 0, DFF, F.W + WF_GU, DM, 0, 1, fg});
    conv_run(F, ConvJob{in_ptr(F, I_FUP), DM, DFF, 0, DFF, F.W + WF_GU, DM, 0, 2, fg});
    conv_run(F, ConvJob{in_ptr(F, I_FDOWN), DFF, DM, 0, DM, F.W + WF_D, DFF, 0, 0, nullptr});
}
__device__ __forceinline__ void convert_experts(Frame& F) {
    PHASE_ENTER(F);
    const float* fg = in_ptr(F, I_FFNG) + DM;
    for (int e = 0; e < NEXP; ++e) {
        conv_run(F, ConvJob{in_ptr(F, I_EGATE) + (size_t)e * DM * DFF, DM, DFF, 0, DFF, F.WE + WE_GU + (size_t)e * NGU * DM, DM, 0, 1, fg});
        conv_run(F, ConvJob{in_ptr(F, I_EUP) + (size_t)e * DM * DFF, DM, DFF, 0, DFF, F.WE + WE_GU + (size_t)e * NGU * DM, DM, 0, 2, fg});
        conv_run(F, ConvJob{in_ptr(F, I_EDOWN) + (size_t)e * DFF * DM, DFF, DM, 0, DM, F.WE + WE_D + (size_t)e * DM * DFF, DFF, 0, 0, nullptr});
    }
}
__device__ __forceinline__ void x_to_hb(Frame& F) {
    PHASE_ENTER(F);
    const int gw = F.bid * 8 + F.wave, NGW = F.G * 8;
    for (int r = gw; r < NROWS; r += NGW) {
        const float* src = r < NREAL ? in_ptr(F, I_X) + (size_t)r * DM : in_ptr(F, I_META) + (size_t)(r - MBASE) * DM;
        const f32x4* xr = (const f32x4*)src + F.lane; u32x2* o = (u32x2*)(F.HB + (size_t)r * DM) + F.lane; float sq = 0.f;
#pragma unroll
        for (int j = 0; j < 4; ++j) { const f32x4 v = xr[64 * j]; u32x2 w; w.x = cvt_pk_bf16(v[0], v[1]); w.y = cvt_pk_bf16(v[2], v[3]); o[64 * j] = w;
            const float a = bf_lo(w.x), b = bf_hi(w.x), c = bf_lo(w.y), d = bf_hi(w.y); sq += (a * a + b * b) + (c * c + d * d); }
        sq = wave_sum(sq);
        if (r < NREAL && F.lane < 4) F.SS[(size_t)r * 4 + F.lane] = F.lane == 0 ? sq : 0.f;
    }
}

__device__ __forceinline__ float meta_tile(Frame& F, const bf16_t* A16, int lda, const bf16_t* Bt, int ldb, int K, int brow0) {
    LAS float* red = (LAS float*)F.lds;
    const int kw = K / 8, k0 = F.wave * kw, fr = F.lane & 15, fq = F.lane >> 4;
    f32x4 acc = (f32x4){0.f, 0.f, 0.f, 0.f};
    const bf16_t* ap = A16 + (size_t)fr * lda + k0 + 8 * fq; const bf16_t* bp = Bt + (size_t)(brow0 + fr) * ldb + k0 + 8 * fq;
    for (int k = 0; k < kw; k += 32) { const bf16x8 a = *(const bf16x8*)(ap + k), b = *(const bf16x8*)(bp + k); acc = __builtin_amdgcn_mfma_f32_16x16x32_bf16(b, a, acc, 0, 0, 0); }
#pragma unroll
    for (int j = 0; j < 4; ++j) red[F.wave * 256 + fr * 16 + 4 * fq + j] = acc[j];
    __syncthreads();
    float v = 0.f;
    if (F.tid < 256) {
#pragma unroll
        for (int w = 0; w < 8; ++w) v += red[w * 256 + F.tid];
    }
    __syncthreads();
    return v;
}


__device__ __forceinline__ void meta_rstd_setup(Frame& F) {
    LAS float* mrs = (LAS float*)(F.lds + 8192);
#pragma unroll
    for (int i = 0; i < 2; ++i) { const int row = 2 * F.wave + i; float hv[16]; const bf16_t* hp = F.HB + (size_t)(MBASE + row) * DM + 16 * F.lane;
        unpack8(*(const u32x4*)hp, *(float(*)[8])&hv[0]); unpack8(*(const u32x4*)(hp + 8), *(float(*)[8])&hv[8]); float sq = 0.f;
#pragma unroll
        for (int j = 0; j < 16; ++j) sq += hv[j] * hv[j];
        sq = wave_sum(sq); if (F.lane == 0) mrs[row] = __builtin_amdgcn_rsqf(sq * (1.0f / DM) + RMS_EPS); }
    __syncthreads();
}
#define META_RS(F, row16) (((const LAS float*)((F).lds + 8192))[row16])

__device__ __forceinline__ void prep_afrags(bf16x8 (&af)[8], const bf16_t* U, const float* mu, int row, int fq) {
    const int prow = prev_row(row), pr = prow >= 0 ? prow : row; const float pm = prow >= 0 ? 1.0f : 0.0f;
    u32x4 rc[8], rp[8];
#pragma unroll
    for (int s = 0; s < 8; ++s) { const int col = 1536 + 32 * s + 8 * fq; rc[s] = *(const u32x4*)(U + (size_t)row * NABC + col); rp[s] = *(const u32x4*)(U + (size_t)pr * NABC + col); }
#pragma unroll
    for (int s = 0; s < 8; ++s) {
        const int col = 1536 + 32 * s + 8 * fq;
        float cur[8], prv[8]; unpack8(rc[s], cur); unpack8(rp[s], prv);
        const f32x4 m0 = *(const f32x4*)(mu + col), m1 = *(const f32x4*)(mu + col + 4);
        float x[8];
#pragma unroll
        for (int j = 0; j < 8; ++j) { const float mm = j < 4 ? m0[j] : m1[j - 4]; float v = cur[j] + (pm * prv[j] - cur[j]) * mm;
            if (s < 2) v = 1.0f - 2.0f * __builtin_amdgcn_rcpf(1.0f + __expf(2.0f * v));
            else if (s >= 4) v = fast_sigmoid(v);
            x[j] = v; }
        const u32x4 p = pack8(x); af[s] = __builtin_bit_cast(bf16x8, p);
    }
}
template <int NG> __device__ __forceinline__ void prep_tile(const bf16x8 (&af)[NG][8], const int (&rows)[NG], int ct, int fr, int fq, const bf16_t* w2t, const bf16_t* a2t, const bf16_t* g2t,
                                                            const float* w0, const float* a0, bf16_t* WAw, bf16_t* WAa, bf16_t* Y) {
    const bf16_t* bw = w2t + (size_t)(16 * ct + fr) * 64 + 8 * fq; const bf16_t* ba = a2t + (size_t)(16 * ct + fr) * 64 + 8 * fq; const bf16_t* bg = g2t + (size_t)(16 * ct + fr) * 128 + 8 * fq;
    bf16x8 fw[2], fa[2], fg[4];
#pragma unroll
    for (int s = 0; s < 2; ++s) { fw[s] = *(const bf16x8*)(bw + 32 * s); fa[s] = *(const bf16x8*)(ba + 32 * s); }
#pragma unroll
    for (int s = 0; s < 4; ++s) fg[s] = *(const bf16x8*)(bg + 32 * s);
    const int c = 16 * ct + 4 * fq;
    const f32x4 w0v = *(const f32x4*)(w0 + c), a0v = *(const f32x4*)(a0 + c);
#pragma unroll
    for (int gi = 0; gi < NG; ++gi) {
        f32x4 aw = (f32x4){0.f, 0.f, 0.f, 0.f}, aa = aw, ag = aw;
#pragma unroll
        for (int s = 0; s < 2; ++s) { aw = __builtin_amdgcn_mfma_f32_16x16x32_bf16(fw[s], af[gi][s], aw, 0, 0, 0); aa = __builtin_amdgcn_mfma_f32_16x16x32_bf16(fa[s], af[gi][2 + s], aa, 0, 0, 0); }
#pragma unroll
        for (int s = 0; s < 4; ++s) ag = __builtin_amdgcn_mfma_f32_16x16x32_bf16(fg[s], af[gi][4 + s], ag, 0, 0, 0);
        u32x2 ow, oa, og;
        ow.x = cvt_pk_bf16(0.60653066f * fast_sigmoid(aw[0] + w0v[0]), 0.60653066f * fast_sigmoid(aw[1] + w0v[1])); ow.y = cvt_pk_bf16(0.60653066f * fast_sigmoid(aw[2] + w0v[2]), 0.60653066f * fast_sigmoid(aw[3] + w0v[3]));
        oa.x = cvt_pk_bf16(fast_sigmoid(aa[0] + a0v[0]), fast_sigmoid(aa[1] + a0v[1])); oa.y = cvt_pk_bf16(fast_sigmoid(aa[2] + a0v[2]), fast_sigmoid(aa[3] + a0v[3]));
        og.x = cvt_pk_bf16(ag[0], ag[1]); og.y = cvt_pk_bf16(ag[2], ag[3]);
        const size_t row = rows[gi];
        *(u32x2*)(WAw + row * AW + c) = ow; *(u32x2*)(WAa + row * AW + c) = oa; *(u32x2*)(Y + row * NY + AW + c) = og;
    }
}
__device__ __forceinline__ void phase_prep(Frame& F, int l) {
    PHASE_ENTER(F);
    const bf16_t* U = F.R1; bf16_t* WAw = F.R2; bf16_t* WAa = F.R2 + (size_t)NROWS * AW; bf16_t* Y = F.R3;
    const bf16_t* WL = F.W + (size_t)l * WL_SIZE; const bf16_t* w2t = WL + WL_W2; const bf16_t* a2t = WL + WL_A2; const bf16_t* g2t = WL + WL_G2;
    const float* mu = in_ptr(F, I_MU) + l * AIN; const float* w0 = in_ptr(F, I_W0) + l * AW; const float* a0 = in_ptr(F, I_A0) + l * AW;
    const int fr = F.lane & 15, fq = F.lane >> 4;
    const int gw = F.bid * 8 + F.wave, NGW = F.G * 8;
    for (int grp = gw; grp < NREAL / 16; grp += 2 * NGW) {
        const int grp2 = grp + NGW;
        if (grp2 < NREAL / 16) {
            bf16x8 af[2][8]; const int rows[2] = {grp * 16 + fr, grp2 * 16 + fr};
            prep_afrags(af[0], U, mu, rows[0], fq); prep_afrags(af[1], U, mu, rows[1], fq);
#pragma unroll 2
            for (int ct = 0; ct < 32; ++ct) prep_tile<2>(af, rows, ct, fr, fq, w2t, a2t, g2t, w0, a0, WAw, WAa, Y);
        } else {
            bf16x8 af[1][8]; const int rows[1] = {grp * 16 + fr};
            prep_afrags(af[0], U, mu, rows[0], fq);
#pragma unroll 2
            for (int ct = 0; ct < 32; ++ct) prep_tile<1>(af, rows, ct, fr, fq, w2t, a2t, g2t, w0, a0, WAw, WAa, Y);
        }
    }
    for (int hi = gw; hi < NB * 256; hi += NGW) { const int hb = hi >> 8, hc = (hi & 255) + 1; const int src = hc == 1 ? MBASE + NMETA - 1 : hb * SEQ + 32 * (hc - 1) - 1;
        bf16_t* hd = (bf16_t*)(F.ws + WS_HALO) + (size_t)hi * 1536;
#pragma unroll
        for (int j = 0; j < 3; ++j) *(u32x4*)(hd + 512 * j + 8 * F.lane) = *(const u32x4*)(U + (size_t)src * NABC + 512 * j + 8 * F.lane); }
    if (gw < 32) { bf16x8 af[1][8]; const int rows[1] = {MBASE + fr}; prep_afrags(af[0], U, mu, rows[0], fq); prep_tile<1>(af, rows, gw, fr, fq, w2t, a2t, g2t, w0, a0, WAw, WAa, Y); }
}

constexpr int SC_TOK = 32, SC_VEC = SC_TOK * 64, SC_BUF_F = 5 * SC_VEC + SC_TOK * 16 * 4, SC_BUF = SC_BUF_F * 4, SC_YB = 2 * SC_BUF, SC_NCH = 1 + SEQ / SC_TOK;
template <int N> __device__ __forceinline__ float ror16(float v) { return __builtin_bit_cast(float, __builtin_amdgcn_update_dpp(0, __builtin_bit_cast(int, v), 0x120 + N, 0xf, 0xf, false)); }
__device__ __forceinline__ float allreduce16(float v) { v += ror16<8>(v); v += ror16<4>(v); v += ror16<2>(v); v += ror16<1>(v); return v; }
struct ScanRegs { u32x4 zr, zrp, zk, zkp, ww, aa, zv, zvp; };
__device__ __forceinline__ void scan_load(ScanRegs& R, const bf16_t* U, const bf16_t* WAw, const bf16_t* WAa, int b, int h, int q, int c, int sw, int lane) {
    c = c < SC_NCH ? c : SC_NCH - 1;
    const int ntok = c == 0 ? NMETA : SC_TOK, p0 = c == 0 ? 0 : NMETA + SC_TOK * (c - 1), per = ntok / 4, i0 = lane >> 3, i = i0 < per ? i0 : per - 1, o = lane & 7;
    const int p = p0 + sw * per + i, row = row_of(b, p), prow = row_of(b, p > 0 ? p - 1 : 0), ch = h * 64 + 8 * o, cv = 1024 + h * 64 + 16 * q + 8 * (o & 1);
    R.zr = *(const u32x4*)(U + (size_t)row * NABC + ch); R.zk = *(const u32x4*)(U + (size_t)row * NABC + 512 + ch);
    R.ww = *(const u32x4*)(WAw + (size_t)row * AW + ch); R.aa = *(const u32x4*)(WAa + (size_t)row * AW + ch);
    R.zv = *(const u32x4*)(U + (size_t)row * NABC + cv);
    R.zrp = *(const u32x4*)(U + (size_t)prow * NABC + ch); R.zkp = *(const u32x4*)(U + (size_t)prow * NABC + 512 + ch); R.zvp = *(const u32x4*)(U + (size_t)prow * NABC + cv);
}
__device__ __forceinline__ void scan_stage(const ScanRegs& R, LAS float* buf, int c, int sw, int lane, const float (&mur)[8], const float (&muk)[8], const float (&muv)[8], const float (&kkc)[8], const float (&kac)[8]) {
    const int ntok = c == 0 ? NMETA : SC_TOK, per = ntok / 4, i = lane >> 3, o = lane & 7;
    if (i < per) {
        const int tt = sw * per + i;
        float zr[8], zrp[8], zk[8], zkp[8], ww[8], aa[8];
        unpack8(R.zr, zr); unpack8(R.zrp, zrp); unpack8(R.zk, zk); unpack8(R.zkp, zkp); unpack8(R.ww, ww); unpack8(R.aa, aa);
        const bool first = (c == 0 && tt == 0);
        if (first) {
#pragma unroll
            for (int j = 0; j < 8; ++j) { zrp[j] = 0.f; zkp[j] = 0.f; } }
        float r[8], kx[8], kk[8], ss = 0.f;
#pragma unroll
        for (int j = 0; j < 8; ++j) { r[j] = zr[j] + (zrp[j] - zr[j]) * mur[j]; kx[j] = zk[j] + (zkp[j] - zk[j]) * muk[j]; kk[j] = kx[j] * kkc[j]; ss += kk[j] * kk[j]; }
        ss = allreduce8(ss);
        const float inv = 1.0f / fmaxf(sqrtf(ss), 1e-12f);
        float av[8], bv[8], dv[8], k2[8], rd[8], br = 0.f, kr = 0.f;
#pragma unroll
        for (int j = 0; j < 8; ++j) { const float kn = kk[j] * inv; av[j] = -kn; bv[j] = kn * aa[j]; dv[j] = __expf(-ww[j]); k2[j] = kx[j] * (1.0f + (aa[j] - 1.0f) * kac[j]); rd[j] = dv[j] * r[j];
            br += bv[j] * r[j]; kr += k2[j] * r[j]; }
        br = allreduce8(br); kr = allreduce8(kr);
        LAS float* dst = buf + tt * 64 + 8 * o;
        *(LAS f32x4*)(dst + 0 * SC_VEC) = (f32x4){av[0], av[1], av[2], av[3]}; *(LAS f32x4*)(dst + 0 * SC_VEC + 4) = (f32x4){av[4], av[5], av[6], av[7]};
        *(LAS f32x4*)(dst + 1 * SC_VEC) = (f32x4){bv[0], bv[1], bv[2], bv[3]}; *(LAS f32x4*)(dst + 1 * SC_VEC + 4) = (f32x4){bv[4], bv[5], bv[6], bv[7]};
        *(LAS f32x4*)(dst + 2 * SC_VEC) = (f32x4){dv[0], dv[1], dv[2], dv[3]}; *(LAS f32x4*)(dst + 2 * SC_VEC + 4) = (f32x4){dv[4], dv[5], dv[6], dv[7]};
        *(LAS f32x4*)(dst + 3 * SC_VEC) = (f32x4){k2[0], k2[1], k2[2], k2[3]}; *(LAS f32x4*)(dst + 3 * SC_VEC + 4) = (f32x4){k2[4], k2[5], k2[6], k2[7]};
        *(LAS f32x4*)(dst + 4 * SC_VEC) = (f32x4){rd[0], rd[1], rd[2], rd[3]}; *(LAS f32x4*)(dst + 4 * SC_VEC + 4) = (f32x4){rd[4], rd[5], rd[6], rd[7]};
        if (o < 2) { float zv[8], zvp[8]; unpack8(R.zv, zv); unpack8(R.zvp, zvp); float v[8];
            if (first) {
#pragma unroll
                for (int j = 0; j < 8; ++j) zvp[j] = 0.f; }
#pragma unroll
            for (int j = 0; j < 8; ++j) { v[j] = zv[j] + (zvp[j] - zv[j]) * muv[j]; }
            LAS float* vd = buf + 5 * SC_VEC + (tt * 16 + 8 * o) * 4;
#pragma unroll
            for (int j = 0; j < 8; ++j) *(LAS f32x4*)(vd + 4 * j) = (f32x4){v[j], br, kr, 0.f}; }
    }
}
struct StepIn { f32x4 a, b, d, k, rd, vs; };
template <int J> __device__ __forceinline__ void step_load(StepIn& I, unsigned avec, unsigned avs) {
    asm volatile("ds_read_b128 %0, %1 offset:%2" : "=v"(I.a) : "v"(avec), "n"(J * 256));
    asm volatile("ds_read_b128 %0, %1 offset:%2" : "=v"(I.b) : "v"(avec), "n"(J * 256 + 8192));
    asm volatile("ds_read_b128 %0, %1 offset:%2" : "=v"(I.d) : "v"(avec), "n"(J * 256 + 16384));
    asm volatile("ds_read_b128 %0, %1 offset:%2" : "=v"(I.k) : "v"(avec), "n"(J * 256 + 24576));
    asm volatile("ds_read_b128 %0, %1 offset:%2" : "=v"(I.rd) : "v"(avec), "n"(J * 256 + 32768));
    asm volatile("ds_read_b128 %0, %1 offset:%2" : "=v"(I.vs) : "v"(avs), "n"(J * 256));
}
#define STEP_WAIT(I, n) asm volatile("s_waitcnt lgkmcnt(" #n ")" : "+v"(I.a), "+v"(I.b), "+v"(I.d), "+v"(I.k), "+v"(I.rd), "+v"(I.vs))
static_assert(SC_VEC * 4 == 8192, "asm offsets");
__device__ __forceinline__ float step_compute(const StepIn& I, f32x2& S01, f32x2& S23) {
    const f32x2 a01 = {I.a[0], I.a[1]}, a23 = {I.a[2], I.a[3]}, r01 = {I.rd[0], I.rd[1]}, r23 = {I.rd[2], I.rd[3]};
    f32x2 q = S01 * a01; q = S23 * a23 + q; f32x2 w = S01 * r01; w = S23 * r23 + w;
    float p1 = q.x + q.y, p2 = w.x + w.y;
    p1 = allreduce16(p1); p2 = allreduce16(p2);
    const float y = p2 + (p1 * I.vs[1] + I.vs[0] * I.vs[2]);
    const f32x2 pv = {p1, p1}, vv = {I.vs[0], I.vs[0]}, b01 = {I.b[0], I.b[1]}, b23 = {I.b[2], I.b[3]}, k01 = {I.k[0], I.k[1]}, k23 = {I.k[2], I.k[3]}, d01 = {I.d[0], I.d[1]}, d23 = {I.d[2], I.d[3]};
    S01 = S01 * d01 + (pv * b01 + vv * k01); S23 = S23 * d23 + (pv * b23 + vv * k23);
    return y;
}
__device__ __forceinline__ void phase_scan(Frame& F, int l) {
    PHASE_ENTER(F);
    const bf16_t* U = F.R1; const bf16_t* WAw = F.R2; const bf16_t* WAa = F.R2 + (size_t)NROWS * AW; bf16_t* Y = F.R3;
    const float* mu = in_ptr(F, I_MU) + l * AIN; const float* kkp = in_ptr(F, I_KK) + l * AW; const float* kap = in_ptr(F, I_KA) + l * AW;
    const int lane = F.lane, wave = F.wave;
    constexpr int NIT = SC_NCH + 4;
    static_assert(NIT % 3 == 0, "NIT");
    for (int unit = F.bid; unit < NB * 8 * 4; unit += F.G) {
        const int b = unit >> 5, h = (unit >> 2) & 7, q = unit & 3;
        __syncthreads();
        if (wave >= 4) {
            const int sw = wave - 4, o = lane & 7, ch = h * 64 + 8 * o, cv = 1024 + h * 64 + 16 * q + 8 * (o & 1);
            float mur[8], muk[8], muv[8], kkc[8], kac[8];
#pragma unroll
            for (int j = 0; j < 8; ++j) { mur[j] = mu[ch + j]; muk[j] = mu[512 + ch + j]; muv[j] = mu[cv + j]; kkc[j] = kkp[ch + j]; kac[j] = kap[ch + j]; }
            ScanRegs R0, R1, R2; scan_load(R0, U, WAw, WAa, b, h, q, 0, sw, lane); scan_load(R1, U, WAw, WAa, b, h, q, 1, sw, lane);
#define SC_FLUSH(kk_) do { const int c_ = (kk_) - 2; if (c_ >= 0 && c_ < SC_NCH) { const int ntok_ = c_ == 0 ? NMETA : SC_TOK, p0_ = c_ == 0 ? 0 : NMETA + SC_TOK * (c_ - 1); \
                const LAS float* yb_ = (const LAS float*)(F.lds + SC_YB + (c_ & 1) * (SC_TOK * 16 * 4)); const int t2_ = sw * 64 + lane, tt_ = t2_ >> 3, pr_ = t2_ & 7; \
                if (tt_ < ntok_ && (b == 0 || c_ > 0)) { const int row_ = row_of(b, p0_ + tt_); \
                    *(unsigned*)(Y + (size_t)row_ * NY + h * 64 + 16 * q + 2 * pr_) = cvt_pk_bf16(yb_[tt_ * 16 + 2 * pr_], yb_[tt_ * 16 + 2 * pr_ + 1]); } } } while (0)
#define SC_SUBIT(kk_, RC_, RL_) do { scan_load(RL_, U, WAw, WAa, b, h, q, (kk_) + 2, sw, lane); \
                if ((kk_) < SC_NCH) scan_stage(RC_, (LAS float*)(F.lds + ((kk_) & 1) * SC_BUF), (kk_), sw, lane, mur, muk, muv, kkc, kac); \
                SC_FLUSH(kk_); LDS_WAIT(); __builtin_amdgcn_s_barrier(); asm volatile("" ::: "memory"); } while (0)
            for (int k = 0; k < NIT; k += 3) { SC_SUBIT(k, R0, R2); SC_SUBIT(k + 1, R1, R0); SC_SUBIT(k + 2, R2, R1); }
#undef SC_SUBIT
#undef SC_FLUSH
        } else {
            const int rr = lane >> 4, kq = lane & 15, row16 = 4 * wave + rr;
            f32x2 S01 = {0.f, 0.f}, S23 = {0.f, 0.f};
            for (int k = 0; k < NIT; ++k) {
                if (k >= 1 && k <= SC_NCH) {
                    const int c = k - 1, ntok = c == 0 ? NMETA : SC_TOK;
                    const LAS float* buf = (const LAS float*)(F.lds + (c & 1) * SC_BUF);
                    LAS float* yb = (LAS float*)(F.lds + SC_YB + (c & 1) * (SC_TOK * 16 * 4));
                    const unsigned bvec = (unsigned)(size_t)buf + 16u * kq, bvs = (unsigned)(size_t)buf + (5 * SC_VEC + row16 * 4) * 4u;
                    for (int t0 = 0; t0 < ntok; t0 += 16) {
                        float yk = 0.f; StepIn I0, I1, I2;
                        const unsigned v0 = bvec + t0 * 256u, w0 = bvs + t0 * 256u;
#define SC_LD(I, j) step_load<j>(I, v0, w0)
#define SC_ST(I, j, n) do { STEP_WAIT(I, n); const float y_ = step_compute(I, S01, S23); yk = (kq == (j)) ? y_ : yk; } while (0)
                        SC_LD(I0, 0); SC_LD(I1, 1);
                        SC_LD(I2, 2); SC_ST(I0, 0, 12); SC_LD(I0, 3); SC_ST(I1, 1, 12); SC_LD(I1, 4); SC_ST(I2, 2, 12);
                        SC_LD(I2, 5); SC_ST(I0, 3, 12); SC_LD(I0, 6); SC_ST(I1, 4, 12); SC_LD(I1, 7); SC_ST(I2, 5, 12);
                        SC_LD(I2, 8); SC_ST(I0, 6, 12); SC_LD(I0, 9); SC_ST(I1, 7, 12); SC_LD(I1, 10); SC_ST(I2, 8, 12);
                        SC_LD(I2, 11); SC_ST(I0, 9, 12); SC_LD(I0, 12); SC_ST(I1, 10, 12); SC_LD(I1, 13); SC_ST(I2, 11, 12);
                        SC_LD(I2, 14); SC_ST(I0, 12, 12); SC_LD(I0, 15); SC_ST(I1, 13, 12); SC_ST(I2, 14, 6); SC_ST(I0, 15, 0);
#undef SC_LD
#undef SC_ST
                        yb[(t0 + kq) * 16 + row16] = yk;
                    }
                }
                LDS_WAIT(); __builtin_amdgcn_s_barrier(); asm volatile("" ::: "memory");
            }
        }
    }
}

#define LD8(dst, p) float dst[8]; { const f32x4 x0_ = *(const f32x4*)(p), x1_ = *(const f32x4*)((p) + 4); dst[0] = x0_[0]; dst[1] = x0_[1]; dst[2] = x0_[2]; dst[3] = x0_[3]; dst[4] = x1_[0]; dst[5] = x1_[1]; dst[6] = x1_[2]; dst[7] = x1_[3]; }
namespace p2 {
constexpr int X_AT = 0, X_RT = 4096, X_BT = 8192, X_KT = 12288, X_VT = 16384, X_AAB = 20480, X_AAK = 24576, X_MRK = 26624, X_TT = 28672, X_A21 = 30720, X_TC11 = 31232, X_Z1T = 31744, SZ = 32256, NW = 4;
constexpr int G_TT = 0, G_MRB = 2048, G_XA = 4096, G_FA = 8192, G_SZ = 12288;
static_assert(NW * SZ <= LDSCTL_OFF && X_AAK == X_AAB + 4096 && X_MRK == X_AAK + 2048 && X_TT == X_MRK + 2048, "prep2 LDS");
}
constexpr int P2_UNITS = 8 * (1 + NB * 256);
static_assert((size_t)P2_UNITS * p2::G_SZ <= (size_t)NREAL * DM * 4, "scan side blocks");
__device__ __forceinline__ int p2_unit(int b, int h, int c) { return (c == 0 ? 0 : 1 + b * 256 + (c - 1)) * 8 + h; }
namespace ck {
constexpr int PSZ = 26880, NSLOT = 4, O_AT = 0, O_RT = 4096, O_TT = 8192, O_MRB = 10240, O_XA = 12288, O_FA = 14336, O_BT = 16384, O_KT = 20992, BK_LD = 72  , O_VV = 25600  , O_GV = 26624;
constexpr int C_BASE = 132096, O_ST = 0, O_U0T = 2048, O_WT = 3072, O_FLAG = 4096, NCH = 1 + SEQ / 32;
static_assert(NSLOT * PSZ <= LDSCTL_OFF && C_BASE + O_FLAG + 64 <= LDS_BYTES && C_BASE >= PTR_OFF + 8 * 40, "chunked-scan LDS map");
typedef float f32x4v __attribute__((ext_vector_type(4)));
__device__ __forceinline__ f32x4 mma(bf16x8 a, bf16x8 b, f32x4 c) { return __builtin_amdgcn_mfma_f32_16x16x32_bf16(a, b, c, 0, 0, 0); }
__device__ __forceinline__ bf16x8 frag(const LAS unsigned char* base, int ld, int row0, int k0, int lane) { return *(const LAS bf16x8*)(base + ((row0 + (lane & 15)) * ld + k0 + 8 * (lane >> 4)) * 2); }
__device__ __forceinline__ bf16x8 frag16(const LAS unsigned char* base, int ld, int row0, int lane) { const bf16x8 z = {0, 0, 0, 0, 0, 0, 0, 0}; const int q = lane >> 4; bf16x8 v = *(const LAS bf16x8*)(base + ((row0 + (lane & 15)) * ld + 8 * (q & 1)) * 2); return q < 2 ? v : z; }
__device__ __forceinline__ void lds_spin(volatile LAS unsigned* p, unsigned want) { while (*p < want) __builtin_amdgcn_s_sleep(1); }
__device__ __forceinline__ bf16x8 frag_tr(const LAS unsigned char* base, int pitch, int k0, int n0, int lane) {
    const unsigned a0 = (unsigned)(size_t)base + (unsigned)((k0 + 8 * (lane >> 4) + ((lane >> 2) & 3)) * pitch + n0 * 2 + 8 * (lane & 3)), a1 = a0 + 4u * (unsigned)pitch;
    u32x2 lo, hi; asm volatile("ds_read_b64_tr_b16 %0, %2\n\tds_read_b64_tr_b16 %1, %3\n\ts_waitcnt lgkmcnt(0)" : "=&v"(lo), "=&v"(hi) : "v"(a0), "v"(a1) : "memory");
    const u32x4 v = {lo.x, lo.y, hi.x, hi.y}; return __builtin_bit_cast(bf16x8, v);
}
}
#define LD8G(dst, p) float dst[8]; { const f32x4 x0_ = *(const GAS f32x4*)(p), x1_ = *(const GAS f32x4*)((p) + 4); dst[0] = x0_[0]; dst[1] = x0_[1]; dst[2] = x0_[2]; dst[3] = x0_[3]; dst[4] = x1_[0]; dst[5] = x1_[1]; dst[6] = x1_[2]; dst[7] = x1_[3]; }
__device__ __forceinline__ bf16x8 pack_acc(f32x4 a, f32x4 b) { const u32x4 v = {cvt_pk_bf16(a[0], a[1]), cvt_pk_bf16(a[2], a[3]), cvt_pk_bf16(b[0], b[1]), cvt_pk_bf16(b[2], b[3])}; return __builtin_bit_cast(bf16x8, v); }
struct TrF { u32x2 lo, hi; };
__device__ __forceinline__ void tr_issue(TrF& f, const LAS unsigned char* base, int pitch, int k0, int n0, int step, int lane) {
    const unsigned a0 = (unsigned)(size_t)base + (unsigned)((k0 + step * (lane >> 4) + ((lane >> 2) & 3)) * pitch + n0 * 2 + 8 * (lane & 3)), a1 = a0 + (unsigned)((step == 8 ? 4 : 16) * pitch);
    asm volatile("ds_read_b64_tr_b16 %0, %2\n\tds_read_b64_tr_b16 %1, %3" : "=&v"(f.lo), "=&v"(f.hi) : "v"(a0), "v"(a1) : "memory");
}
__device__ __forceinline__ bf16x8 tr_get(const TrF& f) { const u32x4 v = {f.lo.x, f.lo.y, f.hi.x, f.hi.y}; return __builtin_bit_cast(bf16x8, v); }
#define TR_WAIT4(a, b, c, d) asm volatile("s_waitcnt lgkmcnt(0)" : "+v"(a.lo), "+v"(a.hi), "+v"(b.lo), "+v"(b.hi), "+v"(c.lo), "+v"(c.hi), "+v"(d.lo), "+v"(d.hi) :: "memory")
#define TR_WAIT5(a, b, c, d, e) asm volatile("s_waitcnt lgkmcnt(0)" : "+v"(a.lo), "+v"(a.hi), "+v"(b.lo), "+v"(b.hi), "+v"(c.lo), "+v"(c.hi), "+v"(d.lo), "+v"(d.hi), "+v"(e.lo), "+v"(e.hi) :: "memory")
__device__ __forceinline__ void ck_fetch(u32x4 (&PR)[24], const bf16_t* U, const bf16_t* WAw, const bf16_t* WAa, const float* GC, const unsigned char* CKX, int b, int h, int q, int c, int lane) {
    c = c < ck::NCH ? c : ck::NCH - 1;
    const int o = lane & 7, ti = lane >> 3, ch = h * 64 + 8 * o; const int p0 = c == 0 ? 0 : NMETA + 32 * (c - 1), nreal = c == 0 ? NMETA : 32;
#pragma unroll
    for (int p = 0; p < 4; ++p) { const int t = 8 * p + ti; const size_t row = (size_t)row_of(b, p0 + (t < nreal ? t : 0));
        PR[p] = *(const GAS u32x4*)(WAw + row * AW + ch); PR[4 + p] = *(const GAS u32x4*)(WAa + row * AW + ch);
        PR[8 + p] = *(const GAS u32x4*)(U + row * NABC + ch); PR[12 + p] = *(const GAS u32x4*)(U + row * NABC + 512 + ch); }
    { const int t = lane >> 1; PR[16] = *(const GAS u32x4*)(U + (size_t)row_of(b, p0 + (t < nreal ? t : 0)) * NABC + 1024 + h * 64 + 16 * q + 8 * (lane & 1)); }
    const unsigned char* gx = CKX + (size_t)p2_unit(b, h, c) * p2::G_SZ;
    PR[17] = *(const GAS u32x4*)(gx + p2::G_TT + lane * 32); PR[18] = *(const GAS u32x4*)(gx + p2::G_TT + lane * 32 + 16);
    PR[19] = *(const GAS u32x4*)(gx + p2::G_MRB + lane * 32); PR[20] = *(const GAS u32x4*)(gx + p2::G_MRB + lane * 32 + 16);
    { const u32x2 x0 = *(const GAS u32x2*)(gx + p2::G_XA + ((q * 2 + 0) * 64 + lane) * 8), x1 = *(const GAS u32x2*)(gx + p2::G_XA + ((q * 2 + 1) * 64 + lane) * 8);
      const u32x2 f0 = *(const GAS u32x2*)(gx + p2::G_FA + ((q * 2 + 0) * 64 + lane) * 8), f1 = *(const GAS u32x2*)(gx + p2::G_FA + ((q * 2 + 1) * 64 + lane) * 8);
      PR[21] = (u32x4){x0.x, x0.y, x1.x, x1.y}; PR[22] = (u32x4){f0.x, f0.y, f1.x, f1.y}; }
    PR[23] = *(const GAS u32x4*)(GC + ((size_t)((c == 0 ? 0 : b) * 8 + h) * 257 + c) * 64 + 4 * (lane & 15));
}
__device__ __forceinline__ void ck_put(LAS unsigned char* pb, const u32x4 (&PR)[24], int c, int lane) {
    using namespace ck;
    const int o = lane & 7, ti = lane >> 3; const int nreal = c == 0 ? NMETA : 32; const u32x4 z4 = {0u, 0u, 0u, 0u};
    const int o4 = o & 3, gl = (4 * (o4 & 1) + (o4 >> 1)) * 8 + (o >> 2) * 64;
#pragma unroll
    for (int p = 0; p < 4; ++p) { const int t = 8 * p + ti; const bool real = t < nreal; const u32x4 xa = real ? PR[p] : z4, xr = real ? PR[8 + p] : z4;
        *(LAS u32x2*)(pb + O_AT + t * 128 + gl) = (u32x2){xa.x, xa.y}; *(LAS u32x2*)(pb + O_AT + t * 128 + gl + 16) = (u32x2){xa.z, xa.w};
        *(LAS u32x2*)(pb + O_RT + t * 128 + gl) = (u32x2){xr.x, xr.y}; *(LAS u32x2*)(pb + O_RT + t * 128 + gl + 16) = (u32x2){xr.z, xr.w};
        *(LAS u32x4*)(pb + O_BT + (t * BK_LD + 8 * o) * 2) = real ? PR[4 + p] : z4; *(LAS u32x4*)(pb + O_KT + (t * BK_LD + 8 * o) * 2) = real ? PR[12 + p] : z4; }
    *(LAS u32x4*)(pb + O_VV + lane * 16) = (lane >> 1) < nreal ? PR[16] : z4;
    { const int trow = lane >> 1, hf = lane & 1;
#pragma unroll
      for (int e = 0; e < 2; ++e) { const int o5 = 2 * hf + e, g5 = (4 * (o5 & 1) + (o5 >> 1)) * 8; const u32x4 xt = PR[17 + e], xm = PR[19 + e];
          *(LAS u32x2*)(pb + O_TT + trow * 64 + g5) = (u32x2){xt.x, xt.y}; *(LAS u32x2*)(pb + O_TT + trow * 64 + g5 + 16) = (u32x2){xt.z, xt.w};
          *(LAS u32x2*)(pb + O_MRB + trow * 64 + g5) = (u32x2){xm.x, xm.y}; *(LAS u32x2*)(pb + O_MRB + trow * 64 + g5 + 16) = (u32x2){xm.z, xm.w}; } }
    { const u32x4 x = PR[21], f = PR[22];
      *(LAS u32x4*)(pb + O_XA + lane * 16) = (u32x4){x.x << 16, x.x & 0xffff0000u, x.y << 16, x.y & 0xffff0000u}; *(LAS u32x4*)(pb + O_XA + (64 + lane) * 16) = (u32x4){x.z << 16, x.z & 0xffff0000u, x.w << 16, x.w & 0xffff0000u};
      *(LAS u32x4*)(pb + O_FA + lane * 16) = (u32x4){f.x << 16, f.x & 0xffff0000u, f.y << 16, f.y & 0xffff0000u}; *(LAS u32x4*)(pb + O_FA + (64 + lane) * 16) = (u32x4){f.z << 16, f.z & 0xffff0000u, f.w << 16, f.w & 0xffff0000u}; }
    if (lane < 16) *(LAS u32x4*)(pb + O_GV + lane * 16) = PR[23];
}
__device__ __forceinline__ void phase_scan_chunked(Frame& F, int l) {
    PHASE_ENTER(F);
    using namespace ck;
    const bf16_t* U = F.R1; const bf16_t* WAw = F.R2; const bf16_t* WAa = F.R2 + (size_t)NROWS * AW; bf16_t* Y = F.R3;
    const float* GC = (const float*)(F.ws + WS_GC); const unsigned char* CKX = (const unsigned char*)lds_ptr(F.lds, 36);
    const int lane = F.lane, wave = F.wave, fr = lane & 15, fq = lane >> 4;
    LAS unsigned char* cb = F.lds + C_BASE; volatile LAS unsigned* flags = (volatile LAS unsigned*)(cb + O_FLAG);
    for (int u0 = F.bid; u0 < NB * 8 * 4; u0 += F.G) {
        const int unit = F.G == 256 ? (u0 & 7) * 32 + (u0 >> 3) : u0;
        const int b = unit >> 5, h = (unit >> 2) & 7, q = unit & 3;
        __syncthreads();
        if (F.tid < 16) flags[F.tid] = 0u;
        for (int i = F.tid; i < 1024; i += 512) ((LAS unsigned*)(cb + O_ST))[i] = 0u;
        __syncthreads();
        if (wave >= 1 && wave <= NSLOT) {
            const int sl = wave - 1; LAS unsigned char* pb = F.lds + sl * PSZ;
            unsigned n = 0; u32x4 PR[24]; ck_fetch(PR, U, WAw, WAa, GC, CKX, b, h, q, sl, lane);
            for (int c = sl; c < NCH; c += NSLOT, ++n) {
                lds_spin(flags + 4 + sl, n);
                asm volatile("" ::: "memory");
                ck_put(pb, PR, c, lane);
                ck_fetch(PR, U, WAw, WAa, GC, CKX, b, h, q, c + NSLOT, lane);
                asm volatile("s_waitcnt lgkmcnt(0)" ::: "memory");
                if (lane == 0) flags[sl] = n + 1;
            }
        } else if (wave == 0) {
            f32x4 accS[4];
#pragma unroll
            for (int kt = 0; kt < 4; ++kt) accS[kt] = (f32x4){0.f, 0.f, 0.f, 0.f};
            for (int c = 0; c < NCH; ++c) {
                const int s = c & (NSLOT - 1); const unsigned n = (unsigned)(c >> 2);
                const LAS unsigned char* sb = F.lds + s * PSZ;
                lds_spin(flags + s, n + 1);
                asm volatile("" ::: "memory");
                f32x4 u0 = *(const LAS f32x4*)(sb + O_XA + lane * 16), u1 = *(const LAS f32x4*)(sb + O_XA + (64 + lane) * 16);
                const bf16x8 a00 = frag(sb + O_AT, 64, 0, 0, lane), a01 = frag(sb + O_AT, 64, 0, 32, lane), a10 = frag(sb + O_AT, 64, 16, 0, lane), a11 = frag(sb + O_AT, 64, 16, 32, lane);
                const bf16x8 t0 = frag(sb + O_TT, 32, 0, 0, lane), t1 = frag(sb + O_TT, 32, 16, 0, lane);
                const bf16x8 pA = pack_acc(accS[0], accS[1]), pB = pack_acc(accS[2], accS[3]);
                asm volatile("" ::: "memory");
                f32x4 y0 = *(const LAS f32x4*)(sb + O_FA + lane * 16), y1 = *(const LAS f32x4*)(sb + O_FA + (64 + lane) * 16);
                const bf16x8 r00 = frag(sb + O_RT, 64, 0, 0, lane), r01 = frag(sb + O_RT, 64, 0, 32, lane), r10 = frag(sb + O_RT, 64, 16, 0, lane), r11 = frag(sb + O_RT, 64, 16, 32, lane);
                const bf16x8 m0 = frag(sb + O_MRB, 32, 0, 0, lane), m1 = frag(sb + O_MRB, 32, 16, 0, lane);
                f32x4 g[4];
#pragma unroll
                for (int kt = 0; kt < 4; ++kt) g[kt] = *(const LAS f32x4*)(sb + O_GV + (16 * kt + 4 * fq) * 4);
                u0 = mma(a00, pA, u0); u1 = mma(a10, pA, u1); u0 = mma(a01, pB, u0); u1 = mma(a11, pB, u1);
                y0 = mma(pA, r00, y0); y1 = mma(pA, r10, y1); y0 = mma(pB, r01, y0); y1 = mma(pB, r11, y1);
                TrF fv, fk[4], fb[4];
                tr_issue(fv, sb + O_VV, 32, 0, 0, 8, lane);
#pragma unroll
                for (int kt = 0; kt < 4; ++kt) tr_issue(fk[kt], sb + O_KT, 2 * BK_LD, 0, 16 * kt, 8, lane);
                const bf16x8 pU = pack_acc(u0, u1);
                f32x4 w0 = {0.f, 0.f, 0.f, 0.f}, w1 = w0; w0 = mma(t0, pU, w0); w1 = mma(t1, pU, w1);
                TR_WAIT5(fv, fk[0], fk[1], fk[2], fk[3]);
#pragma unroll
                for (int kt = 0; kt < 4; ++kt) tr_issue(fb[kt], sb + O_BT, 2 * BK_LD, 0, 16 * kt, 4, lane);
                { const bf16x8 fvv = tr_get(fv);
#pragma unroll
                  for (int kt = 0; kt < 4; ++kt) accS[kt] = mma(tr_get(fk[kt]), fvv, accS[kt]); }
                const bf16x8 pW = pack_acc(w0, w1);
                y0 = mma(pW, m0, y0); y1 = mma(pW, m1, y1);
                TR_WAIT4(fb[0], fb[1], fb[2], fb[3]);
                if (lane == 0) flags[4 + s] = n + 1;
#pragma unroll
                for (int kt = 0; kt < 4; ++kt) { accS[kt] = mma(tr_get(fb[kt]), pW, accS[kt]); accS[kt] = accS[kt] * g[kt]; }
                { const int nreal = c == 0 ? NMETA : 32, p0 = c == 0 ? 0 : NMETA + 32 * (c - 1);
                  if (fr < nreal && (b == 0 || c > 0)) *(u32x2*)(Y + (size_t)row_of(b, p0 + fr) * NY + h * 64 + 16 * q + 4 * fq) = (u32x2){cvt_pk_bf16(y0[0], y0[1]), cvt_pk_bf16(y0[2], y0[3])};
                  if (16 + fr < nreal && (b == 0 || c > 0)) *(u32x2*)(Y + (size_t)row_of(b, p0 + 16 + fr) * NY + h * 64 + 16 * q + 4 * fq) = (u32x2){cvt_pk_bf16(y1[0], y1[1]), cvt_pk_bf16(y1[2], y1[3])}; }
            }
        }
    }
    __syncthreads();
}

template <int WIN> __device__ __forceinline__ void pool_group(const bf16_t* U, bf16_t* Y, const bf16_t* pwt, const float* csc, int b, int pbase, int g, int lane) {
    const int fr = lane & 15, fq = lane >> 4, p = pbase + fr, row = row_of(b, p), cnt = (p + 1) < WIN ? (p + 1) : WIN;
    const float inv = 1.0f / (float)cnt;
    int rows[WIN];
#pragma unroll
    for (int i = 0; i < WIN; ++i) rows[i] = row_of(b, p - i > 0 ? p - i : 0);
    bf16x8 af[4];
#pragma unroll
    for (int ks = 0; ks < 4; ++ks) {
        const int col = AIN + 1024 + g * 128 + 32 * ks + 8 * fq;
        float sum[8], z0[8];
        constexpr int NB8 = WIN < 8 ? WIN : 8;
#pragma unroll
        for (int i0 = 0; i0 < WIN; i0 += NB8) {
            u32x4 raw[NB8];
#pragma unroll
            for (int i = 0; i < NB8; ++i) raw[i] = *(const u32x4*)(U + (size_t)rows[i0 + i] * NABC + col);
#pragma unroll
            for (int i = 0; i < NB8; ++i) { float zz[8]; unpack8(raw[i], zz);
                if (i0 + i == 0) {
#pragma unroll
                    for (int j = 0; j < 8; ++j) { z0[j] = zz[j]; sum[j] = zz[j]; } }
                else { const float m = (i0 + i) < cnt ? 1.0f : 0.0f;
#pragma unroll
                    for (int j = 0; j < 8; ++j) sum[j] += m * zz[j]; } }
        }
#pragma unroll
        for (int j = 0; j < 8; ++j) sum[j] = sum[j] * inv - z0[j];
        const u32x4 pk = pack8(sum); af[ks] = __builtin_bit_cast(bf16x8, pk);
    }
    const bf16_t* bw = pwt + (size_t)g * 128 * 128;
#pragma unroll 2
    for (int ctile = 0; ctile < 8; ++ctile) {
        f32x4 acc = (f32x4){0.f, 0.f, 0.f, 0.f};
#pragma unroll
        for (int ks = 0; ks < 4; ++ks) acc = __builtin_amdgcn_mfma_f32_16x16x32_bf16(*(const bf16x8*)(bw + (size_t)(16 * ctile + fr) * 128 + 32 * ks + 8 * fq), af[ks], acc, 0, 0, 0);
        const int c = g * 128 + 16 * ctile + 4 * fq; const f32x4 sc = *(const f32x4*)(csc + c);
        u32x2 o; o.x = cvt_pk_bf16(acc[0] * sc[0], acc[1] * sc[1]); o.y = cvt_pk_bf16(acc[2] * sc[2], acc[3] * sc[3]);
        *(u32x2*)(Y + (size_t)row * NY + 2 * AW + c) = o;
    }
}
constexpr int PB_CW = 0, PB_CT = 31 * 512 * 4, PB_NUNIT = NREAL / 32 + 1;
#ifndef PB_REP
#define PB_REP 0
#endif
__device__ __forceinline__ void pb_unit(int u, int& b, int& p0, int& ntok) { const bool meta = (u == PB_NUNIT - 1); b = meta ? 0 : (u >> 8); p0 = meta ? 0 : NMETA + 32 * (u & 255); ntok = meta ? NMETA : 32; }
template <bool DRY> __device__ __forceinline__ void postbc_a(Frame& F, int l) {
    PHASE_ENTER(F);
    const bf16_t* U = F.R1; const float* BS = (const float*)(F.ws + WS_BS); bf16_t* Y = F.R3;
    const int lane = F.lane, wave = F.wave, c8 = 8 * lane;
    float lxw[8], lxb[8];
#pragma unroll
    for (int j = 0; j < 8; ++j) { lxw[j] = in_ptr(F, I_LNXW)[l * AW + c8 + j]; lxb[j] = in_ptr(F, I_LNXB)[l * AW + c8 + j]; }
    for (int u = F.bid; u < PB_NUNIT; u += F.G) {
        int b, p0, ntok; pb_unit(u, b, p0, ntok);
        for (int tt = wave; tt < ntok; tt += 8) {
            const int p = p0 + tt, row = row_of(b, p);
            float y[8], zv[8], gv[8];
            unpack8(*(const u32x4*)(Y + (size_t)row * NY + c8), y); unpack8(*(const u32x4*)(Y + (size_t)row * NY + AW + c8), gv);
            unpack8(*(const u32x4*)(U + (size_t)row * NABC + 1024 + c8), zv);
            const float bs = BS[(size_t)row * 8 + (lane >> 3)];
            float s = 0.f;
#pragma unroll
            for (int j = 0; j < 8; ++j) s += y[j];
            s = allreduce8(s);
            const float mean = s * (1.0f / 64.0f); float qv = 0.f;
#pragma unroll
            for (int j = 0; j < 8; ++j) { y[j] -= mean; qv += y[j] * y[j]; }
            qv = allreduce8(qv);
            const float rstd = __builtin_amdgcn_rsqf(qv * (1.0f / 64.0f) + LNX_EPS);
            float o[8];
#pragma unroll
            for (int j = 0; j < 8; ++j) o[j] = (y[j] * rstd * lxw[j] + lxb[j] + bs * zv[j]) * gv[j];
            if (DRY) *(u32x4*)((bf16_t*)(F.ws + 962 * MiB) + (size_t)(row & 32767) * AW + c8) = pack8(o); else *(u32x4*)(Y + (size_t)row * NY + c8) = pack8(o);
        }
    }
}
__device__ __forceinline__ void postbc_b(Frame& F, int l) {
    PHASE_ENTER(F);
    const bf16_t* U = F.R1; bf16_t* Y = F.R3;
    LAS float* cw = (LAS float*)(F.lds + PB_CW); LAS bf16_t* ct = (LAS bf16_t*)(F.lds + PB_CT);
    const int lane = F.lane, wave = F.wave, c8 = 8 * lane;
    __syncthreads();
    for (int i = F.tid; i < 31 * 512; i += 512) cw[i] = in_ptr(F, I_CONVW)[(size_t)l * 31 * 512 + i];
    float cvb[8], lng[8], lnb[8];
#pragma unroll
    for (int j = 0; j < 8; ++j) { cvb[j] = in_ptr(F, I_CONVB)[l * AW + c8 + j]; lng[j] = in_ptr(F, I_BLNG)[l * AW + c8 + j]; lnb[j] = in_ptr(F, I_BLNB)[l * AW + c8 + j]; }
    for (int u = F.bid; u < PB_NUNIT; u += F.G) {
        int b, p0, ntok; pb_unit(u, b, p0, ntok);
        __syncthreads();
        {
            u32x4 r1[8], r2[8];
#pragma unroll
            for (int it = 0; it < 8; ++it) { const int idx = F.tid + it * 512, i = idx >> 6, oc = idx & 63, p = p0 - 30 + i; const int row = row_of(b, p > 0 ? p : 0);
                r1[it] = *(const u32x4*)(U + (size_t)row * NABC + AIN + 8 * oc); r2[it] = *(const u32x4*)(U + (size_t)row * NABC + AIN + 512 + 8 * oc); }
#pragma unroll
            for (int it = 0; it < 8; ++it) { const int idx = F.tid + it * 512, i = idx >> 6, oc = idx & 63, p = p0 - 30 + i;
                if (i < 30 + ntok) { float z1[8], z2[8]; unpack8(r1[it], z1); unpack8(r2[it], z2); const float m = p >= 0 ? 1.0f : 0.0f;
#pragma unroll
                    for (int j = 0; j < 8; ++j) z1[j] *= m * fast_sigmoid(z2[j]);
                    *(LAS u32x4*)(ct + i * 512 + 8 * oc) = pack8(z1); } }
        }
        __syncthreads();
        const int TPW = ntok / 8, t0w = wave * TPW;
        {
            float acc[4][8];
#pragma unroll
            for (int i = 0; i < 4; ++i)
#pragma unroll
                for (int j = 0; j < 8; ++j) acc[i][j] = cvb[j];
            float win[4][8];
#pragma unroll
            for (int i = 0; i < 3; ++i) unpack8(*(const LAS u32x4*)(ct + (t0w + i) * 512 + c8), win[i + 1]);
#pragma unroll 2
            for (int jt = 0; jt < 31; ++jt) {
#pragma unroll
                for (int i = 0; i < 3; ++i)
#pragma unroll
                    for (int j = 0; j < 8; ++j) win[i][j] = win[i + 1][j];
                unpack8(*(const LAS u32x4*)(ct + (t0w + jt + 3) * 512 + c8), win[3]);
                const f32x4 w0 = *(const LAS f32x4*)(cw + jt * 512 + c8), w1 = *(const LAS f32x4*)(cw + jt * 512 + c8 + 4);
#pragma unroll
                for (int i = 0; i < 4; ++i)
#pragma unroll
                    for (int j = 0; j < 4; ++j) { acc[i][j] += win[i][j] * w0[j]; acc[i][4 + j] += win[i][4 + j] * w1[j]; }
            }
#pragma unroll
            for (int i = 0; i < 4; ++i) {
                if (i < TPW) {
                    const int row = row_of(b, p0 + t0w + i);
                    float s = 0.f;
#pragma unroll
                    for (int j = 0; j < 8; ++j) s += acc[i][j];
                    const float mean = wave_sum(s) * (1.0f / 512.0f); float qv = 0.f;
#pragma unroll
                    for (int j = 0; j < 8; ++j) { acc[i][j] -= mean; qv += acc[i][j] * acc[i][j]; }
                    const float rstd = __builtin_amdgcn_rsqf(wave_sum(qv) * (1.0f / 512.0f) + LN_EPS);
                    float o[8];
#pragma unroll
                    for (int j = 0; j < 8; ++j) { const float x = acc[i][j] * rstd * lng[j] + lnb[j]; o[j] = x * fast_sigmoid(x); }
                    *(u32x4*)(Y + (size_t)row * NY + AW + c8) = pack8(o);
                }
            }
        }
    }
    __syncthreads();
}
__device__ __forceinline__ void postbc_c(Frame& F, int l) {
    PHASE_ENTER(F);
    const bf16_t* U = F.R1; bf16_t* Y = F.R3; const bf16_t* pwt = F.W + (size_t)l * WL_SIZE + WL_PW; const float* csc = in_ptr(F, I_CSCALE) + l * AW;
    const int lane = F.lane, rg = F.wave & 1, g = F.wave >> 1, fr = lane & 15, fq = lane >> 4;
    LAS unsigned char* tile = F.lds;
    for (int u = F.bid; u < PB_NUNIT; u += F.G) {
        int b, p0, ntok; pb_unit(u, b, p0, ntok);
        __syncthreads();
        {
            u32x4 rr[6];
#pragma unroll
            for (int it = 0; it < 6; ++it) { const int idx = F.tid + it * 512, i = idx >> 6, oc = idx & 63, p = p0 - 15 + i; const int row = row_of(b, p > 0 ? (p < NMETA + SEQ ? p : 0) : 0);
                rr[it] = *(const GAS u32x4*)(U + (size_t)row * NABC + AIN + 1024 + 8 * oc); }
#pragma unroll
            for (int it = 0; it < 6; ++it) { const int idx = F.tid + it * 512, i = idx >> 6, oc = idx & 63, p = p0 - 15 + i;
                if (i < 15 + ntok) *(LAS u32x4*)(tile + (i * 512 + 8 * oc) * 2) = p >= 0 ? rr[it] : (u32x4){0u, 0u, 0u, 0u}; }
        }
        __syncthreads();
        if (rg * 16 < ntok) {
            const int win = 2 << g, t = rg * 16 + fr, p = p0 + t, cnt = (p + 1) < win ? (p + 1) : win; const float inv = 1.0f / (float)cnt;
            const bf16_t* bwp = pwt + (size_t)g * 128 * 128 + (size_t)fr * 128 + 8 * fq;
            bf16x8 bfr[4][4];
#pragma unroll
            for (int ctile = 0; ctile < 4; ++ctile)
#pragma unroll
                for (int ks = 0; ks < 4; ++ks) bfr[ctile][ks] = *(const GAS bf16x8*)(bwp + (size_t)(16 * ctile) * 128 + 32 * ks);
            bf16x8 af[4];
#pragma unroll
            for (int ks = 0; ks < 4; ++ks) {
                const LAS unsigned char* cp = tile + ((15 + t) * 512 + g * 128 + 32 * ks + 8 * fq) * 2;
                float z0[8], sum[8]; unpack8(*(const LAS u32x4*)cp, z0);
#pragma unroll
                for (int j = 0; j < 8; ++j) sum[j] = z0[j];
#pragma unroll 1
                for (int i = 1; i < win; ++i) { float zz[8]; unpack8(*(const LAS u32x4*)(cp - i * 1024), zz);
#pragma unroll
                    for (int j = 0; j < 8; ++j) sum[j] += zz[j]; }
#pragma unroll
                for (int j = 0; j < 8; ++j) sum[j] = sum[j] * inv - z0[j];
                const u32x4 pk = pack8(sum); af[ks] = __builtin_bit_cast(bf16x8, pk);
            }
            const int row = row_of(b, p);
#pragma unroll
            for (int half = 0; half < 2; ++half) {
                if (half == 1) {
#pragma unroll
                    for (int ctile = 0; ctile < 4; ++ctile)
#pragma unroll
                        for (int ks = 0; ks < 4; ++ks) bfr[ctile][ks] = *(const GAS bf16x8*)(bwp + (size_t)(16 * (4 + ctile)) * 128 + 32 * ks);
                }
#pragma unroll
                for (int ct4 = 0; ct4 < 4; ++ct4) {
                    const int ctile = 4 * half + ct4;
                    f32x4 acc = (f32x4){0.f, 0.f, 0.f, 0.f};
#pragma unroll
                    for (int ks = 0; ks < 4; ++ks) acc = __builtin_amdgcn_mfma_f32_16x16x32_bf16(bfr[ct4][ks], af[ks], acc, 0, 0, 0);
                    const int c = g * 128 + 16 * ctile + 4 * fq; const f32x4 sc = *(const GAS f32x4*)(csc + c);
                    u32x2 o; o.x = cvt_pk_bf16(acc[0] * sc[0], acc[1] * sc[1]); o.y = cvt_pk_bf16(acc[2] * sc[2], acc[3] * sc[3]);
                    *(u32x2*)(Y + (size_t)row * NY + 2 * AW + c) = o;
                }
            }
        }
    }
    __syncthreads();
}
__device__ __forceinline__ void phase_postbc(Frame& F, int l) {
    if (PB_REP & 4) postbc_a<true>(F, l); postbc_a<false>(F, l); postbc_b(F, l); if (PB_REP & 1) postbc_b(F, l); postbc_c(F, l); if (PB_REP & 2) postbc_c(F, l);
}

__device__ __forceinline__ void phase_prep2(Frame& F, int l) {
    PHASE_ENTER(F);
    using namespace p2; using ck::frag; using ck::frag16; using ck::frag_tr; using ck::mma;
    bf16_t* U = F.R1; bf16_t* WAw = F.R2; bf16_t* WAa = F.R2 + (size_t)NROWS * AW;
    const bf16_t* HALO = (const bf16_t*)(F.ws + WS_HALO); float* GC = (float*)(F.ws + WS_GC); float* BS = (float*)(F.ws + WS_BS);
    const float* mu = in_ptr(F, I_MU) + l * AIN; const float* kkp = in_ptr(F, I_KK) + l * AW; const float* kap = in_ptr(F, I_KA) + l * AW; const float* rkp = in_ptr(F, I_RK) + l * AW;
    const int lane = F.lane, o = lane & 7, ti = lane >> 3;
    if (F.wave < NW) {
    LAS unsigned char* pb = F.lds + F.wave * SZ; LAS float* cwb = (LAS float*)(pb + X_AAB);
    for (int un = F.bid * NW + F.wave; un < P2_UNITS; un += F.G * NW) {
        const int h = un & 7; const int b = un < 16384 ? (un >> 3) & 7 : 0, c = un < 16384 ? 256 - (un >> 6) : 0; const int uidx = p2_unit(b, h, c);
        const int ch = h * 64 + 8 * o, p0 = c == 0 ? 0 : NMETA + 32 * (c - 1), nreal = c == 0 ? NMETA : 32;
        const bool real = 4 * ti < nreal; const int row0 = row_of(b, p0 + (real ? 4 * ti : 0));
        u32x4 zr[5], zk[5], zv[5], ww[4], aa[4];
        { const bf16_t* prow = (real ? ti : 0) == 0 ? HALO + (size_t)(b * 256 + (c > 0 ? c - 1 : 0)) * 1536 : U + (size_t)(row0 - 1) * NABC;
          zr[0] = *(const GAS u32x4*)(prow + ch); zk[0] = *(const GAS u32x4*)(prow + 512 + ch); zv[0] = *(const GAS u32x4*)(prow + 1024 + ch); }
        { const bf16_t* ur = U + (size_t)row0 * NABC + ch; const bf16_t* wr = WAw + (size_t)row0 * AW + ch; const bf16_t* ar = WAa + (size_t)row0 * AW + ch;
#pragma unroll
          for (int p = 0; p < 4; ++p) { zr[p + 1] = *(const GAS u32x4*)(ur + p * NABC); zk[p + 1] = *(const GAS u32x4*)(ur + p * NABC + 512); zv[p + 1] = *(const GAS u32x4*)(ur + p * NABC + 1024);
              ww[p] = *(const GAS u32x4*)(wr + p * AW); aa[p] = *(const GAS u32x4*)(ar + p * AW); } }
        { const float msk = real ? 1.0f : 0.0f;
#pragma unroll
          for (int p = 0; p < 4; ++p) { float w8[8]; unpack8(ww[p], w8); LAS float* cw = cwb + (4 * ti + p) * 64 + 8 * o;
            *(LAS f32x4*)cw = (f32x4){msk * w8[0], msk * w8[1], msk * w8[2], msk * w8[3]}; *(LAS f32x4*)(cw + 4) = (f32x4){msk * w8[4], msk * w8[5], msk * w8[6], msk * w8[7]}; } }
        LDS_WAIT();
        { LAS float* cw = cwb + lane; float cv_[32];
#pragma unroll
          for (int i = 0; i < 32; ++i) cv_[i] = cw[i * 64];
          asm volatile("" ::: "memory");
#pragma unroll
          for (int i = 1; i < 32; ++i) cv_[i] += cv_[i - 1];
#pragma unroll
          for (int i = 0; i < 32; ++i) cw[i * 64] = cv_[i]; }
        LDS_WAIT();
        float cx[8];
        { const LAS float* cwp = cwb + (ti > 0 ? 4 * ti - 1 : 0) * 64 + 8 * o; const f32x4 x0 = *(const LAS f32x4*)cwp, x1 = *(const LAS f32x4*)(cwp + 4);
#pragma unroll
          for (int j = 0; j < 8; ++j) cx[j] = ti > 0 ? (j < 4 ? x0[j] : x1[j - 4]) : 0.f; }
        {
        LD8G(mur, mu + ch) LD8G(muk, mu + 512 + ch) LD8G(muv, mu + 1024 + ch) LD8G(kkc, kkp + ch) LD8G(kac, kap + ch) LD8G(rkc, rkp + ch)
        int row0s = row0; asm volatile("" : "+v"(row0s));
        bf16_t* ud = U + (size_t)row0s * NABC + ch; bf16_t* wd = WAw + (size_t)row0s * AW + ch; bf16_t* ad = WAa + (size_t)row0s * AW + ch;
        const float msk = real ? 1.0f : 0.0f;
#pragma unroll
        for (int p = 0; p < 4; ++p) {
            const float pm = (c == 0 && ti == 0 && p == 0) ? 0.0f : 1.0f; const int t = 4 * ti + p;
            float r8[8], rp8[8], k8[8], kp8[8], a8[8], v8[8], vp8[8];
            unpack8(zr[p + 1], r8); unpack8(zr[p], rp8); unpack8(zk[p + 1], k8); unpack8(zk[p], kp8); unpack8(aa[p], a8); unpack8(zv[p + 1], v8); unpack8(zv[p], vp8);
            float A[8], B[8], K[8], R[8], V[8], kx[8], kk[8], ss = 0.f, bsum = 0.f;
#pragma unroll
            for (int j = 0; j < 8; ++j) { R[j] = msk * (r8[j] + (pm * rp8[j] - r8[j]) * mur[j]); kx[j] = k8[j] + (pm * kp8[j] - k8[j]) * muk[j]; kk[j] = kx[j] * kkc[j]; ss += kk[j] * kk[j]; V[j] = msk * (v8[j] + (pm * vp8[j] - v8[j]) * muv[j]); }
            ss = allreduce8(ss);
            const float inv = msk / fmaxf(sqrtf(ss), 1e-12f);
#pragma unroll
            for (int j = 0; j < 8; ++j) { const float kn = kk[j] * inv; A[j] = -kn; B[j] = kn * a8[j]; K[j] = msk * kx[j] * (1.0f + (a8[j] - 1.0f) * kac[j]); bsum += R[j] * K[j] * rkc[j]; }
            bsum = allreduce8(bsum);
            const LAS float* cw = cwb + t * 64 + 8 * o; const f32x4 c0 = *(const LAS f32x4*)cw, c1 = *(const LAS f32x4*)(cw + 4);
            float at[8], rt[8], bt[8], kt[8], en[8];
#pragma unroll
            for (int j = 0; j < 8; ++j) { const float ci = j < 4 ? c0[j] : c1[j - 4]; const float ep = __expf(ci); en[j] = __builtin_amdgcn_rcpf(ep);
                at[j] = A[j] * __expf(-cx[j]); rt[j] = R[j] * en[j]; bt[j] = B[j] * ep; kt[j] = K[j] * ep; cx[j] = ci; }
            const u32x4 pa = pack8(at), pr = pack8(rt), pbv = pack8(bt), pk = pack8(kt), pv = pack8(V);
            *(LAS u32x4*)(pb + X_AT + (t * 64 + 8 * o) * 2) = pa; *(LAS u32x4*)(pb + X_RT + (t * 64 + 8 * o) * 2) = pr; *(LAS u32x4*)(pb + X_BT + (t * 64 + 8 * o) * 2) = pbv;
            *(LAS u32x4*)(pb + X_KT + (t * 64 + 8 * o) * 2) = pk; *(LAS u32x4*)(pb + X_VT + (t * 64 + 8 * o) * 2) = pv;
            if (real) {
                *(u32x4*)(wd + p * AW) = pa; *(u32x4*)(ad + p * AW) = pbv; *(u32x4*)(ud + p * NABC) = pr; *(u32x4*)(ud + p * NABC + 512) = pk; *(u32x4*)(ud + p * NABC + 1024) = pv;
                if (o == 0) BS[(size_t)(row0s + p) * 8 + h] = bsum;
            }
            if (p == 3 && ti == 7) { float* gv = GC + ((size_t)(b * 8 + h) * 257 + c) * 64 + 8 * o; *(f32x4*)gv = (f32x4){en[0], en[1], en[2], en[3]}; *(f32x4*)(gv + 4) = (f32x4){en[4], en[5], en[6], en[7]}; }
        }
        }
        LDS_WAIT();
        int ln; asm volatile("v_mbcnt_lo_u32_b32 %0, -1, 0\n\tv_mbcnt_hi_u32_b32 %0, -1, %0" : "=v"(ln)); const int fr = ln & 15, fq = ln >> 4;
        unsigned char* gx0 = (unsigned char*)lds_ptr(F.lds, 36) + (size_t)uidx * G_SZ; asm volatile("" : "+s"(gx0)); GAS unsigned char* gx = (GAS unsigned char*)gx0;
#pragma unroll
        for (int it = 0; it < 2; ++it)
#pragma unroll
            for (int jt = 0; jt < 2; ++jt) {
                f32x4 ab = {0.f, 0.f, 0.f, 0.f}, ak = ab, rb = ab, rk = ab;
                if (jt <= it) {
#pragma unroll
                    for (int s = 0; s < 2; ++s) { const bf16x8 fb = frag(pb + X_BT, 64, 16 * jt, 32 * s, ln), fk = frag(pb + X_KT, 64, 16 * jt, 32 * s, ln), fa = frag(pb + X_AT, 64, 16 * it, 32 * s, ln), frr = frag(pb + X_RT, 64, 16 * it, 32 * s, ln);
                        ab = mma(fb, fa, ab); ak = mma(fk, fa, ak); rb = mma(fb, frr, rb); rk = mma(fk, frr, rk); }
                }
                const int i = 16 * it + fr, j0 = 16 * jt + 4 * fq;
#pragma unroll
                for (int jj = 0; jj < 4; ++jj) { const bool st = (j0 + jj) < i, inc = (j0 + jj) <= i; ab[jj] = st ? ab[jj] : 0.f; ak[jj] = st ? ak[jj] : 0.f; rb[jj] = inc ? rb[jj] : 0.f; rk[jj] = inc ? rk[jj] : 0.f; }
                asm volatile("" : "+v"(ab), "+v"(ak), "+v"(rb), "+v"(rk));
                *(LAS f32x4*)(pb + X_AAB + (i * 32 + j0) * 4) = ab;
                *(LAS u32x2*)(pb + X_AAK + (i * 32 + j0) * 2) = (u32x2){cvt_pk_bf16(ak[0], ak[1]), cvt_pk_bf16(ak[2], ak[3])};
                *(LAS u32x2*)(pb + X_MRK + (i * 32 + j0) * 2) = (u32x2){cvt_pk_bf16(rk[0], rk[1]), cvt_pk_bf16(rk[2], rk[3])};
                *(u32x2*)(gx + G_MRB + (i * 32 + j0) * 2) = (u32x2){cvt_pk_bf16(rb[0], rb[1]), cvt_pk_bf16(rb[2], rb[3])};
            }
        LDS_WAIT();
        {
            const int blk = (ln >> 4) & 1, jc = ln & 15; float t[16];
            const LAS float* arow = (const LAS float*)(pb + X_AAB) + (16 * blk) * 32 + 16 * blk;
#pragma unroll
            for (int i = 0; i < 16; ++i) { float acc = (i == jc) ? 1.0f : 0.f;
#pragma unroll
                for (int m4 = 0; m4 < 4; ++m4) { if (4 * m4 < i) { const f32x4 a4 = *(const LAS f32x4*)(arow + i * 32 + 4 * m4);
#pragma unroll
                    for (int mm = 0; mm < 4; ++mm) if (4 * m4 + mm < i) acc += a4[mm] * t[4 * m4 + mm]; } }
                t[i] = acc; if ((i & 3) == 3) asm volatile("" ::: "memory"); }
            { const int ar = ln >> 2, ac = 4 * (ln & 3); const f32x4 a4 = *(const LAS f32x4*)(pb + X_AAB + ((16 + ar) * 32 + ac) * 4);
              asm volatile("" ::: "memory");
              *(LAS u32x2*)(pb + X_A21 + (ar * 16 + ac) * 2) = (u32x2){cvt_pk_bf16(a4[0], a4[1]), cvt_pk_bf16(a4[2], a4[3])}; }
            if (ln < 32) {
#pragma unroll
                for (int i = 0; i < 16; ++i) *(LAS unsigned short*)(pb + X_TT + ((16 * blk + i) * 32 + 16 * blk + jc) * 2) = f2bf(t[i]);
                if (blk == 0) {
#pragma unroll
                    for (int i = 0; i < 16; ++i) *(LAS unsigned short*)(pb + X_TT + (i * 32 + 16 + jc) * 2) = 0;
                    u32x4 lo, hi; lo.x = cvt_pk_bf16(t[0], t[1]); lo.y = cvt_pk_bf16(t[2], t[3]); lo.z = cvt_pk_bf16(t[4], t[5]); lo.w = cvt_pk_bf16(t[6], t[7]);
                    hi.x = cvt_pk_bf16(t[8], t[9]); hi.y = cvt_pk_bf16(t[10], t[11]); hi.z = cvt_pk_bf16(t[12], t[13]); hi.w = cvt_pk_bf16(t[14], t[15]);
                    *(LAS u32x4*)(pb + X_TC11 + jc * 32) = lo; *(LAS u32x4*)(pb + X_TC11 + jc * 32 + 16) = hi;
                }
            }
            LDS_WAIT();
            { f32x4 z = {0.f, 0.f, 0.f, 0.f}; z = mma(frag16(pb + X_A21, 16, 0, ln), frag16(pb + X_TC11, 16, 0, ln), z);
              *(LAS u32x2*)(pb + X_Z1T + (fr * 16 + 4 * fq) * 2) = (u32x2){cvt_pk_bf16(z[0], z[1]), cvt_pk_bf16(z[2], z[3])}; }
            LDS_WAIT();
            { f32x4 d = {0.f, 0.f, 0.f, 0.f}; const bf16x8 zz = {0, 0, 0, 0, 0, 0, 0, 0};
              bf16x8 t22 = *(const LAS bf16x8*)(pb + X_TT + ((16 + fr) * 32 + 16 + 8 * (fq & 1)) * 2); t22 = fq < 2 ? t22 : zz;
              d = mma(frag16(pb + X_Z1T, 16, 0, ln), t22, d);
              *(LAS u32x2*)(pb + X_TT + ((16 + fr) * 32 + 4 * fq) * 2) = (u32x2){cvt_pk_bf16(d[0], d[1]), cvt_pk_bf16(d[2], d[3])}; }
            LDS_WAIT();
            { const u32x4 t0 = *(const LAS u32x4*)(pb + X_TT + ln * 32), t1 = *(const LAS u32x4*)(pb + X_TT + ln * 32 + 16); *(u32x4*)(gx + G_TT + ln * 32) = t0; *(u32x4*)(gx + G_TT + ln * 32 + 16) = t1; }
        }
#pragma unroll 1
        for (int vq = 0; vq < 4; ++vq) {
            const bf16x8 fvt = frag_tr(pb + X_VT, 128, 0, 16 * vq, ln);
#pragma unroll
            for (int tt2 = 0; tt2 < 2; ++tt2) {
                f32x4 x = {0.f, 0.f, 0.f, 0.f}, f = x;
                x = mma(frag(pb + X_AAK, 32, 16 * tt2, 0, ln), fvt, x);
                f = mma(fvt, frag(pb + X_MRK, 32, 16 * tt2, 0, ln), f);
                *(u32x2*)(gx + G_XA + ((vq * 2 + tt2) * 64 + ln) * 8) = (u32x2){cvt_pk_bf16(x[0], x[1]), cvt_pk_bf16(x[2], x[3])};
                *(u32x2*)(gx + G_FA + ((vq * 2 + tt2) * 64 + ln) * 8) = (u32x2){cvt_pk_bf16(f[0], f[1]), cvt_pk_bf16(f[2], f[3])};
            }
        }
        LDS_WAIT();
    }
    }
}

__device__ __forceinline__ void phase_router(Frame& F) {
    PHASE_ENTER(F);
    LAS int* hist = (LAS int*)(F.lds + 32768);
    const float* ss = F.SS + 3 * SS_STRIDE;
    u32x4* tokinfo = (u32x4*)(F.ws + RT_TOKINFO); int* slot_tok = (int*)(F.ws + RT_SLOTTOK); int* cnt = (int*)(F.ws + RT_CNT);
    const int lane = F.lane;
    f32x4 wr[16][2];
    { const float* RW = in_ptr(F, I_RW) + (size_t)(16 * lane) * NEXP; const float* fgp = in_ptr(F, I_FFNG) + DM + 16 * lane;
#pragma unroll
      for (int k = 0; k < 16; ++k) { const float gk = fgp[k]; wr[k][0] = *(const f32x4*)(RW + NEXP * k) * gk; wr[k][1] = *(const f32x4*)(RW + NEXP * k + 4) * gk; } }
    for (int blk = F.bid; blk < NREAL / 256; blk += F.G) {
        __syncthreads();
        if (F.tid < NEXP) hist[F.tid] = 0;
        for (int i = F.tid; i < MAXBLK; i += 512) { slot_tok[blk * MAXBLK + i] = -1; ((float*)(F.ws + RT_SLOTRS))[blk * MAXBLK + i] = 0.f; }
        __syncthreads();
        for (int t = F.wave; t < 256; t += 16) {
            const int tok0 = blk * 256 + t, tok1 = tok0 + 8;
            u32x4 raw[2][2];
            raw[0][0] = *(const u32x4*)(F.HB + (size_t)tok0 * DM + 16 * lane); raw[0][1] = *(const u32x4*)(F.HB + (size_t)tok0 * DM + 16 * lane + 8);
            raw[1][0] = *(const u32x4*)(F.HB + (size_t)tok1 * DM + 16 * lane); raw[1][1] = *(const u32x4*)(F.HB + (size_t)tok1 * DM + 16 * lane + 8);
            const float rs2[2] = {rstd_of(ss, tok0), rstd_of(ss, tok1)};
#pragma unroll
            for (int q = 0; q < 2; ++q) {
                const int tok = q == 0 ? tok0 : tok1;
                float hv[16]; unpack8(raw[q][0], *(float(*)[8])&hv[0]); unpack8(raw[q][1], *(float(*)[8])&hv[8]);
                float lg[8];
#pragma unroll
                for (int e = 0; e < 8; ++e) lg[e] = 0.f;
#pragma unroll
                for (int k = 0; k < 16; ++k) {
#pragma unroll
                    for (int e = 0; e < 4; ++e) { lg[e] += hv[k] * wr[k][0][e]; lg[4 + e] += hv[k] * wr[k][1][e]; } }
                const float rs = rs2[q];
#pragma unroll
                for (int e = 0; e < 8; ++e) lg[e] = wave_sum(lg[e]) * rs + in_ptr(F, I_RB)[e];
                int e1 = 0; float l1 = lg[0];
#pragma unroll
                for (int e = 1; e < 8; ++e) if (lg[e] > l1) { l1 = lg[e]; e1 = e; }
                int e2 = -1; float l2 = -3.0e38f;
#pragma unroll
                for (int e = 0; e < 8; ++e) if (e != e1 && lg[e] > l2) { l2 = lg[e]; e2 = e; }
                const float g2 = 1.0f / (1.0f + __expf(l1 - l2)), g1 = 1.0f - g2;
                if (lane == 0) { tokinfo[tok] = (u32x4){(unsigned)(e1 | (e2 << 8)), __float_as_uint(g1), __float_as_uint(g2), 0u}; __hip_atomic_fetch_add(&hist[e1], 1, __ATOMIC_RELAXED, __HIP_MEMORY_SCOPE_WORKGROUP); __hip_atomic_fetch_add(&hist[e2], 1, __ATOMIC_RELAXED, __HIP_MEMORY_SCOPE_WORKGROUP); }
            }
        }
        __syncthreads();
        if (F.tid < NEXP) cnt[blk * NEXP + F.tid] = hist[F.tid];
    }
    __syncthreads();
}
__device__ __forceinline__ void phase_assign(Frame& F) {
    PHASE_ENTER(F);
    LAS int* L = (LAS int*)F.lds;
    const u32x4* tokinfo = (const u32x4*)(F.ws + RT_TOKINFO); int* slot_tok = (int*)(F.ws + RT_SLOTTOK); const int* cnt = (const int*)(F.ws + RT_CNT);
    int* block_e = (int*)(F.ws + RT_CNT + 16384); int* nblkp = (int*)(F.ws + RT_CNT + 32768); int* tokslot = (int*)(F.ws + RT_TOKSLOT);
    for (int blk = F.bid; blk < NREAL / 256; blk += F.G) {
        __syncthreads();
        if (F.tid < 256) {
            const u32x4 c0 = *(const u32x4*)(cnt + F.tid * NEXP), c1 = *(const u32x4*)(cnt + F.tid * NEXP + 4); const unsigned cc[8] = {c0.x, c0.y, c0.z, c0.w, c1.x, c1.y, c1.z, c1.w};
            const float inf = F.tid < blk ? 1.0f : 0.0f;
#pragma unroll
            for (int e = 0; e < NEXP; ++e) { const float tt = wave_sum((float)cc[e]), pp = wave_sum(inf * (float)cc[e]); if (F.lane == 0) { L[64 + F.wave * 16 + e] = (int)tt; L[64 + F.wave * 16 + 8 + e] = (int)pp; } }
        }
        __syncthreads();
        if (F.tid < NEXP) { int tot = 0, pre = 0;
#pragma unroll
            for (int w = 0; w < 4; ++w) { tot += L[64 + w * 16 + F.tid]; pre += L[64 + w * 16 + 8 + F.tid]; } L[F.tid] = tot; L[8 + F.tid] = pre; }
        __syncthreads();
        if (F.tid == 0) { int start = 0; for (int e = 0; e < NEXP; ++e) { L[16 + e] = start; start += (L[e] + 255) & ~255; L[24 + e] = start; }
            if (blk == 0) *nblkp = start >> 8; }
        __syncthreads();
        if (blk == 0) { const int nb_ = L[24 + NEXP - 1] >> 8;
            for (int j = F.tid; j < nb_; j += 512) { int e = 0; while (e < NEXP - 1 && L[24 + e] <= j * 256) ++e; block_e[j] = e; } }
        int e1 = 0, e2 = 0, r1 = 0, r2 = 0; const int w = F.wave, lane = F.lane;
        if (F.tid < 256) {
            const unsigned ee = tokinfo[blk * 256 + F.tid].x; e1 = ee & 0xff; e2 = (ee >> 8) & 0xff;
            const unsigned long long lt = (1ull << lane) - 1ull;
#pragma unroll
            for (int e = 0; e < NEXP; ++e) { const unsigned long long m1 = __ballot(e1 == e), m2 = __ballot(e2 == e);
                if (e1 == e) r1 = __popcll(m1 & lt); if (e2 == e) r2 = __popcll(m1) + __popcll(m2 & lt);
                if (lane == 0) L[32 + w * 8 + e] = __popcll(m1) + __popcll(m2); }
        }
        __syncthreads();
        if (F.tid < 256) {
            int o1 = L[16 + e1] + L[8 + e1], o2 = L[16 + e2] + L[8 + e2];
            for (int ww = 0; ww < w; ++ww) { o1 += L[32 + ww * 8 + e1]; o2 += L[32 + ww * 8 + e2]; }
            const int s1 = o1 + r1, s2 = o2 + r2, tok = blk * 256 + F.tid;
            slot_tok[s1] = tok; slot_tok[s2] = tok; tokslot[2 * tok] = s1; tokslot[2 * tok + 1] = s2;
            { const float rs = rstd_of(F.SS + 3 * SS_STRIDE, tok); float* srs = (float*)(F.ws + RT_SLOTRS); srs[s1] = rs; srs[s2] = rs; }
        }
    }
    __syncthreads();
}
__device__ __forceinline__ void phase_combine(Frame& F) {
    PHASE_ENTER(F);
    const u32x4* tokinfo = (const u32x4*)(F.ws + RT_TOKINFO); const int* tokslot = (const int*)(F.ws + RT_TOKSLOT);
    const int gw = F.bid * 8 + F.wave, NGW = F.G * 8, lane = F.lane;
    f32x4 gf[4];
#pragma unroll
    for (int j = 0; j < 4; ++j) gf[j] = *(const f32x4*)(in_ptr(F, I_FINALG) + 4 * lane + 256 * j);
    float* outp = (float*)lds_ptr(F.lds, 36);
    int tokA = gw, tokB = gw + NGW;
    u32x4 tiA = tokinfo[tokA < NREAL ? tokA : 0], tiB = tokinfo[tokB < NREAL ? tokB : 0];
    u32x2 slA = *(const u32x2*)(tokslot + 2 * (tokA < NREAL ? tokA : 0)), slB = *(const u32x2*)(tokslot + 2 * (tokB < NREAL ? tokB : 0));
    for (; tokA < NREAL; tokA += 2 * NGW, tokB += 2 * NGW) {
        const int nA = tokA + 2 * NGW, nB = tokB + 2 * NGW;
        const u32x4 tinA = tokinfo[nA < NREAL ? nA : 0], tinB = tokinfo[nB < NREAL ? nB : 0];
        const u32x2 slnA = *(const u32x2*)(tokslot + 2 * (nA < NREAL ? nA : 0)), slnB = *(const u32x2*)(tokslot + 2 * (nB < NREAL ? nB : 0));
        const bool hasB = tokB < NREAL; const int tB = hasB ? tokB : tokA;
        const u32x2* hpA = (const u32x2*)(F.HB + (size_t)tokA * DM) + lane; const u32x2* y1A = (const u32x2*)(F.YS + (size_t)slA.x * DM) + lane; const u32x2* y2A = (const u32x2*)(F.YS + (size_t)slA.y * DM) + lane;
        const u32x2* hpB = (const u32x2*)(F.HB + (size_t)tB * DM) + lane; const u32x2* y1B = (const u32x2*)(F.YS + (size_t)(hasB ? slB.x : slA.x) * DM) + lane; const u32x2* y2B = (const u32x2*)(F.YS + (size_t)(hasB ? slB.y : slA.y) * DM) + lane;
        u32x2 hA[4], aA[4], bA[4], hB[4], aB[4], bB[4];
#pragma unroll
        for (int j = 0; j < 4; ++j) { hA[j] = hpA[64 * j]; aA[j] = y1A[64 * j]; bA[j] = y2A[64 * j]; hB[j] = hpB[64 * j]; aB[j] = y1B[64 * j]; bB[j] = y2B[64 * j]; }
#define CMB_ONE(TOK, TI, H, A, B) do { const float g1 = __uint_as_float((TI).y), g2 = __uint_as_float((TI).z); f32x4 v[4]; float sq = 0.f; \
        _Pragma("unroll") for (int j = 0; j < 4; ++j) { \
            v[j][0] = bf_lo(H[j].x) + g1 * bf_lo(A[j].x) + g2 * bf_lo(B[j].x); v[j][1] = bf_hi(H[j].x) + g1 * bf_hi(A[j].x) + g2 * bf_hi(B[j].x); \
            v[j][2] = bf_lo(H[j].y) + g1 * bf_lo(A[j].y) + g2 * bf_lo(B[j].y); v[j][3] = bf_hi(H[j].y) + g1 * bf_hi(A[j].y) + g2 * bf_hi(B[j].y); \
            sq += (v[j][0] * v[j][0] + v[j][1] * v[j][1]) + (v[j][2] * v[j][2] + v[j][3] * v[j][3]); } \
        const float rs = __builtin_amdgcn_rsqf(wave_sum(sq) * (1.0f / DM) + RMS_EPS); \
        f32x4* op = (f32x4*)(outp + (size_t)(TOK) * DM) + lane; \
        _Pragma("unroll") for (int j = 0; j < 4; ++j) op[64 * j] = v[j] * rs * gf[j]; } while (0)
        CMB_ONE(tokA, tiA, hA, aA, bA);
        if (hasB) CMB_ONE(tokB, tiB, hB, aB, bB);
#undef CMB_ONE
        tiA = tinA; tiB = tinB; slA = slnA; slB = slnB;
    }
}

__device__ __forceinline__ SchedGrid grid_sched(Frame& F, int nN, int lda, int ldb, int rev = 0) { return SchedGrid{NREAL / 256, nN, F.G, F.bid, (size_t)256 * lda * 2, (size_t)256 * ldb * 2, rev}; }
__device__ __forceinline__ void phase_g1(Frame& F, int l) {
    PHASE_ENTER(F);
    const bf16_t* Wt = F.W + (size_t)l * WL_SIZE + WL_ABC; const float* ss = F.SS + (size_t)(2 * l) * SS_STRIDE; bf16_t* U = F.R1;
    meta_rstd_setup(F);
    for (int j = F.bid; j < NABC / 16; j += F.G) { const float v = meta_tile(F, F.HB + (size_t)MBASE * DM, DM, Wt, DM, DM, 16 * j);
        if (F.tid < 256) { const int row = MBASE + (F.tid >> 4); U[(size_t)row * NABC + 16 * j + (F.tid & 15)] = f2bf(v * META_RS(F, F.tid >> 4)); } }
    __syncthreads();
    pg8::gemm_phase<EpiScale, SchedGrid, false>(F.lds, F.wave, GemmD{F.HB, Wt, DM, DM, DM}, grid_sched(F, NABC / 256, DM, DM), EpiScale{U, NABC, ss});
}
__device__ __forceinline__ void phase_g2(Frame& F, int l) {
    PHASE_ENTER(F);
    const bf16_t* Wt = F.W + (size_t)l * WL_SIZE + WL_G; const float* ss = F.SS + (size_t)(2 * l) * SS_STRIDE; bf16_t* ZG = F.R1; const float* gb = in_ptr(F, I_GATEB) + l * NGATE;
    if (l == 0) { meta_rstd_setup(F); for (int j = F.bid; j < NGATE / 16; j += F.G) { const float v = meta_tile(F, F.HB + (size_t)MBASE * DM, DM, Wt, DM, DM, 16 * j);
        if (F.tid < 256) { const int row = MBASE + (F.tid >> 4), col = 16 * j + (F.tid & 15); ZG[(size_t)row * NGATE + col] = f2bf(fast_sigmoid(v * META_RS(F, F.tid >> 4) + gb[col])); } }
        __syncthreads(); }
    pg8::gemm_phase<EpiGate, SchedGrid, false>(F.lds, F.wave, GemmD{F.HB, Wt, DM, DM, DM}, grid_sched(F, NGATE / 256, DM, DM), EpiGate{ZG, NGATE, ss, gb});
}
__device__ __forceinline__ void phase_g3(Frame& F, int l) {
    PHASE_ENTER(F);
    const bf16_t* Pt = F.W + (size_t)l * WL_SIZE + WL_P; const bf16_t* ZG = F.R1; const bf16_t* Y = F.R3; bf16_t* MB = F.R2;
    if (l == 0) for (int j = F.bid; j < DM / 16; j += F.G) { float tot = 0.f;
        for (int br = 0; br < 3; ++br) { const float v = meta_tile(F, Y + (size_t)MBASE * NY + br * AW, NY, Pt + br * AW, NY, AW, 16 * j);
            if (F.tid < 256) tot += v * bf2f(ZG[(size_t)(MBASE + (F.tid >> 4)) * NGATE + br * DM + 16 * j + (F.tid & 15)]); }
        if (F.tid < 256) MB[(size_t)(MBASE + (F.tid >> 4)) * DM + 16 * j + (F.tid & 15)] = f2bf(tot); }
    pg8::gemm_phase<EpiMerge3, SchedGrid, false>(F.lds, F.wave, GemmD{Y, Pt, NY, NY, NY}, grid_sched(F, DM / 256, NY, NY, 1), EpiMerge3{MB, ZG});
}
__device__ __forceinline__ void phase_resid(Frame& F, const bf16_t* Amat, int K, const bf16_t* Wt, float* ssn, bool do_meta) {
    PHASE_ENTER(F);
    if (do_meta) for (int j = F.bid; j < DM / 16; j += F.G) { const float v = meta_tile(F, Amat + (size_t)MBASE * K, K, Wt, K, K, 16 * j);
        if (F.tid < 256) { const int row = MBASE + (F.tid >> 4); bf16_t* hp = F.HB + (size_t)row * DM + 16 * j + (F.tid & 15); *hp = f2bf(bf2f(*hp) + v); } }
    pg8::gemm_phase<EpiResid, SchedGrid, false>(F.lds, F.wave, GemmD{Amat, Wt, K, K, K}, grid_sched(F, DM / 256, K, K, K == DFF ? 1 : 0), EpiResid{F.HB, ssn, (LAS float*)(F.lds + 139264)});
}
__device__ __forceinline__ void phase_g5(Frame& F) {
    PHASE_ENTER(F);
    const bf16_t* Wt = F.W + WF_GU; const float* ss = F.SS + SS_STRIDE; bf16_t* HID = F.R1;
    meta_rstd_setup(F);
    for (int j = F.bid; j < DFF / 16; j += F.G) { const int c0 = 16 * j, br = 256 * (c0 / 128) + (c0 % 128);
        const float vg = meta_tile(F, F.HB + (size_t)MBASE * DM, DM, Wt, DM, DM, br), vu = meta_tile(F, F.HB + (size_t)MBASE * DM, DM, Wt, DM, DM, br + 128);
        if (F.tid < 256) { const int row = MBASE + (F.tid >> 4); const float rs = META_RS(F, F.tid >> 4), g = vg * rs, u = vu * rs; HID[(size_t)row * DFF + c0 + (F.tid & 15)] = f2bf(g * fast_sigmoid(g) * u); } }
    __syncthreads();
    pg8::gemm_phase<EpiSwiglu, SchedGrid, false>(F.lds, F.wave, GemmD{F.HB, Wt, DM, DM, DM}, grid_sched(F, NGU / 256, DM, DM), EpiSwiglu{HID, ss, nullptr, 0});
}
__device__ __forceinline__ void moe_range(Frame& F, int pass, int& blk0, int& nb) {
    const int nblk = *(const int*)(F.ws + RT_CNT + 32768); blk0 = pass * PASS0; nb = nblk - blk0; if (nb > (pass == 0 ? PASS0 : MAXBLK - PASS0)) nb = (pass == 0 ? PASS0 : MAXBLK - PASS0); if (nb < 0) nb = 0;
}
__device__ __forceinline__ void phase_g5m(Frame& F, int pass) {
    int blk0, nb; moe_range(F, pass, blk0, nb);
    const int* block_e = (const int*)(F.ws + RT_CNT + 16384); const int* slot_tok = (const int*)(F.ws + RT_SLOTTOK);
    pg8::gemm_phase<EpiSwiglu, SchedMoe, true>(F.lds, F.wave, GemmD{F.HB, F.WE + WE_GU, DM, DM, DM},
        SchedMoe{blk0, nb, NGU / 256, F.G, F.bid, block_e, slot_tok, 0, (size_t)256 * DM * 2, (size_t)NGU * DM * 2, 0}, EpiSwiglu{F.R1, (const float*)(F.ws + RT_SLOTRS), slot_tok, blk0 * 256});
}
__device__ __forceinline__ void phase_g6m(Frame& F, int pass) {
    int blk0, nb; moe_range(F, pass, blk0, nb);
    const int* block_e = (const int*)(F.ws + RT_CNT + 16384); const int* slot_tok = (const int*)(F.ws + RT_SLOTTOK);
    pg8::gemm_phase<EpiStore, SchedMoe, false>(F.lds, F.wave, GemmD{F.R1, F.WE + WE_D, DFF, DFF, DFF},
        SchedMoe{blk0, nb, DM / 256, F.G, F.bid, block_e, slot_tok, (size_t)256 * DFF * 2, (size_t)256 * DFF * 2, (size_t)DM * DFF * 2, 1}, EpiStore{F.YS, DM});
}

#ifndef CK_MODE
#define CK_MODE 1
#endif
constexpr int N_PHASES = 24;
__global__ void __launch_bounds__(512, 2) fwd_kernel(Args args) {
    extern __shared__ __attribute__((aligned(16))) unsigned char lds[];
    Frame F;
    F.lds = (LAS unsigned char*)lds; F.tid = threadIdx.x; F.lane = F.tid & 63; F.wave = __builtin_amdgcn_readfirstlane(F.tid >> 6); F.G = gridDim.x; F.bid = blockIdx.x;
    volatile LAS unsigned* MISC = (volatile LAS unsigned*)(F.lds + LDSCTL_OFF);
    for (int u = F.tid; u < (LDS_BYTES - LDSCTL_OFF) / 4; u += 512) MISC[u] = 0u;
    __syncthreads();
    if (F.tid < 38) { const unsigned long long pv = F.tid < 36 ? (unsigned long long)args.in[F.tid] : (F.tid == 36 ? (unsigned long long)args.out : (unsigned long long)args.ws);
        *(LAS unsigned long long*)(F.lds + PTR_OFF + 8 * F.tid) = pv; }
    __syncthreads();
    frame_ptrs(F);
    const int lo = args.ph_lo, hi = args.ph_hi;
    XcdBarrier bar; bar.bar = (unsigned*)F.ws + CW_BAR + args.li * XCD_BAR_WORDS; bar.x = 0; bar.st = MISC + 8;
    if (hi - lo > 1) bar = xcd_barrier_post((unsigned*)F.ws + CW_BAR + args.li * XCD_BAR_WORDS, MISC + 8);
#ifdef ONLY_PH
#define PH(p) ((p) == ONLY_PH || ((p) - 9) == ONLY_PH)
#else
#define PH(p) (lo <= (p) && (p) < hi)
#endif
#ifndef REP_MASK
#define REP_MASK 0ull
#endif
#define REPS(p) ((REP_MASK >> (p)) & 1ull)
#define SEAM(p) do { if (PH(p) && PH((p) + 1)) { XcdBarrier b2_ = bar; asm volatile("" : "+s"(b2_.bar)); xcd_barrier(b2_, F.wave); } } while (0)
    if (PH(0)) { convert_common(F); x_to_hb(F); if (REPS(0)) { convert_common(F); x_to_hb(F); } } SEAM(0);
    for (int l = 0; l < 2; ++l) {
        const int pb = 1 + 9 * l;
        if (PH(pb + 0)) { phase_g1(F, l); if (REPS(pb + 0)) phase_g1(F, l); } SEAM(pb + 0);
        if (PH(pb + 1)) { phase_prep(F, l); { XcdBarrier b2_ = bar; asm volatile("" : "+s"(b2_.bar)); xcd_barrier(b2_, F.wave); } phase_prep2(F, l); } SEAM(pb + 1);
        if (PH(pb + 2)) { if (CK_MODE != 1) phase_scan(F, l); if (CK_MODE != 0) phase_scan_chunked(F, l); } SEAM(pb + 2);
        if (PH(pb + 3)) phase_postbc(F, l); SEAM(pb + 3);
        if (PH(pb + 4)) { phase_g2(F, l); if (REPS(pb + 4)) phase_g2(F, l); } SEAM(pb + 4);
        if (PH(pb + 5)) { phase_g3(F, l); if (REPS(pb + 5)) phase_g3(F, l); } SEAM(pb + 5);
        if (PH(pb + 6)) phase_resid(F, F.R2, DM, F.W + (size_t)l * WL_SIZE + WL_OUT, F.SS + (size_t)(2 * l + 1) * SS_STRIDE, l == 0); SEAM(pb + 6);
        if (l == 0) {
            if (PH(8)) { phase_g5(F); if (REPS(8)) phase_g5(F); } SEAM(8);
            if (PH(9)) phase_resid(F, F.R1, DFF, F.W + WF_D, F.SS + 2 * SS_STRIDE, true); SEAM(9);
        }
    }
    if (PH(17)) { convert_experts(F); phase_router(F); if (REPS(17)) { convert_experts(F); phase_router(F); } } SEAM(17);
    if (PH(18)) { phase_assign(F); if (REPS(18)) phase_assign(F); } SEAM(18);
    for (int pass = 0; pass < 2; ++pass) {
        if (PH(19 + 2 * pass)) { phase_g5m(F, pass); if (REPS(19 + 2 * pass)) phase_g5m(F, pass); } SEAM(19 + 2 * pass);
        if (PH(20 + 2 * pass)) { phase_g6m(F, pass); if (REPS(20 + 2 * pass)) phase_g6m(F, pass); } SEAM(20 + 2 * pass);
    }
    if (PH(23)) { phase_combine(F); if (REPS(23)) phase_combine(F); }
#undef PH
#undef SEAM
}

#ifndef MK_N_LAUNCHES
#define MK_N_LAUNCHES 1
#endif
extern "C" void kernel_launch(void* const* d_in, const int* in_sizes, int n_in, void* d_out, int out_size, void* d_ws, size_t ws_size, hipStream_t stream) {
    static int grid = 0;
    if (grid == 0) {
        if (n_in != 36 || in_sizes[0] != NREAL * DM || out_size != NREAL * DM || ws_size < WS_END) {
            fprintf(stderr, "kernel_launch: unexpected problem (n_in %d, in0 %d, out %d, ws %zu; need ws >= %zu); nothing launched\n", n_in, n_in > 0 ? in_sizes[0] : -1, out_size, ws_size, (size_t)WS_END); grid = -1; return; }
        int dev = 0, cus = 0, per_cu = 0;
        if (hipGetDevice(&dev) != hipSuccess || hipDeviceGetAttribute(&cus, hipDeviceAttributeMultiprocessorCount, dev) != hipSuccess) { grid = -1; return; }
        if (hipFuncSetAttribute((const void*)fwd_kernel, hipFuncAttributeMaxDynamicSharedMemorySize, LDS_BYTES) != hipSuccess) { fprintf(stderr, "kernel_launch: hipFuncSetAttribute failed\n"); grid = -1; return; }
        if (hipOccupancyMaxActiveBlocksPerMultiprocessor(&per_cu, (const void*)fwd_kernel, 512, LDS_BYTES) != hipSuccess || per_cu < 1) { fprintf(stderr, "kernel_launch: occupancy query says %d blocks per CU\n", per_cu); (void)hipGetLastError(); grid = -1; return; }
        grid = cus;
    }
    if (grid < 0) return;
    if (hipMemsetAsync((char*)d_ws + WS_CTL, 0, CTL_ZERO_BYTES, stream) != hipSuccess) return;
    Args a{};
    for (int i = 0; i < 36; ++i) a.in[i] = (const float*)d_in[i];
    a.out = (float*)d_out; a.ws = (unsigned char*)d_ws;
    if (MK_N_LAUNCHES == 1) { a.ph_lo = 0; a.ph_hi = N_PHASES; a.li = 0; hipLaunchKernelGGL(fwd_kernel, dim3(grid), dim3(512), LDS_BYTES, stream, a); }
    else for (int p = 0; p < N_PHASES; ++p) { a.ph_lo = p; a.ph_hi = p + 1; a.li = 0; hipLaunchKernelGGL(fwd_kernel, dim3(grid), dim3(512), LDS_BYTES, stream, a); }
}
```

```cpp
#include <hip/hip_runtime.h>
#include <cstdio>
#include <cstdint>

#define LAS __attribute__((address_space(3)))
#define GAS __attribute__((address_space(1)))
typedef unsigned short bf16_t;
typedef short bf16x8 __attribute__((ext_vector_type(8)));
typedef float f32x4 __attribute__((ext_vector_type(4)));
typedef float f32x2 __attribute__((ext_vector_type(2)));
typedef unsigned u32x4 __attribute__((ext_vector_type(4)));
typedef unsigned u32x2 __attribute__((ext_vector_type(2)));

constexpr int NB = 8, SEQ = 8192, DM = 1024, NMETA = 16;
constexpr int NREAL = NB * SEQ;
constexpr int MBASE = NREAL;
constexpr int NROWS = NREAL + NMETA;
constexpr int AW = 512, AIN = 1792, NABC = 3328, NGATE = 3072, NY = 1536, DFF = 2816, NGU = 5632, NEXP = 8;
constexpr int MAXBLK = 520, PASS0 = 256;
constexpr float RMS_EPS = 1e-6f, LN_EPS = 1e-5f, LNX_EPS = 64e-5f;

constexpr size_t MiB = 1u << 20;
constexpr size_t WS_CTL = 0, CTL_ZERO_BYTES = 1 * MiB;
constexpr size_t WS_SS = 8 * MiB, SS_STRIDE = (size_t)NREAL * 4;
constexpr size_t WS_RT = 4 * MiB;
constexpr size_t WS_ZGM = 20 * MiB;
constexpr size_t WS_HALO = 1 * MiB;
constexpr size_t WS_GC = 12 * MiB, WS_BS = 17 * MiB;
constexpr size_t RT_SLOTRS = WS_RT + 3 * MiB;
constexpr size_t RT_TOKINFO = WS_RT, RT_SLOTTOK = WS_RT + 1 * MiB, RT_CNT = WS_RT + 2 * MiB, RT_TOKSLOT = WS_RT + 3 * MiB - 512 * 1024;
constexpr size_t WS_W = 24 * MiB, WS_HB = 78 * MiB, WS_R1 = 207 * MiB, WS_R2 = 624 * MiB, WS_R3 = 753 * MiB;
constexpr size_t WS_YS = 570 * MiB, WS_WE = 830 * MiB, WS_END = 962 * MiB;
constexpr size_t WL_ABC = 0, WL_G = WL_ABC + (size_t)NABC * DM, WL_P = WL_G + (size_t)NGATE * DM, WL_OUT = WL_P + (size_t)DM * NY,
                 WL_W2 = WL_OUT + (size_t)DM * DM, WL_A2 = WL_W2 + 512 * 64, WL_G2 = WL_A2 + 512 * 64, WL_PW = WL_G2 + 512 * 128, WL_SIZE = WL_PW + 4 * 128 * 128;
constexpr size_t WF_GU = 2 * WL_SIZE, WF_D = WF_GU + (size_t)NGU * DM, W_TOTAL = WF_D + (size_t)DM * DFF;
static_assert(W_TOTAL * 2 <= 54 * MiB, "weights region");
constexpr size_t WE_GU = 0, WE_D = (size_t)NEXP * NGU * DM;
static_assert((WE_D + (size_t)NEXP * DM * DFF) * 2 <= 132 * MiB, "expert region");
static_assert((size_t)NROWS * NABC * 2 <= 417 * MiB && (size_t)NROWS * NGATE * 2 <= 417 * MiB && (size_t)(MAXBLK - PASS0) * 256 * DFF * 2 <= 363 * MiB, "R1");
static_assert((size_t)NROWS * 1024 * 2 <= 129 * MiB && (size_t)NROWS * NY * 2 <= 193 * MiB && (size_t)MAXBLK * 256 * 1024 * 2 <= 260 * MiB, "R2/R3/YS");
constexpr int CW_BAR = 4096;

constexpr int RING_BYTES = 131072, LDSCTL_OFF = RING_BYTES, LDS_BYTES = 147456;

typedef __bf16 bf16x2_t __attribute__((ext_vector_type(2)));
__device__ __forceinline__ unsigned cvt_pk_bf16(float lo, float hi) { const f32x2 v = {lo, hi}; return __builtin_bit_cast(unsigned, __builtin_convertvector(v, bf16x2_t)); }
__device__ __forceinline__ float bf_lo(unsigned u) { return __uint_as_float(u << 16); }
__device__ __forceinline__ float bf_hi(unsigned u) { return __uint_as_float(u & 0xffff0000u); }
__device__ __forceinline__ float bf2f(bf16_t b) { return __uint_as_float(((unsigned)b) << 16); }
__device__ __forceinline__ bf16_t f2bf(float f) { return (bf16_t)(cvt_pk_bf16(f, 0.f) & 0xffffu); }
__device__ __forceinline__ float fast_sigmoid(float x) { return __builtin_amdgcn_rcpf(1.0f + __expf(-x)); }
template <int CTRL> __device__ __forceinline__ float dpp_mov(float v) { return __builtin_bit_cast(float, __builtin_amdgcn_update_dpp(0, __builtin_bit_cast(int, v), CTRL, 0xf, 0xf, false)); }
__device__ __forceinline__ float allreduce8(float v) { v += dpp_mov<0xB1>(v); v += dpp_mov<0x4E>(v); v += dpp_mov<0x141>(v); return v; }
__device__ __forceinline__ float wave_sum(float v) {
    v = allreduce8(v); v += dpp_mov<0x140>(v);
    const int iv = __builtin_bit_cast(int, v);
    const float a = __builtin_bit_cast(float, __builtin_amdgcn_readlane(iv, 0)), b = __builtin_bit_cast(float, __builtin_amdgcn_readlane(iv, 16)),
                c = __builtin_bit_cast(float, __builtin_amdgcn_readlane(iv, 32)), d = __builtin_bit_cast(float, __builtin_amdgcn_readlane(iv, 48));
    return (a + b) + (c + d);
}
__device__ __forceinline__ void unpack8(const u32x4 w, float (&f)[8]) {
    f[0] = bf_lo(w.x); f[1] = bf_hi(w.x); f[2] = bf_lo(w.y); f[3] = bf_hi(w.y); f[4] = bf_lo(w.z); f[5] = bf_hi(w.z); f[6] = bf_lo(w.w); f[7] = bf_hi(w.w);
}
__device__ __forceinline__ u32x4 pack8(const float (&f)[8]) {
    u32x4 w; w.x = cvt_pk_bf16(f[0], f[1]); w.y = cvt_pk_bf16(f[2], f[3]); w.z = cvt_pk_bf16(f[4], f[5]); w.w = cvt_pk_bf16(f[6], f[7]); return w;
}

namespace pg8 {
constexpr int BM = 256, BK = 64, HALF = 128, HTB = HALF * BK * 2, STAGE_BYTES = 8 * HTB, NXCD = 8, WGM = 8;
__host__ __device__ __forceinline__ int lds_byte(int r, int c) { const int st = (r >> 4) * 2 + (c >> 5), rr = r & 15, cc = c & 31, ob = rr * 64 + cc * 2; return st * 1024 + (ob ^ (((ob >> 9) & 1) << 5)); }
__host__ __device__ __forceinline__ void stage_rc(int b, int& R, int& C) { const int st = b / 1024, sb = b % 1024, swz = sb ^ (((sb >> 9) & 1) << 5); R = (st >> 1) * 16 + swz / 64; C = (st & 1) * 32 + (swz % 64) / 2; }
__host__ __device__ __forceinline__ int perm32(int rho) { const int n = rho >> 4, i = rho & 15; return 8 * (i >> 2) + 4 * n + (i & 3); }

struct Unit { int pm, pn, aux; };
struct GemmD { const bf16_t* A; const bf16_t* Bt; int lda, ldb, K; };

__device__ __forceinline__ void tile_of(int wgid, int nM, int nN, int& pm, int& pn) {
    const int nwg = nM * nN;
    { const int q = nwg / NXCD, r = nwg % NXCD, xcd = wgid % NXCD, off = wgid / NXCD; wgid = (xcd < r ? xcd * (q + 1) : r * (q + 1) + (xcd - r) * q) + off; }
    const int nig = WGM * nN, gid = wgid / nig, fm = gid * WGM, gsz = (nM - fm) < WGM ? (nM - fm) : WGM;
    pm = fm + ((wgid % nig) % gsz); pn = (wgid % nig) / gsz;
}

template <class Epi, class Sched, bool GATHER>
__device__ __forceinline__ void gemm_phase(LAS unsigned char* lds, int wave_id, const GemmD g, const Sched& S, const Epi& E) {
    int lane; asm volatile("v_mbcnt_lo_u32_b32 %0, -1, 0\n\tv_mbcnt_hi_u32_b32 %0, -1, %0" : "=v"(lane), "+s"(wave_id));
    const int wid = wave_id, tid = wid * 64 + lane, wr = wid >> 2, wc = wid & 3, fr = lane & 15, fq = lane >> 4;
    const int K = g.K, nt = K / BK;
    int Rst[2], Cst[2];
    unsigned voffB[2];
#pragma unroll
    for (int i = 0; i < 2; ++i) { int R, C; stage_rc(tid * 16 + i * 8192, R, C); Rst[i] = R; Cst[i] = C; const int Rb = (R & ~31) + perm32(R & 31); voffB[i] = (unsigned)(Rb * g.ldb + C) * 2u; }
    const size_t kstep = (size_t)(BK * 2);
    const size_t hstepB = (size_t)HALF * g.ldb * 2;
    const unsigned ldsw = (unsigned)wid * 1024u;
    const int aoff = lds_byte(wr * 64 + fr, fq * 8), boff = lds_byte(wc * 32 + fr, fq * 8);
#define PG8_SA(b, h) (((b) * 2 + (h)) * HTB)
#define PG8_SB(b, h) ((4 + (b) * 2 + (h)) * HTB)
#define PG8_STAGE(bufoff, gbase, v0, v1) do { \
        __builtin_amdgcn_global_load_lds((const unsigned*)((const char*)(gbase) + (v0)), (LAS unsigned*)(lds + (bufoff) + ldsw), 16, 0, 0); \
        __builtin_amdgcn_global_load_lds((const unsigned*)((const char*)(gbase) + (v1)), (LAS unsigned*)(lds + (bufoff) + ldsw + 8192), 16, 0, 0); } while (0)
#define PG8_STAGE_B(bufoff, gbase) PG8_STAGE(bufoff, gbase, voffB[0], voffB[1])
#define PG8_LDA(dst, b, h) do { _Pragma("unroll") for (int m = 0; m < 4; ++m) _Pragma("unroll") for (int k = 0; k < 2; ++k) dst[m][k] = *(const LAS bf16x8*)(lds + PG8_SA(b, h) + aoff + m * 2048 + k * 1024); } while (0)
#define PG8_LDB(dst, b, h) do { _Pragma("unroll") for (int n = 0; n < 2; ++n) _Pragma("unroll") for (int k = 0; k < 2; ++k) dst[n][k] = *(const LAS bf16x8*)(lds + PG8_SB(b, h) + boff + n * 2048 + k * 1024); } while (0)
#define PG8_MMA(ai, bj, At, Bt) do { __builtin_amdgcn_s_setprio(1); _Pragma("unroll") for (int m = 0; m < 4; ++m) _Pragma("unroll") for (int n = 0; n < 2; ++n) _Pragma("unroll") for (int k = 0; k < 2; ++k) \
        acc[ai][bj][m][n] = __builtin_amdgcn_mfma_f32_16x16x32_bf16(Bt[n][k], At[m][k], acc[ai][bj][m][n], 0, 0, 0); __builtin_amdgcn_s_setprio(0); } while (0)
#define PG8_WAIT_V(n) asm volatile("s_waitcnt vmcnt(" #n ")" ::: "memory")
#define PG8_WAIT_L(n) asm volatile("s_waitcnt lgkmcnt(" #n ")" ::: "memory")
#define PG8_BAR __builtin_amdgcn_s_barrier()
#define PG8_SCHED __builtin_amdgcn_sched_barrier(0)
    Unit cur, nxt; int ui = 0;
    if (!S.next(0, cur)) return;
    bool has_next = S.next(1, nxt);
    unsigned vAc[2][2], vAn[2][2];
#pragma unroll
    for (int h = 0; h < 2; ++h)
#pragma unroll
        for (int i = 0; i < 2; ++i) {
            const int rl = h * HALF + Rst[i];
            if constexpr (GATHER) { vAc[h][i] = (unsigned)(S.a_row(cur, rl) * g.lda + Cst[i]) * 2u; vAn[h][i] = has_next ? (unsigned)(S.a_row(nxt, rl) * g.lda + Cst[i]) * 2u : vAc[h][i]; }
            else { vAc[h][i] = (unsigned)(rl * g.lda + Cst[i]) * 2u; vAn[h][i] = vAc[h][i]; }
        }
    f32x4 acc[2][2][4][2];
#pragma unroll
    for (int a = 0; a < 2; ++a)
#pragma unroll
        for (int b = 0; b < 2; ++b)
#pragma unroll
            for (int m = 0; m < 4; ++m)
#pragma unroll
                for (int n = 0; n < 2; ++n) acc[a][b][m][n] = (f32x4){0.f, 0.f, 0.f, 0.f};
    bf16x8 At[4][2], B0[2][2], B1[2][2];
    const char* cA = (const char*)g.A + S.a_off(cur); const char* cB = (const char*)g.Bt + S.b_off(cur);
    PG8_STAGE_B(PG8_SB(0, 0), cB); PG8_STAGE_B(PG8_SB(0, 1), cB + hstepB); PG8_STAGE(PG8_SA(0, 0), cA, vAc[0][0], vAc[0][1]); PG8_STAGE(PG8_SA(0, 1), cA, vAc[1][0], vAc[1][1]);
    if (wr == 1) PG8_BAR;
    PG8_WAIT_V(2); PG8_BAR;
    PG8_STAGE_B(PG8_SB(1, 0), cB + kstep); PG8_STAGE(PG8_SA(1, 0), cA + kstep, vAc[0][0], vAc[0][1]); PG8_STAGE_B(PG8_SB(1, 1), cB + hstepB + kstep);
    PG8_WAIT_V(6); PG8_BAR;
    for (;;) {
        const char* nA = has_next ? (const char*)g.A + S.a_off(nxt) : cA; const char* nB = has_next ? (const char*)g.Bt + S.b_off(nxt) : cB;
        for (int t = 0; t < nt; t += 2) {
            const bool last = (t == nt - 2);
            if constexpr (Epi::MID_EVERY > 0) { if (t > 0 && t % Epi::MID_EVERY == 0) E.mid(acc, cur, wr, wc, fr, fq, t / Epi::MID_EVERY); }
            const char* a1 = cA + (size_t)(t + 1) * kstep;
            const char* a2 = last ? nA : cA + (size_t)(t + 2) * kstep; const char* b2 = last ? nB : cB + (size_t)(t + 2) * kstep;
            const char* a3 = a2 + kstep; const char* b3 = b2 + kstep;
            unsigned v2[2][2];
#pragma unroll
            for (int h = 0; h < 2; ++h)
#pragma unroll
                for (int i = 0; i < 2; ++i) v2[h][i] = (GATHER && last) ? vAn[h][i] : vAc[h][i];
            PG8_LDB(B0, 0, 0); PG8_LDB(B1, 0, 1); PG8_SCHED; PG8_LDA(At, 0, 0); PG8_STAGE(PG8_SA(1, 1), a1, vAc[1][0], vAc[1][1]);
            PG8_WAIT_V(8); PG8_WAIT_L(0); PG8_BAR; PG8_MMA(0, 0, At, B0); PG8_MMA(0, 1, At, B1); PG8_BAR; PG8_SCHED;
            PG8_LDA(At, 0, 1); PG8_STAGE_B(PG8_SB(0, 0), b2); PG8_STAGE_B(PG8_SB(0, 1), b2 + hstepB); PG8_STAGE(PG8_SA(0, 0), a2, v2[0][0], v2[0][1]);
            PG8_WAIT_V(8); PG8_WAIT_L(0); PG8_BAR; PG8_MMA(1, 0, At, B0); PG8_MMA(1, 1, At, B1); PG8_BAR; PG8_SCHED;
            PG8_LDB(B0, 1, 0); PG8_LDB(B1, 1, 1); PG8_SCHED; PG8_LDA(At, 1, 0); PG8_STAGE(PG8_SA(0, 1), a2, v2[1][0], v2[1][1]);
            PG8_WAIT_V(8); PG8_WAIT_L(0); PG8_BAR; PG8_MMA(0, 0, At, B0); PG8_MMA(0, 1, At, B1); PG8_BAR; PG8_SCHED;
            PG8_LDA(At, 1, 1); PG8_STAGE_B(PG8_SB(1, 0), b3); PG8_STAGE_B(PG8_SB(1, 1), b3 + hstepB); PG8_STAGE(PG8_SA(1, 0), a3, v2[0][0], v2[0][1]);
            PG8_WAIT_V(8); PG8_WAIT_L(0); PG8_BAR; PG8_MMA(1, 0, At, B0); PG8_MMA(1, 1, At, B1); PG8_BAR; PG8_SCHED;
        }
        if (wr == 0) PG8_BAR;
        E(acc, cur, wr, wc, fr, fq);
        if (!has_next) break;
#pragma unroll
        for (int a = 0; a < 2; ++a)
#pragma unroll
            for (int b = 0; b < 2; ++b)
#pragma unroll
                for (int m = 0; m < 4; ++m)
#pragma unroll
                    for (int n = 0; n < 2; ++n) acc[a][b][m][n] = (f32x4){0.f, 0.f, 0.f, 0.f};
        cur = nxt; cA = nA; cB = nB; ++ui;
        has_next = S.next(ui + 1, nxt);
        if constexpr (GATHER) {
#pragma unroll
            for (int h = 0; h < 2; ++h)
#pragma unroll
                for (int i = 0; i < 2; ++i) { vAc[h][i] = vAn[h][i]; if (has_next) vAn[h][i] = (unsigned)(S.a_row(nxt, h * HALF + Rst[i]) * g.lda + Cst[i]) * 2u; }
        }
        if (wr == 1) PG8_BAR;
    }
    PG8_WAIT_V(0);
    PG8_BAR;
#undef PG8_SA
#undef PG8_SB
#undef PG8_STAGE
#undef PG8_STAGE_B
#undef PG8_LDA
#undef PG8_LDB
#undef PG8_MMA
#undef PG8_WAIT_V
#undef PG8_WAIT_L
#undef PG8_BAR
#undef PG8_SCHED
}
}

using pg8::Unit; using pg8::GemmD;
struct SchedGrid {
    int nM, nN, G, c; size_t a_tile, b_tile; int rev;
    __device__ __forceinline__ bool next(int i, Unit& u) const { const long L = (long)i * G + c; if (L >= (long)nM * nN) return false; pg8::tile_of((int)L, nM, nN, u.pm, u.pn); if (rev) u.pm = nM - 1 - u.pm; u.aux = 0; return true; }
    __device__ __forceinline__ size_t a_off(const Unit& u) const { return (size_t)u.pm * a_tile; }
    __device__ __forceinline__ size_t b_off(const Unit& u) const { return (size_t)u.pn * b_tile; }
    __device__ __forceinline__ int a_row(const Unit&, int) const { return 0; }
};
struct SchedMerge {
    int nM, nN, G, c; size_t a_tile, b_tile;
    __device__ __forceinline__ bool next(int i, Unit& u) const { const long L = (long)(i / 3) * G + c; if (L >= (long)nM * nN) return false; pg8::tile_of((int)L, nM, nN, u.pm, u.pn); u.aux = i % 3; return true; }
    __device__ __forceinline__ size_t a_off(const Unit& u) const { return (size_t)u.pm * a_tile + (size_t)u.aux * (AW * 2); }
    __device__ __forceinline__ size_t b_off(const Unit& u) const { return (size_t)u.pn * b_tile + (size_t)u.aux * (AW * 2); }
    __device__ __forceinline__ int a_row(const Unit&, int) const { return 0; }
};
struct SchedMoe {
    int blk0, nblk, nN, G, c; const int* block_e; const int* slot_tok; size_t a_tile, b_tile, b_exp; int rev;
    __device__ __forceinline__ bool next(int i, Unit& u) const { const long L = (long)i * G + c; if (L >= (long)nblk * nN) return false; int pm, pn; pg8::tile_of((int)L, nblk, nN, pm, pn); u.pm = blk0 + (rev ? nblk - 1 - pm : pm); u.pn = pn; u.aux = block_e[u.pm]; return true; }
    __device__ __forceinline__ size_t a_off(const Unit& u) const { return (size_t)(u.pm - blk0) * a_tile; }
    __device__ __forceinline__ size_t b_off(const Unit& u) const { return (size_t)u.aux * b_exp + (size_t)u.pn * b_tile; }
    __device__ __forceinline__ int a_row(const Unit& u, int r) const { const int t = slot_tok[u.pm * 256 + r]; return t < 0 ? 0 : t; }
};

struct SchedMoeK {
    int base0, blk0, nblk, G, c; const int* block_e; size_t a_tile, b_tile, b_exp, kbytes;
    __device__ __forceinline__ bool next(int i, Unit& u) const { const long L = (long)i * G + c; if (L >= (long)nblk * 8) return false; int pm, pn; pg8::tile_of((int)L, nblk, 8, pm, pn); u.pm = blk0 + pm; u.pn = pn; u.aux = block_e[u.pm]; return true; }
    __device__ __forceinline__ size_t a_off(const Unit& u) const { return (size_t)(u.pm - base0) * a_tile + (size_t)(u.pn >> 2) * kbytes; }
    __device__ __forceinline__ size_t b_off(const Unit& u) const { return (size_t)u.aux * b_exp + (size_t)(u.pn & 3) * b_tile + (size_t)(u.pn >> 2) * kbytes; }
    __device__ __forceinline__ int a_row(const Unit&, int) const { return 0; }
};

constexpr int PTR_OFF = LDSCTL_OFF + 64;
__device__ __forceinline__ GAS unsigned char* lds_ptr(LAS unsigned char* lds, int i) {
    const LAS unsigned* p = (const LAS unsigned*)(lds + PTR_OFF + 8 * i);
    const unsigned lo = __builtin_amdgcn_readfirstlane(p[0]), hi = __builtin_amdgcn_readfirstlane(p[1]);
    return (GAS unsigned char*)(((unsigned long long)hi << 32) | lo);
}
#define EPI_ROWS_BEGIN _Pragma("unroll") for (int ai = 0; ai < 2; ++ai) _Pragma("unroll") for (int m = 0; m < 4; ++m) { const int r = u.pm * 256 + ai * 128 + wr * 64 + m * 16 + fr;
#define EPI_ROWS_END }
__device__ __forceinline__ float rstd_of(const float* ss, int r) {
    const f32x4 a = *(const f32x4*)(ss + (size_t)r * 4);
    return __builtin_amdgcn_rsqf(((a[0] + a[1]) + (a[2] + a[3])) * (1.0f / DM) + RMS_EPS);
}

#define EPI_RSTD8(rsv, ss)  float rsv[2][4]; { f32x4 raw_[2][4]; \
    _Pragma("unroll") for (int ai = 0; ai < 2; ++ai) _Pragma("unroll") for (int m = 0; m < 4; ++m) raw_[ai][m] = *(const f32x4*)((ss) + (size_t)(u.pm * 256 + ai * 128 + wr * 64 + m * 16 + fr) * 4); \
    asm volatile("" : "+v"(raw_[0][0]), "+v"(raw_[0][1]), "+v"(raw_[0][2]), "+v"(raw_[0][3]), "+v"(raw_[1][0]), "+v"(raw_[1][1]), "+v"(raw_[1][2]), "+v"(raw_[1][3])); \
    _Pragma("unroll") for (int ai = 0; ai < 2; ++ai) _Pragma("unroll") for (int m = 0; m < 4; ++m) rsv[ai][m] = __builtin_amdgcn_rsqf(((raw_[ai][m][0] + raw_[ai][m][1]) + (raw_[ai][m][2] + raw_[ai][m][3])) * (1.0f / DM) + RMS_EPS); }
struct EpiScale { static constexpr int MID_EVERY = 0;
    bf16_t* O; int ldo; const float* ss;
    __device__ __forceinline__ void operator()(const f32x4 (&acc)[2][2][4][2], const Unit& u, int wr, int wc, int fr, int fq) const {
        const int c0 = u.pn * 256 + wc * 32 + 8 * fq;
        EPI_RSTD8(rsv, ss)
        EPI_ROWS_BEGIN
            const float rs = rsv[ai][m]; bf16_t* rowp = O + (size_t)r * ldo + c0;
#pragma unroll
            for (int bj = 0; bj < 2; ++bj) { const f32x4 v0 = acc[ai][bj][m][0] * rs, v1 = acc[ai][bj][m][1] * rs;
                u32x4 w; w.x = cvt_pk_bf16(v0[0], v0[1]); w.y = cvt_pk_bf16(v0[2], v0[3]); w.z = cvt_pk_bf16(v1[0], v1[1]); w.w = cvt_pk_bf16(v1[2], v1[3]); *(u32x4*)(rowp + bj * 128) = w; }
        EPI_ROWS_END
    }
};
__device__ __forceinline__ u32x2 gate_pack8(const float (&g)[8]) {
    unsigned lo = 0u, hi = 0u;
    lo = __builtin_amdgcn_cvt_pk_u8_f32(g[0] * 256.0f - 0.5f, 0, lo); lo = __builtin_amdgcn_cvt_pk_u8_f32(g[1] * 256.0f - 0.5f, 1, lo); lo = __builtin_amdgcn_cvt_pk_u8_f32(g[2] * 256.0f - 0.5f, 2, lo); lo = __builtin_amdgcn_cvt_pk_u8_f32(g[3] * 256.0f - 0.5f, 3, lo);
    hi = __builtin_amdgcn_cvt_pk_u8_f32(g[4] * 256.0f - 0.5f, 0, hi); hi = __builtin_amdgcn_cvt_pk_u8_f32(g[5] * 256.0f - 0.5f, 1, hi); hi = __builtin_amdgcn_cvt_pk_u8_f32(g[6] * 256.0f - 0.5f, 2, hi); hi = __builtin_amdgcn_cvt_pk_u8_f32(g[7] * 256.0f - 0.5f, 3, hi);
    return (u32x2){lo, hi};
}
__device__ __forceinline__ void gate_unpack8(u32x2 w, float (&g)[8]) {
    constexpr float sc = 1.0f / 256.0f, of = 0.5f / 256.0f;
    g[0] = (float)((w.x >> 0) & 0xffu) * sc + of; g[1] = (float)((w.x >> 8) & 0xffu) * sc + of; g[2] = (float)((w.x >> 16) & 0xffu) * sc + of; g[3] = (float)((w.x >> 24) & 0xffu) * sc + of;
    g[4] = (float)((w.y >> 0) & 0xffu) * sc + of; g[5] = (float)((w.y >> 8) & 0xffu) * sc + of; g[6] = (float)((w.y >> 16) & 0xffu) * sc + of; g[7] = (float)((w.y >> 24) & 0xffu) * sc + of;
}
__device__ __forceinline__ f32x2 sig_code2(f32x2 t) {
    f32x2 d = (f32x2){__builtin_amdgcn_exp2f(t.x), __builtin_amdgcn_exp2f(t.y)} + (f32x2){1.0f, 1.0f};
    return (f32x2){__builtin_amdgcn_rcpf(d.x), __builtin_amdgcn_rcpf(d.y)} * (f32x2){256.0f, 256.0f} - (f32x2){0.5f, 0.5f};
}
struct EpiGate { static constexpr int MID_EVERY = 0;
    unsigned char* O0; unsigned char* O2; const float* ss; const float* bias;
    __device__ __forceinline__ void operator()(const f32x4 (&acc)[2][2][4][2], const Unit& u, int wr, int wc, int fr, int fq) const {
        const int c0 = u.pn * 256 + wc * 32 + 8 * fq; const int br_ = u.pn >> 2; unsigned char* O = br_ < 2 ? O0 + (size_t)br_ * NREAL * DM : O2; const int cb = c0 & (DM - 1);
        f32x4 bv[2][2];
#pragma unroll
        for (int bj = 0; bj < 2; ++bj) { bv[bj][0] = *(const f32x4*)(bias + c0 + bj * 128) * -1.44269504f; bv[bj][1] = *(const f32x4*)(bias + c0 + bj * 128 + 4) * -1.44269504f; }
        EPI_RSTD8(rsv, ss)
        EPI_ROWS_BEGIN
            const float rsn = rsv[ai][m] * -1.44269504f; const f32x2 rs2 = {rsn, rsn}; unsigned char* rowp = O + (size_t)r * DM + (u.pn & 3) * 256 + (wc * 4 + fq) * 16;
            u32x2 q2[2];
#pragma unroll
            for (int bj = 0; bj < 2; ++bj) { unsigned w_[2];
#pragma unroll
                for (int n = 0; n < 2; ++n) { const f32x4 a4 = acc[ai][bj][m][n], b4 = bv[bj][n];
                    const f32x2 c01 = sig_code2((f32x2){a4[0], a4[1]} * rs2 + (f32x2){b4[0], b4[1]}), c23 = sig_code2((f32x2){a4[2], a4[3]} * rs2 + (f32x2){b4[2], b4[3]});
                    unsigned q = 0u; q = __builtin_amdgcn_cvt_pk_u8_f32(c01.x, 0, q); q = __builtin_amdgcn_cvt_pk_u8_f32(c01.y, 1, q); q = __builtin_amdgcn_cvt_pk_u8_f32(c23.x, 2, q); q = __builtin_amdgcn_cvt_pk_u8_f32(c23.y, 3, q); w_[n] = q; }
                q2[bj] = (u32x2){w_[0], w_[1]}; }
            *(u32x4*)rowp = (u32x4){q2[0].x, q2[0].y, q2[1].x, q2[1].y};
        EPI_ROWS_END
    }
};
struct EpiMerge { static constexpr int MID_EVERY = 0;
    bf16_t* MB; const bf16_t* ZG;
    __device__ __forceinline__ void operator()(const f32x4 (&acc)[2][2][4][2], const Unit& u, int wr, int wc, int fr, int fq) const {
        const int c0 = u.pn * 256 + wc * 32 + 8 * fq; const int br = u.aux;
#pragma unroll
        for (int ai = 0; ai < 2; ++ai) {
            u32x4 graw[4][2], praw[4][2];
#pragma unroll
            for (int m = 0; m < 4; ++m) { const int r = u.pm * 256 + ai * 128 + wr * 64 + m * 16 + fr; const bf16_t* gp = ZG + (size_t)r * NGATE + br * DM + c0; const bf16_t* pp = MB + (size_t)r * DM + c0;
                graw[m][0] = *(const u32x4*)gp; graw[m][1] = *(const u32x4*)(gp + 128);
                if (br > 0) { praw[m][0] = *(const u32x4*)pp; praw[m][1] = *(const u32x4*)(pp + 128); } else { praw[m][0] = (u32x4){0u, 0u, 0u, 0u}; praw[m][1] = praw[m][0]; } }
            asm volatile("" : "+v"(graw[0][0]), "+v"(graw[0][1]), "+v"(graw[1][0]), "+v"(graw[1][1]), "+v"(graw[2][0]), "+v"(graw[2][1]), "+v"(graw[3][0]), "+v"(graw[3][1]),
                              "+v"(praw[0][0]), "+v"(praw[0][1]), "+v"(praw[1][0]), "+v"(praw[1][1]), "+v"(praw[2][0]), "+v"(praw[2][1]), "+v"(praw[3][0]), "+v"(praw[3][1]));
#pragma unroll
            for (int m = 0; m < 4; ++m) { const int r = u.pm * 256 + ai * 128 + wr * 64 + m * 16 + fr; bf16_t* rowp = MB + (size_t)r * DM + c0;
#pragma unroll
                for (int bj = 0; bj < 2; ++bj) {
                    float gt[8], pv[8]; unpack8(graw[m][bj], gt); unpack8(praw[m][bj], pv);
                    float o[8];
#pragma unroll
                    for (int j = 0; j < 4; ++j) { o[j] = pv[j] + gt[j] * acc[ai][bj][m][0][j]; o[4 + j] = pv[4 + j] + gt[4 + j] * acc[ai][bj][m][1][j]; }
                    *(u32x4*)(rowp + bj * 128) = pack8(o); } }
        }
    }
};
constexpr float GATE_FLOOR = 1e-20f;
struct EpiMerge3 { static constexpr int MID_EVERY = 8;
    bf16_t* MB; LAS unsigned char* ldsb; const unsigned char* Z2;
    __device__ __forceinline__ void mid(f32x4 (&acc)[2][2][4][2], const Unit& u, int wr, int wc, int fr_, int fq_, int seg) const {
        int fr = fr_, fq = fq_; asm volatile("" : "+v"(fr), "+v"(fq));
        const int c0 = u.pn * 256 + wc * 32 + 8 * fq;
        const unsigned char* Z0 = (const unsigned char*)lds_ptr(ldsb, 36); const unsigned char* Z2 = this->Z2; asm volatile("" : "+s"(Z2));
        u32x4 ga[2][4], gb[2][4];
#pragma unroll
        for (int ai = 0; ai < 2; ++ai)
#pragma unroll
            for (int m = 0; m < 4; ++m) { const size_t go = (size_t)(u.pm * 256 + ai * 128 + wr * 64 + m * 16 + fr) * DM + u.pn * 256 + (wc * 4 + fq) * 16; const unsigned char* gp = Z0 + (seg == 1 ? (size_t)0 : (size_t)NREAL * DM) + go; const unsigned char* gq = (seg == 1 ? Z0 + (size_t)NREAL * DM : Z2) + go;
                ga[ai][m] = *(const u32x4*)gp; gb[ai][m] = *(const u32x4*)gq; }
        asm volatile("" : "+v"(ga[0][0]), "+v"(ga[0][1]), "+v"(ga[0][2]), "+v"(ga[0][3]), "+v"(ga[1][0]), "+v"(ga[1][1]), "+v"(ga[1][2]), "+v"(ga[1][3]),
                          "+v"(gb[0][0]), "+v"(gb[0][1]), "+v"(gb[0][2]), "+v"(gb[0][3]), "+v"(gb[1][0]), "+v"(gb[1][1]), "+v"(gb[1][2]), "+v"(gb[1][3]));
        const f32x2 half2 = {0.5f, 0.5f};
#pragma unroll
        for (int ai = 0; ai < 2; ++ai)
#pragma unroll
            for (int m = 0; m < 4; ++m) { const unsigned xa[4] = {ga[ai][m].x, ga[ai][m].y, ga[ai][m].z, ga[ai][m].w}, ya[4] = {gb[ai][m].x, gb[ai][m].y, gb[ai][m].z, gb[ai][m].w};
#pragma unroll
                for (int w4 = 0; w4 < 4; ++w4) {
                    const f32x2 x01 = (f32x2){(float)(xa[w4] & 0xffu), (float)((xa[w4] >> 8) & 0xffu)} + half2, x23 = (f32x2){(float)((xa[w4] >> 16) & 0xffu), (float)(xa[w4] >> 24)} + half2;
                    const f32x2 y01 = (f32x2){(float)(ya[w4] & 0xffu), (float)((ya[w4] >> 8) & 0xffu)} + half2, y23 = (f32x2){(float)((ya[w4] >> 16) & 0xffu), (float)(ya[w4] >> 24)} + half2;
                    const f32x2 r01 = x01 * (f32x2){__builtin_amdgcn_rcpf(y01.x), __builtin_amdgcn_rcpf(y01.y)}, r23 = x23 * (f32x2){__builtin_amdgcn_rcpf(y23.x), __builtin_amdgcn_rcpf(y23.y)};
                    f32x4& a4 = acc[ai][w4 >> 1][m][w4 & 1];
                    const f32x2 o01 = (f32x2){a4[0], a4[1]} * r01, o23 = (f32x2){a4[2], a4[3]} * r23; a4 = (f32x4){o01.x, o01.y, o23.x, o23.y}; } }
    }
    __device__ __forceinline__ void operator()(const f32x4 (&acc)[2][2][4][2], const Unit& u, int wr, int wc, int fr_, int fq_) const {
        int fr = fr_, fq = fq_; asm volatile("" : "+v"(fr), "+v"(fq));
        const int c0 = u.pn * 256 + wc * 32 + 8 * fq;
        const unsigned char* Z2 = this->Z2; bf16_t* MB = this->MB; asm volatile("" : "+s"(Z2), "+s"(MB));
        u32x4 g2[2][4];
#pragma unroll
        for (int ai = 0; ai < 2; ++ai)
#pragma unroll
            for (int m = 0; m < 4; ++m) g2[ai][m] = *(const u32x4*)(Z2 + (size_t)(u.pm * 256 + ai * 128 + wr * 64 + m * 16 + fr) * DM + u.pn * 256 + (wc * 4 + fq) * 16);
        asm volatile("" : "+v"(g2[0][0]), "+v"(g2[0][1]), "+v"(g2[0][2]), "+v"(g2[0][3]), "+v"(g2[1][0]), "+v"(g2[1][1]), "+v"(g2[1][2]), "+v"(g2[1][3]));
        EPI_ROWS_BEGIN
            bf16_t* rowp = MB + (size_t)r * DM + c0;
#pragma unroll
            for (int bj = 0; bj < 2; ++bj) { float gt[8], o[8]; gate_unpack8(bj == 0 ? (u32x2){g2[ai][m].x, g2[ai][m].y} : (u32x2){g2[ai][m].z, g2[ai][m].w}, gt);
#pragma unroll
                for (int j = 0; j < 4; ++j) { o[j] = gt[j] * acc[ai][bj][m][0][j]; o[4 + j] = gt[4 + j] * acc[ai][bj][m][1][j]; }
                *(u32x4*)(rowp + bj * 128) = pack8(o); }
        EPI_ROWS_END
    }
};
struct EpiResid { static constexpr int MID_EVERY = 0;
    bf16_t* HB; float* ssn; LAS float* red;
    __device__ __forceinline__ void operator()(const f32x4 (&acc)[2][2][4][2], const Unit& u, int wr, int wc, int fr, int fq) const {
        const int c0 = u.pn * 256 + wc * 32 + 8 * fq;
        u32x4 hraw[2][4][2];
#pragma unroll
        for (int ai = 0; ai < 2; ++ai)
#pragma unroll
            for (int m = 0; m < 4; ++m) { const bf16_t* rp = HB + (size_t)(u.pm * 256 + ai * 128 + wr * 64 + m * 16 + fr) * DM + c0; hraw[ai][m][0] = *(const u32x4*)rp; hraw[ai][m][1] = *(const u32x4*)(rp + 128); }
        asm volatile("" : "+v"(hraw[0][0][0]), "+v"(hraw[0][0][1]), "+v"(hraw[0][1][0]), "+v"(hraw[0][1][1]), "+v"(hraw[0][2][0]), "+v"(hraw[0][2][1]), "+v"(hraw[0][3][0]), "+v"(hraw[0][3][1]),
                          "+v"(hraw[1][0][0]), "+v"(hraw[1][0][1]), "+v"(hraw[1][1][0]), "+v"(hraw[1][1][1]), "+v"(hraw[1][2][0]), "+v"(hraw[1][2][1]), "+v"(hraw[1][3][0]), "+v"(hraw[1][3][1]));
        EPI_ROWS_BEGIN
            bf16_t* rowp = HB + (size_t)r * DM + c0; float sq; f32x2 sq2 = {0.f, 0.f};
#pragma unroll
            for (int bj = 0; bj < 2; ++bj) {
                float hv[8]; unpack8(hraw[ai][m][bj], hv);
                f32x2 h2[4];
#pragma unroll
                for (int j = 0; j < 2; ++j) { h2[j] = (f32x2){hv[2 * j], hv[2 * j + 1]} + (f32x2){acc[ai][bj][m][0][2 * j], acc[ai][bj][m][0][2 * j + 1]}; h2[2 + j] = (f32x2){hv[4 + 2 * j], hv[5 + 2 * j]} + (f32x2){acc[ai][bj][m][1][2 * j], acc[ai][bj][m][1][2 * j + 1]}; }
#pragma unroll
                for (int j = 0; j < 4; ++j) { hv[2 * j] = h2[j].x; hv[2 * j + 1] = h2[j].y; }
                const u32x4 w = pack8(hv); *(u32x4*)(rowp + bj * 128) = w;
                float rv[8]; unpack8(w, rv);
#pragma unroll
                for (int j = 0; j < 4; ++j) { const f32x2 r2 = {rv[2 * j], rv[2 * j + 1]}; sq2 = r2 * r2 + sq2; } }
            sq = sq2.x + sq2.y;
            { const int ln = fq * 16 + fr; sq += __builtin_bit_cast(float, __builtin_amdgcn_ds_bpermute((ln ^ 16) << 2, __builtin_bit_cast(int, sq))); sq += __builtin_bit_cast(float, __builtin_amdgcn_ds_bpermute((ln ^ 32) << 2, __builtin_bit_cast(int, sq))); }
            if (fq == 0) red[(ai * 128 + wr * 64 + m * 16 + fr) * 4 + wc] = sq;
        EPI_ROWS_END
        asm volatile("s_waitcnt lgkmcnt(0)" ::: "memory"); __builtin_amdgcn_s_barrier(); asm volatile("" ::: "memory");
        { const int t = (wr * 4 + wc) * 64 + fq * 16 + fr;
          if (t < 256) { const f32x4 p = *(const LAS f32x4*)(red + t * 4); ssn[(size_t)(u.pm * 256 + t) * 4 + u.pn] = (p[0] + p[1]) + (p[2] + p[3]); } }
    }
};
struct EpiSwiglu { static constexpr int MID_EVERY = 0;
    bf16_t* HID; const float* ss; const int* slot_tok; int row0;
    __device__ __forceinline__ void operator()(const f32x4 (&acc)[2][2][4][2], const Unit& u, int wr, int wc, int fr, int fq) const {
        const int c0 = u.pn * 128 + wc * 32 + 8 * fq;
        float rsv[2][4];
        if (slot_tok) {
#pragma unroll
            for (int ai = 0; ai < 2; ++ai)
#pragma unroll
                for (int m = 0; m < 4; ++m) rsv[ai][m] = ss[u.pm * 256 + ai * 128 + wr * 64 + m * 16 + fr];
            asm volatile("" : "+v"(rsv[0][0]), "+v"(rsv[0][1]), "+v"(rsv[0][2]), "+v"(rsv[0][3]), "+v"(rsv[1][0]), "+v"(rsv[1][1]), "+v"(rsv[1][2]), "+v"(rsv[1][3]));
        } else { EPI_RSTD8(rs2, ss)
#pragma unroll
            for (int ai = 0; ai < 2; ++ai)
#pragma unroll
                for (int m = 0; m < 4; ++m) rsv[ai][m] = rs2[ai][m]; }
        EPI_ROWS_BEGIN
            const float rs = rsv[ai][m]; const int orow = slot_tok ? r - row0 : r;
            const float rsn = rs * -1.44269504f, rq = rs * rs; const f32x2 rn2 = {rsn, rsn}, rq2 = {rq, rq}, one2 = {1.0f, 1.0f};
            float o[8];
#pragma unroll
            for (int n = 0; n < 2; ++n) { const f32x4 ga = acc[ai][0][m][n], ua = acc[ai][1][m][n];
#pragma unroll
                for (int hh = 0; hh < 2; ++hh) { const f32x2 g2 = {ga[2 * hh], ga[2 * hh + 1]}, u2 = {ua[2 * hh], ua[2 * hh + 1]};
                    const f32x2 t = g2 * rn2; const f32x2 d = (f32x2){__builtin_amdgcn_exp2f(t.x), __builtin_amdgcn_exp2f(t.y)} + one2;
                    const f32x2 v = (g2 * u2) * rq2 * (f32x2){__builtin_amdgcn_rcpf(d.x), __builtin_amdgcn_rcpf(d.y)};
                    o[4 * n + 2 * hh] = v.x; o[4 * n + 2 * hh + 1] = v.y; } }
            *(u32x4*)(HID + (size_t)orow * DFF + c0) = pack8(o);
        EPI_ROWS_END
    }
};
struct EpiStore { static constexpr int MID_EVERY = 0;
    bf16_t* O; int ldo;
    __device__ __forceinline__ void operator()(const f32x4 (&acc)[2][2][4][2], const Unit& u, int wr, int wc, int fr, int fq) const {
        const int c0 = u.pn * 256 + wc * 32 + 8 * fq;
        EPI_ROWS_BEGIN
            bf16_t* rowp = O + (size_t)r * ldo + c0;
#pragma unroll
            for (int bj = 0; bj < 2; ++bj) { const f32x4 v0 = acc[ai][bj][m][0], v1 = acc[ai][bj][m][1];
                u32x4 w; w.x = cvt_pk_bf16(v0[0], v0[1]); w.y = cvt_pk_bf16(v0[2], v0[3]); w.z = cvt_pk_bf16(v1[0], v1[1]); w.w = cvt_pk_bf16(v1[2], v1[3]); *(u32x4*)(rowp + bj * 128) = w; }
        EPI_ROWS_END
    }
};

struct EpiStoreK { static constexpr int MID_EVERY = 0;
    bf16_t* O; bf16_t* O2; int ldo, row0;
    __device__ __forceinline__ void operator()(const f32x4 (&acc)[2][2][4][2], const Unit& u, int wr, int wc, int fr, int fq) const {
        const int c0 = (u.pn & 3) * 256 + wc * 32 + 8 * fq;
        bf16_t* base = O + ((u.pn & 4) ? (O2 - O) - (ptrdiff_t)row0 * ldo : (ptrdiff_t)0);
        EPI_ROWS_BEGIN
            bf16_t* rowp = base + (size_t)r * ldo + c0;
#pragma unroll
            for (int bj = 0; bj < 2; ++bj) { const f32x4 v0 = acc[ai][bj][m][0], v1 = acc[ai][bj][m][1];
                u32x4 w; w.x = cvt_pk_bf16(v0[0], v0[1]); w.y = cvt_pk_bf16(v0[2], v0[3]); w.z = cvt_pk_bf16(v1[0], v1[1]); w.w = cvt_pk_bf16(v1[2], v1[3]); *(u32x4*)(rowp + bj * 128) = w; }
        EPI_ROWS_END
    }
};

#define XB_TMO      128
#define XB_XCNT(j)  (256  + 64 * (j))
#define XB_XSUB(j)  (1280 + 64 * (j))
#define XB_XGEN(j)  (2304 + 64 * (j))
#define XB_TOP      3328
#define XB_TOPGEN   3392
#define XCD_BAR_WORDS 3456
#define XB_SPIN_CAP (1u << 18)
__device__ __forceinline__ unsigned xb_ld(unsigned* p)              { return __hip_atomic_load(p, __ATOMIC_RELAXED, __HIP_MEMORY_SCOPE_AGENT); }
__device__ __forceinline__ unsigned xb_add(unsigned* p, unsigned v) { return __hip_atomic_fetch_add(p, v, __ATOMIC_RELAXED, __HIP_MEMORY_SCOPE_AGENT); }
__device__ __forceinline__ unsigned xb_xcc_id() { return (unsigned)__builtin_amdgcn_s_getreg((3 << 11) | 20) & 0xFu; }
#define XB_SPIN(cond, bar) do { unsigned _sp = 0; while (cond) { __builtin_amdgcn_s_sleep(1); \
    if ((++_sp & 255u) == 0u) { if (xb_ld(&(bar)[XB_TMO])) break; if (_sp > XB_SPIN_CAP) { atomicAdd(&(bar)[XB_TMO], 1u); break; } } } } while (0)
struct XcdBarrier { unsigned* bar; unsigned x; volatile LAS unsigned* st; };
__device__ __forceinline__ XcdBarrier xcd_barrier_post(unsigned* bar, volatile LAS unsigned* st) {
    XcdBarrier b; b.bar = bar; b.x = xb_xcc_id(); b.st = st;
    if (threadIdx.x == 0) (void)xb_add(&bar[XB_XCNT(b.x)], 1u);
    return b;
}
__device__ __forceinline__ void xcd_barrier_complete(unsigned* bar, unsigned x, unsigned& nloc, unsigned& nx) {
    const unsigned G = gridDim.x * gridDim.y * gridDim.z;
    unsigned sum, cnt, mine, sp = 0u;
    for (;;) {
        sum = 0u; cnt = 0u; mine = 0u;
#pragma unroll
        for (unsigned j = 0; j < 16; ++j) { const unsigned c = xb_ld(&bar[XB_XCNT(j)]); sum += c; cnt += (c > 0u) ? 1u : 0u; mine = (j == x) ? c : mine; }
        if (sum == G) break;
        __builtin_amdgcn_s_sleep(1);
        if ((++sp & 255u) == 0u) { if (xb_ld(&bar[XB_TMO])) break; if (sp > XB_SPIN_CAP) { atomicAdd(&bar[XB_TMO], 1u); break; } }
    }
    nloc = mine > 0u ? mine : 1u; nx = cnt > 0u ? cnt : 1u;
}
__device__ __forceinline__ void xcd_barrier(const XcdBarrier& b, int wave_id) {
    asm volatile("s_waitcnt vmcnt(0)" ::: "memory");
    __syncthreads();
    int lane_; asm volatile("v_mbcnt_lo_u32_b32 %0, -1, 0\n\tv_mbcnt_hi_u32_b32 %0, -1, %0" : "=v"(lane_));
    if (wave_id == 0 && lane_ == 0) {
        unsigned* bar = b.bar;
        __builtin_amdgcn_s_waitcnt(0);
        unsigned nloc = b.st[0], nx = b.st[1];
        if (nloc == 0u) { xcd_barrier_complete(bar, b.x, nloc, nx); b.st[0] = nloc; b.st[1] = nx; }
        const unsigned old = xb_add(&bar[XB_XSUB(b.x)], 1u);
        const unsigned gen = old / nloc;
        if (old + 1u == (gen + 1u) * nloc) {
            __builtin_amdgcn_fence(__ATOMIC_RELEASE, "agent");
            asm volatile("s_waitcnt vmcnt(0)" ::: "memory");
            const unsigned og = xb_add(&bar[XB_TOP], 1u);
            const unsigned tg = og / nx;
            if (og + 1u == (tg + 1u) * nx) xb_add(&bar[XB_TOPGEN], 1u);
            else XB_SPIN(xb_ld(&bar[XB_TOPGEN]) == tg, bar);
            __builtin_amdgcn_fence(__ATOMIC_ACQUIRE, "agent");
            xb_add(&bar[XB_XGEN(b.x)], 1u);
            asm volatile("s_waitcnt vmcnt(0)" ::: "memory");
        } else {
            XB_SPIN(xb_ld(&bar[XB_XGEN(b.x)]) == gen, bar);
            __builtin_amdgcn_fence(__ATOMIC_ACQUIRE, "agent");
            asm volatile("s_waitcnt vmcnt(0)" ::: "memory");
        }
    }
    __syncthreads();
}

struct Args { const float* in[36]; float* out; unsigned char* ws; int ph_lo, ph_hi, li, pad; };
enum { I_X = 0, I_META, I_MIXG, I_WIN, I_GATEB, I_MU, I_W0, I_W2, I_A0, I_A2, I_G2, I_KK, I_KA, I_RK, I_LNXW, I_LNXB, I_CONVW, I_CONVB, I_BLNG, I_BLNB, I_POOLW, I_CSCALE,
       I_PROJA, I_PROJB, I_PROJC, I_WOUT, I_FFNG, I_FGATE, I_FUP, I_FDOWN, I_RW, I_RB, I_EGATE, I_EUP, I_EDOWN, I_FINALG };
struct Frame {
    LAS unsigned char* lds; int tid, lane, wave, G, bid;
    unsigned char* ws;
    bf16_t* W; bf16_t* WE; bf16_t* HB; bf16_t* R1; bf16_t* R2; bf16_t* R3; bf16_t* YS; float* SS;
};
__device__ __forceinline__ void frame_ptrs(Frame& F) {
    GAS unsigned char* ws = lds_ptr(F.lds, 37); F.ws = (unsigned char*)ws;
    F.W = (bf16_t*)(ws + WS_W); F.WE = (bf16_t*)(ws + WS_WE); F.HB = (bf16_t*)(ws + WS_HB); F.R1 = (bf16_t*)(ws + WS_R1); F.R2 = (bf16_t*)(ws + WS_R2); F.R3 = (bf16_t*)(ws + WS_R3);
    F.YS = (bf16_t*)(ws + WS_YS); F.SS = (float*)(ws + WS_SS);
}
__device__ __forceinline__ const float* in_ptr(const Frame& F, int i) { return (const float*)lds_ptr(F.lds, i); }
#define LDS_WAIT() asm volatile("s_waitcnt lgkmcnt(0)" ::: "memory")
#define PHASE_ENTER(F) do { int l_; int w_ = (F).wave, g_ = (F).G, b_ = (F).bid; asm volatile("v_mbcnt_lo_u32_b32 %0, -1, 0\n\tv_mbcnt_hi_u32_b32 %0, -1, %0" : "=v"(l_), "+s"(w_), "+s"(g_), "+s"(b_) :: "memory"); (F).lane = l_; (F).wave = w_; (F).G = g_; (F).bid = b_; (F).tid = w_ * 64 + l_; frame_ptrs(F); } while (0)


__device__ __forceinline__ int row_of(int b, int l) { return l < NMETA ? MBASE + l : b * SEQ + (l - NMETA); }
__device__ __forceinline__ int prev_row(int r) { if (r >= MBASE) return r > MBASE ? r - 1 : -1; return (r & (SEQ - 1)) ? r - 1 : MBASE + NMETA - 1; }

struct ConvJob { const float* src; int K, srcN, col0, ncols; bf16_t* dst; int dld, dcol0, mode; const float* sc; };
__device__ __forceinline__ int conv_items(const ConvJob& j) { return (j.K / 64) * (j.ncols / 32); }
__device__ __forceinline__ void conv_item(const ConvJob& j, LAS float* scr, int item, int lane) {
    const int nblk = j.ncols / 32, kb = item / nblk, nb = item % nblk, k0 = 64 * kb, n0 = 32 * nb;
    float vv[32];
#pragma unroll
    for (int i = 0; i < 32; ++i) { const int kk = 2 * i + (lane >> 5); vv[i] = j.src[(size_t)(k0 + kk) * j.srcN + j.col0 + n0 + (lane & 31)]; }
    if (j.sc) {
#pragma unroll
        for (int i = 0; i < 32; ++i) vv[i] *= j.sc[k0 + 2 * i + (lane >> 5)]; }
#pragma unroll
    for (int i = 0; i < 32; ++i) { const int kk = 2 * i + (lane >> 5); scr[kk * 33 + (lane & 31)] = vv[i]; }
    LDS_WAIT(); asm volatile("" ::: "memory");
    const int c = lane & 7;
    int drow0 = n0; if (j.mode == 1) drow0 = 256 * (n0 / 128) + (n0 % 128); else if (j.mode == 2) drow0 = 256 * (n0 / 128) + 128 + (n0 % 128);
#pragma unroll
    for (int jj = 0; jj < 4; ++jj) { const int n = (lane >> 3) + 8 * jj; const LAS float* s = scr + (8 * c) * 33 + n;
        u32x4 o; o.x = cvt_pk_bf16(s[0 * 33], s[1 * 33]); o.y = cvt_pk_bf16(s[2 * 33], s[3 * 33]); o.z = cvt_pk_bf16(s[4 * 33], s[5 * 33]); o.w = cvt_pk_bf16(s[6 * 33], s[7 * 33]);
        *(u32x4*)(j.dst + (size_t)(drow0 + n) * j.dld + j.dcol0 + k0 + 8 * c) = o; }
    LDS_WAIT(); asm volatile("" ::: "memory");
}
__device__ __forceinline__ void conv_run(Frame& F, const ConvJob& j) {
    LAS float* scr = (LAS float*)(F.lds + F.wave * 16384);
    const int gw = F.bid * 8 + F.wave, NGW = F.G * 8, n = conv_items(j);
    for (int it = gw; it < n; it += NGW) conv_item(j, scr, it, F.lane);
}
__device__ __forceinline__ void convert_common(Frame& F) {
    PHASE_ENTER(F);
    for (int l = 0; l < 2; ++l) {
        bf16_t* WL = F.W + (size_t)l * WL_SIZE; const float* mg = in_ptr(F, I_MIXG) + l * DM;
        const float* win = in_ptr(F, I_WIN) + (size_t)l * DM * 6400;
        conv_run(F, ConvJob{win, DM, 6400, 0, NABC, WL + WL_ABC, DM, 0, 0, mg});
        conv_run(F, ConvJob{win, DM, 6400, NABC, NGATE, WL + WL_G, DM, 0, 0, mg});
        conv_run(F, ConvJob{in_ptr(F, I_PROJA) + (size_t)l * AW * DM, AW, DM, 0, DM, WL + WL_P, NY, 0, 0, nullptr});
        conv_run(F, ConvJob{in_ptr(F, I_PROJB) + (size_t)l * AW * DM, AW, DM, 0, DM, WL + WL_P, NY, AW, 0, nullptr});
        conv_run(F, ConvJob{in_ptr(F, I_PROJC) + (size_t)l * AW * DM, AW, DM, 0, DM, WL + WL_P, NY, 2 * AW, 0, nullptr});
        conv_run(F, ConvJob{in_ptr(F, I_WOUT) + (size_t)l * DM * DM, DM, DM, 0, DM, WL + WL_OUT, DM, 0, 0, nullptr});
        conv_run(F, ConvJob{in_ptr(F, I_W2) + (size_t)l * 64 * AW, 64, AW, 0, AW, WL + WL_W2, 64, 0, 0, nullptr});
        conv_run(F, ConvJob{in_ptr(F, I_A2) + (size_t)l * 64 * AW, 64, AW, 0, AW, WL + WL_A2, 64, 0, 0, nullptr});
        conv_run(F, ConvJob{in_ptr(F, I_G2) + (size_t)l * 128 * AW, 128, AW, 0, AW, WL + WL_G2, 128, 0, 0, nullptr});
        for (int g = 0; g < 4; ++g) conv_run(F, ConvJob{in_ptr(F, I_POOLW) + ((size_t)l * 4 + g) * 128 * 128, 128, 128, 0, 128, WL + WL_PW + (size_t)g * 128 * 128, 128, 0, 0, nullptr});
    }
    const float* fg = in_ptr(F, I_FFNG);
    conv_run(F, ConvJob{in_ptr(F, I_FGATE), DM, DFF, 0, DFF, F.W + WF_GU, DM, 0, 1, fg});
    conv_run(F, ConvJob{in_ptr(F, I_FUP), DM, DFF, 0, DFF, F.W + WF_GU, DM, 0, 2, fg});
    conv_run(F, ConvJob{in_ptr(F, I_FDOWN), DFF, DM, 0, DM, F.W + WF_D, DFF, 0, 0, nullptr});
}
constexpr int CE_PER = 1408, CE_TOTAL = NEXP * 3 * CE_PER;
static_assert((DM / 64) * (DFF / 32) == CE_PER && (DFF / 64) * (DM / 32) == CE_PER, "expert conversion items");
__device__ __forceinline__ ConvJob expert_job(Frame& F, int g, int& item) {
    const int gc = g < CE_TOTAL ? g : CE_TOTAL - 1; const int e = gc / (3 * CE_PER), j = (gc / CE_PER) % 3; item = gc % CE_PER;
    if (j == 2) return ConvJob{in_ptr(F, I_EDOWN) + (size_t)e * DFF * DM, DFF, DM, 0, DM, F.WE + WE_D + (size_t)e * DM * DFF, DFF, 0, 0, nullptr};
    return ConvJob{in_ptr(F, j == 0 ? I_EGATE : I_EUP) + (size_t)e * DM * DFF, DM, DFF, 0, DFF, F.WE + WE_GU + (size_t)e * NGU * DM, DM, 0, j + 1, in_ptr(F, I_FFNG) + DM};
}
__device__ __forceinline__ void conv_load(const ConvJob& j, int item, int lane, float (&vv)[32], f32x4 (&sc2)[2]) {
    const int nblk = j.ncols / 32, kb = item / nblk, nb = item % nblk, k0 = 64 * kb, n0 = 32 * nb;
#pragma unroll
    for (int i = 0; i < 32; ++i) { const int kk = 2 * i + (lane >> 5); vv[i] = j.src[(size_t)(k0 + kk) * j.srcN + j.col0 + n0 + (lane & 31)]; }
    const float* sp = (j.sc ? j.sc : j.src) + k0 + 8 * (lane & 7);
    sc2[0] = *(const f32x4*)sp; sc2[1] = *(const f32x4*)(sp + 4);
}
__device__ __forceinline__ void conv_finish(const ConvJob& j, LAS float* scr, int item, int lane, const float (&vv)[32], const f32x4 (&sc2)[2]) {
    const int nblk = j.ncols / 32, kb = item / nblk, nb = item % nblk, k0 = 64 * kb, n0 = 32 * nb;
#pragma unroll
    for (int i = 0; i < 32; ++i) { const int kk = 2 * i + (lane >> 5); scr[kk * 33 + (lane & 31)] = vv[i]; }
    LDS_WAIT(); asm volatile("" ::: "memory");
    const int c = lane & 7; const bool hs = j.sc != nullptr;
    float m[8];
#pragma unroll
    for (int q = 0; q < 8; ++q) m[q] = hs ? (q < 4 ? sc2[0][q] : sc2[1][q - 4]) : 1.0f;
    int drow0 = n0; if (j.mode == 1) drow0 = 256 * (n0 / 128) + (n0 % 128); else if (j.mode == 2) drow0 = 256 * (n0 / 128) + 128 + (n0 % 128);
#pragma unroll
    for (int jj = 0; jj < 4; ++jj) { const int n = (lane >> 3) + 8 * jj; const LAS float* s_ = scr + (8 * c) * 33 + n;
        u32x4 o; o.x = cvt_pk_bf16(s_[0 * 33] * m[0], s_[1 * 33] * m[1]); o.y = cvt_pk_bf16(s_[2 * 33] * m[2], s_[3 * 33] * m[3]); o.z = cvt_pk_bf16(s_[4 * 33] * m[4], s_[5 * 33] * m[5]); o.w = cvt_pk_bf16(s_[6 * 33] * m[6], s_[7 * 33] * m[7]);
        *(u32x4*)(j.dst + (size_t)(drow0 + n) * j.dld + j.dcol0 + k0 + 8 * c) = o; }
    LDS_WAIT(); asm volatile("" ::: "memory");
}
__device__ __forceinline__ void convert_experts(Frame& F) {
    PHASE_ENTER(F);
    LAS float* scr = (LAS float*)(F.lds + F.wave * 16384);
    const int gw = F.bid * 8 + F.wave, NGW = F.G * 8, lane = F.lane;
    if (gw >= CE_TOTAL) return;
    float va[32], vb[32]; f32x4 sa[2], sb[2]; int ia, ib;
    ConvJob ja = expert_job(F, gw, ia), jb = ja; conv_load(ja, ia, lane, va, sa);
    for (int g = gw; ; ) {
        jb = expert_job(F, g + NGW, ib); conv_load(jb, ib, lane, vb, sb);
        conv_finish(ja, scr, ia, lane, va, sa);
        g += NGW; if (g >= CE_TOTAL) break;
        ja = expert_job(F, g + NGW, ia); conv_load(ja, ia, lane, va, sa);
        conv_finish(jb, scr, ib, lane, vb, sb);
        g += NGW; if (g >= CE_TOTAL) break;
    }
}
__device__ __forceinline__ void x_to_hb(Frame& F) {
    PHASE_ENTER(F);
    const int gw = F.bid * 8 + F.wave, NGW = F.G * 8;
    for (int r = gw; r < NROWS; r += NGW) {
        const float* src = r < NREAL ? in_ptr(F, I_X) + (size_t)r * DM : in_ptr(F, I_META) + (size_t)(r - MBASE) * DM;
        const f32x4* xr = (const f32x4*)src + F.lane; u32x2* o = (u32x2*)(F.HB + (size_t)r * DM) + F.lane; float sq = 0.f;
#pragma unroll
        for (int j = 0; j < 4; ++j) { const f32x4 v = xr[64 * j]; u32x2 w; w.x = cvt_pk_bf16(v[0], v[1]); w.y = cvt_pk_bf16(v[2], v[3]); o[64 * j] = w;
            const float a = bf_lo(w.x), b = bf_hi(w.x), c = bf_lo(w.y), d = bf_hi(w.y); sq += (a * a + b * b) + (c * c + d * d); }
        sq = wave_sum(sq);
        if (r < NREAL && F.lane < 4) F.SS[(size_t)r * 4 + F.lane] = F.lane == 0 ? sq : 0.f;
    }
}

__device__ __forceinline__ float meta_tile(Frame& F, const bf16_t* A16, int lda, const bf16_t* Bt, int ldb, int K, int brow0) {
    LAS float* red = (LAS float*)F.lds;
    const int kw = K / 8, k0 = F.wave * kw, fr = F.lane & 15, fq = F.lane >> 4;
    f32x4 acc = (f32x4){0.f, 0.f, 0.f, 0.f};
    const bf16_t* ap = A16 + (size_t)fr * lda + k0 + 8 * fq; const bf16_t* bp = Bt + (size_t)(brow0 + fr) * ldb + k0 + 8 * fq;
    for (int k = 0; k < kw; k += 32) { const bf16x8 a = *(const bf16x8*)(ap + k), b = *(const bf16x8*)(bp + k); acc = __builtin_amdgcn_mfma_f32_16x16x32_bf16(b, a, acc, 0, 0, 0); }
#pragma unroll
    for (int j = 0; j < 4; ++j) red[F.wave * 256 + fr * 16 + 4 * fq + j] = acc[j];
    __syncthreads();
    float v = 0.f;
    if (F.tid < 256) {
#pragma unroll
        for (int w = 0; w < 8; ++w) v += red[w * 256 + F.tid];
    }
    __syncthreads();
    return v;
}


__device__ __forceinline__ void meta_rstd_setup(Frame& F) {
    LAS float* mrs = (LAS float*)(F.lds + 8192);
#pragma unroll
    for (int i = 0; i < 2; ++i) { const int row = 2 * F.wave + i; float hv[16]; const bf16_t* hp = F.HB + (size_t)(MBASE + row) * DM + 16 * F.lane;
        unpack8(*(const u32x4*)hp, *(float(*)[8])&hv[0]); unpack8(*(const u32x4*)(hp + 8), *(float(*)[8])&hv[8]); float sq = 0.f;
#pragma unroll
        for (int j = 0; j < 16; ++j) sq += hv[j] * hv[j];
        sq = wave_sum(sq); if (F.lane == 0) mrs[row] = __builtin_amdgcn_rsqf(sq * (1.0f / DM) + RMS_EPS); }
    __syncthreads();
}
#define META_RS(F, row16) (((const LAS float*)((F).lds + 8192))[row16])

__device__ __forceinline__ void prep_afrags(bf16x8 (&af)[8], const bf16_t* U, const float* mu, int row, int fq) {
    const int prow = prev_row(row), pr = prow >= 0 ? prow : row; const float pm = prow >= 0 ? 1.0f : 0.0f;
    u32x4 rc[8], rp[8];
#pragma unroll
    for (int s = 0; s < 8; ++s) { const int col = 1536 + 32 * s + 8 * fq; rc[s] = *(const u32x4*)(U + (size_t)row * NABC + col); rp[s] = *(const u32x4*)(U + (size_t)pr * NABC + col); }
#pragma unroll
    for (int s = 0; s < 8; ++s) {
        const int col = 1536 + 32 * s + 8 * fq;
        float cur[8], prv[8]; unpack8(rc[s], cur); unpack8(rp[s], prv);
        const f32x4 m0 = *(const f32x4*)(mu + col), m1 = *(const f32x4*)(mu + col + 4);
        float x[8];
#pragma unroll
        for (int j = 0; j < 8; ++j) { const float mm = j < 4 ? m0[j] : m1[j - 4]; float v = cur[j] + (pm * prv[j] - cur[j]) * mm;
            if (s < 2) v = 1.0f - 2.0f * __builtin_amdgcn_rcpf(1.0f + __expf(2.0f * v));
            else if (s >= 4) v = fast_sigmoid(v);
            x[j] = v; }
        const u32x4 p = pack8(x); af[s] = __builtin_bit_cast(bf16x8, p);
    }
}
template <int NG> __device__ __forceinline__ void prep_tile(const bf16x8 (&af)[NG][8], const int (&rows)[NG], int ct, int fr, int fq, const bf16_t* w2t, const bf16_t* a2t, const bf16_t* g2t,
                                                            const float* w0, const float* a0, bf16_t* WAw, bf16_t* WAa, bf16_t* Y) {
    const bf16_t* bw = w2t + (size_t)(16 * ct + fr) * 64 + 8 * fq; const bf16_t* ba = a2t + (size_t)(16 * ct + fr) * 64 + 8 * fq; const bf16_t* bg = g2t + (size_t)(16 * ct + fr) * 128 + 8 * fq;
    bf16x8 fw[2], fa[2], fg[4];
#pragma unroll
    for (int s = 0; s < 2; ++s) { fw[s] = *(const bf16x8*)(bw + 32 * s); fa[s] = *(const bf16x8*)(ba + 32 * s); }
#pragma unroll
    for (int s = 0; s < 4; ++s) fg[s] = *(const bf16x8*)(bg + 32 * s);
    const int c = 16 * ct + 4 * fq;
    const f32x4 w0v = *(const f32x4*)(w0 + c), a0v = *(const f32x4*)(a0 + c);
#pragma unroll
    for (int gi = 0; gi < NG; ++gi) {
        f32x4 aw = (f32x4){0.f, 0.f, 0.f, 0.f}, aa = aw, ag = aw;
#pragma unroll
        for (int s = 0; s < 2; ++s) { aw = __builtin_amdgcn_mfma_f32_16x16x32_bf16(fw[s], af[gi][s], aw, 0, 0, 0); aa = __builtin_amdgcn_mfma_f32_16x16x32_bf16(fa[s], af[gi][2 + s], aa, 0, 0, 0); }
#pragma unroll
        for (int s = 0; s < 4; ++s) ag = __builtin_amdgcn_mfma_f32_16x16x32_bf16(fg[s], af[gi][4 + s], ag, 0, 0, 0);
        u32x2 ow, oa, og;
        ow.x = cvt_pk_bf16(0.60653066f * fast_sigmoid(aw[0] + w0v[0]), 0.60653066f * fast_sigmoid(aw[1] + w0v[1])); ow.y = cvt_pk_bf16(0.60653066f * fast_sigmoid(aw[2] + w0v[2]), 0.60653066f * fast_sigmoid(aw[3] + w0v[3]));
        oa.x = cvt_pk_bf16(fast_sigmoid(aa[0] + a0v[0]), fast_sigmoid(aa[1] + a0v[1])); oa.y = cvt_pk_bf16(fast_sigmoid(aa[2] + a0v[2]), fast_sigmoid(aa[3] + a0v[3]));
        og.x = cvt_pk_bf16(ag[0], ag[1]); og.y = cvt_pk_bf16(ag[2], ag[3]);
        const size_t row = rows[gi];
        *(u32x2*)(WAw + row * AW + c) = ow; *(u32x2*)(WAa + row * AW + c) = oa; *(u32x2*)(Y + row * NY + AW + c) = og;
    }
}
__device__ __forceinline__ void phase_prep(Frame& F, int l) {
    PHASE_ENTER(F);
    const bf16_t* U = F.R1; bf16_t* WAw = F.R2; bf16_t* WAa = F.R2 + (size_t)NROWS * AW; bf16_t* Y = F.R3;
    const bf16_t* WL = F.W + (size_t)l * WL_SIZE; const bf16_t* w2t = WL + WL_W2; const bf16_t* a2t = WL + WL_A2; const bf16_t* g2t = WL + WL_G2;
    const float* mu = in_ptr(F, I_MU) + l * AIN; const float* w0 = in_ptr(F, I_W0) + l * AW; const float* a0 = in_ptr(F, I_A0) + l * AW;
    const int fr = F.lane & 15, fq = F.lane >> 4;
    const int gw = F.bid * 8 + F.wave, NGW = F.G * 8;
    for (int grp = gw; grp < NREAL / 16; grp += 2 * NGW) {
        const int grp2 = grp + NGW;
        if (grp2 < NREAL / 16) {
            bf16x8 af[2][8]; const int rows[2] = {grp * 16 + fr, grp2 * 16 + fr};
            prep_afrags(af[0], U, mu, rows[0], fq); prep_afrags(af[1], U, mu, rows[1], fq);
#pragma unroll 2
            for (int ct = 0; ct < 32; ++ct) prep_tile<2>(af, rows, ct, fr, fq, w2t, a2t, g2t, w0, a0, WAw, WAa, Y);
        } else {
            bf16x8 af[1][8]; const int rows[1] = {grp * 16 + fr};
            prep_afrags(af[0], U, mu, rows[0], fq);
#pragma unroll 2
            for (int ct = 0; ct < 32; ++ct) prep_tile<1>(af, rows, ct, fr, fq, w2t, a2t, g2t, w0, a0, WAw, WAa, Y);
        }
    }
    for (int hi = gw; hi < NB * 256; hi += NGW) { const int hb = hi >> 8, hc = (hi & 255) + 1; const int src = hc == 1 ? MBASE + NMETA - 1 : hb * SEQ + 32 * (hc - 1) - 1;
        bf16_t* hd = (bf16_t*)(F.ws + WS_HALO) + (size_t)hi * 1536;
#pragma unroll
        for (int j = 0; j < 3; ++j) *(u32x4*)(hd + 512 * j + 8 * F.lane) = *(const u32x4*)(U + (size_t)src * NABC + 512 * j + 8 * F.lane); }
    if (gw < 32) { bf16x8 af[1][8]; const int rows[1] = {MBASE + fr}; prep_afrags(af[0], U, mu, rows[0], fq); prep_tile<1>(af, rows, gw, fr, fq, w2t, a2t, g2t, w0, a0, WAw, WAa, Y); }
}

constexpr int SC_TOK = 32, SC_VEC = SC_TOK * 64, SC_BUF_F = 5 * SC_VEC + SC_TOK * 16 * 4, SC_BUF = SC_BUF_F * 4, SC_YB = 2 * SC_BUF, SC_NCH = 1 + SEQ / SC_TOK;
template <int N> __device__ __forceinline__ float ror16(float v) { return __builtin_bit_cast(float, __builtin_amdgcn_update_dpp(0, __builtin_bit_cast(int, v), 0x120 + N, 0xf, 0xf, false)); }
__device__ __forceinline__ float allreduce16(float v) { v += ror16<8>(v); v += ror16<4>(v); v += ror16<2>(v); v += ror16<1>(v); return v; }
struct ScanRegs { u32x4 zr, zrp, zk, zkp, ww, aa, zv, zvp; };
__device__ __forceinline__ void scan_load(ScanRegs& R, const bf16_t* U, const bf16_t* WAw, const bf16_t* WAa, int b, int h, int q, int c, int sw, int lane) {
    c = c < SC_NCH ? c : SC_NCH - 1;
    const int ntok = c == 0 ? NMETA : SC_TOK, p0 = c == 0 ? 0 : NMETA + SC_TOK * (c - 1), per = ntok / 4, i0 = lane >> 3, i = i0 < per ? i0 : per - 1, o = lane & 7;
    const int p = p0 + sw * per + i, row = row_of(b, p), prow = row_of(b, p > 0 ? p - 1 : 0), ch = h * 64 + 8 * o, cv = 1024 + h * 64 + 16 * q + 8 * (o & 1);
    R.zr = *(const u32x4*)(U + (size_t)row * NABC + ch); R.zk = *(const u32x4*)(U + (size_t)row * NABC + 512 + ch);
    R.ww = *(const u32x4*)(WAw + (size_t)row * AW + ch); R.aa = *(const u32x4*)(WAa + (size_t)row * AW + ch);
    R.zv = *(const u32x4*)(U + (size_t)row * NABC + cv);
    R.zrp = *(const u32x4*)(U + (size_t)prow * NABC + ch); R.zkp = *(const u32x4*)(U + (size_t)prow * NABC + 512 + ch); R.zvp = *(const u32x4*)(U + (size_t)prow * NABC + cv);
}
__device__ __forceinline__ void scan_stage(const ScanRegs& R, LAS float* buf, int c, int sw, int lane, const float (&mur)[8], const float (&muk)[8], const float (&muv)[8], const float (&kkc)[8], const float (&kac)[8]) {
    const int ntok = c == 0 ? NMETA : SC_TOK, per = ntok / 4, i = lane >> 3, o = lane & 7;
    if (i < per) {
        const int tt = sw * per + i;
        float zr[8], zrp[8], zk[8], zkp[8], ww[8], aa[8];
        unpack8(R.zr, zr); unpack8(R.zrp, zrp); unpack8(R.zk, zk); unpack8(R.zkp, zkp); unpack8(R.ww, ww); unpack8(R.aa, aa);
        const bool first = (c == 0 && tt == 0);
        if (first) {
#pragma unroll
            for (int j = 0; j < 8; ++j) { zrp[j] = 0.f; zkp[j] = 0.f; } }
        float r[8], kx[8], kk[8], ss = 0.f;
#pragma unroll
        for (int j = 0; j < 8; ++j) { r[j] = zr[j] + (zrp[j] - zr[j]) * mur[j]; kx[j] = zk[j] + (zkp[j] - zk[j]) * muk[j]; kk[j] = kx[j] * kkc[j]; ss += kk[j] * kk[j]; }
        ss = allreduce8(ss);
        const float inv = 1.0f / fmaxf(sqrtf(ss), 1e-12f);
        float av[8], bv[8], dv[8], k2[8], rd[8], br = 0.f, kr = 0.f;
#pragma unroll
        for (int j = 0; j < 8; ++j) { const float kn = kk[j] * inv; av[j] = -kn; bv[j] = kn * aa[j]; dv[j] = __expf(-ww[j]); k2[j] = kx[j] * (1.0f + (aa[j] - 1.0f) * kac[j]); rd[j] = dv[j] * r[j];
            br += bv[j] * r[j]; kr += k2[j] * r[j]; }
        br = allreduce8(br); kr = allreduce8(kr);
        LAS float* dst = buf + tt * 64 + 8 * o;
        *(LAS f32x4*)(dst + 0 * SC_VEC) = (f32x4){av[0], av[1], av[2], av[3]}; *(LAS f32x4*)(dst + 0 * SC_VEC + 4) = (f32x4){av[4], av[5], av[6], av[7]};
        *(LAS f32x4*)(dst + 1 * SC_VEC) = (f32x4){bv[0], bv[1], bv[2], bv[3]}; *(LAS f32x4*)(dst + 1 * SC_VEC + 4) = (f32x4){bv[4], bv[5], bv[6], bv[7]};
        *(LAS f32x4*)(dst + 2 * SC_VEC) = (f32x4){dv[0], dv[1], dv[2], dv[3]}; *(LAS f32x4*)(dst + 2 * SC_VEC + 4) = (f32x4){dv[4], dv[5], dv[6], dv[7]};
        *(LAS f32x4*)(dst + 3 * SC_VEC) = (f32x4){k2[0], k2[1], k2[2], k2[3]}; *(LAS f32x4*)(dst + 3 * SC_VEC + 4) = (f32x4){k2[4], k2[5], k2[6], k2[7]};
        *(LAS f32x4*)(dst + 4 * SC_VEC) = (f32x4){rd[0], rd[1], rd[2], rd[3]}; *(LAS f32x4*)(dst + 4 * SC_VEC + 4) = (f32x4){rd[4], rd[5], rd[6], rd[7]};
        if (o < 2) { float zv[8], zvp[8]; unpack8(R.zv, zv); unpack8(R.zvp, zvp); float v[8];
            if (first) {
#pragma unroll
                for (int j = 0; j < 8; ++j) zvp[j] = 0.f; }
#pragma unroll
            for (int j = 0; j < 8; ++j) { v[j] = zv[j] + (zvp[j] - zv[j]) * muv[j]; }
            LAS float* vd = buf + 5 * SC_VEC + (tt * 16 + 8 * o) * 4;
#pragma unroll
            for (int j = 0; j < 8; ++j) *(LAS f32x4*)(vd + 4 * j) = (f32x4){v[j], br, kr, 0.f}; }
    }
}
struct StepIn { f32x4 a, b, d, k, rd, vs; };
template <int J> __device__ __forceinline__ void step_load(StepIn& I, unsigned avec, unsigned avs) {
    asm volatile("ds_read_b128 %0, %1 offset:%2" : "=v"(I.a) : "v"(avec), "n"(J * 256));
    asm volatile("ds_read_b128 %0, %1 offset:%2" : "=v"(I.b) : "v"(avec), "n"(J * 256 + 8192));
    asm volatile("ds_read_b128 %0, %1 offset:%2" : "=v"(I.d) : "v"(avec), "n"(J * 256 + 16384));
    asm volatile("ds_read_b128 %0, %1 offset:%2" : "=v"(I.k) : "v"(avec), "n"(J * 256 + 24576));
    asm volatile("ds_read_b128 %0, %1 offset:%2" : "=v"(I.rd) : "v"(avec), "n"(J * 256 + 32768));
    asm volatile("ds_read_b128 %0, %1 offset:%2" : "=v"(I.vs) : "v"(avs), "n"(J * 256));
}
#define STEP_WAIT(I, n) asm volatile("s_waitcnt lgkmcnt(" #n ")" : "+v"(I.a), "+v"(I.b), "+v"(I.d), "+v"(I.k), "+v"(I.rd), "+v"(I.vs))
static_assert(SC_VEC * 4 == 8192, "asm offsets");
__device__ __forceinline__ float step_compute(const StepIn& I, f32x2& S01, f32x2& S23) {
    const f32x2 a01 = {I.a[0], I.a[1]}, a23 = {I.a[2], I.a[3]}, r01 = {I.rd[0], I.rd[1]}, r23 = {I.rd[2], I.rd[3]};
    f32x2 q = S01 * a01; q = S23 * a23 + q; f32x2 w = S01 * r01; w = S23 * r23 + w;
    float p1 = q.x + q.y, p2 = w.x + w.y;
    p1 = allreduce16(p1); p2 = allreduce16(p2);
    const float y = p2 + (p1 * I.vs[1] + I.vs[0] * I.vs[2]);
    const f32x2 pv = {p1, p1}, vv = {I.vs[0], I.vs[0]}, b01 = {I.b[0], I.b[1]}, b23 = {I.b[2], I.b[3]}, k01 = {I.k[0], I.k[1]}, k23 = {I.k[2], I.k[3]}, d01 = {I.d[0], I.d[1]}, d23 = {I.d[2], I.d[3]};
    S01 = S01 * d01 + (pv * b01 + vv * k01); S23 = S23 * d23 + (pv * b23 + vv * k23);
    return y;
}
__device__ __forceinline__ void phase_scan(Frame& F, int l) {
    PHASE_ENTER(F);
    const bf16_t* U = F.R1; const bf16_t* WAw = F.R2; const bf16_t* WAa = F.R2 + (size_t)NROWS * AW; bf16_t* Y = F.R3;
    const float* mu = in_ptr(F, I_MU) + l * AIN; const float* kkp = in_ptr(F, I_KK) + l * AW; const float* kap = in_ptr(F, I_KA) + l * AW;
    const int lane = F.lane, wave = F.wave;
    constexpr int NIT = SC_NCH + 4;
    static_assert(NIT % 3 == 0, "NIT");
    for (int unit = F.bid; unit < NB * 8 * 4; unit += F.G) {
        const int b = unit >> 5, h = (unit >> 2) & 7, q = unit & 3;
        __syncthreads();
        if (wave >= 4) {
            const int sw = wave - 4, o = lane & 7, ch = h * 64 + 8 * o, cv = 1024 + h * 64 + 16 * q + 8 * (o & 1);
            float mur[8], muk[8], muv[8], kkc[8], kac[8];
#pragma unroll
            for (int j = 0; j < 8; ++j) { mur[j] = mu[ch + j]; muk[j] = mu[512 + ch + j]; muv[j] = mu[cv + j]; kkc[j] = kkp[ch + j]; kac[j] = kap[ch + j]; }
            ScanRegs R0, R1, R2; scan_load(R0, U, WAw, WAa, b, h, q, 0, sw, lane); scan_load(R1, U, WAw, WAa, b, h, q, 1, sw, lane);
#define SC_FLUSH(kk_) do { const int c_ = (kk_) - 2; if (c_ >= 0 && c_ < SC_NCH) { const int ntok_ = c_ == 0 ? NMETA : SC_TOK, p0_ = c_ == 0 ? 0 : NMETA + SC_TOK * (c_ - 1); \
                const LAS float* yb_ = (const LAS float*)(F.lds + SC_YB + (c_ & 1) * (SC_TOK * 16 * 4)); const int t2_ = sw * 64 + lane, tt_ = t2_ >> 3, pr_ = t2_ & 7; \
                if (tt_ < ntok_ && (b == 0 || c_ > 0)) { const int row_ = row_of(b, p0_ + tt_); \
                    *(unsigned*)(Y + (size_t)row_ * NY + h * 64 + 16 * q + 2 * pr_) = cvt_pk_bf16(yb_[tt_ * 16 + 2 * pr_], yb_[tt_ * 16 + 2 * pr_ + 1]); } } } while (0)
#define SC_SUBIT(kk_, RC_, RL_) do { scan_load(RL_, U, WAw, WAa, b, h, q, (kk_) + 2, sw, lane); \
                if ((kk_) < SC_NCH) scan_stage(RC_, (LAS float*)(F.lds + ((kk_) & 1) * SC_BUF), (kk_), sw, lane, mur, muk, muv, kkc, kac); \
                SC_FLUSH(kk_); LDS_WAIT(); __builtin_amdgcn_s_barrier(); asm volatile("" ::: "memory"); } while (0)
            for (int k = 0; k < NIT; k += 3) { SC_SUBIT(k, R0, R2); SC_SUBIT(k + 1, R1, R0); SC_SUBIT(k + 2, R2, R1); }
#undef SC_SUBIT
#undef SC_FLUSH
        } else {
            const int rr = lane >> 4, kq = lane & 15, row16 = 4 * wave + rr;
            f32x2 S01 = {0.f, 0.f}, S23 = {0.f, 0.f};
            for (int k = 0; k < NIT; ++k) {
                if (k >= 1 && k <= SC_NCH) {
                    const int c = k - 1, ntok = c == 0 ? NMETA : SC_TOK;
                    const LAS float* buf = (const LAS float*)(F.lds + (c & 1) * SC_BUF);
                    LAS float* yb = (LAS float*)(F.lds + SC_YB + (c & 1) * (SC_TOK * 16 * 4));
                    const unsigned bvec = (unsigned)(size_t)buf + 16u * kq, bvs = (unsigned)(size_t)buf + (5 * SC_VEC + row16 * 4) * 4u;
                    for (int t0 = 0; t0 < ntok; t0 += 16) {
                        float yk = 0.f; StepIn I0, I1, I2;
                        const unsigned v0 = bvec + t0 * 256u, w0 = bvs + t0 * 256u;
#define SC_LD(I, j) step_load<j>(I, v0, w0)
#define SC_ST(I, j, n) do { STEP_WAIT(I, n); const float y_ = step_compute(I, S01, S23); yk = (kq == (j)) ? y_ : yk; } while (0)
                        SC_LD(I0, 0); SC_LD(I1, 1);
                        SC_LD(I2, 2); SC_ST(I0, 0, 12); SC_LD(I0, 3); SC_ST(I1, 1, 12); SC_LD(I1, 4); SC_ST(I2, 2, 12);
                        SC_LD(I2, 5); SC_ST(I0, 3, 12); SC_LD(I0, 6); SC_ST(I1, 4, 12); SC_LD(I1, 7); SC_ST(I2, 5, 12);
                        SC_LD(I2, 8); SC_ST(I0, 6, 12); SC_LD(I0, 9); SC_ST(I1, 7, 12); SC_LD(I1, 10); SC_ST(I2, 8, 12);
                        SC_LD(I2, 11); SC_ST(I0, 9, 12); SC_LD(I0, 12); SC_ST(I1, 10, 12); SC_LD(I1, 13); SC_ST(I2, 11, 12);
                        SC_LD(I2, 14); SC_ST(I0, 12, 12); SC_LD(I0, 15); SC_ST(I1, 13, 12); SC_ST(I2, 14, 6); SC_ST(I0, 15, 0);
#undef SC_LD
#undef SC_ST
                        yb[(t0 + kq) * 16 + row16] = yk;
                    }
                }
                LDS_WAIT(); __builtin_amdgcn_s_barrier(); asm volatile("" ::: "memory");
            }
        }
    }
}

#define LD8(dst, p) float dst[8]; { const f32x4 x0_ = *(const f32x4*)(p), x1_ = *(const f32x4*)((p) + 4); dst[0] = x0_[0]; dst[1] = x0_[1]; dst[2] = x0_[2]; dst[3] = x0_[3]; dst[4] = x1_[0]; dst[5] = x1_[1]; dst[6] = x1_[2]; dst[7] = x1_[3]; }
namespace p2 {
constexpr int X_AT = 0, X_RT = 4096, X_BT = 8192, X_KT = 12288, X_VT = 16384, X_AAB = 20480, X_AAK = 24576, X_MRK = 26624, X_TT = 28672, X_A21 = 30720, X_TC11 = 31232, X_Z1T = 31744, SZ = 32256, NW = 4;
constexpr int G_TT = 0, G_MRB = 2048, G_XA = 4096, G_FA = 8192, G_SZ = 12288;
static_assert(NW * SZ <= LDSCTL_OFF && X_AAK == X_AAB + 4096 && X_MRK == X_AAK + 2048 && X_TT == X_MRK + 2048, "prep2 LDS");
}
constexpr int P2_UNITS = 8 * (1 + NB * 256);
static_assert((size_t)P2_UNITS * p2::G_SZ <= (size_t)NREAL * DM * 4, "scan side blocks");
__device__ __forceinline__ int p2_unit(int b, int h, int c) { return (c == 0 ? 0 : 1 + b * 256 + (c - 1)) * 8 + h; }
namespace ck {
constexpr int PSZ = 26880, NSLOT = 4, O_AT = 0, O_RT = 4096, O_TT = 8192, O_MRB = 10240, O_XA = 12288, O_FA = 14336, O_BT = 16384, O_KT = 20992, BK_LD = 72  , O_VV = 25600  , O_GV = 26624;
constexpr int C_BASE = 132096, O_ST = 0, O_U0T = 2048, O_WT = 3072, O_FLAG = 4096, NCH = 1 + SEQ / 32;
static_assert(NSLOT * PSZ <= LDSCTL_OFF && C_BASE + O_FLAG + 64 <= LDS_BYTES && C_BASE >= PTR_OFF + 8 * 40, "chunked-scan LDS map");
typedef float f32x4v __attribute__((ext_vector_type(4)));
__device__ __forceinline__ f32x4 mma(bf16x8 a, bf16x8 b, f32x4 c) { return __builtin_amdgcn_mfma_f32_16x16x32_bf16(a, b, c, 0, 0, 0); }
__device__ __forceinline__ bf16x8 frag(const LAS unsigned char* base, int ld, int row0, int k0, int lane) { return *(const LAS bf16x8*)(base + ((row0 + (lane & 15)) * ld + k0 + 8 * (lane >> 4)) * 2); }
__device__ __forceinline__ bf16x8 frag16(const LAS unsigned char* base, int ld, int row0, int lane) { const bf16x8 z = {0, 0, 0, 0, 0, 0, 0, 0}; const int q = lane >> 4; bf16x8 v = *(const LAS bf16x8*)(base + ((row0 + (lane & 15)) * ld + 8 * (q & 1)) * 2); return q < 2 ? v : z; }
__device__ __forceinline__ void lds_spin(volatile LAS unsigned* p, unsigned want) { while (*p < want) __builtin_amdgcn_s_sleep(1); }
__device__ __forceinline__ bf16x8 frag_tr(const LAS unsigned char* base, int pitch, int k0, int n0, int lane) {
    const unsigned a0 = (unsigned)(size_t)base + (unsigned)((k0 + 8 * (lane >> 4) + ((lane >> 2) & 3)) * pitch + n0 * 2 + 8 * (lane & 3)), a1 = a0 + 4u * (unsigned)pitch;
    u32x2 lo, hi; asm volatile("ds_read_b64_tr_b16 %0, %2\n\tds_read_b64_tr_b16 %1, %3\n\ts_waitcnt lgkmcnt(0)" : "=&v"(lo), "=&v"(hi) : "v"(a0), "v"(a1) : "memory");
    const u32x4 v = {lo.x, lo.y, hi.x, hi.y}; return __builtin_bit_cast(bf16x8, v);
}
}
#define LD8G(dst, p) float dst[8]; { const f32x4 x0_ = *(const GAS f32x4*)(p), x1_ = *(const GAS f32x4*)((p) + 4); dst[0] = x0_[0]; dst[1] = x0_[1]; dst[2] = x0_[2]; dst[3] = x0_[3]; dst[4] = x1_[0]; dst[5] = x1_[1]; dst[6] = x1_[2]; dst[7] = x1_[3]; }
__device__ __forceinline__ bf16x8 pack_acc(f32x4 a, f32x4 b) { const u32x4 v = {cvt_pk_bf16(a[0], a[1]), cvt_pk_bf16(a[2], a[3]), cvt_pk_bf16(b[0], b[1]), cvt_pk_bf16(b[2], b[3])}; return __builtin_bit_cast(bf16x8, v); }
struct TrF { u32x2 lo, hi; };
__device__ __forceinline__ void tr_issue(TrF& f, const LAS unsigned char* base, int pitch, int k0, int n0, int step, int lane) {
    const unsigned a0 = (unsigned)(size_t)base + (unsigned)((k0 + step * (lane >> 4) + ((lane >> 2) & 3)) * pitch + n0 * 2 + 8 * (lane & 3)), a1 = a0 + (unsigned)((step == 8 ? 4 : 16) * pitch);
    asm volatile("ds_read_b64_tr_b16 %0, %2\n\tds_read_b64_tr_b16 %1, %3" : "=&v"(f.lo), "=&v"(f.hi) : "v"(a0), "v"(a1) : "memory");
}
__device__ __forceinline__ bf16x8 tr_get(const TrF& f) { const u32x4 v = {f.lo.x, f.lo.y, f.hi.x, f.hi.y}; return __builtin_bit_cast(bf16x8, v); }
#define TR_WAIT4(a, b, c, d) asm volatile("s_waitcnt lgkmcnt(0)" : "+v"(a.lo), "+v"(a.hi), "+v"(b.lo), "+v"(b.hi), "+v"(c.lo), "+v"(c.hi), "+v"(d.lo), "+v"(d.hi) :: "memory")
#define TR_WAIT5(a, b, c, d, e) asm volatile("s_waitcnt lgkmcnt(0)" : "+v"(a.lo), "+v"(a.hi), "+v"(b.lo), "+v"(b.hi), "+v"(c.lo), "+v"(c.hi), "+v"(d.lo), "+v"(d.hi), "+v"(e.lo), "+v"(e.hi) :: "memory")
__device__ __forceinline__ void ck_fetch(u32x4 (&PR)[24], const bf16_t* U, const bf16_t* WAw, const bf16_t* WAa, const float* GC, const unsigned char* CKX, int b, int h, int q, int c, int lane) {
    c = c < ck::NCH ? c : ck::NCH - 1;
    const int o = lane & 7, ti = lane >> 3, ch = h * 64 + 8 * o; const int p0 = c == 0 ? 0 : NMETA + 32 * (c - 1), nreal = c == 0 ? NMETA : 32;
#pragma unroll
    for (int p = 0; p < 4; ++p) { const int t = 8 * p + ti; const size_t row = (size_t)row_of(b, p0 + (t < nreal ? t : 0));
        PR[p] = *(const GAS u32x4*)(WAw + row * AW + ch); PR[4 + p] = *(const GAS u32x4*)(WAa + row * AW + ch);
        PR[8 + p] = *(const GAS u32x4*)(U + row * NABC + ch); PR[12 + p] = *(const GAS u32x4*)(U + row * NABC + 512 + ch); }
    { const int t = lane >> 1; PR[16] = *(const GAS u32x4*)(U + (size_t)row_of(b, p0 + (t < nreal ? t : 0)) * NABC + 1024 + h * 64 + 16 * q + 8 * (lane & 1)); }
    const unsigned char* gx = CKX + (size_t)p2_unit(b, h, c) * p2::G_SZ;
    PR[17] = (u32x4){0u, 0u, 0u, 0u}; PR[18] = PR[17];
    PR[19] = *(const GAS u32x4*)(gx + p2::G_MRB + lane * 32); PR[20] = *(const GAS u32x4*)(gx + p2::G_MRB + lane * 32 + 16);
    { const u32x2 x0 = *(const GAS u32x2*)(gx + p2::G_XA + ((q * 2 + 0) * 64 + lane) * 8), x1 = *(const GAS u32x2*)(gx + p2::G_XA + ((q * 2 + 1) * 64 + lane) * 8);
      const u32x2 f0 = *(const GAS u32x2*)(gx + p2::G_FA + ((q * 2 + 0) * 64 + lane) * 8), f1 = *(const GAS u32x2*)(gx + p2::G_FA + ((q * 2 + 1) * 64 + lane) * 8);
      PR[21] = (u32x4){x0.x, x0.y, x1.x, x1.y}; PR[22] = (u32x4){f0.x, f0.y, f1.x, f1.y}; }
    PR[23] = *(const GAS u32x4*)(GC + ((size_t)((c == 0 ? 0 : b) * 8 + h) * 257 + c) * 64 + 4 * (lane & 15));
}
__device__ __forceinline__ void ck_put(LAS unsigned char* pb, const u32x4 (&PR)[24], int c, int lane) {
    using namespace ck;
    const int o = lane & 7, ti = lane >> 3; const int nreal = c == 0 ? NMETA : 32; const u32x4 z4 = {0u, 0u, 0u, 0u};
    const int o4 = o & 3, gl = (4 * (o4 & 1) + (o4 >> 1)) * 8 + (o >> 2) * 64;
#pragma unroll
    for (int p = 0; p < 4; ++p) { const int t = 8 * p + ti; const bool real = t < nreal; const u32x4 xa = real ? PR[p] : z4, xr = real ? PR[8 + p] : z4;
        *(LAS u32x2*)(pb + O_AT + t * 128 + gl) = (u32x2){xa.x, xa.y}; *(LAS u32x2*)(pb + O_AT + t * 128 + gl + 16) = (u32x2){xa.z, xa.w};
        *(LAS u32x2*)(pb + O_RT + t * 128 + gl) = (u32x2){xr.x, xr.y}; *(LAS u32x2*)(pb + O_RT + t * 128 + gl + 16) = (u32x2){xr.z, xr.w};
        *(LAS u32x4*)(pb + O_BT + (t * BK_LD + 8 * o) * 2) = real ? PR[4 + p] : z4; *(LAS u32x4*)(pb + O_KT + (t * BK_LD + 8 * o) * 2) = real ? PR[12 + p] : z4; }
    *(LAS u32x4*)(pb + O_VV + lane * 16) = (lane >> 1) < nreal ? PR[16] : z4;
    { const int trow = lane >> 1, hf = lane & 1;
#pragma unroll
      for (int e = 0; e < 2; ++e) { const int o5 = 2 * hf + e, g5 = (4 * (o5 & 1) + (o5 >> 1)) * 8; const u32x4 xm = PR[19 + e];
          *(LAS u32x2*)(pb + O_MRB + trow * 64 + g5) = (u32x2){xm.x, xm.y}; *(LAS u32x2*)(pb + O_MRB + trow * 64 + g5 + 16) = (u32x2){xm.z, xm.w}; } }
    { const u32x4 x = PR[21], f = PR[22];
      *(LAS u32x4*)(pb + O_XA + lane * 16) = (u32x4){x.x << 16, x.x & 0xffff0000u, x.y << 16, x.y & 0xffff0000u}; *(LAS u32x4*)(pb + O_XA + (64 + lane) * 16) = (u32x4){x.z << 16, x.z & 0xffff0000u, x.w << 16, x.w & 0xffff0000u};
      *(LAS u32x4*)(pb + O_FA + lane * 16) = (u32x4){f.x << 16, f.x & 0xffff0000u, f.y << 16, f.y & 0xffff0000u}; *(LAS u32x4*)(pb + O_FA + (64 + lane) * 16) = (u32x4){f.z << 16, f.z & 0xffff0000u, f.w << 16, f.w & 0xffff0000u}; }
    if (lane < 16) *(LAS u32x4*)(pb + O_GV + lane * 16) = PR[23];
}
__device__ __forceinline__ void phase_scan_chunked(Frame& F, int l) {
    PHASE_ENTER(F);
    using namespace ck;
    const bf16_t* U = F.R1; const bf16_t* WAw = F.R2; const bf16_t* WAa = F.R2 + (size_t)NROWS * AW; bf16_t* Y = F.R3;
    const float* GC = (const float*)(F.ws + WS_GC); const unsigned char* CKX = (const unsigned char*)lds_ptr(F.lds, 36);
    const int lane = F.lane, wave = F.wave, fr = lane & 15, fq = lane >> 4;
    LAS unsigned char* cb = F.lds + C_BASE; volatile LAS unsigned* flags = (volatile LAS unsigned*)(cb + O_FLAG);
    for (int u0 = F.bid; u0 < NB * 8 * 4; u0 += F.G) {
        const int unit = F.G == 256 ? (u0 & 7) * 32 + (u0 >> 3) : u0;
        const int b = unit >> 5, h = (unit >> 2) & 7, q = unit & 3;
        __syncthreads();
        if (F.tid < 16) flags[F.tid] = 0u;
        for (int i = F.tid; i < 1024; i += 512) ((LAS unsigned*)(cb + O_ST))[i] = 0u;
        __syncthreads();
        if (wave >= 1 && wave <= NSLOT) {
            const int sl = wave - 1; LAS unsigned char* pb = F.lds + sl * PSZ;
            unsigned n = 0; u32x4 PR[24]; ck_fetch(PR, U, WAw, WAa, GC, CKX, b, h, q, sl, lane);
            for (int c = sl; c < NCH; c += NSLOT, ++n) {
                lds_spin(flags + 4 + sl, n);
                asm volatile("" ::: "memory");
                ck_put(pb, PR, c, lane);
                ck_fetch(PR, U, WAw, WAa, GC, CKX, b, h, q, c + NSLOT, lane);
                asm volatile("s_waitcnt lgkmcnt(0)" ::: "memory");
                if (lane == 0) flags[sl] = n + 1;
            }
        } else if (wave == 0) {
            f32x4 accS[4];
#pragma unroll
            for (int kt = 0; kt < 4; ++kt) accS[kt] = (f32x4){0.f, 0.f, 0.f, 0.f};
            for (int c = 0; c < NCH; ++c) {
                const int s = c & (NSLOT - 1); const unsigned n = (unsigned)(c >> 2);
                const LAS unsigned char* sb = F.lds + s * PSZ;
                lds_spin(flags + s, n + 1);
                asm volatile("" ::: "memory");
                f32x4 u0 = *(const LAS f32x4*)(sb + O_XA + lane * 16), u1 = *(const LAS f32x4*)(sb + O_XA + (64 + lane) * 16);
                const bf16x8 a00 = frag(sb + O_AT, 64, 0, 0, lane), a01 = frag(sb + O_AT, 64, 0, 32, lane), a10 = frag(sb + O_AT, 64, 16, 0, lane), a11 = frag(sb + O_AT, 64, 16, 32, lane);
                const bf16x8 pA = pack_acc(accS[0], accS[1]), pB = pack_acc(accS[2], accS[3]);
                asm volatile("" ::: "memory");
                f32x4 y0 = *(const LAS f32x4*)(sb + O_FA + lane * 16), y1 = *(const LAS f32x4*)(sb + O_FA + (64 + lane) * 16);
                const bf16x8 r00 = frag(sb + O_RT, 64, 0, 0, lane), r01 = frag(sb + O_RT, 64, 0, 32, lane), r10 = frag(sb + O_RT, 64, 16, 0, lane), r11 = frag(sb + O_RT, 64, 16, 32, lane);
                const bf16x8 m0 = frag(sb + O_MRB, 32, 0, 0, lane), m1 = frag(sb + O_MRB, 32, 16, 0, lane);
                f32x4 g[4];
#pragma unroll
                for (int kt = 0; kt < 4; ++kt) g[kt] = *(const LAS f32x4*)(sb + O_GV + (16 * kt + 4 * fq) * 4);
                u0 = mma(a00, pA, u0); u1 = mma(a10, pA, u1); u0 = mma(a01, pB, u0); u1 = mma(a11, pB, u1);
                y0 = mma(pA, r00, y0); y1 = mma(pA, r10, y1); y0 = mma(pB, r01, y0); y1 = mma(pB, r11, y1);
                TrF fv, fk[4], fb[4];
                tr_issue(fv, sb + O_VV, 32, 0, 0, 8, lane);
#pragma unroll
                for (int kt = 0; kt < 4; ++kt) tr_issue(fk[kt], sb + O_KT, 2 * BK_LD, 0, 16 * kt, 8, lane);
                const f32x4 w0 = u0, w1 = u1;
                TR_WAIT5(fv, fk[0], fk[1], fk[2], fk[3]);
#pragma unroll
                for (int kt = 0; kt < 4; ++kt) tr_issue(fb[kt], sb + O_BT, 2 * BK_LD, 0, 16 * kt, 4, lane);
                { const bf16x8 fvv = tr_get(fv);
#pragma unroll
                  for (int kt = 0; kt < 4; ++kt) accS[kt] = mma(tr_get(fk[kt]), fvv, accS[kt]); }
                const bf16x8 pW = pack_acc(w0, w1);
                y0 = mma(pW, m0, y0); y1 = mma(pW, m1, y1);
                TR_WAIT4(fb[0], fb[1], fb[2], fb[3]);
                if (lane == 0) flags[4 + s] = n + 1;
#pragma unroll
                for (int kt = 0; kt < 4; ++kt) { accS[kt] = mma(tr_get(fb[kt]), pW, accS[kt]); accS[kt] = accS[kt] * g[kt]; }
                { const int nreal = c == 0 ? NMETA : 32, p0 = c == 0 ? 0 : NMETA + 32 * (c - 1);
                  if (fr < nreal && (b == 0 || c > 0)) *(u32x2*)(Y + (size_t)row_of(b, p0 + fr) * NY + h * 64 + 16 * q + 4 * fq) = (u32x2){cvt_pk_bf16(y0[0], y0[1]), cvt_pk_bf16(y0[2], y0[3])};
                  if (16 + fr < nreal && (b == 0 || c > 0)) *(u32x2*)(Y + (size_t)row_of(b, p0 + 16 + fr) * NY + h * 64 + 16 * q + 4 * fq) = (u32x2){cvt_pk_bf16(y1[0], y1[1]), cvt_pk_bf16(y1[2], y1[3])}; }
            }
        }
    }
    __syncthreads();
}

template <int WIN> __device__ __forceinline__ void pool_group(const bf16_t* U, bf16_t* Y, const bf16_t* pwt, const float* csc, int b, int pbase, int g, int lane) {
    const int fr = lane & 15, fq = lane >> 4, p = pbase + fr, row = row_of(b, p), cnt = (p + 1) < WIN ? (p + 1) : WIN;
    const float inv = 1.0f / (float)cnt;
    int rows[WIN];
#pragma unroll
    for (int i = 0; i < WIN; ++i) rows[i] = row_of(b, p - i > 0 ? p - i : 0);
    bf16x8 af[4];
#pragma unroll
    for (int ks = 0; ks < 4; ++ks) {
        const int col = AIN + 1024 + g * 128 + 32 * ks + 8 * fq;
        float sum[8], z0[8];
        constexpr int NB8 = WIN < 8 ? WIN : 8;
#pragma unroll
        for (int i0 = 0; i0 < WIN; i0 += NB8) {
            u32x4 raw[NB8];
#pragma unroll
            for (int i = 0; i < NB8; ++i) raw[i] = *(const u32x4*)(U + (size_t)rows[i0 + i] * NABC + col);
#pragma unroll
            for (int i = 0; i < NB8; ++i) { float zz[8]; unpack8(raw[i], zz);
                if (i0 + i == 0) {
#pragma unroll
                    for (int j = 0; j < 8; ++j) { z0[j] = zz[j]; sum[j] = zz[j]; } }
                else { const float m = (i0 + i) < cnt ? 1.0f : 0.0f;
#pragma unroll
                    for (int j = 0; j < 8; ++j) sum[j] += m * zz[j]; } }
        }
#pragma unroll
        for (int j = 0; j < 8; ++j) sum[j] = sum[j] * inv - z0[j];
        const u32x4 pk = pack8(sum); af[ks] = __builtin_bit_cast(bf16x8, pk);
    }
    const bf16_t* bw = pwt + (size_t)g * 128 * 128;
#pragma unroll 2
    for (int ctile = 0; ctile < 8; ++ctile) {
        f32x4 acc = (f32x4){0.f, 0.f, 0.f, 0.f};
#pragma unroll
        for (int ks = 0; ks < 4; ++ks) acc = __builtin_amdgcn_mfma_f32_16x16x32_bf16(*(const bf16x8*)(bw + (size_t)(16 * ctile + fr) * 128 + 32 * ks + 8 * fq), af[ks], acc, 0, 0, 0);
        const int c = g * 128 + 16 * ctile + 4 * fq; const f32x4 sc = *(const f32x4*)(csc + c);
        u32x2 o; o.x = cvt_pk_bf16(acc[0] * sc[0], acc[1] * sc[1]); o.y = cvt_pk_bf16(acc[2] * sc[2], acc[3] * sc[3]);
        *(u32x2*)(Y + (size_t)row * NY + 2 * AW + c) = o;
    }
}
constexpr int PB_CW = 0, PB_CT = 31 * 512 * 4, PB_NUNIT = NREAL / 32 + 1;
#ifndef PB_REP
#define PB_REP 0
#endif
__device__ __forceinline__ void pb_unit(int u, int& b, int& p0, int& ntok) { const bool meta = (u == PB_NUNIT - 1); b = meta ? 0 : (u >> 8); p0 = meta ? 0 : NMETA + 32 * (u & 255); ntok = meta ? NMETA : 32; }
template <bool DRY> __device__ __forceinline__ void postbc_a(Frame& F, int l) {
    PHASE_ENTER(F);
    const bf16_t* U = F.R1; const float* BS = (const float*)(F.ws + WS_BS); bf16_t* Y = F.R3;
    const int lane = F.lane, wave = F.wave, c8 = 8 * lane;
    float lxw[8], lxb[8];
#pragma unroll
    for (int j = 0; j < 8; ++j) { lxw[j] = in_ptr(F, I_LNXW)[l * AW + c8 + j]; lxb[j] = in_ptr(F, I_LNXB)[l * AW + c8 + j]; }
    for (int u = F.bid; u < PB_NUNIT; u += F.G) {
        int b, p0, ntok; pb_unit(u, b, p0, ntok);
        for (int tt = wave; tt < ntok; tt += 8) {
            const int p = p0 + tt, row = row_of(b, p);
            float y[8], zv[8], gv[8];
            unpack8(*(const u32x4*)(Y + (size_t)row * NY + c8), y); unpack8(*(const u32x4*)(Y + (size_t)row * NY + AW + c8), gv);
            unpack8(*(const u32x4*)(U + (size_t)row * NABC + 1024 + c8), zv);
            const float bs = BS[(size_t)row * 8 + (lane >> 3)];
            float s = 0.f;
#pragma unroll
            for (int j = 0; j < 8; ++j) s += y[j];
            s = allreduce8(s);
            const float mean = s * (1.0f / 64.0f); float qv = 0.f;
#pragma unroll
            for (int j = 0; j < 8; ++j) { y[j] -= mean; qv += y[j] * y[j]; }
            qv = allreduce8(qv);
            const float rstd = __builtin_amdgcn_rsqf(qv * (1.0f / 64.0f) + LNX_EPS);
            float o[8];
#pragma unroll
            for (int j = 0; j < 8; ++j) o[j] = (y[j] * rstd * lxw[j] + lxb[j] + bs * zv[j]) * gv[j];
            if (DRY) *(u32x4*)((bf16_t*)(F.ws + 962 * MiB) + (size_t)(row & 32767) * AW + c8) = pack8(o); else *(u32x4*)(Y + (size_t)row * NY + c8) = pack8(o);
        }
    }
}
__device__ __forceinline__ void postbc_b(Frame& F, int l) {
    PHASE_ENTER(F);
    const bf16_t* U = F.R1; bf16_t* Y = F.R3;
    LAS float* cw = (LAS float*)(F.lds + PB_CW); LAS bf16_t* ct = (LAS bf16_t*)(F.lds + PB_CT);
    const int lane = F.lane, wave = F.wave, c8 = 8 * lane;
    __syncthreads();
    for (int i = F.tid; i < 31 * 512; i += 512) cw[i] = in_ptr(F, I_CONVW)[(size_t)l * 31 * 512 + i];
    float cvb[8], lng[8], lnb[8];
#pragma unroll
    for (int j = 0; j < 8; ++j) { cvb[j] = in_ptr(F, I_CONVB)[l * AW + c8 + j]; lng[j] = in_ptr(F, I_BLNG)[l * AW + c8 + j]; lnb[j] = in_ptr(F, I_BLNB)[l * AW + c8 + j]; }
    for (int u = F.bid; u < PB_NUNIT; u += F.G) {
        int b, p0, ntok; pb_unit(u, b, p0, ntok);
        __syncthreads();
        {
            u32x4 r1[8], r2[8];
#pragma unroll
            for (int it = 0; it < 8; ++it) { const int idx = F.tid + it * 512, i = idx >> 6, oc = idx & 63, p = p0 - 30 + i; const int row = row_of(b, p > 0 ? p : 0);
                r1[it] = *(const u32x4*)(U + (size_t)row * NABC + AIN + 8 * oc); r2[it] = *(const u32x4*)(U + (size_t)row * NABC + AIN + 512 + 8 * oc); }
#pragma unroll
            for (int it = 0; it < 8; ++it) { const int idx = F.tid + it * 512, i = idx >> 6, oc = idx & 63, p = p0 - 30 + i;
                if (i < 30 + ntok) { float z1[8], z2[8]; unpack8(r1[it], z1); unpack8(r2[it], z2); const float m = p >= 0 ? 1.0f : 0.0f;
#pragma unroll
                    for (int j = 0; j < 8; ++j) z1[j] *= m * fast_sigmoid(z2[j]);
                    *(LAS u32x4*)(ct + i * 512 + 8 * oc) = pack8(z1); } }
        }
        __syncthreads();
        const int TPW = ntok / 8, t0w = wave * TPW;
        {
            f32x2 acc2[4][4];
#pragma unroll
            for (int i = 0; i < 4; ++i)
#pragma unroll
                for (int jj = 0; jj < 4; ++jj) acc2[i][jj] = (f32x2){cvb[2 * jj], cvb[2 * jj + 1]};
            f32x2 win2[4][4];
#define PB_ROW(SLOT, R) do { float t_[8]; unpack8(*(const LAS u32x4*)(ct + (R) * 512 + c8), t_); _Pragma("unroll") for (int jj = 0; jj < 4; ++jj) win2[SLOT][jj] = (f32x2){t_[2 * jj], t_[2 * jj + 1]}; } while (0)
#define PB_TAP(JT, K) do { PB_ROW(((K) + 3) & 3, t0w + (JT) + 3);         \
                const f32x4 w0 = *(const LAS f32x4*)(cw + (JT) * 512 + c8), w1 = *(const LAS f32x4*)(cw + (JT) * 512 + c8 + 4); const f32x2 wq[4] = {{w0[0], w0[1]}, {w0[2], w0[3]}, {w1[0], w1[1]}, {w1[2], w1[3]}}; \
                _Pragma("unroll") for (int i = 0; i < 4; ++i) _Pragma("unroll") for (int jj = 0; jj < 4; ++jj) acc2[i][jj] = win2[((K) + i) & 3][jj] * wq[jj] + acc2[i][jj]; } while (0)
            PB_ROW(0, t0w); PB_ROW(1, t0w + 1); PB_ROW(2, t0w + 2);
#pragma unroll 1
            for (int jb = 0; jb < 28; jb += 4) { PB_TAP(jb, 0); PB_TAP(jb + 1, 1); PB_TAP(jb + 2, 2); PB_TAP(jb + 3, 3); }
            PB_TAP(28, 0); PB_TAP(29, 1); PB_TAP(30, 2);
#undef PB_TAP
#undef PB_ROW
            float acc[4][8];
#pragma unroll
            for (int i = 0; i < 4; ++i)
#pragma unroll
                for (int jj = 0; jj < 4; ++jj) { acc[i][2 * jj] = acc2[i][jj].x; acc[i][2 * jj + 1] = acc2[i][jj].y; }
#pragma unroll
            for (int i = 0; i < 4; ++i) {
                if (i < TPW) {
                    const int row = row_of(b, p0 + t0w + i);
                    float s = 0.f;
#pragma unroll
                    for (int j = 0; j < 8; ++j) s += acc[i][j];
                    const float mean = wave_sum(s) * (1.0f / 512.0f); float qv = 0.f;
#pragma unroll
                    for (int j = 0; j < 8; ++j) { acc[i][j] -= mean; qv += acc[i][j] * acc[i][j]; }
                    const float rstd = __builtin_amdgcn_rsqf(wave_sum(qv) * (1.0f / 512.0f) + LN_EPS);
                    float o[8];
#pragma unroll
                    for (int j = 0; j < 8; ++j) { const float x = acc[i][j] * rstd * lng[j] + lnb[j]; o[j] = x * fast_sigmoid(x); }
                    *(u32x4*)(Y + (size_t)row * NY + AW + c8) = pack8(o);
                }
            }
        }
    }
    __syncthreads();
}
__device__ __forceinline__ void postbc_c(Frame& F, int l) {
    PHASE_ENTER(F);
    const bf16_t* U = F.R1; bf16_t* Y = F.R3; const bf16_t* pwt = F.W + (size_t)l * WL_SIZE + WL_PW; const float* csc = in_ptr(F, I_CSCALE) + l * AW;
    const int lane = F.lane, rg = F.wave & 1, g = F.wave >> 1, fr = lane & 15, fq = lane >> 4;
    LAS unsigned char* tile = F.lds;
    for (int u = F.bid; u < PB_NUNIT; u += F.G) {
        int b, p0, ntok; pb_unit(u, b, p0, ntok);
        __syncthreads();
        {
            u32x4 rr[6];
#pragma unroll
            for (int it = 0; it < 6; ++it) { const int idx = F.tid + it * 512, i = idx >> 6, oc = idx & 63, p = p0 - 15 + i; const int row = row_of(b, p > 0 ? (p < NMETA + SEQ ? p : 0) : 0);
                rr[it] = *(const GAS u32x4*)(U + (size_t)row * NABC + AIN + 1024 + 8 * oc); }
#pragma unroll
            for (int it = 0; it < 6; ++it) { const int idx = F.tid + it * 512, i = idx >> 6, oc = idx & 63, p = p0 - 15 + i;
                if (i < 15 + ntok) *(LAS u32x4*)(tile + (i * 512 + 8 * oc) * 2) = p >= 0 ? rr[it] : (u32x4){0u, 0u, 0u, 0u}; }
        }
        __syncthreads();
        if (rg * 16 < ntok) {
            const int win = 2 << g, t = rg * 16 + fr, p = p0 + t, cnt = (p + 1) < win ? (p + 1) : win; const float inv = 1.0f / (float)cnt;
            const bf16_t* bwp = pwt + (size_t)g * 128 * 128 + (size_t)fr * 128 + 8 * fq;
            bf16x8 bfr[4][4];
#pragma unroll
            for (int ctile = 0; ctile < 4; ++ctile)
#pragma unroll
                for (int ks = 0; ks < 4; ++ks) bfr[ctile][ks] = *(const GAS bf16x8*)(bwp + (size_t)(16 * ctile) * 128 + 32 * ks);
            bf16x8 af[4];
#pragma unroll
            for (int ks = 0; ks < 4; ++ks) {
                const LAS unsigned char* cp = tile + ((15 + t) * 512 + g * 128 + 32 * ks + 8 * fq) * 2;
                float z0[8], sum[8]; unpack8(*(const LAS u32x4*)cp, z0);
#pragma unroll
                for (int j = 0; j < 8; ++j) sum[j] = z0[j];
#pragma unroll 1
                for (int i = 1; i < win; ++i) { float zz[8]; unpack8(*(const LAS u32x4*)(cp - i * 1024), zz);
#pragma unroll
                    for (int j = 0; j < 8; ++j) sum[j] += zz[j]; }
#pragma unroll
                for (int j = 0; j < 8; ++j) sum[j] = sum[j] * inv - z0[j];
                const u32x4 pk = pack8(sum); af[ks] = __builtin_bit_cast(bf16x8, pk);
            }
            const int row = row_of(b, p);
#pragma unroll
            for (int half = 0; half < 2; ++half) {
                if (half == 1) {
#pragma unroll
                    for (int ctile = 0; ctile < 4; ++ctile)
#pragma unroll
                        for (int ks = 0; ks < 4; ++ks) bfr[ctile][ks] = *(const GAS bf16x8*)(bwp + (size_t)(16 * (4 + ctile)) * 128 + 32 * ks);
                }
#pragma unroll
                for (int ct4 = 0; ct4 < 4; ++ct4) {
                    const int ctile = 4 * half + ct4;
                    f32x4 acc = (f32x4){0.f, 0.f, 0.f, 0.f};
#pragma unroll
                    for (int ks = 0; ks < 4; ++ks) acc = __builtin_amdgcn_mfma_f32_16x16x32_bf16(bfr[ct4][ks], af[ks], acc, 0, 0, 0);
                    const int c = g * 128 + 16 * ctile + 4 * fq; const f32x4 sc = *(const GAS f32x4*)(csc + c);
                    u32x2 o; o.x = cvt_pk_bf16(acc[0] * sc[0], acc[1] * sc[1]); o.y = cvt_pk_bf16(acc[2] * sc[2], acc[3] * sc[3]);
                    *(u32x2*)(Y + (size_t)row * NY + 2 * AW + c) = o;
                }
            }
        }
    }
    __syncthreads();
}
__device__ __forceinline__ void phase_postbc(Frame& F, int l) {
    if (PB_REP & 4) postbc_a<true>(F, l); postbc_a<false>(F, l); postbc_b(F, l); if (PB_REP & 1) postbc_b(F, l); postbc_c(F, l); if (PB_REP & 2) postbc_c(F, l);
}

__device__ __forceinline__ void phase_prep2(Frame& F, int l) {
    PHASE_ENTER(F);
    using namespace p2; using ck::frag; using ck::frag16; using ck::frag_tr; using ck::mma;
    bf16_t* U = F.R1; bf16_t* WAw = F.R2; bf16_t* WAa = F.R2 + (size_t)NROWS * AW;
    const bf16_t* HALO = (const bf16_t*)(F.ws + WS_HALO); float* GC = (float*)(F.ws + WS_GC); float* BS = (float*)(F.ws + WS_BS);
    const float* mu = in_ptr(F, I_MU) + l * AIN; const float* kkp = in_ptr(F, I_KK) + l * AW; const float* kap = in_ptr(F, I_KA) + l * AW; const float* rkp = in_ptr(F, I_RK) + l * AW;
    const int lane = F.lane, o = lane & 7, ti = lane >> 3;
    if (F.wave < NW) {
    LAS unsigned char* pb = F.lds + F.wave * SZ; LAS float* cwb = (LAS float*)(pb + X_AAB);
    for (int un = F.bid * NW + F.wave; un < P2_UNITS; un += F.G * NW) {
        const int h = un & 7; const int b = un < 16384 ? (un >> 3) & 7 : 0, c = un < 16384 ? 256 - (un >> 6) : 0; const int uidx = p2_unit(b, h, c);
        const int ch = h * 64 + 8 * o, p0 = c == 0 ? 0 : NMETA + 32 * (c - 1), nreal = c == 0 ? NMETA : 32;
        const bool real = 4 * ti < nreal; const int row0 = row_of(b, p0 + (real ? 4 * ti : 0));
        u32x4 zr[5], zk[5], zv[5], ww[4], aa[4];
        { const bf16_t* prow = (real ? ti : 0) == 0 ? HALO + (size_t)(b * 256 + (c > 0 ? c - 1 : 0)) * 1536 : U + (size_t)(row0 - 1) * NABC;
          zr[0] = *(const GAS u32x4*)(prow + ch); zk[0] = *(const GAS u32x4*)(prow + 512 + ch); zv[0] = *(const GAS u32x4*)(prow + 1024 + ch); }
        { const bf16_t* ur = U + (size_t)row0 * NABC + ch; const bf16_t* wr = WAw + (size_t)row0 * AW + ch; const bf16_t* ar = WAa + (size_t)row0 * AW + ch;
#pragma unroll
          for (int p = 0; p < 4; ++p) { zr[p + 1] = *(const GAS u32x4*)(ur + p * NABC); zk[p + 1] = *(const GAS u32x4*)(ur + p * NABC + 512); zv[p + 1] = *(const GAS u32x4*)(ur + p * NABC + 1024);
              ww[p] = *(const GAS u32x4*)(wr + p * AW); aa[p] = *(const GAS u32x4*)(ar + p * AW); } }
        { const float msk = real ? 1.0f : 0.0f;
#pragma unroll
          for (int p = 0; p < 4; ++p) { float w8[8]; unpack8(ww[p], w8); LAS float* cw = cwb + (4 * ti + p) * 64 + 8 * o;
            *(LAS f32x4*)cw = (f32x4){msk * w8[0], msk * w8[1], msk * w8[2], msk * w8[3]}; *(LAS f32x4*)(cw + 4) = (f32x4){msk * w8[4], msk * w8[5], msk * w8[6], msk * w8[7]}; } }
        LDS_WAIT();
        { LAS float* cw = cwb + lane; float cv_[32];
#pragma unroll
          for (int i = 0; i < 32; ++i) cv_[i] = cw[i * 64];
          asm volatile("" ::: "memory");
#pragma unroll
          for (int i = 1; i < 32; ++i) cv_[i] += cv_[i - 1];
#pragma unroll
          for (int i = 0; i < 32; ++i) cw[i * 64] = cv_[i]; }
        LDS_WAIT();
        float cx[8];
        { const LAS float* cwp = cwb + (ti > 0 ? 4 * ti - 1 : 0) * 64 + 8 * o; const f32x4 x0 = *(const LAS f32x4*)cwp, x1 = *(const LAS f32x4*)(cwp + 4);
#pragma unroll
          for (int j = 0; j < 8; ++j) cx[j] = ti > 0 ? (j < 4 ? x0[j] : x1[j - 4]) : 0.f; }
        {
        LD8G(mur, mu + ch) LD8G(muk, mu + 512 + ch) LD8G(muv, mu + 1024 + ch) LD8G(kkc, kkp + ch) LD8G(kac, kap + ch) LD8G(rkc, rkp + ch)
        int row0s = row0; asm volatile("" : "+v"(row0s));
        bf16_t* ud = U + (size_t)row0s * NABC + ch; bf16_t* wd = WAw + (size_t)row0s * AW + ch; bf16_t* ad = WAa + (size_t)row0s * AW + ch;
        const float msk = real ? 1.0f : 0.0f;
#pragma unroll
        for (int p = 0; p < 4; ++p) {
            const float pm = (c == 0 && ti == 0 && p == 0) ? 0.0f : 1.0f; const int t = 4 * ti + p;
            float r8[8], rp8[8], k8[8], kp8[8], a8[8], v8[8], vp8[8];
            unpack8(zr[p + 1], r8); unpack8(zr[p], rp8); unpack8(zk[p + 1], k8); unpack8(zk[p], kp8); unpack8(aa[p], a8); unpack8(zv[p + 1], v8); unpack8(zv[p], vp8);
            float A[8], B[8], K[8], R[8], V[8], kx[8], kk[8], ss = 0.f, bsum = 0.f;
#pragma unroll
            for (int j = 0; j < 8; ++j) { R[j] = msk * (r8[j] + (pm * rp8[j] - r8[j]) * mur[j]); kx[j] = k8[j] + (pm * kp8[j] - k8[j]) * muk[j]; kk[j] = kx[j] * kkc[j]; ss += kk[j] * kk[j]; V[j] = msk * (v8[j] + (pm * vp8[j] - v8[j]) * muv[j]); }
            ss = allreduce8(ss);
            const float inv = msk / fmaxf(sqrtf(ss), 1e-12f);
#pragma unroll
            for (int j = 0; j < 8; ++j) { const float kn = kk[j] * inv; A[j] = -kn; B[j] = kn * a8[j]; K[j] = msk * kx[j] * (1.0f + (a8[j] - 1.0f) * kac[j]); bsum += R[j] * K[j] * rkc[j]; }
            bsum = allreduce8(bsum);
            const LAS float* cw = cwb + t * 64 + 8 * o; const f32x4 c0 = *(const LAS f32x4*)cw, c1 = *(const LAS f32x4*)(cw + 4);
            float at[8], rt[8], bt[8], kt[8], en[8];
#pragma unroll
            for (int j = 0; j < 8; ++j) { const float ci = j < 4 ? c0[j] : c1[j - 4]; const float ep = __expf(ci); en[j] = __builtin_amdgcn_rcpf(ep);
                at[j] = A[j] * __expf(-cx[j]); rt[j] = R[j] * en[j]; bt[j] = B[j] * ep; kt[j] = K[j] * ep; cx[j] = ci; }
            const u32x4 pa = pack8(at), pr = pack8(rt), pbv = pack8(bt), pk = pack8(kt), pv = pack8(V);
            *(LAS u32x4*)(pb + X_AT + (t * 64 + 8 * o) * 2) = pa; *(LAS u32x4*)(pb + X_RT + (t * 64 + 8 * o) * 2) = pr; *(LAS u32x4*)(pb + X_BT + (t * 64 + 8 * o) * 2) = pbv;
            *(LAS u32x4*)(pb + X_KT + (t * 64 + 8 * o) * 2) = pk; *(LAS u32x4*)(pb + X_VT + (t * 64 + 8 * o) * 2) = pv;
            if (real) {
                *(u32x4*)(ad + p * AW) = pbv; *(u32x4*)(ud + p * NABC) = pr; *(u32x4*)(ud + p * NABC + 512) = pk; *(u32x4*)(ud + p * NABC + 1024) = pv;
                if (o == 0) BS[(size_t)(row0s + p) * 8 + h] = bsum;
            }
            if (p == 3 && ti == 7) { float* gv = GC + ((size_t)(b * 8 + h) * 257 + c) * 64 + 8 * o; *(f32x4*)gv = (f32x4){en[0], en[1], en[2], en[3]}; *(f32x4*)(gv + 4) = (f32x4){en[4], en[5], en[6], en[7]}; }
        }
        }
        LDS_WAIT();
        int ln; asm volatile("v_mbcnt_lo_u32_b32 %0, -1, 0\n\tv_mbcnt_hi_u32_b32 %0, -1, %0" : "=v"(ln)); const int fr = ln & 15, fq = ln >> 4;
        unsigned char* gx0 = (unsigned char*)lds_ptr(F.lds, 36) + (size_t)uidx * G_SZ; asm volatile("" : "+s"(gx0)); GAS unsigned char* gx = (GAS unsigned char*)gx0;
#pragma unroll
        for (int it = 0; it < 2; ++it)
#pragma unroll
            for (int jt = 0; jt < 2; ++jt) {
                f32x4 ab = {0.f, 0.f, 0.f, 0.f}, ak = ab, rb = ab, rk = ab;
                if (jt <= it) {
#pragma unroll
                    for (int s = 0; s < 2; ++s) { const bf16x8 fb = frag(pb + X_BT, 64, 16 * jt, 32 * s, ln), fk = frag(pb + X_KT, 64, 16 * jt, 32 * s, ln), fa = frag(pb + X_AT, 64, 16 * it, 32 * s, ln), frr = frag(pb + X_RT, 64, 16 * it, 32 * s, ln);
                        ab = mma(fb, fa, ab); ak = mma(fk, fa, ak); rb = mma(fb, frr, rb); rk = mma(fk, frr, rk); }
                }
                const int i = 16 * it + fr, j0 = 16 * jt + 4 * fq;
#pragma unroll
                for (int jj = 0; jj < 4; ++jj) { const bool st = (j0 + jj) < i, inc = (j0 + jj) <= i; ab[jj] = st ? ab[jj] : 0.f; ak[jj] = st ? ak[jj] : 0.f; rb[jj] = inc ? rb[jj] : 0.f; rk[jj] = inc ? rk[jj] : 0.f; }
                asm volatile("" : "+v"(ab), "+v"(ak), "+v"(rb), "+v"(rk));
                *(LAS f32x4*)(pb + X_AAB + (i * 32 + j0) * 4) = ab;
                *(LAS u32x2*)(pb + X_AAK + (i * 32 + j0) * 2) = (u32x2){cvt_pk_bf16(ak[0], ak[1]), cvt_pk_bf16(ak[2], ak[3])};
                *(LAS u32x2*)(pb + X_MRK + (i * 32 + j0) * 2) = (u32x2){cvt_pk_bf16(rk[0], rk[1]), cvt_pk_bf16(rk[2], rk[3])};
                *(u32x2*)(gx + G_MRB + (i * 32 + j0) * 2) = (u32x2){cvt_pk_bf16(rb[0], rb[1]), cvt_pk_bf16(rb[2], rb[3])};
            }
        LDS_WAIT();
        {
            const int blk = (ln >> 4) & 1, jc = ln & 15; float t[16];
            const LAS float* arow = (const LAS float*)(pb + X_AAB) + (16 * blk) * 32 + 16 * blk;
#pragma unroll
            for (int i = 0; i < 16; ++i) { float acc = (i == jc) ? 1.0f : 0.f;
#pragma unroll
                for (int m4 = 0; m4 < 4; ++m4) { if (4 * m4 < i) { const f32x4 a4 = *(const LAS f32x4*)(arow + i * 32 + 4 * m4);
#pragma unroll
                    for (int mm = 0; mm < 4; ++mm) if (4 * m4 + mm < i) acc += a4[mm] * t[4 * m4 + mm]; } }
                t[i] = acc; if ((i & 3) == 3) asm volatile("" ::: "memory"); }
            { const int ar = ln >> 2, ac = 4 * (ln & 3); const f32x4 a4 = *(const LAS f32x4*)(pb + X_AAB + ((16 + ar) * 32 + ac) * 4);
              asm volatile("" ::: "memory");
              *(LAS u32x2*)(pb + X_A21 + (ar * 16 + ac) * 2) = (u32x2){cvt_pk_bf16(a4[0], a4[1]), cvt_pk_bf16(a4[2], a4[3])}; }
            if (ln < 32) {
#pragma unroll
                for (int i = 0; i < 16; ++i) *(LAS unsigned short*)(pb + X_TT + ((16 * blk + i) * 32 + 16 * blk + jc) * 2) = f2bf(t[i]);
                if (blk == 0) {
#pragma unroll
                    for (int i = 0; i < 16; ++i) *(LAS unsigned short*)(pb + X_TT + (i * 32 + 16 + jc) * 2) = 0;
                    u32x4 lo, hi; lo.x = cvt_pk_bf16(t[0], t[1]); lo.y = cvt_pk_bf16(t[2], t[3]); lo.z = cvt_pk_bf16(t[4], t[5]); lo.w = cvt_pk_bf16(t[6], t[7]);
                    hi.x = cvt_pk_bf16(t[8], t[9]); hi.y = cvt_pk_bf16(t[10], t[11]); hi.z = cvt_pk_bf16(t[12], t[13]); hi.w = cvt_pk_bf16(t[14], t[15]);
                    *(LAS u32x4*)(pb + X_TC11 + jc * 32) = lo; *(LAS u32x4*)(pb + X_TC11 + jc * 32 + 16) = hi;
                }
            }
            LDS_WAIT();
            { f32x4 z = {0.f, 0.f, 0.f, 0.f}; z = mma(frag16(pb + X_A21, 16, 0, ln), frag16(pb + X_TC11, 16, 0, ln), z);
              *(LAS u32x2*)(pb + X_Z1T + (fr * 16 + 4 * fq) * 2) = (u32x2){cvt_pk_bf16(z[0], z[1]), cvt_pk_bf16(z[2], z[3])}; }
            LDS_WAIT();
            { f32x4 d = {0.f, 0.f, 0.f, 0.f}; const bf16x8 zz = {0, 0, 0, 0, 0, 0, 0, 0};
              bf16x8 t22 = *(const LAS bf16x8*)(pb + X_TT + ((16 + fr) * 32 + 16 + 8 * (fq & 1)) * 2); t22 = fq < 2 ? t22 : zz;
              d = mma(frag16(pb + X_Z1T, 16, 0, ln), t22, d);
              *(LAS u32x2*)(pb + X_TT + ((16 + fr) * 32 + 4 * fq) * 2) = (u32x2){cvt_pk_bf16(d[0], d[1]), cvt_pk_bf16(d[2], d[3])}; }
            LDS_WAIT();
            {
                const bf16x8 ft0 = frag(pb + X_TT, 32, 0, 0, ln), ft1 = frag(pb + X_TT, 32, 16, 0, ln);
                TrF fa_[4], fk2_[2];
#pragma unroll
                for (int kt = 0; kt < 4; ++kt) tr_issue(fa_[kt], pb + X_AT, 128, 0, 16 * kt, 8, ln);
#pragma unroll
                for (int jt = 0; jt < 2; ++jt) tr_issue(fk2_[jt], pb + X_AAK, 64, 0, 16 * jt, 8, ln);
                asm volatile("s_waitcnt lgkmcnt(0)" : "+v"(fa_[0].lo), "+v"(fa_[0].hi), "+v"(fa_[1].lo), "+v"(fa_[1].hi), "+v"(fa_[2].lo), "+v"(fa_[2].hi), "+v"(fa_[3].lo), "+v"(fa_[3].hi),
                                                      "+v"(fk2_[0].lo), "+v"(fk2_[0].hi), "+v"(fk2_[1].lo), "+v"(fk2_[1].hi) :: "memory");
#pragma unroll
                for (int kt = 0; kt < 4; ++kt) { const bf16x8 fa = tr_get(fa_[kt]);
#pragma unroll
                    for (int it = 0; it < 2; ++it) { f32x4 d = {0.f, 0.f, 0.f, 0.f}; d = mma(fa, it == 0 ? ft0 : ft1, d);
                        const int ti_ = 16 * it + fr;
                        if (ti_ < nreal) *(u32x2*)(WAw + (size_t)row_of(b, p0 + ti_) * AW + h * 64 + 16 * kt + 4 * fq) = (u32x2){cvt_pk_bf16(d[0], d[1]), cvt_pk_bf16(d[2], d[3])}; } }
#pragma unroll
                for (int jt = 0; jt < 2; ++jt) { const bf16x8 fk_ = tr_get(fk2_[jt]);
#pragma unroll
                    for (int it = 0; it < 2; ++it) { f32x4 d = {0.f, 0.f, 0.f, 0.f}; d = mma(fk_, it == 0 ? ft0 : ft1, d);
                        *(LAS u32x2*)(pb + X_AAB + ((16 * it + fr) * 32 + 16 * jt + 4 * fq) * 2) = (u32x2){cvt_pk_bf16(d[0], d[1]), cvt_pk_bf16(d[2], d[3])}; } }
            }
            LDS_WAIT();
        }
#pragma unroll 1
        for (int vq = 0; vq < 4; ++vq) {
            const bf16x8 fvt = frag_tr(pb + X_VT, 128, 0, 16 * vq, ln);
#pragma unroll
            for (int tt2 = 0; tt2 < 2; ++tt2) {
                f32x4 x = {0.f, 0.f, 0.f, 0.f}, f = x;
                x = mma(frag(pb + X_AAB, 32, 16 * tt2, 0, ln), fvt, x);
                f = mma(fvt, frag(pb + X_MRK, 32, 16 * tt2, 0, ln), f);
                *(u32x2*)(gx + G_XA + ((vq * 2 + tt2) * 64 + ln) * 8) = (u32x2){cvt_pk_bf16(x[0], x[1]), cvt_pk_bf16(x[2], x[3])};
                *(u32x2*)(gx + G_FA + ((vq * 2 + tt2) * 64 + ln) * 8) = (u32x2){cvt_pk_bf16(f[0], f[1]), cvt_pk_bf16(f[2], f[3])};
            }
        }
        LDS_WAIT();
    }
    }
}

__device__ __forceinline__ void phase_router(Frame& F) {
    PHASE_ENTER(F);
    LAS int* hist = (LAS int*)(F.lds + 32768);
    const float* ss = F.SS + 3 * SS_STRIDE;
    u32x4* tokinfo = (u32x4*)(F.ws + RT_TOKINFO); int* slot_tok = (int*)(F.ws + RT_SLOTTOK); int* cnt = (int*)(F.ws + RT_CNT);
    const int lane = F.lane;
    f32x4 wr[16][2];
    { const float* RW = in_ptr(F, I_RW) + (size_t)(16 * lane) * NEXP; const float* fgp = in_ptr(F, I_FFNG) + DM + 16 * lane;
#pragma unroll
      for (int k = 0; k < 16; ++k) { const float gk = fgp[k]; wr[k][0] = *(const f32x4*)(RW + NEXP * k) * gk; wr[k][1] = *(const f32x4*)(RW + NEXP * k + 4) * gk; } }
    for (int blk = F.bid; blk < NREAL / 256; blk += F.G) {
        __syncthreads();
        if (F.tid < NEXP) hist[F.tid] = 0;
        for (int i = F.tid; i < MAXBLK; i += 512) { slot_tok[blk * MAXBLK + i] = -1; ((float*)(F.ws + RT_SLOTRS))[blk * MAXBLK + i] = 0.f; }
        __syncthreads();
        for (int t = F.wave; t < 256; t += 16) {
            const int tok0 = blk * 256 + t, tok1 = tok0 + 8;
            u32x4 raw[2][2];
            raw[0][0] = *(const u32x4*)(F.HB + (size_t)tok0 * DM + 16 * lane); raw[0][1] = *(const u32x4*)(F.HB + (size_t)tok0 * DM + 16 * lane + 8);
            raw[1][0] = *(const u32x4*)(F.HB + (size_t)tok1 * DM + 16 * lane); raw[1][1] = *(const u32x4*)(F.HB + (size_t)tok1 * DM + 16 * lane + 8);
            const float rs2[2] = {rstd_of(ss, tok0), rstd_of(ss, tok1)};
#pragma unroll
            for (int q = 0; q < 2; ++q) {
                const int tok = q == 0 ? tok0 : tok1;
                float hv[16]; unpack8(raw[q][0], *(float(*)[8])&hv[0]); unpack8(raw[q][1], *(float(*)[8])&hv[8]);
                float lg[8];
#pragma unroll
                for (int e = 0; e < 8; ++e) lg[e] = 0.f;
#pragma unroll
                for (int k = 0; k < 16; ++k) {
#pragma unroll
                    for (int e = 0; e < 4; ++e) { lg[e] += hv[k] * wr[k][0][e]; lg[4 + e] += hv[k] * wr[k][1][e]; } }
                const float rs = rs2[q];
#pragma unroll
                for (int e = 0; e < 8; ++e) lg[e] = wave_sum(lg[e]) * rs + in_ptr(F, I_RB)[e];
                int e1 = 0; float l1 = lg[0];
#pragma unroll
                for (int e = 1; e < 8; ++e) if (lg[e] > l1) { l1 = lg[e]; e1 = e; }
                int e2 = -1; float l2 = -3.0e38f;
#pragma unroll
                for (int e = 0; e < 8; ++e) if (e != e1 && lg[e] > l2) { l2 = lg[e]; e2 = e; }
                const float g2 = 1.0f / (1.0f + __expf(l1 - l2)), g1 = 1.0f - g2;
                if (lane == 0) { tokinfo[tok] = (u32x4){(unsigned)(e1 | (e2 << 8)), __float_as_uint(g1), __float_as_uint(g2), 0u}; __hip_atomic_fetch_add(&hist[e1], 1, __ATOMIC_RELAXED, __HIP_MEMORY_SCOPE_WORKGROUP); __hip_atomic_fetch_add(&hist[e2], 1, __ATOMIC_RELAXED, __HIP_MEMORY_SCOPE_WORKGROUP); }
            }
        }
        __syncthreads();
        if (F.tid < NEXP) cnt[blk * NEXP + F.tid] = hist[F.tid];
    }
    __syncthreads();
}
__device__ __forceinline__ void phase_assign(Frame& F) {
    PHASE_ENTER(F);
    LAS int* L = (LAS int*)F.lds;
    const u32x4* tokinfo = (const u32x4*)(F.ws + RT_TOKINFO); int* slot_tok = (int*)(F.ws + RT_SLOTTOK); const int* cnt = (const int*)(F.ws + RT_CNT);
    int* block_e = (int*)(F.ws + RT_CNT + 16384); int* nblkp = (int*)(F.ws + RT_CNT + 32768); int* tokslot = (int*)(F.ws + RT_TOKSLOT);
    for (int blk = F.bid; blk < NREAL / 256; blk += F.G) {
        __syncthreads();
        if (F.tid < 256) {
            const u32x4 c0 = *(const u32x4*)(cnt + F.tid * NEXP), c1 = *(const u32x4*)(cnt + F.tid * NEXP + 4); const unsigned cc[8] = {c0.x, c0.y, c0.z, c0.w, c1.x, c1.y, c1.z, c1.w};
            const float inf = F.tid < blk ? 1.0f : 0.0f;
#pragma unroll
            for (int e = 0; e < NEXP; ++e) { const float tt = wave_sum((float)cc[e]), pp = wave_sum(inf * (float)cc[e]); if (F.lane == 0) { L[64 + F.wave * 16 + e] = (int)tt; L[64 + F.wave * 16 + 8 + e] = (int)pp; } }
        }
        __syncthreads();
        if (F.tid < NEXP) { int tot = 0, pre = 0;
#pragma unroll
            for (int w = 0; w < 4; ++w) { tot += L[64 + w * 16 + F.tid]; pre += L[64 + w * 16 + 8 + F.tid]; } L[F.tid] = tot; L[8 + F.tid] = pre; }
        __syncthreads();
        if (F.tid == 0) { int start = 0; for (int e = 0; e < NEXP; ++e) { L[16 + e] = start; start += (L[e] + 255) & ~255; L[24 + e] = start; }
            if (blk == 0) *nblkp = start >> 8; }
        __syncthreads();
        if (blk == 0) { const int nb_ = L[24 + NEXP - 1] >> 8;
            for (int j = F.tid; j < nb_; j += 512) { int e = 0; while (e < NEXP - 1 && L[24 + e] <= j * 256) ++e; block_e[j] = e; } }
        int e1 = 0, e2 = 0, r1 = 0, r2 = 0; const int w = F.wave, lane = F.lane;
        if (F.tid < 256) {
            const unsigned ee = tokinfo[blk * 256 + F.tid].x; e1 = ee & 0xff; e2 = (ee >> 8) & 0xff;
            const unsigned long long lt = (1ull << lane) - 1ull;
#pragma unroll
            for (int e = 0; e < NEXP; ++e) { const unsigned long long m1 = __ballot(e1 == e), m2 = __ballot(e2 == e);
                if (e1 == e) r1 = __popcll(m1 & lt); if (e2 == e) r2 = __popcll(m1) + __popcll(m2 & lt);
                if (lane == 0) L[32 + w * 8 + e] = __popcll(m1) + __popcll(m2); }
        }
        __syncthreads();
        if (F.tid < 256) {
            int o1 = L[16 + e1] + L[8 + e1], o2 = L[16 + e2] + L[8 + e2];
            for (int ww = 0; ww < w; ++ww) { o1 += L[32 + ww * 8 + e1]; o2 += L[32 + ww * 8 + e2]; }
            const int s1 = o1 + r1, s2 = o2 + r2, tok = blk * 256 + F.tid;
            slot_tok[s1] = tok; slot_tok[s2] = tok; tokslot[2 * tok] = s1; tokslot[2 * tok + 1] = s2;
            { const float rs = rstd_of(F.SS + 3 * SS_STRIDE, tok); float* srs = (float*)(F.ws + RT_SLOTRS); srs[s1] = rs; srs[s2] = rs; }
        }
    }
    __syncthreads();
}
__device__ __forceinline__ int moe_tail(int nb) { const int t = nb - (nb / 64) * 64; return t > 8 ? 0 : t; }
__device__ __forceinline__ void phase_combine(Frame& F) {
    PHASE_ENTER(F);
    const u32x4* tokinfo = (const u32x4*)(F.ws + RT_TOKINFO); const int* tokslot = (const int*)(F.ws + RT_TOKSLOT);
    const int gw = F.bid * 8 + F.wave, NGW = F.G * 8, lane = F.lane;
    f32x4 gf[4];
#pragma unroll
    for (int j = 0; j < 4; ++j) gf[j] = *(const f32x4*)(in_ptr(F, I_FINALG) + 4 * lane + 256 * j);
    float* outp = (float*)lds_ptr(F.lds, 36);
    int T0; { const int nblk = *(const int*)(F.ws + RT_CNT + 32768); int nb = nblk - PASS0; if (nb > MAXBLK - PASS0) nb = MAXBLK - PASS0; if (nb < 0) nb = 0; const int nt_ = moe_tail(nb); T0 = nt_ > 0 ? (PASS0 + nb - nt_) * 256 : 0x7fffffff; }
    const bf16_t* YS2 = (const bf16_t*)(F.ws + WS_GC);
    int tokA = gw, tokB = gw + NGW;
    u32x4 tiA = tokinfo[tokA < NREAL ? tokA : 0], tiB = tokinfo[tokB < NREAL ? tokB : 0];
    u32x2 slA = *(const u32x2*)(tokslot + 2 * (tokA < NREAL ? tokA : 0)), slB = *(const u32x2*)(tokslot + 2 * (tokB < NREAL ? tokB : 0));
    for (; tokA < NREAL; tokA += 2 * NGW, tokB += 2 * NGW) {
        const int nA = tokA + 2 * NGW, nB = tokB + 2 * NGW;
        const u32x4 tinA = tokinfo[nA < NREAL ? nA : 0], tinB = tokinfo[nB < NREAL ? nB : 0];
        const u32x2 slnA = *(const u32x2*)(tokslot + 2 * (nA < NREAL ? nA : 0)), slnB = *(const u32x2*)(tokslot + 2 * (nB < NREAL ? nB : 0));
        const bool hasB = tokB < NREAL; const int tB = hasB ? tokB : tokA;
        const u32x2* hpA = (const u32x2*)(F.HB + (size_t)tokA * DM) + lane; const u32x2* y1A = (const u32x2*)(F.YS + (size_t)slA.x * DM) + lane; const u32x2* y2A = (const u32x2*)(F.YS + (size_t)slA.y * DM) + lane;
        const u32x2* hpB = (const u32x2*)(F.HB + (size_t)tB * DM) + lane; const u32x2* y1B = (const u32x2*)(F.YS + (size_t)(hasB ? slB.x : slA.x) * DM) + lane; const u32x2* y2B = (const u32x2*)(F.YS + (size_t)(hasB ? slB.y : slA.y) * DM) + lane;
        u32x2 hA[4], aA[4], bA[4], hB[4], aB[4], bB[4];
#pragma unroll
        for (int j = 0; j < 4; ++j) { hA[j] = hpA[64 * j]; aA[j] = y1A[64 * j]; bA[j] = y2A[64 * j]; hB[j] = hpB[64 * j]; aB[j] = y1B[64 * j]; bB[j] = y2B[64 * j]; }
#define CMB_FIX(SL, ARR) if ((int)(SL) >= T0) { const u32x2* yp = (const u32x2*)(YS2 + (size_t)((int)(SL) - T0) * DM) + lane; _Pragma("unroll") for (int j = 0; j < 4; ++j) { const u32x2 e = yp[64 * j]; \
            ARR[j].x = cvt_pk_bf16(bf_lo(ARR[j].x) + bf_lo(e.x), bf_hi(ARR[j].x) + bf_hi(e.x)); ARR[j].y = cvt_pk_bf16(bf_lo(ARR[j].y) + bf_lo(e.y), bf_hi(ARR[j].y) + bf_hi(e.y)); } }
        CMB_FIX(slA.x, aA) CMB_FIX(slA.y, bA) if (hasB) { CMB_FIX(slB.x, aB) CMB_FIX(slB.y, bB) }
#undef CMB_FIX
#define CMB_ONE(TOK, TI, H, A, B) do { const float g1 = __uint_as_float((TI).y), g2 = __uint_as_float((TI).z); f32x4 v[4]; float sq = 0.f; \
        _Pragma("unroll") for (int j = 0; j < 4; ++j) { \
            v[j][0] = bf_lo(H[j].x) + g1 * bf_lo(A[j].x) + g2 * bf_lo(B[j].x); v[j][1] = bf_hi(H[j].x) + g1 * bf_hi(A[j].x) + g2 * bf_hi(B[j].x); \
            v[j][2] = bf_lo(H[j].y) + g1 * bf_lo(A[j].y) + g2 * bf_lo(B[j].y); v[j][3] = bf_hi(H[j].y) + g1 * bf_hi(A[j].y) + g2 * bf_hi(B[j].y); \
            sq += (v[j][0] * v[j][0] + v[j][1] * v[j][1]) + (v[j][2] * v[j][2] + v[j][3] * v[j][3]); } \
        const float rs = __builtin_amdgcn_rsqf(wave_sum(sq) * (1.0f / DM) + RMS_EPS); \
        f32x4* op = (f32x4*)(outp + (size_t)(TOK) * DM) + lane; \
        _Pragma("unroll") for (int j = 0; j < 4; ++j) op[64 * j] = v[j] * rs * gf[j]; } while (0)
        CMB_ONE(tokA, tiA, hA, aA, bA);
        if (hasB) CMB_ONE(tokB, tiB, hB, aB, bB);
#undef CMB_ONE
        tiA = tinA; tiB = tinB; slA = slnA; slB = slnB;
    }
}

__device__ __forceinline__ SchedGrid grid_sched(Frame& F, int nN, int lda, int ldb, int rev = 0) { return SchedGrid{NREAL / 256, nN, F.G, F.bid, (size_t)256 * lda * 2, (size_t)256 * ldb * 2, rev}; }
__device__ __forceinline__ void phase_g1(Frame& F, int l) {
    PHASE_ENTER(F);
    const bf16_t* Wt = F.W + (size_t)l * WL_SIZE + WL_ABC; const float* ss = F.SS + (size_t)(2 * l) * SS_STRIDE; bf16_t* U = F.R1;
    meta_rstd_setup(F);
    for (int j = F.bid; j < NABC / 16; j += F.G) { const float v = meta_tile(F, F.HB + (size_t)MBASE * DM, DM, Wt, DM, DM, 16 * j);
        if (F.tid < 256) { const int row = MBASE + (F.tid >> 4); U[(size_t)row * NABC + 16 * j + (F.tid & 15)] = f2bf(v * META_RS(F, F.tid >> 4)); } }
    __syncthreads();
    pg8::gemm_phase<EpiScale, SchedGrid, false>(F.lds, F.wave, GemmD{F.HB, Wt, DM, DM, DM}, grid_sched(F, NABC / 256, DM, DM, 1), EpiScale{U, NABC, ss});
}
__device__ __forceinline__ void phase_g2(Frame& F, int l) {
    PHASE_ENTER(F);
    const bf16_t* Wt = F.W + (size_t)l * WL_SIZE + WL_G; const float* ss = F.SS + (size_t)(2 * l) * SS_STRIDE; const float* gb = in_ptr(F, I_GATEB) + l * NGATE;
    unsigned char* Z0 = (unsigned char*)lds_ptr(F.lds, 36); unsigned char* Z2 = (unsigned char*)F.R2; bf16_t* ZGM = (bf16_t*)(F.ws + WS_ZGM);
    if (l == 0) { meta_rstd_setup(F); for (int j = F.bid; j < NGATE / 16; j += F.G) { const float v = meta_tile(F, F.HB + (size_t)MBASE * DM, DM, Wt, DM, DM, 16 * j);
        if (F.tid < 256) { const int col = 16 * j + (F.tid & 15); ZGM[(size_t)(F.tid >> 4) * NGATE + col] = f2bf(fast_sigmoid(v * META_RS(F, F.tid >> 4) + gb[col])); } }
        __syncthreads(); }
    pg8::gemm_phase<EpiGate, SchedGrid, false>(F.lds, F.wave, GemmD{F.HB, Wt, DM, DM, DM}, grid_sched(F, NGATE / 256, DM, DM), EpiGate{Z0, Z2, ss, gb});
}
__device__ __forceinline__ void phase_g3(Frame& F, int l) {
    PHASE_ENTER(F);
    const bf16_t* Pt = F.W + (size_t)l * WL_SIZE + WL_P; const bf16_t* Y = F.R3; bf16_t* MB = F.R1;
    const unsigned char* Z2 = (const unsigned char*)F.R2; const bf16_t* ZGM = (const bf16_t*)(F.ws + WS_ZGM);
    if (l == 0) for (int j = F.bid; j < DM / 16; j += F.G) { float tot = 0.f;
        for (int br = 0; br < 3; ++br) { const float v = meta_tile(F, Y + (size_t)MBASE * NY + br * AW, NY, Pt + br * AW, NY, AW, 16 * j);
            if (F.tid < 256) tot += v * bf2f(ZGM[(size_t)(F.tid >> 4) * NGATE + br * DM + 16 * j + (F.tid & 15)]); }
        if (F.tid < 256) MB[(size_t)(MBASE + (F.tid >> 4)) * DM + 16 * j + (F.tid & 15)] = f2bf(tot); }
    pg8::gemm_phase<EpiMerge3, SchedGrid, false>(F.lds, F.wave, GemmD{Y, Pt, NY, NY, NY}, grid_sched(F, DM / 256, NY, NY, 1), EpiMerge3{MB, F.lds, Z2});
}
__device__ __forceinline__ void phase_resid(Frame& F, const bf16_t* Amat, int K, const bf16_t* Wt, float* ssn, bool do_meta) {
    PHASE_ENTER(F);
    if (do_meta) for (int j = F.bid; j < DM / 16; j += F.G) { const float v = meta_tile(F, Amat + (size_t)MBASE * K, K, Wt, K, K, 16 * j);
        if (F.tid < 256) { const int row = MBASE + (F.tid >> 4); bf16_t* hp = F.HB + (size_t)row * DM + 16 * j + (F.tid & 15); *hp = f2bf(bf2f(*hp) + v); } }
    pg8::gemm_phase<EpiResid, SchedGrid, false>(F.lds, F.wave, GemmD{Amat, Wt, K, K, K}, grid_sched(F, DM / 256, K, K, 0), EpiResid{F.HB, ssn, (LAS float*)(F.lds + 139264)});
}
__device__ __forceinline__ void phase_g5(Frame& F) {
    PHASE_ENTER(F);
    const bf16_t* Wt = F.W + WF_GU; const float* ss = F.SS + SS_STRIDE; bf16_t* HID = F.R1;
    meta_rstd_setup(F);
    for (int j = F.bid; j < DFF / 16; j += F.G) { const int c0 = 16 * j, br = 256 * (c0 / 128) + (c0 % 128);
        const float vg = meta_tile(F, F.HB + (size_t)MBASE * DM, DM, Wt, DM, DM, br), vu = meta_tile(F, F.HB + (size_t)MBASE * DM, DM, Wt, DM, DM, br + 128);
        if (F.tid < 256) { const int row = MBASE + (F.tid >> 4); const float rs = META_RS(F, F.tid >> 4), g = vg * rs, u = vu * rs; HID[(size_t)row * DFF + c0 + (F.tid & 15)] = f2bf(g * fast_sigmoid(g) * u); } }
    __syncthreads();
    pg8::gemm_phase<EpiSwiglu, SchedGrid, false>(F.lds, F.wave, GemmD{F.HB, Wt, DM, DM, DM}, grid_sched(F, NGU / 256, DM, DM, 1), EpiSwiglu{HID, ss, nullptr, 0});
}
__device__ __forceinline__ void moe_range(Frame& F, int pass, int& blk0, int& nb) {
    const int nblk = *(const int*)(F.ws + RT_CNT + 32768); blk0 = pass * PASS0; nb = nblk - blk0; if (nb > (pass == 0 ? PASS0 : MAXBLK - PASS0)) nb = (pass == 0 ? PASS0 : MAXBLK - PASS0); if (nb < 0) nb = 0;
}
__device__ __forceinline__ void phase_g5m(Frame& F, int pass) {
    int blk0, nb; moe_range(F, pass, blk0, nb);
    const int* block_e = (const int*)(F.ws + RT_CNT + 16384); const int* slot_tok = (const int*)(F.ws + RT_SLOTTOK);
    pg8::gemm_phase<EpiSwiglu, SchedMoe, true>(F.lds, F.wave, GemmD{F.HB, F.WE + WE_GU, DM, DM, DM},
        SchedMoe{blk0, nb, NGU / 256, F.G, F.bid, block_e, slot_tok, 0, (size_t)256 * DM * 2, (size_t)NGU * DM * 2, 0}, EpiSwiglu{F.R1, (const float*)(F.ws + RT_SLOTRS), slot_tok, blk0 * 256});
}
__device__ __forceinline__ void phase_g6m(Frame& F, int pass) {
    int blk0, nb; moe_range(F, pass, blk0, nb);
    const int* block_e = (const int*)(F.ws + RT_CNT + 16384); const int* slot_tok = (const int*)(F.ws + RT_SLOTTOK);
    const int nt_ = pass == 1 ? moe_tail(nb) : 0, nm = nb - nt_;
    pg8::gemm_phase<EpiStore, SchedMoe, false>(F.lds, F.wave, GemmD{F.R1, F.WE + WE_D, DFF, DFF, DFF},
        SchedMoe{blk0, nm, DM / 256, F.G, F.bid, block_e, slot_tok, (size_t)256 * DFF * 2, (size_t)256 * DFF * 2, (size_t)DM * DFF * 2, 1}, EpiStore{F.YS, DM});
    if (nt_ > 0)
        pg8::gemm_phase<EpiStoreK, SchedMoeK, false>(F.lds, F.wave, GemmD{F.R1, F.WE + WE_D, DFF, DFF, DFF / 2},
            SchedMoeK{blk0, blk0 + nm, nt_, F.G, F.bid, block_e, (size_t)256 * DFF * 2, (size_t)256 * DFF * 2, (size_t)DM * DFF * 2, (size_t)(DFF / 2) * 2}, EpiStoreK{F.YS, (bf16_t*)(F.ws + WS_GC), DM, (blk0 + nm) * 256});
}

#ifndef CK_MODE
#define CK_MODE 1
#endif
constexpr int N_PHASES = 24;
__global__ void __launch_bounds__(512, 2) fwd_kernel(Args args) {
    extern __shared__ __attribute__((aligned(16))) unsigned char lds[];
    Frame F;
    F.lds = (LAS unsigned char*)lds; F.tid = threadIdx.x; F.lane = F.tid & 63; F.wave = __builtin_amdgcn_readfirstlane(F.tid >> 6); F.G = gridDim.x; F.bid = blockIdx.x;
    volatile LAS unsigned* MISC = (volatile LAS unsigned*)(F.lds + LDSCTL_OFF);
    for (int u = F.tid; u < (LDS_BYTES - LDSCTL_OFF) / 4; u += 512) MISC[u] = 0u;
    __syncthreads();
    if (F.tid < 38) { const unsigned long long pv = F.tid < 36 ? (unsigned long long)args.in[F.tid] : (F.tid == 36 ? (unsigned long long)args.out : (unsigned long long)args.ws);
        *(LAS unsigned long long*)(F.lds + PTR_OFF + 8 * F.tid) = pv; }
    __syncthreads();
    frame_ptrs(F);
    const int lo = args.ph_lo, hi = args.ph_hi;
    XcdBarrier bar; bar.bar = (unsigned*)F.ws + CW_BAR + args.li * XCD_BAR_WORDS; bar.x = 0; bar.st = MISC + 8;
    if (hi - lo > 1) bar = xcd_barrier_post((unsigned*)F.ws + CW_BAR + args.li * XCD_BAR_WORDS, MISC + 8);
#ifdef ONLY_PH
#define PH(p) ((p) == ONLY_PH || ((p) - 9) == ONLY_PH)
#else
#define PH(p) (lo <= (p) && (p) < hi)
#endif
#ifndef REP_MASK
#define REP_MASK 0ull
#endif
#define REPS(p) ((REP_MASK >> (p)) & 1ull)
#define SEAM(p) do { if (PH(p) && PH((p) + 1)) { XcdBarrier b2_ = bar; asm volatile("" : "+s"(b2_.bar)); xcd_barrier(b2_, F.wave); } } while (0)
    if (PH(0)) { convert_common(F); x_to_hb(F); if (REPS(0)) { convert_common(F); x_to_hb(F); } } SEAM(0);
    for (int l = 0; l < 2; ++l) {
        const int pb = 1 + 9 * l;
        if (PH(pb + 0)) { phase_g1(F, l); if (REPS(pb + 0)) phase_g1(F, l); } SEAM(pb + 0);
        if (PH(pb + 1)) { phase_prep(F, l); { XcdBarrier b2_ = bar; asm volatile("" : "+s"(b2_.bar)); xcd_barrier(b2_, F.wave); } phase_prep2(F, l); } SEAM(pb + 1);
        if (PH(pb + 2)) { if (CK_MODE != 1) phase_scan(F, l); if (CK_MODE != 0) phase_scan_chunked(F, l); } SEAM(pb + 2);
        if (PH(pb + 3)) { phase_postbc(F, l); phase_g2(F, l); } SEAM(pb + 4);
        if (PH(pb + 5)) { phase_g3(F, l); if (REPS(pb + 5)) phase_g3(F, l); } SEAM(pb + 5);
        if (PH(pb + 6)) phase_resid(F, F.R1, DM, F.W + (size_t)l * WL_SIZE + WL_OUT, F.SS + (size_t)(2 * l + 1) * SS_STRIDE, l == 0); SEAM(pb + 6);
        if (l == 0) {
            if (PH(8)) { phase_g5(F); if (REPS(8)) phase_g5(F); } SEAM(8);
            if (PH(9)) phase_resid(F, F.R1, DFF, F.W + WF_D, F.SS + 2 * SS_STRIDE, true); SEAM(9);
        }
    }
    if (PH(17)) { convert_experts(F); phase_router(F); if (REPS(17)) { convert_experts(F); phase_router(F); } } SEAM(17);
    if (PH(18)) { phase_assign(F); if (REPS(18)) phase_assign(F); } SEAM(18);
    for (int pass = 0; pass < 2; ++pass) {
        if (PH(19 + 2 * pass)) { phase_g5m(F, pass); if (REPS(19 + 2 * pass)) phase_g5m(F, pass); } SEAM(19 + 2 * pass);
        if (PH(20 + 2 * pass)) { phase_g6m(F, pass); if (REPS(20 + 2 * pass)) phase_g6m(F, pass); } SEAM(20 + 2 * pass);
    }
    if (PH(23)) { phase_combine(F); if (REPS(23)) phase_combine(F); }
#undef PH
#undef SEAM
}

#ifndef MK_N_LAUNCHES
#define MK_N_LAUNCHES 1
#endif
extern "C" void kernel_launch(void* const* d_in, const int* in_sizes, int n_in, void* d_out, int out_size, void* d_ws, size_t ws_size, hipStream_t stream) {
    static int grid = 0;
    if (grid == 0) {
        if (n_in != 36 || in_sizes[0] != NREAL * DM || out_size != NREAL * DM || ws_size < WS_END) {
            fprintf(stderr, "kernel_launch: unexpected problem (n_in %d, in0 %d, out %d, ws %zu; need ws >= %zu); nothing launched\n", n_in, n_in > 0 ? in_sizes[0] : -1, out_size, ws_size, (size_t)WS_END); grid = -1; return; }
        int dev = 0, cus = 0, per_cu = 0;
        if (hipGetDevice(&dev) != hipSuccess || hipDeviceGetAttribute(&cus, hipDeviceAttributeMultiprocessorCount, dev) != hipSuccess) { grid = -1; return; }
        if (hipFuncSetAttribute((const void*)fwd_kernel, hipFuncAttributeMaxDynamicSharedMemorySize, LDS_BYTES) != hipSuccess) { fprintf(stderr, "kernel_launch: hipFuncSetAttribute failed\n"); grid = -1; return; }
        if (hipOccupancyMaxActiveBlocksPerMultiprocessor(&per_cu, (const void*)fwd_kernel, 512, LDS_BYTES) != hipSuccess || per_cu < 1) { fprintf(stderr, "kernel_launch: occupancy query says %d blocks per CU\n", per_cu); (void)hipGetLastError(); grid = -1; return; }
        grid = cus;
    }
    if (grid < 0) return;
    if (hipMemsetAsync((char*)d_ws + WS_CTL, 0, CTL_ZERO_BYTES, stream) != hipSuccess) return;
    Args a{};
    for (int i = 0; i < 36; ++i) a.in[i] = (const float*)d_in[i];
    a.out = (float*)d_out; a.ws = (unsigned char*)d_ws;
    if (MK_N_LAUNCHES == 1) { a.ph_lo = 0; a.ph_hi = N_PHASES; a.li = 0; hipLaunchKernelGGL(fwd_kernel, dim3(grid), dim3(512), LDS_BYTES, stream, a); }
    else for (int p = 0; p < N_PHASES; ++p) { a.ph_lo = p; a.ph_hi = p + 1; a.li = 0; hipLaunchKernelGGL(fwd_kernel, dim3(grid), dim3(512), LDS_BYTES, stream, a); }
}
```
